# Optimizing an MI355X kernel written in HIP

```python
import jax, jax.numpy as jnp
from jax import lax
import numpy as np

D_MODEL = 1024
BATCH = 16
SEQ = 4096
DEPTH = 4

GRID_W = 64
CTX_LEN = 256
HEAD_DIM = 64
N_Q_HEADS = 8
N_KV_HEADS = 2
Q_PER_KV = N_Q_HEADS // N_KV_HEADS
ATTN_WIDTH = N_Q_HEADS * HEAD_DIM
KV_WIDTH = N_KV_HEADS * HEAD_DIM
CONV_WIDTH = D_MODEL - ATTN_WIDTH
WINDOW = 128
BLOCK = 128
ROPE_THETA = 10000.0
N_FOURIER_GROUPS = 4
FOURIER_GROUP = D_MODEL // N_FOURIER_GROUPS
D_FF = -(-(-(-8 * D_MODEL // 3)) // 256) * 256
N_EVEN = (DEPTH + 1) // 2
N_ODD = DEPTH // 2
B_START = 0
C_START = CONV_WIDTH
H_START = 2 * CONV_WIDTH
Q_START = 3 * CONV_WIDTH
K_START = Q_START + ATTN_WIDTH
V_START = K_START + KV_WIDTH
IN_WIDTH = V_START + KV_WIDTH
EPS = 1e-6

kernel_name = "hybrid_conv_swa_fourier_dit_block"


def rmsnorm(x, g):
    xf = x.astype(jnp.float32)
    y = xf * lax.rsqrt(jnp.mean(xf * xf, axis=-1, keepdims=True) + EPS)
    return (y * g.astype(jnp.float32)).astype(x.dtype)


def modulate(h, shift, scale):
    return h * (1 + scale) + shift


def adaln(cond, w, bias):
    return jax.nn.silu(cond) @ w + bias


def swiglu(h, wg, wu, wd):
    return (jax.nn.silu(h @ wg) * (h @ wu)) @ wd


def axial_rope_tables(n, dtype):
    rows = n // GRID_W
    r = jnp.repeat(jnp.arange(rows), GRID_W).astype(jnp.float32)
    col = jnp.tile(jnp.arange(GRID_W), rows).astype(jnp.float32)
    quarter = HEAD_DIM // 4
    inv = ROPE_THETA ** (-jnp.arange(quarter, dtype=jnp.float32) / quarter)
    ang_r = (r[:, None] * inv)[:, None, :]
    ang_c = (col[:, None] * inv)[:, None, :]
    return (jnp.cos(ang_r).astype(dtype), jnp.sin(ang_r).astype(dtype),
            jnp.cos(ang_c).astype(dtype), jnp.sin(ang_c).astype(dtype))


def _rope_half(x, cos, sin):
    h = x.shape[-1] // 2
    x1, x2 = x[..., :h], x[..., h:]
    return jnp.concatenate([x1 * cos - x2 * sin, x2 * cos + x1 * sin], axis=-1)


def apply_axial_rope(x, tabs):
    cr, sr, cc, sc = tabs
    half = HEAD_DIM // 2
    return jnp.concatenate([_rope_half(x[..., :half], cr, sr),
                            _rope_half(x[..., half:], cc, sc)], axis=-1)


def short_conv(u, w):
    n = u.shape[1]
    up = jnp.pad(u, ((0, 0), (1, 1), (0, 0)))
    return up[:, :n] * w[0] + up[:, 1:n + 1] * w[1] + up[:, 2:] * w[2]


def gated_conv(p, conv_w):
    bg = p[..., B_START:C_START]
    cg = p[..., C_START:H_START]
    hv = p[..., H_START:Q_START]
    return bg * short_conv(cg * hv, conv_w)


def window_attention(q, k, v, kc, vc, sink):
    b, n = q.shape[:2]
    nb = n // BLOCK
    scale = HEAD_DIM ** -0.5
    qb = q.reshape(b, nb, BLOCK, N_KV_HEADS, Q_PER_KV, HEAD_DIM)

    def band(t):
        tp = jnp.pad(t, ((0, 0), (BLOCK, BLOCK), (0, 0), (0, 0)))
        tp = tp.reshape(b, nb + 2, BLOCK, N_KV_HEADS, HEAD_DIM)
        return jnp.concatenate([tp[:, :-2], tp[:, 1:-1], tp[:, 2:]], axis=2)

    kb, vb = band(k), band(v)
    qpos = jnp.arange(n).reshape(nb, BLOCK)
    kpos = jnp.arange(nb)[:, None] * BLOCK - BLOCK + jnp.arange(3 * BLOCK)[None, :]
    dist = qpos[:, :, None] - kpos[:, None, :]
    valid = (jnp.abs(dist) <= WINDOW) & (kpos[:, None, :] >= 0) & (kpos[:, None, :] < n)
    s_loc = jnp.einsum('bnqhgd,bnkhd->bnhgqk', qb, kb).astype(jnp.float32) * scale
    s_loc = jnp.where(valid[None, :, None, None], s_loc, -jnp.inf)
    s_ctx = jnp.einsum('bnqhgd,bchd->bnhgqc', qb, kc).astype(jnp.float32) * scale
    s_sink = jnp.broadcast_to(sink.astype(jnp.float32).reshape(N_KV_HEADS, Q_PER_KV)[None, None, :, :, None, None],
                              s_loc.shape[:-1] + (1,))
    probs = jax.nn.softmax(jnp.concatenate([s_loc, s_ctx, s_sink], axis=-1), axis=-1).astype(v.dtype)
    n_loc = 3 * BLOCK
    n_ctx = kc.shape[1]
    out = (jnp.einsum('bnhgqk,bnkhd->bnqhgd', probs[..., :n_loc], vb)
           + jnp.einsum('bnhgqc,bchd->bnqhgd', probs[..., n_loc:n_loc + n_ctx], vc))
    return out.reshape(b, n, ATTN_WIDTH)


def context_attention(q, k, v, sink):
    b, L = q.shape[:2]
    scale = HEAD_DIM ** -0.5
    qg = q.reshape(b, L, N_KV_HEADS, Q_PER_KV, HEAD_DIM)
    s = jnp.einsum('blhgd,bchd->bhglc', qg, k).astype(jnp.float32) * scale
    s_sink = jnp.broadcast_to(sink.astype(jnp.float32).reshape(N_KV_HEADS, Q_PER_KV)[None, :, :, None, None],
                              s.shape[:-1] + (1,))
    probs = jax.nn.softmax(jnp.concatenate([s, s_sink], axis=-1), axis=-1).astype(v.dtype)
    out = jnp.einsum('bhglc,bchd->blhgd', probs[..., :-1], v)
    return out.reshape(b, L, ATTN_WIDTH)


def fourier_mix(h):
    b, n, _ = h.shape
    hg = h.astype(jnp.float32).reshape(b, n, N_FOURIER_GROUPS, FOURIER_GROUP)
    f = jnp.fft.fft2(hg, axes=(1, 3), norm='ortho').real
    return f.reshape(b, n, D_MODEL).astype(h.dtype)


def setup_inputs(seed: int = 0) -> dict:
    key = jax.random.key(seed)
    ks = jax.random.split(key, 20)
    f32 = jnp.float32
    d = D_MODEL
    return {
        'x': jax.random.normal(ks[0], (BATCH, SEQ, d), f32),
        'c': jax.random.normal(ks[1], (BATCH, d), f32),
        'ctx': jax.random.normal(ks[2], (BATCH, CTX_LEN, d), f32),
        'c_ctx': jax.random.normal(ks[3], (d,), f32),
        'w_ada': jax.random.normal(ks[4], (DEPTH, d, 6 * d), f32) * (0.5 * d ** -0.5),
        'b_ada': jax.random.normal(ks[5], (DEPTH, 6 * d), f32) * 0.01,
        'norm1_g': 1.0 + 0.01 * jax.random.normal(ks[6], (DEPTH, d), f32),
        'norm2_g': 1.0 + 0.01 * jax.random.normal(ks[7], (DEPTH, d), f32),
        'w_in': jax.random.normal(ks[8], (N_EVEN, d, IN_WIDTH), f32) * d ** -0.5,
        'conv_w': jax.random.normal(ks[9], (N_EVEN, 3, CONV_WIDTH), f32) * 3 ** -0.5,
        'sink': jax.random.normal(ks[10], (N_EVEN, N_Q_HEADS), f32),
        'w_mix_out': jax.random.normal(ks[11], (N_EVEN, CONV_WIDTH + ATTN_WIDTH, d), f32) * (CONV_WIDTH + ATTN_WIDTH) ** -0.5,
        'w_fourier_out': jax.random.normal(ks[12], (N_ODD, d, d), f32) * d ** -0.5,
        'w_ffn_gate': jax.random.normal(ks[13], (DEPTH, d, D_FF), f32) * d ** -0.5,
        'w_ffn_up': jax.random.normal(ks[14], (DEPTH, d, D_FF), f32) * d ** -0.5,
        'w_ffn_down': jax.random.normal(ks[15], (DEPTH, D_FF, d), f32) * D_FF ** -0.5,
        'final_g': 1.0 + 0.01 * jax.random.normal(ks[16], (d,), f32),
    }


def reference(x, c, ctx, c_ctx, w_ada, b_ada, norm1_g, norm2_g, w_in, conv_w, sink,
              w_mix_out, w_fourier_out, w_ffn_gate, w_ffn_up, w_ffn_down, final_g):
    b, n, _ = x.shape
    L = ctx.shape[1]
    rope_tabs = axial_rope_tables(n, x.dtype)
    xc = ctx
    for l in range(DEPTH):
        ctx_after = any(j % 2 == 0 for j in range(l + 1, DEPTH))
        ctx_here = (l % 2 == 0) or ctx_after
        sh1, sc1, g1, sh2, sc2, g2 = jnp.split(adaln(c, w_ada[l], b_ada[l])[:, None, :], 6, axis=-1)
        h = modulate(rmsnorm(x, norm1_g[l]), sh1, sc1)
        if ctx_here:
            csh1, csc1, cg1, csh2, csc2, cg2 = jnp.split(adaln(c_ctx, w_ada[l], b_ada[l]), 6, axis=-1)
            hc = modulate(rmsnorm(xc, norm1_g[l]), csh1, csc1)
        if l % 2 == 0:
            e = l // 2
            if ctx_after:
                pc = hc @ w_in[e]
                kvc = pc[..., K_START:]
            else:
                kvc = hc @ w_in[e][:, K_START:]
            kc = kvc[..., :KV_WIDTH].reshape(b, L, N_KV_HEADS, HEAD_DIM)
            vc = kvc[..., KV_WIDTH:].reshape(b, L, N_KV_HEADS, HEAD_DIM)
            p = h @ w_in[e]
            a_out = gated_conv(p, conv_w[e])
            q = apply_axial_rope(p[..., Q_START:K_START].reshape(b, n, N_Q_HEADS, HEAD_DIM), rope_tabs)
            k = apply_axial_rope(p[..., K_START:V_START].reshape(b, n, N_KV_HEADS, HEAD_DIM), rope_tabs)
            v = p[..., V_START:].reshape(b, n, N_KV_HEADS, HEAD_DIM)
            b_out = window_attention(q, k, v, kc, vc, sink[e])
            x = x + g1 * (jnp.concatenate([a_out, b_out], axis=-1) @ w_mix_out[e])
            if ctx_after:
                a_c = gated_conv(pc, conv_w[e])
                qc = pc[..., Q_START:K_START].reshape(b, L, N_Q_HEADS, HEAD_DIM)
                b_c = context_attention(qc, kc, vc, sink[e])
                xc = xc + cg1 * (jnp.concatenate([a_c, b_c], axis=-1) @ w_mix_out[e])
        else:
            o = l // 2
            x = x + g1 * (fourier_mix(h) @ w_fourier_out[o])
            if ctx_after:
                xc = xc + cg1 * (fourier_mix(hc) @ w_fourier_out[o])
        h2 = modulate(rmsnorm(x, norm2_g[l]), sh2, sc2)
        x = x + g2 * swiglu(h2, w_ffn_gate[l], w_ffn_up[l], w_ffn_down[l])
        if ctx_after:
            hc2 = modulate(rmsnorm(xc, norm2_g[l]), csh2, csc2)
            xc = xc + cg2 * swiglu(hc2, w_ffn_gate[l], w_ffn_up[l], w_ffn_down[l])
    return rmsnorm(x, final_g)
```

```cpp
#include <hip/hip_runtime.h>
#include <hip/hip_cooperative_groups.h>
#include <cstdio>
#include <cstdint>
#include <cmath>
namespace cg = cooperative_groups;

namespace pg8 {
#define PG8_LAS __attribute__((address_space(3)))
typedef unsigned short bf16_t;
typedef short bf16x8 __attribute__((ext_vector_type(8)));
typedef float f32x4 __attribute__((ext_vector_type(4)));
typedef unsigned u32x4 __attribute__((ext_vector_type(4)));
constexpr int BM = 256, BK = 64, HALF = 128, HTB = HALF * BK * 2  , STAGE_BYTES = 8 * HTB, NXCD = 8, WGM = 8;

__host__ __device__ __forceinline__ int lds_byte(int r, int c) { const int st = (r >> 4) * 2 + (c >> 5), rr = r & 15, cc = c & 31, ob = rr * 64 + cc * 2; return st * 1024 + (ob ^ (((ob >> 9) & 1) << 5)); }
__host__ __device__ __forceinline__ void stage_rc(int b, int& R, int& C) { const int st = b / 1024, sb = b % 1024, swz = sb ^ (((sb >> 9) & 1) << 5); R = (st >> 1) * 16 + swz / 64; C = (st & 1) * 32 + (swz % 64) / 2; }
__host__ __device__ __forceinline__ int perm32(int rho) { const int n = rho >> 4, i = rho & 15; return 8 * (i >> 2) + 4 * n + (i & 3); }

struct Unit { int pm, pn; };
struct Gemm { const bf16_t* A; const bf16_t* Bt; int M, N, K; };

struct StaticOrder {
    int nM, nN, nwg, G, c;
    __host__ __device__ void init(int M, int N, int G_, int c_) { nM = M / BM; nN = N / BM; nwg = nM * nN; G = G_; c = c_; }
    __host__ __device__ bool next(int i, Unit& u) const {
        const long L = (long)i * G + c; if (L >= nwg) return false;
        int wgid = (int)L; { const int q = nwg / NXCD, r = nwg % NXCD, xcd = wgid % NXCD, off = wgid / NXCD; wgid = (xcd < r ? xcd * (q + 1) : r * (q + 1) + (xcd - r) * q) + off; }
        const int nig = WGM * nN, gid = wgid / nig, fm = gid * WGM, gsz = (nM - fm) < WGM ? (nM - fm) : WGM;
        u.pm = fm + ((wgid % nig) % gsz); u.pn = (wgid % nig) / gsz; return true;
    }
    __device__ __forceinline__ void a_ready(const Unit&) const {}
    __device__ __forceinline__ void done(const Unit&) const {}
};

template <class Epi, class Sched, bool ALIGN_EPI = false, bool SP2 = false>
__device__ __forceinline__ void gemm_phase(PG8_LAS unsigned char* lds, const Gemm g, const Sched& S, const Epi& E, int tid_in) {
    const int tid = tid_in, wid = __builtin_amdgcn_readfirstlane(tid >> 6), lane = tid & 63, wr = wid >> 2, wc = wid & 3, fr = lane & 15, fq = lane >> 4;
    const int K = g.K, nt = K / BK;
    unsigned voffA[2], voffB[2];
#pragma unroll
    for (int i = 0; i < 2; ++i) { int R, C; stage_rc(tid * 16 + i * 8192, R, C); const int Rb = Epi::PERM ? ((R & ~31) + perm32(R & 31)) : R;
        voffA[i] = (unsigned)(R * K + C) * 2u; voffB[i] = (unsigned)(Rb * K + C) * 2u; }
    const size_t kstep = (size_t)(BK * 2);
    const size_t hstep = (size_t)HALF * K * 2;
    const size_t tstep = 2 * hstep;
    const unsigned ldsw = (unsigned)wid * 1024u;
    const int aoff = lds_byte(wr * 64 + fr, fq * 8), boff = lds_byte(wc * 32 + fr, fq * 8);
#define PG8_SA(b, h) (((b) * 2 + (h)) * HTB)
#define PG8_SB(b, h) ((4 + (b) * 2 + (h)) * HTB)
#define PG8_STAGE(bufoff, gbase, voff) do { _Pragma("unroll") for (int _i = 0; _i < 2; ++_i) \
        __builtin_amdgcn_global_load_lds((const unsigned*)((const char*)(gbase) + (voff)[_i]), (PG8_LAS unsigned*)(lds + (bufoff) + ldsw + _i * 8192), 16, 0, 0); } while (0)
#define PG8_LDA(dst, b, h) do { _Pragma("unroll") for (int m = 0; m < 4; ++m) _Pragma("unroll") for (int k = 0; k < 2; ++k) dst[m][k] = *(const PG8_LAS bf16x8*)(lds + PG8_SA(b, h) + aoff + m * 2048 + k * 1024); } while (0)
#define PG8_LDB(dst, b, h) do { _Pragma("unroll") for (int n = 0; n < 2; ++n) _Pragma("unroll") for (int k = 0; k < 2; ++k) dst[n][k] = *(const PG8_LAS bf16x8*)(lds + PG8_SB(b, h) + boff + n * 2048 + k * 1024); } while (0)
#define PG8_MMA(ai, bj, At, Bt) do { __builtin_amdgcn_s_setprio(1); _Pragma("unroll") for (int m = 0; m < 4; ++m) _Pragma("unroll") for (int n = 0; n < 2; ++n) _Pragma("unroll") for (int k = 0; k < 2; ++k) \
        acc[ai][bj][m][n] = __builtin_amdgcn_mfma_f32_16x16x32_bf16(Bt[n][k], At[m][k], acc[ai][bj][m][n], 0, 0, 0); __builtin_amdgcn_s_setprio(0); } while (0)
#define PG8_WAIT_V(n) asm volatile("s_waitcnt vmcnt(" #n ")" ::: "memory")
#define PG8_WAIT_L(n) asm volatile("s_waitcnt lgkmcnt(" #n ")" ::: "memory")
#define PG8_BAR __builtin_amdgcn_s_barrier()
#define PG8_SCHED __builtin_amdgcn_sched_barrier(0)
    Unit cur, nxt; int ui = 0;
    if (!S.next(0, cur)) return;
    f32x4 acc[2][2][4][2];
#pragma unroll
    for (int a = 0; a < 2; ++a)
#pragma unroll
        for (int b = 0; b < 2; ++b)
#pragma unroll
            for (int m = 0; m < 4; ++m)
#pragma unroll
                for (int n = 0; n < 2; ++n) acc[a][b][m][n] = (f32x4){0.f, 0.f, 0.f, 0.f};
    bf16x8 At[4][2], B0[2][2], B1[2][2];
    const char* cA = (const char*)g.A + (size_t)cur.pm * tstep; const char* cB = (const char*)g.Bt + (size_t)cur.pn * tstep;
    S.a_ready(cur);
    if constexpr (SP2) {
        PG8_STAGE(PG8_SB(0, 0), cB, voffB); PG8_STAGE(PG8_SB(0, 1), cB + hstep, voffB); PG8_STAGE(PG8_SA(0, 0), cA, voffA); PG8_STAGE(PG8_SA(0, 1), cA + hstep, voffA);
        if (wr == 1) PG8_BAR;
        PG8_WAIT_V(2); PG8_BAR;
        PG8_STAGE(PG8_SB(1, 0), cB + kstep, voffB); PG8_STAGE(PG8_SA(1, 0), cA + kstep, voffA); PG8_STAGE(PG8_SB(1, 1), cB + hstep + kstep, voffB);
        PG8_WAIT_V(6); PG8_BAR;
    } else {
        PG8_STAGE(PG8_SB(0, 0), cB, voffB); PG8_STAGE(PG8_SA(0, 0), cA, voffA); PG8_STAGE(PG8_SB(0, 1), cB + hstep, voffB); PG8_STAGE(PG8_SA(0, 1), cA + hstep, voffA);
        if (wr == 1) PG8_BAR;
        PG8_WAIT_V(4); PG8_BAR;
        PG8_STAGE(PG8_SB(1, 0), cB + kstep, voffB); PG8_STAGE(PG8_SA(1, 0), cA + kstep, voffA); PG8_STAGE(PG8_SB(1, 1), cB + hstep + kstep, voffB);
        PG8_WAIT_V(6); PG8_BAR;
    }
    for (;;) {
        const bool has_next = S.next(ui + 1, nxt);
        const char* nA = has_next ? (const char*)g.A + (size_t)nxt.pm * tstep : cA; const char* nB = has_next ? (const char*)g.Bt + (size_t)nxt.pn * tstep : cB;
        for (int t = 0; t < nt; t += 2) {
            const bool last = (t == nt - 2);
            const char* a1 = cA + (size_t)(t + 1) * kstep;
            const char* a2 = last ? nA : cA + (size_t)(t + 2) * kstep; const char* b2 = last ? nB : cB + (size_t)(t + 2) * kstep;
            const char* a3 = a2 + kstep; const char* b3 = b2 + kstep;
            if (last && has_next) S.a_ready(nxt);
            if constexpr (SP2) {
            PG8_LDB(B0, 0, 0); PG8_LDB(B1, 0, 1); PG8_SCHED; PG8_LDA(At, 0, 0); PG8_STAGE(PG8_SA(1, 1), a1 + hstep, voffA);
            PG8_WAIT_V(8); PG8_WAIT_L(0); PG8_BAR; PG8_MMA(0, 0, At, B0); PG8_MMA(0, 1, At, B1); PG8_BAR; PG8_SCHED;
            PG8_LDA(At, 0, 1); PG8_STAGE(PG8_SB(0, 0), b2, voffB); PG8_STAGE(PG8_SB(0, 1), b2 + hstep, voffB); PG8_STAGE(PG8_SA(0, 0), a2, voffA);
            PG8_WAIT_V(8); PG8_WAIT_L(0); PG8_BAR; PG8_MMA(1, 0, At, B0); PG8_MMA(1, 1, At, B1); PG8_BAR; PG8_SCHED;
            PG8_LDB(B0, 1, 0); PG8_LDB(B1, 1, 1); PG8_SCHED; PG8_LDA(At, 1, 0); PG8_STAGE(PG8_SA(0, 1), a2 + hstep, voffA);
            PG8_WAIT_V(8); PG8_WAIT_L(0); PG8_BAR; PG8_MMA(0, 0, At, B0); PG8_MMA(0, 1, At, B1); PG8_BAR; PG8_SCHED;
            PG8_LDA(At, 1, 1); PG8_STAGE(PG8_SB(1, 0), b3, voffB); PG8_STAGE(PG8_SB(1, 1), b3 + hstep, voffB); PG8_STAGE(PG8_SA(1, 0), a3, voffA);
            PG8_WAIT_V(8); PG8_WAIT_L(0); PG8_BAR; PG8_MMA(1, 0, At, B0); PG8_MMA(1, 1, At, B1); PG8_BAR; PG8_SCHED;
            } else {
            PG8_LDB(B0, 0, 0); PG8_SCHED; PG8_LDA(At, 0, 0); PG8_STAGE(PG8_SA(1, 1), a1 + hstep, voffA);
            PG8_WAIT_L(8); PG8_BAR; PG8_WAIT_L(0); PG8_MMA(0, 0, At, B0); PG8_BAR; PG8_SCHED;
            PG8_LDB(B1, 0, 1); PG8_STAGE(PG8_SB(0, 0), b2, voffB);
            PG8_BAR; PG8_WAIT_L(0); PG8_MMA(0, 1, At, B1); PG8_BAR;
            PG8_LDA(At, 0, 1); PG8_STAGE(PG8_SA(0, 0), a2, voffA);
            PG8_BAR; PG8_WAIT_L(0); PG8_MMA(1, 0, At, B0); PG8_BAR; PG8_SCHED;
            PG8_STAGE(PG8_SB(0, 1), b2 + hstep, voffB);
            PG8_WAIT_V(6); PG8_BAR; PG8_MMA(1, 1, At, B1); PG8_BAR;
            PG8_LDB(B0, 1, 0); PG8_SCHED; PG8_LDA(At, 1, 0); PG8_STAGE(PG8_SA(0, 1), a2 + hstep, voffA);
            PG8_WAIT_L(8); PG8_BAR; PG8_WAIT_L(0); PG8_MMA(0, 0, At, B0); PG8_BAR; PG8_SCHED;
            PG8_LDB(B1, 1, 1); PG8_STAGE(PG8_SB(1, 0), b3, voffB);
            PG8_BAR; PG8_WAIT_L(0); PG8_MMA(0, 1, At, B1); PG8_BAR;
            PG8_LDA(At, 1, 1); PG8_STAGE(PG8_SA(1, 0), a3, voffA);
            PG8_BAR; PG8_WAIT_L(0); PG8_MMA(1, 0, At, B0); PG8_BAR; PG8_SCHED;
            PG8_STAGE(PG8_SB(1, 1), b3 + hstep, voffB);
            PG8_WAIT_V(6); PG8_BAR; PG8_MMA(1, 1, At, B1); PG8_BAR;
            }
        }
        if constexpr (ALIGN_EPI) { if (wr == 0) PG8_BAR; }
        if constexpr (!Epi::AFTER_DRAIN) { E(acc, cur, wr, wc, fr, fq); S.done(cur); }
        if (!has_next) break;
#pragma unroll
        for (int a = 0; a < 2; ++a)
#pragma unroll
            for (int b = 0; b < 2; ++b)
#pragma unroll
                for (int m = 0; m < 4; ++m)
#pragma unroll
                    for (int n = 0; n < 2; ++n) acc[a][b][m][n] = (f32x4){0.f, 0.f, 0.f, 0.f};
        cur = nxt; cA = nA; cB = nB; ++ui;
        if constexpr (ALIGN_EPI) { if (wr == 1) PG8_BAR; }
    }
    PG8_WAIT_V(0);
    if constexpr (!ALIGN_EPI) { if (wr == 0) PG8_BAR; }
    PG8_BAR;
    if constexpr (Epi::AFTER_DRAIN) { E.fused(acc, cur, wr, wc, fr, fq, lds, wid, lane); S.done(cur); }
#undef PG8_SA
#undef PG8_SB
#undef PG8_STAGE
#undef PG8_LDA
#undef PG8_LDB
#undef PG8_MMA
#undef PG8_WAIT_V
#undef PG8_WAIT_L
#undef PG8_BAR
#undef PG8_SCHED
}
}

#define LAS __attribute__((address_space(3)))
typedef unsigned short bf16_t;
typedef short bf16x8 __attribute__((ext_vector_type(8)));
typedef float f32x4 __attribute__((ext_vector_type(4)));
typedef float f32x16 __attribute__((ext_vector_type(16)));
typedef unsigned u32x4 __attribute__((ext_vector_type(4)));
typedef unsigned u32x2 __attribute__((ext_vector_type(2)));

constexpr int DM = 1024, NBATCH = 16, SEQ = 4096, TLAT = NBATCH * SEQ, LCTX = 256, TCTX = NBATCH * LCTX, MALL = TLAT + TCTX;
constexpr int DFF = 2816, INW = 2304, NWAVES = 8, NTHR = 512;
constexpr int QS = 1536, KS_ = 2048, VS_ = 2176;
constexpr float C2 = 0.125f * 1.4426950408889634f, LOG2E = 1.4426950408889634f;
constexpr size_t MiB = 1u << 20;
constexpr size_t WS_MOD = 1 * MiB, WS_TAB = 3 * MiB, WS_WIN = 4 * MiB, WS_WMIX = 13 * MiB, WS_WF = 17 * MiB, WS_WGU = 21 * MiB, WS_WD = 65 * MiB;
constexpr size_t WS_XC = 88 * MiB, WS_H = 104 * MiB, WS_R = 240 * MiB;
constexpr size_t WS_P = WS_R, WS_CAT = WS_R + 306 * MiB, WS_ACT = WS_R, WS_Z1 = WS_R, WS_ZC = WS_R + 256 * MiB, WS_A1 = WS_R + 272 * MiB, WS_FM = WS_R, WS_END = 1024 * MiB;
constexpr size_t TAB_ROPE = 0, TAB_TW = 64 * 1024, TAB_D1 = 128 * 1024, TAB_D2 = 192 * 1024, TAB_DC = 256 * 1024, TAB_DCTX = 512 * 1024;
constexpr int LDS_BYTES = 147456;

typedef float f32x2_t __attribute__((ext_vector_type(2))); typedef __bf16 bf16x2_t __attribute__((ext_vector_type(2)));
__device__ __forceinline__ unsigned cvt_pk(float lo, float hi) { f32x2_t v = {lo, hi}; bf16x2_t b = __builtin_convertvector(v, bf16x2_t); return __builtin_bit_cast(unsigned, b); }
__device__ __forceinline__ float bf_lo(unsigned w) { return __builtin_bit_cast(float, w << 16); }
__device__ __forceinline__ float bf_hi(unsigned w) { return __builtin_bit_cast(float, w & 0xffff0000u); }
__device__ __forceinline__ float fast_exp2(float x) { return __builtin_amdgcn_exp2f(x); }
__device__ __forceinline__ float fast_rcp(float x) { return __builtin_amdgcn_rcpf(x); }
__device__ __forceinline__ float silu_f(float x) { return x * fast_rcp(1.0f + fast_exp2(-x * LOG2E)); }
#define LDS_WAIT() asm volatile("s_waitcnt lgkmcnt(0)" ::: "memory")

struct Args {
    const float* x; const float* c; const float* ctx; const float* c_ctx; const float* w_ada; const float* b_ada; const float* n1g; const float* n2g;
    const float* w_in; const float* conv_w; const float* sink; const float* w_mix; const float* w_four; const float* w_gate; const float* w_up; const float* w_down; const float* final_g;
    float* out; unsigned char* ws;
    double invf[16];
};

struct EpiInProj {
    static constexpr bool PERM = false, AFTER_DRAIN = false;
    bf16_t* P; const float* rope;
    __device__ __forceinline__ void operator()(const f32x4 (&acc)[2][2][4][2], const pg8::Unit& u, int wr, int wc, int fr, int fq) const {
        const bool lat = u.pm < 256, doq = (u.pn == 6 || u.pn == 7), ropeT = lat && u.pn >= 6;
#pragma unroll
        for (int ai = 0; ai < 2; ++ai)
#pragma unroll
            for (int m = 0; m < 4; ++m) {
                const int row = u.pm * 256 + ai * 128 + wr * 64 + m * 16 + fr;
                f32x4 cv = {1.f, 1.f, 1.f, 1.f}, sv = {0.f, 0.f, 0.f, 0.f};
                if (ropeT) { const int t = row & 4095; const int a = (wc & 1) ? (t & 63) : (t >> 6);
                    const f32x4* rp = (const f32x4*)(rope + (a * 16 + 4 * fq) * 2); const f32x4 c0 = rp[0], c1 = rp[1];
                    cv = (f32x4){c0.x, c0.z, c1.x, c1.z}; sv = (f32x4){c0.y, c0.w, c1.y, c1.w}; }
#pragma unroll
                for (int bj = 0; bj < 2; ++bj) {
                    f32x4 x1 = acc[ai][bj][m][0], x2 = acc[ai][bj][m][1];
                    if (ropeT && !(u.pn == 8 && bj == 1)) { const f32x4 o1 = x1 * cv - x2 * sv, o2 = x2 * cv + x1 * sv; x1 = o1; x2 = o2; }
                    if (doq) { x1 = x1 * C2; x2 = x2 * C2; }
                    bf16_t* p = P + (size_t)row * INW + u.pn * 256 + bj * 128 + wc * 32 + 4 * fq;
                    u32x2 w1, w2; w1.x = cvt_pk(x1[0], x1[1]); w1.y = cvt_pk(x1[2], x1[3]); w2.x = cvt_pk(x2[0], x2[1]); w2.y = cvt_pk(x2[2], x2[3]);
                    *(u32x2*)p = w1; *(u32x2*)(p + 16) = w2;
                }
            }
    }
};
struct EpiRes {
    static constexpr bool PERM = false, AFTER_DRAIN = false;
    const float* in_lat; const float* in_ctx; float* out_lat; float* out_ctx; const float* modl; int gate_idx;
    __device__ __forceinline__ void operator()(const f32x4 (&acc)[2][2][4][2], const pg8::Unit& u, int wr, int wc, int fr, int fq) const {
        const bool lat = u.pm < 256; const int rbase = lat ? u.pm * 256 : u.pm * 256 - TLAT; const int r = lat ? (u.pm >> 4) : 16;
        const float* ip = lat ? in_lat : in_ctx; float* op = lat ? out_lat : out_ctx;
        const float* gate = modl + (r * 6 + gate_idx) * 1024;
#pragma unroll
        for (int ai = 0; ai < 2; ++ai)
#pragma unroll
            for (int m = 0; m < 4; ++m) {
                const int row = rbase + ai * 128 + wr * 64 + m * 16 + fr;
#pragma unroll
                for (int bj = 0; bj < 2; ++bj)
#pragma unroll
                    for (int n = 0; n < 2; ++n) {
                        const int col = u.pn * 256 + bj * 128 + wc * 32 + 16 * n + 4 * fq;
                        const f32x4 gv = *(const f32x4*)(gate + col);
                        const size_t off = (size_t)row * DM + col;
                        const f32x4 xi = *(const f32x4*)(ip + off);
                        *(f32x4*)(op + off) = xi + gv * acc[ai][bj][m][n];
                    }
                if (m & 1) asm volatile("" ::: "memory");
            }
    }
};
struct EpiSwiGLU {
    static constexpr bool PERM = false, AFTER_DRAIN = false;
    bf16_t* ACT;
    __device__ __forceinline__ void operator()(const f32x4 (&acc)[2][2][4][2], const pg8::Unit& u, int wr, int wc, int fr, int fq) const {
#pragma unroll
        for (int ai = 0; ai < 2; ++ai)
#pragma unroll
            for (int m = 0; m < 4; ++m) {
                const int row = u.pm * 256 + ai * 128 + wr * 64 + m * 16 + fr;
#pragma unroll
                for (int bj = 0; bj < 2; ++bj) {
                    const f32x4 g = acc[ai][bj][m][0], v = acc[ai][bj][m][1];
                    const int f = (u.pn * 8 + bj * 4 + wc) * 16 + 4 * fq;
                    u32x2 w; w.x = cvt_pk(silu_f(g[0]) * v[0], silu_f(g[1]) * v[1]); w.y = cvt_pk(silu_f(g[2]) * v[2], silu_f(g[3]) * v[3]);
                    *(u32x2*)(ACT + (size_t)row * DFF + f) = w;
                }
            }
    }
};
struct EpiPlain {
    static constexpr bool PERM = false, AFTER_DRAIN = false;
    bf16_t* O; int ldc;
    __device__ __forceinline__ void operator()(const f32x4 (&acc)[2][2][4][2], const pg8::Unit& u, int wr, int wc, int fr, int fq) const {
#pragma unroll
        for (int ai = 0; ai < 2; ++ai)
#pragma unroll
            for (int m = 0; m < 4; ++m) {
                const int row = u.pm * 256 + ai * 128 + wr * 64 + m * 16 + fr;
#pragma unroll
                for (int bj = 0; bj < 2; ++bj)
#pragma unroll
                    for (int n = 0; n < 2; ++n) {
                        const f32x4 x = acc[ai][bj][m][n]; u32x2 w; w.x = cvt_pk(x[0], x[1]); w.y = cvt_pk(x[2], x[3]);
                        *(u32x2*)(O + (size_t)row * ldc + u.pn * 256 + bj * 128 + wc * 32 + 16 * n + 4 * fq) = w;
                    }
            }
    }
};

__device__ __forceinline__ void sincos_turns(double x, double& s, double& c) {
    x = x - floor(x);
    const double q4 = floor(x * 4.0 + 0.5);
    const double r = x - q4 * 0.25;
    const int q = ((int)q4) & 3;
    const double th = r * 6.283185307179586476925, t2 = th * th;
    const double sp = th * (1.0 + t2 * (-1.0 / 6 + t2 * (1.0 / 120 + t2 * (-1.0 / 5040 + t2 * (1.0 / 362880 + t2 * (-1.0 / 39916800 + t2 * (1.0 / 6227020800.0)))))));
    const double cp = 1.0 + t2 * (-0.5 + t2 * (1.0 / 24 + t2 * (-1.0 / 720 + t2 * (1.0 / 40320 + t2 * (-1.0 / 3628800 + t2 * (1.0 / 479001600.0 + t2 * (-1.0 / 87178291200.0)))))));
    if (q == 0) { s = sp; c = cp; } else if (q == 1) { s = cp; c = -sp; } else if (q == 2) { s = -sp; c = -cp; } else { s = -cp; c = sp; }
}
__device__ __forceinline__ unsigned short f2bf(float f) { return __builtin_bit_cast(unsigned short, (__bf16)f); }

__device__ __forceinline__ void transpose_item(const float* W, int K, int N, bf16_t* WT, int mode, LAS float* scr, int item, int lane) {
    const int nblk = N / 32, kb = item / nblk, nb = item % nblk, k0 = 64 * kb, n0 = 32 * nb;
#pragma unroll 8
    for (int i = 0; i < 32; ++i) { const int kk = 2 * i + (lane >> 5); scr[kk * 33 + (lane & 31)] = W[(size_t)(k0 + kk) * N + n0 + (lane & 31)]; }
    LDS_WAIT(); asm volatile("" ::: "memory");
    const int c = lane & 7;
#pragma unroll
    for (int j = 0; j < 4; ++j) { const int n = (lane >> 3) + 8 * j; const LAS float* s = scr + (8 * c) * 33 + n;
        u32x4 o; o.x = cvt_pk(s[0 * 33], s[1 * 33]); o.y = cvt_pk(s[2 * 33], s[3 * 33]); o.z = cvt_pk(s[4 * 33], s[5 * 33]); o.w = cvt_pk(s[6 * 33], s[7 * 33]);
        const int f = n0 + n; const int orow = (mode == 0) ? f : (((f >> 4) << 5) + (f & 15) + (mode == 2 ? 16 : 0));
        *(u32x4*)(WT + (size_t)orow * K + k0 + 8 * c) = o; }
    LDS_WAIT(); asm volatile("" ::: "memory");
}

__device__ __forceinline__ void prologue(const Args& A, LAS unsigned char* lds, int tid, int wave, int lane, int G) {
    unsigned char* ws = A.ws;
    {
        LAS float* scr = (LAS float*)(lds + wave * 16384);
        const int gw = blockIdx.x * NWAVES + wave, NGW = G * NWAVES;
        constexpr int I_IN = 16 * 72, I_SQ = 16 * 32, I_FF = 16 * 88, I_DN = 44 * 32;
        constexpr int NIT = 2 * I_IN + 4 * I_SQ + 8 * I_FF + 4 * I_DN;
        for (int it = gw; it < NIT; it += NGW) {
            int r = it;
            if (r < 2 * I_IN) { const int e = r / I_IN; transpose_item(A.w_in + (size_t)e * DM * INW, DM, INW, (bf16_t*)(ws + WS_WIN) + (size_t)e * INW * DM, 0, scr, r % I_IN, lane); continue; } r -= 2 * I_IN;
            if (r < 2 * I_SQ) { const int e = r / I_SQ; transpose_item(A.w_mix + (size_t)e * DM * DM, DM, DM, (bf16_t*)(ws + WS_WMIX) + (size_t)e * DM * DM, 0, scr, r % I_SQ, lane); continue; } r -= 2 * I_SQ;
            if (r < 2 * I_SQ) { const int e = r / I_SQ; transpose_item(A.w_four + (size_t)e * DM * DM, DM, DM, (bf16_t*)(ws + WS_WF) + (size_t)e * DM * DM, 0, scr, r % I_SQ, lane); continue; } r -= 2 * I_SQ;
            if (r < 4 * I_FF) { const int l = r / I_FF; transpose_item(A.w_gate + (size_t)l * DM * DFF, DM, DFF, (bf16_t*)(ws + WS_WGU) + (size_t)l * 2 * DFF * DM, 1, scr, r % I_FF, lane); continue; } r -= 4 * I_FF;
            if (r < 4 * I_FF) { const int l = r / I_FF; transpose_item(A.w_up + (size_t)l * DM * DFF, DM, DFF, (bf16_t*)(ws + WS_WGU) + (size_t)l * 2 * DFF * DM, 2, scr, r % I_FF, lane); continue; } r -= 4 * I_FF;
            { const int l = r / I_DN; transpose_item(A.w_down + (size_t)l * DFF * DM, DFF, DM, (bf16_t*)(ws + WS_WD) + (size_t)l * DM * DFF, 0, scr, r % I_DN, lane); }
        }
    }
    {
        const int gt = blockIdx.x * NTHR + tid, NGT = G * NTHR;
        float* rope = (float*)(ws + WS_TAB + TAB_ROPE); float* tw = (float*)(ws + WS_TAB + TAB_TW);
        bf16_t* D1 = (bf16_t*)(ws + WS_TAB + TAB_D1); bf16_t* D2 = (bf16_t*)(ws + WS_TAB + TAB_D2); bf16_t* DC = (bf16_t*)(ws + WS_TAB + TAB_DC); bf16_t* DX = (bf16_t*)(ws + WS_TAB + TAB_DCTX);
        constexpr int N_ROPE = 1024, N_TW = 4096, N_D1 = 16384, N_D2 = 8192, N_DC = 131072, N_DX = 131072;
        for (int i = gt; i < N_ROPE + N_TW + N_D1 + N_D2 + N_DC + N_DX; i += NGT) {
            int r = i; double s, c;
            if (r < N_ROPE) { const int a = r >> 4, f = r & 15; sincos_turns((double)a * A.invf[f] * 0.15915494309189533577, s, c); rope[2 * r] = (float)c; rope[2 * r + 1] = (float)s; continue; } r -= N_ROPE;
            if (r < N_TW) { const int k1 = r >> 6, n2 = r & 63; sincos_turns((double)(k1 * n2) / 4096.0, s, c); tw[2 * r] = (float)c; tw[2 * r + 1] = (float)s; continue; } r -= N_TW;
            if (r < N_D1) { const int row = r >> 7, col = r & 127, k1 = row >> 1, rio = row & 1, rii = col >> 6, n1 = col & 63; sincos_turns((double)((k1 * n1) & 63) / 64.0, s, c);
                const double v = (rio == rii) ? c : (rio == 0 ? s : -s); D1[r] = f2bf((float)(v * 0.125)); continue; } r -= N_D1;
            if (r < N_D2) { const int k2 = r >> 7, col = r & 127, ri = col >> 6, n2 = col & 63; sincos_turns((double)((k2 * n2) & 63) / 64.0, s, c); D2[r] = f2bf((float)((ri ? s : c) * 0.125)); continue; } r -= N_D2;
            if (r < N_DC) { const int row = r >> 8, cc = r & 255, ri = row >> 8, m = row & 255; sincos_turns((double)((m * cc) & 255) / 256.0, s, c); DC[r] = f2bf((float)((ri ? -s : c) * 0.0625)); continue; } r -= N_DC;
            { const int k = r >> 9, col = r & 511, ri = col >> 8, n = col & 255; sincos_turns((double)((k * n) & 255) / 256.0, s, c); DX[r] = f2bf((float)((ri ? s : c) * 0.0625)); }
        }
    }
    __syncthreads();
    {
        LAS float* S = (LAS float*)lds; LAS float* Pp = (LAS float*)(lds + 69632);
        for (int i = tid; i < 17 * 1024; i += NTHR) { const int r = i >> 10, k = i & 1023; const float v = (r < 16) ? A.c[r * 1024 + k] : A.c_ctx[k]; S[i] = v / (1.0f + expf(-v)); }
        __syncthreads();
        float* mod = (float*)(ws + WS_MOD);
        for (int task = blockIdx.x; task < 4 * 96; task += G) {
            const int l = task / 96, j0 = (task % 96) * 64;
            const float* w = A.w_ada + (size_t)l * 1024 * 6144 + j0 + lane;
            float acc[17];
#pragma unroll
            for (int r = 0; r < 17; ++r) acc[r] = 0.f;
#pragma unroll 4
            for (int kk = 0; kk < 128; ++kk) { const int k = wave * 128 + kk; const float wv = w[(size_t)k * 6144];
#pragma unroll
                for (int r = 0; r < 17; ++r) acc[r] += S[r * 1024 + k] * wv; }
#pragma unroll
            for (int r = 0; r < 17; ++r) Pp[(wave * 17 + r) * 64 + lane] = acc[r];
            __syncthreads();
            for (int o = tid; o < 17 * 64; o += NTHR) { const int r = o >> 6, jj = o & 63; float sum = 0.f;
#pragma unroll
                for (int w8 = 0; w8 < 8; ++w8) sum += Pp[(w8 * 17 + r) * 64 + jj];
                mod[(size_t)(l * 17 + r) * 6144 + j0 + jj] = sum + A.b_ada[l * 6144 + j0 + jj]; }
            __syncthreads();
        }
    }
}

__device__ __forceinline__ void norm_phase(const float* lat, const float* ctxp, const float* g, const float* modl, int shift_idx, bf16_t* hout, int M, int gw, int NGW, int lane) {
    f32x4 gv[4];
#pragma unroll
    for (int j = 0; j < 4; ++j) gv[j] = *(const f32x4*)(g + 4 * lane + 256 * j);
    for (int row = gw; row < M; row += NGW) {
        const float* xr = (row < TLAT) ? lat + (size_t)row * DM : ctxp + (size_t)(row - TLAT) * DM;
        const int r = (row < TLAT) ? (row >> 12) : 16;
        const float* sh = modl + (r * 6 + shift_idx) * 1024; const float* sc = sh + 1024;
        f32x4 v[4]; float ss = 0.f;
#pragma unroll
        for (int j = 0; j < 4; ++j) { v[j] = *(const f32x4*)(xr + 4 * lane + 256 * j); ss += (v[j].x * v[j].x + v[j].y * v[j].y) + (v[j].z * v[j].z + v[j].w * v[j].w); }
#pragma unroll
        for (int o = 1; o < 64; o <<= 1) ss += __shfl_xor(ss, o);
        const float rstd = 1.0f / sqrtf(ss * (1.0f / DM) + 1e-6f);
#pragma unroll
        for (int j = 0; j < 4; ++j) { const f32x4 scv = *(const f32x4*)(sc + 4 * lane + 256 * j), shv = *(const f32x4*)(sh + 4 * lane + 256 * j);
            const f32x4 o = v[j] * rstd * gv[j] * (scv + 1.0f) + shv;
            u32x2 w; w.x = cvt_pk(o.x, o.y); w.y = cvt_pk(o.z, o.w);
            *(u32x2*)(hout + (size_t)row * DM + 4 * lane + 256 * j) = w; }
    }
}
__device__ __forceinline__ void final_norm_phase(float* xo, const float* g, int gw, int NGW, int lane) {
    f32x4 gv[4];
#pragma unroll
    for (int j = 0; j < 4; ++j) gv[j] = *(const f32x4*)(g + 4 * lane + 256 * j);
    for (int row = gw; row < TLAT; row += NGW) {
        float* xr = xo + (size_t)row * DM;
        f32x4 v[4]; float ss = 0.f;
#pragma unroll
        for (int j = 0; j < 4; ++j) { v[j] = *(const f32x4*)(xr + 4 * lane + 256 * j);
#ifdef SANITIZE
            for (int q = 0; q < 4; ++q) if (!(fabsf(v[j][q]) < 1e30f)) v[j][q] = 0.f;
#endif
            ss += (v[j].x * v[j].x + v[j].y * v[j].y) + (v[j].z * v[j].z + v[j].w * v[j].w); }
#pragma unroll
        for (int o = 1; o < 64; o <<= 1) ss += __shfl_xor(ss, o);
        const float rstd = 1.0f / sqrtf(ss * (1.0f / DM) + 1e-6f);
#pragma unroll
        for (int j = 0; j < 4; ++j) *(f32x4*)(xr + 4 * lane + 256 * j) = v[j] * rstd * gv[j];
    }
}

__device__ __forceinline__ int crow(int r, int hi) { return (r & 3) + 8 * (r >> 2) + 4 * hi; }

__device__ __forceinline__ void attn_phase(LAS unsigned char* lds, const bf16_t* P, bf16_t* cat, const float* sink, bool ctxq, int G, int tid, int wave, int lane) {
    constexpr int KROW = 144, VROW = 264;
    LAS unsigned char* Kl = lds; LAS unsigned char* Vl = lds + 128 * KROW;
    const int r32 = lane & 31, hi = lane >> 5, g = wave & 3, qh = wave >> 2;
    const int nitems = 1024 + (ctxq ? 64 : 0);
    for (int it = blockIdx.x; it < nitems; it += G) {
        int b, hk, qb, qr0; const bool isl = it < 1024;
        if (isl) { b = it >> 6; hk = (it >> 5) & 1; qb = it & 31; qr0 = b * SEQ + qb * 128; }
        else { const int j = it - 1024; b = j >> 2; hk = (j >> 1) & 1; qb = j & 1; qr0 = TLAT + b * LCTX + qb * 128; }
        const int crow0 = TLAT + b * LCTX, head = hk * 4 + g;
        bf16x8 qf[2][4];
#pragma unroll
        for (int s = 0; s < 2; ++s)
#pragma unroll
            for (int ks = 0; ks < 4; ++ks) qf[s][ks] = *(const bf16x8*)(P + (size_t)(qr0 + 64 * qh + 32 * s + r32) * INW + QS + head * 64 + 16 * ks + 8 * hi);
        float mrun[2], lrun[2]; f32x16 O[2][2];
        const float sk2 = sink[head] * LOG2E;
#pragma unroll
        for (int s = 0; s < 2; ++s) { mrun[s] = sk2; lrun[s] = 1.0f;
#pragma unroll
            for (int dt = 0; dt < 2; ++dt)
#pragma unroll
                for (int r = 0; r < 16; ++r) O[s][dt][r] = 0.f; }
#pragma unroll 1
        for (int ti = 0; ti < 5; ++ti) {
            int krow0, mtype = 0; bool valid = true;
            if (ti == 0) { krow0 = qr0 - 128; mtype = 1; valid = isl && qb > 0; }
            else if (ti == 1) { krow0 = qr0; valid = isl; }
            else if (ti == 2) { krow0 = qr0 + 128; mtype = 2; valid = isl && qb < 31; }
            else { krow0 = crow0 + (ti - 3) * 128; }
            if (!valid) continue;
            __syncthreads();
#pragma unroll
            for (int i = 0; i < 2; ++i) { const int id = tid + NTHR * i, key = id >> 3, c = id & 7;
                const u32x4 v = *(const u32x4*)(P + (size_t)(krow0 + key) * INW + KS_ + hk * 64 + 8 * c);
                *(LAS u32x4*)(Kl + key * KROW + c * 16) = v; }
#pragma unroll
            for (int i = 0; i < 2; ++i) { const int id = tid + NTHR * i, key = id & 127, c = id >> 7;
                const u32x4 v = *(const u32x4*)(P + (size_t)(krow0 + key) * INW + VS_ + hk * 64 + 8 * c);
                LAS unsigned char* vp = Vl + (8 * c) * VROW + key * 2;
                *(LAS unsigned short*)(vp + 0 * VROW) = (unsigned short)(v.x & 0xffffu); *(LAS unsigned short*)(vp + 1 * VROW) = (unsigned short)(v.x >> 16);
                *(LAS unsigned short*)(vp + 2 * VROW) = (unsigned short)(v.y & 0xffffu); *(LAS unsigned short*)(vp + 3 * VROW) = (unsigned short)(v.y >> 16);
                *(LAS unsigned short*)(vp + 4 * VROW) = (unsigned short)(v.z & 0xffffu); *(LAS unsigned short*)(vp + 5 * VROW) = (unsigned short)(v.z >> 16);
                *(LAS unsigned short*)(vp + 6 * VROW) = (unsigned short)(v.w & 0xffffu); *(LAS unsigned short*)(vp + 7 * VROW) = (unsigned short)(v.w >> 16); }
            __syncthreads();
#pragma unroll
            for (int half = 0; half < 2; ++half)
#pragma unroll
                for (int s = 0; s < 2; ++s) {
                    f32x16 S[2];
#pragma unroll
                    for (int rt = 0; rt < 2; ++rt) {
#pragma unroll
                        for (int r = 0; r < 16; ++r) S[rt][r] = 0.f;
#ifndef DIAG
                        asm volatile("" : "+v"(S[rt]));
#endif
#pragma unroll
                        for (int ks = 0; ks < 4; ++ks) { const bf16x8 kf = *(const LAS bf16x8*)(Kl + (64 * half + 32 * rt + r32) * KROW + (16 * ks + 8 * hi) * 2);
                            S[rt] = __builtin_amdgcn_mfma_f32_32x32x16_bf16(kf, qf[s][ks], S[rt], 0, 0, 0); }
                    }
                    if (mtype != 0) { int il = 64 * qh + 32 * s + r32; asm volatile("" : "+v"(il));
#pragma unroll
                        for (int rt = 0; rt < 2; ++rt)
#pragma unroll
                            for (int r = 0; r < 16; ++r) { const int jl = 64 * half + 32 * rt + crow(r, hi); const bool ok = (mtype == 1) ? (jl >= il) : (jl <= il); if (!ok) S[rt][r] = -INFINITY; } }
                    float tmax = S[0][0];
#pragma unroll
                    for (int rt = 0; rt < 2; ++rt)
#pragma unroll
                        for (int r = 0; r < 16; ++r) tmax = fmaxf(tmax, S[rt][r]);
                    tmax = fmaxf(tmax, __shfl_xor(tmax, 32));
                    const float mnew = fmaxf(mrun[s], tmax), alpha = fast_exp2(mrun[s] - mnew);
                    mrun[s] = mnew;
                    float psum = 0.f;
#pragma unroll
                    for (int rt = 0; rt < 2; ++rt)
#pragma unroll
                        for (int r = 0; r < 16; ++r) { const float p = fast_exp2(S[rt][r] - mnew); S[rt][r] = p; psum += p; }
                    psum += __shfl_xor(psum, 32);
                    lrun[s] = lrun[s] * alpha + psum;
#pragma unroll
                    for (int dt = 0; dt < 2; ++dt)
#pragma unroll
                        for (int r = 0; r < 16; ++r) O[s][dt][r] *= alpha;
#pragma unroll
                    for (int rt = 0; rt < 2; ++rt)
#pragma unroll
                        for (int s2 = 0; s2 < 2; ++s2) {
                            u32x4 pw; pw.x = cvt_pk(S[rt][8 * s2 + 0], S[rt][8 * s2 + 1]); pw.y = cvt_pk(S[rt][8 * s2 + 2], S[rt][8 * s2 + 3]);
                            pw.z = cvt_pk(S[rt][8 * s2 + 4], S[rt][8 * s2 + 5]); pw.w = cvt_pk(S[rt][8 * s2 + 6], S[rt][8 * s2 + 7]);
                            const bf16x8 pf = __builtin_bit_cast(bf16x8, pw);
#pragma unroll
                            for (int dt = 0; dt < 2; ++dt) {
                                const LAS unsigned char* vb = Vl + (32 * dt + r32) * VROW + (64 * half + 32 * rt + 16 * s2 + 4 * hi) * 2;
                                const u32x2 v0 = *(const LAS u32x2*)vb, v1 = *(const LAS u32x2*)(vb + 16);
                                const u32x4 vv = {v0.x, v0.y, v1.x, v1.y};
                                O[s][dt] = __builtin_amdgcn_mfma_f32_32x32x16_bf16(__builtin_bit_cast(bf16x8, vv), pf, O[s][dt], 0, 0, 0);
                            }
                        }
                }
        }
#pragma unroll
        for (int s = 0; s < 2; ++s) { const float inv = 1.0f / lrun[s];
            bf16_t* orow = cat + (size_t)(qr0 + 64 * qh + 32 * s + r32) * DM + 512 + head * 64;
#pragma unroll
            for (int dt = 0; dt < 2; ++dt)
#pragma unroll
                for (int q4 = 0; q4 < 4; ++q4) { u32x2 w; w.x = cvt_pk(O[s][dt][4 * q4 + 0] * inv, O[s][dt][4 * q4 + 1] * inv); w.y = cvt_pk(O[s][dt][4 * q4 + 2] * inv, O[s][dt][4 * q4 + 3] * inv);
                    *(u32x2*)(orow + 32 * dt + 8 * q4 + 4 * hi) = w; } }
    }
    __syncthreads();
}

__device__ __forceinline__ void load_u(const bf16_t* P, int t, int s0, int s1, int c8, float (&u)[8]) {
    if (t < s0 || t >= s1) {
#pragma unroll
        for (int j = 0; j < 8; ++j) u[j] = 0.f;
    } else {
        const u32x4 cv = *(const u32x4*)(P + (size_t)t * INW + 512 + 8 * c8), hv = *(const u32x4*)(P + (size_t)t * INW + 1024 + 8 * c8);
        u[0] = bf_lo(cv.x) * bf_lo(hv.x); u[1] = bf_hi(cv.x) * bf_hi(hv.x); u[2] = bf_lo(cv.y) * bf_lo(hv.y); u[3] = bf_hi(cv.y) * bf_hi(hv.y);
        u[4] = bf_lo(cv.z) * bf_lo(hv.z); u[5] = bf_hi(cv.z) * bf_hi(hv.z); u[6] = bf_lo(cv.w) * bf_lo(hv.w); u[7] = bf_hi(cv.w) * bf_hi(hv.w);
    }
}
__device__ __forceinline__ void conv_phase(const bf16_t* P, bf16_t* cat, const float* cw, int M, int G, int tid) {
    const int c8 = tid & 63, tg = tid >> 6;
    float w0[8], w1[8], w2[8];
#pragma unroll
    for (int j = 0; j < 8; ++j) { w0[j] = cw[8 * c8 + j]; w1[j] = cw[512 + 8 * c8 + j]; w2[j] = cw[1024 + 8 * c8 + j]; }
    for (int it = blockIdx.x; it < M / 128; it += G) {
        const int t0 = it * 128, ts = t0 + 16 * tg;
        int s0, s1; if (t0 < TLAT) { s0 = t0 & ~4095; s1 = s0 + 4096; } else { s0 = TLAT + ((t0 - TLAT) & ~255); s1 = s0 + 256; }
        float up[8], uc[8], un[8];
        load_u(P, ts - 1, s0, s1, c8, up); load_u(P, ts, s0, s1, c8, uc);
#pragma unroll 2
        for (int i = 0; i < 16; ++i) { const int t = ts + i;
            load_u(P, t + 1, s0, s1, c8, un);
            const u32x4 bv = *(const u32x4*)(P + (size_t)t * INW + 8 * c8);
            float bb[8] = {bf_lo(bv.x), bf_hi(bv.x), bf_lo(bv.y), bf_hi(bv.y), bf_lo(bv.z), bf_hi(bv.z), bf_lo(bv.w), bf_hi(bv.w)};
            float o[8];
#pragma unroll
            for (int j = 0; j < 8; ++j) { o[j] = bb[j] * (w0[j] * up[j] + w1[j] * uc[j] + w2[j] * un[j]); up[j] = uc[j]; uc[j] = un[j]; }
            u32x4 w; w.x = cvt_pk(o[0], o[1]); w.y = cvt_pk(o[2], o[3]); w.z = cvt_pk(o[4], o[5]); w.w = cvt_pk(o[6], o[7]);
            *(u32x4*)(cat + (size_t)t * DM + 8 * c8) = w; }
    }
}

template <int MT, int KS> __device__ __forceinline__ void dft_load_a(bf16x8 (&a)[MT][KS], const bf16_t* Mat, int row0, int r32, int hi) {
#pragma unroll
    for (int rt = 0; rt < MT; ++rt)
#pragma unroll
        for (int ks = 0; ks < KS; ++ks) a[rt][ks] = *(const bf16x8*)(Mat + (size_t)(row0 + 32 * rt + r32) * (KS * 16) + 16 * ks + 8 * hi);
}
template <int MT, int KS> __device__ __forceinline__ void dft_mm(f32x16 (&acc)[MT], const bf16x8 (&a)[MT][KS], const bf16_t* vec) {
#pragma unroll
    for (int rt = 0; rt < MT; ++rt)
#pragma unroll
        for (int r = 0; r < 16; ++r) acc[rt][r] = 0.f;
#pragma unroll
    for (int rt = 0; rt < MT; ++rt) asm volatile("" : "+v"(acc[rt]));
    constexpr int KC = 8;
#pragma unroll
    for (int kc = 0; kc < KS / KC; ++kc) {
        bf16x8 b[KC];
#pragma unroll
        for (int i = 0; i < KC; ++i) b[i] = *(const bf16x8*)(vec + 16 * (kc * KC + i));
#pragma unroll
        for (int i = 0; i < KC; ++i)
#pragma unroll
            for (int rt = 0; rt < MT; ++rt) acc[rt] = __builtin_amdgcn_mfma_f32_32x32x16_bf16(a[rt][kc * KC + i], b[i], acc[rt], 0, 0, 0);
    }
}
__device__ __forceinline__ void fourier_a(const bf16_t* H, const bf16_t* DC, bf16_t* Z1, bf16_t* Zc, bool with_ctx, int G, int wave, int lane) {
    const int r32 = lane & 31, hi = lane >> 5, sl = wave;
    bf16x8 a[2][16]; dft_load_a<2, 16>(a, DC, 64 * sl, r32, hi);
    const int ntile = 8192 + (with_ctx ? 512 : 0);
    for (int tile = blockIdx.x; tile < ntile; tile += G) {
        f32x16 acc[2];
        if (tile < 8192) {
            const int n1h = tile & 1, n2 = (tile >> 1) & 63, g = (tile >> 7) & 3, b = tile >> 9;
            const int token = b * SEQ + 64 * (32 * n1h + r32) + n2;
            dft_mm<2, 16>(acc, a, H + (size_t)token * DM + g * 256 + 8 * hi);
            bf16_t* zb = Z1 + ((((size_t)((b * 4 + g) * 256 + 64 * (sl & 3) + 4 * hi)) * 64 + n2) * 2 + (sl >> 2)) * 64 + 32 * n1h + r32;
            asm volatile("" : "+v"(zb));
#pragma unroll
            for (int rt = 0; rt < 2; ++rt)
#pragma unroll
                for (int r = 0; r < 16; ++r) zb[(size_t)(32 * rt + (r & 3) + 8 * (r >> 2)) * 8192] = f2bf(acc[rt][r]);
        } else {
            const int tc = tile - 8192, nq = tc & 7, g = (tc >> 3) & 3, b = tc >> 5;
            const int token = TLAT + b * LCTX + 32 * nq + r32;
            dft_mm<2, 16>(acc, a, H + (size_t)token * DM + g * 256 + 8 * hi);
            bf16_t* zb = Zc + (((size_t)((b * 4 + g) * 256 + 64 * (sl & 3) + 4 * hi)) * 2 + (sl >> 2)) * 256 + 32 * nq + r32;
            asm volatile("" : "+v"(zb));
#pragma unroll
            for (int rt = 0; rt < 2; ++rt)
#pragma unroll
                for (int r = 0; r < 16; ++r) zb[(size_t)(32 * rt + (r & 3) + 8 * (r >> 2)) * 512] = f2bf(acc[rt][r]);
        }
    }
}
__device__ __forceinline__ void fourier_s1(const bf16_t* Z1, const bf16_t* D1, const float* tw, bf16_t* A1p, int G, int wave, int lane) {
    const int r32 = lane & 31, hi = lane >> 5, sl = wave & 1;
    bf16x8 a[2][8]; dft_load_a<2, 8>(a, D1, 64 * sl, r32, hi);
    for (int tile = blockIdx.x * 4 + (wave >> 1); tile < 32768; tile += G * 4) {
        f32x16 acc[2];
        dft_mm<2, 8>(acc, a, Z1 + ((size_t)tile * 32 + r32) * 128 + 8 * hi);
        const int n2 = 32 * (tile & 1) + r32, bgm = tile >> 1, bg = bgm >> 8, m = bgm & 255;
        bf16_t* ab = A1p + ((((size_t)(bg * 64 + 32 * sl + 2 * hi)) * 256 + m) * 2) * 64 + n2;
        const float* twb = tw + 2 * ((32 * sl + 2 * hi) * 64 + n2);
        asm volatile("" : "+v"(ab), "+v"(twb));
#pragma unroll
        for (int rt = 0; rt < 2; ++rt)
#pragma unroll
            for (int q4 = 0; q4 < 4; ++q4)
#pragma unroll
                for (int e = 0; e < 2; ++e) { const int dk = 16 * rt + 4 * q4 + e;
                    const float re = acc[rt][4 * q4 + 2 * e], im = acc[rt][4 * q4 + 2 * e + 1];
                    const float2 cs = *(const float2*)(twb + dk * 128);
                    const float re2 = re * cs.x + im * cs.y, im2 = im * cs.x - re * cs.y;
                    ab[(size_t)dk * 32768] = f2bf(re2); ab[(size_t)dk * 32768 + 64] = f2bf(im2); }
    }
}
__device__ __forceinline__ void fourier_s2(const bf16_t* A1p, const bf16_t* D2, const bf16_t* Zc, const bf16_t* DX, bf16_t* FM, bool with_ctx, int G, int gw, int NGW, int wave, int lane) {
    const int r32 = lane & 31, hi = lane >> 5;
    {
        bf16x8 a[2][8]; dft_load_a<2, 8>(a, D2, 0, r32, hi);
        for (int tile = gw; tile < 32768; tile += NGW) {
            f32x16 acc[2];
            dft_mm<2, 8>(acc, a, A1p + ((size_t)tile * 32 + r32) * 128 + 8 * hi);
            const int m = 32 * (tile & 7) + r32, k1 = (tile >> 3) & 63, bg = tile >> 9, b = bg >> 2, g = bg & 3;
            bf16_t* fb = FM + (size_t)(b * SEQ + k1 + 256 * hi) * DM + g * 256 + m;
            asm volatile("" : "+v"(fb));
#pragma unroll
            for (int rt = 0; rt < 2; ++rt)
#pragma unroll
                for (int r = 0; r < 16; ++r) fb[(size_t)(32 * rt + (r & 3) + 8 * (r >> 2)) * 65536] = f2bf(acc[rt][r]);
        }
    }
    if (with_ctx) {
        for (int tile = blockIdx.x; tile < 512; tile += G) {
            f32x16 acc;
#pragma unroll
            for (int r = 0; r < 16; ++r) acc[r] = 0.f;
            asm volatile("" : "+v"(acc));
            const bf16_t* ap = DX + (size_t)(32 * wave + r32) * 512 + 8 * hi;
            const bf16_t* bp = Zc + ((size_t)tile * 32 + r32) * 512 + 8 * hi;
#pragma unroll 1
            for (int kc = 0; kc < 4; ++kc) {
                bf16x8 av[8], bv[8];
#pragma unroll
                for (int i = 0; i < 8; ++i) { av[i] = *(const bf16x8*)(ap + 16 * (kc * 8 + i)); bv[i] = *(const bf16x8*)(bp + 16 * (kc * 8 + i)); }
#pragma unroll
                for (int i = 0; i < 8; ++i) acc = __builtin_amdgcn_mfma_f32_32x32x16_bf16(av[i], bv[i], acc, 0, 0, 0);
            }
            const int m = 32 * (tile & 7) + r32, bg = tile >> 3, b = bg >> 2, g = bg & 3;
            bf16_t* fb = FM + (size_t)(TLAT + b * LCTX + 32 * wave + 4 * hi) * DM + g * 256 + m;
            asm volatile("" : "+v"(fb));
#pragma unroll
            for (int r = 0; r < 16; ++r) fb[(size_t)((r & 3) + 8 * (r >> 2)) * 1024] = f2bf(acc[r]);
        }
    }
}


#ifdef DIAG
__device__ __forceinline__ void diag_scan(unsigned* ctl, const void* buf, size_t bytes, bool is_bf16, int stage) {
    const size_t n16 = bytes / 16; const u32x4* p = (const u32x4*)buf; bool bad = false;
    int ln = (int)__builtin_amdgcn_mbcnt_hi(~0u, __builtin_amdgcn_mbcnt_lo(~0u, 0u)); asm volatile("" : "+v"(ln)); ln += 64 * __builtin_amdgcn_readfirstlane((int)threadIdx.x >> 6);
    for (size_t i = (size_t)blockIdx.x * NTHR + ln; i < n16; i += (size_t)gridDim.x * NTHR) {
        const u32x4 v = p[i];
        if (is_bf16) { for (int q = 0; q < 4; ++q) { const unsigned w = v[q]; if (((w >> 7) & 0xff) == 0xff || ((w >> 23) & 0xff) == 0xff) bad = true; } }
        else { for (int q = 0; q < 4; ++q) { if (((v[q] >> 23) & 0xff) >= 0xf0) bad = true; } }
    }
    if (bad) atomicMin(ctl, (unsigned)stage);
}
#define DIAG_SCAN(buf, bytes, isbf, stage) diag_scan((unsigned*)ws, buf, bytes, isbf, stage)
#else
#define DIAG_SCAN(buf, bytes, isbf, stage) do {} while (0)
#endif

#ifdef DIAG2
__device__ __forceinline__ void diag_max(unsigned* ctl, const void* buf, size_t bytes) {
    const size_t n16 = bytes / 16; const u32x4* p = (const u32x4*)buf; unsigned mx = 0, nb = 0;
    int ln = (int)__builtin_amdgcn_mbcnt_hi(~0u, __builtin_amdgcn_mbcnt_lo(~0u, 0u)); asm volatile("" : "+v"(ln)); ln += 64 * __builtin_amdgcn_readfirstlane((int)threadIdx.x >> 6);
    for (size_t i = (size_t)blockIdx.x * NTHR + ln; i < n16; i += (size_t)gridDim.x * NTHR) {
        const u32x4 v = p[i];
        for (int q = 0; q < 4; ++q) { const unsigned lo = (v[q] << 16) & 0x7fffffffu, hi = v[q] & 0x7fff0000u;
            if ((lo >> 23) == 0xff) ++nb; else mx = mx > lo ? mx : lo;
            if ((hi >> 23) == 0xff) ++nb; else mx = mx > hi ? mx : hi; }
    }
    atomicMax(ctl + 1, mx); if (nb) atomicAdd(ctl + 2, nb);
}
#endif
__global__ void __launch_bounds__(NTHR, 2) fwd_megakernel(Args A) {
    extern __shared__ __attribute__((aligned(16))) unsigned char lds_raw[];
    cg::grid_group grid = cg::this_grid();
#define GRID_SYNC() do { asm volatile("s_waitcnt vmcnt(0) lgkmcnt(0)" ::: "memory"); grid.sync(); } while (0)
    LAS unsigned char* lds = (LAS unsigned char*)lds_raw;
    const int wave = __builtin_amdgcn_readfirstlane((int)threadIdx.x >> 6);
#define FRESH_LANE(v) int v = LANE_ID(); asm volatile("" : "+v"(v))
#define LANE_ID() ((int)__builtin_amdgcn_mbcnt_hi(~0u, __builtin_amdgcn_mbcnt_lo(~0u, 0u)))
    const int lane = LANE_ID(), tid = wave * 64 + lane;
    const int G = gridDim.x, gw = blockIdx.x * NWAVES + wave, NGW = G * NWAVES;
    unsigned char* ws = A.ws;
#ifdef DIAG
    if (blockIdx.x == 0 && threadIdx.x == 0) *(unsigned*)ws = 0x7fffffffu;
#endif
#ifdef DIAG2
    if (blockIdx.x == 0 && threadIdx.x == 0) { ((unsigned*)ws)[1] = 0u; ((unsigned*)ws)[2] = 0u; }
#endif
    float* mod = (float*)(ws + WS_MOD);
    const float* rope = (const float*)(ws + WS_TAB + TAB_ROPE); const float* tw = (const float*)(ws + WS_TAB + TAB_TW);
    const bf16_t* D1 = (const bf16_t*)(ws + WS_TAB + TAB_D1); const bf16_t* D2 = (const bf16_t*)(ws + WS_TAB + TAB_D2);
    const bf16_t* DC = (const bf16_t*)(ws + WS_TAB + TAB_DC); const bf16_t* DX = (const bf16_t*)(ws + WS_TAB + TAB_DCTX);
    float* xc = (float*)(ws + WS_XC);
    bf16_t* Hb = (bf16_t*)(ws + WS_H); bf16_t* Pb = (bf16_t*)(ws + WS_P); bf16_t* CAT = (bf16_t*)(ws + WS_CAT); bf16_t* ACT = (bf16_t*)(ws + WS_ACT);
    bf16_t* Z1 = (bf16_t*)(ws + WS_Z1); bf16_t* Zc = (bf16_t*)(ws + WS_ZC); bf16_t* A1p = (bf16_t*)(ws + WS_A1); bf16_t* FM = (bf16_t*)(ws + WS_FM);


#ifndef SKIP_PRO
    prologue(A, lds, tid, wave, lane, G);
#endif

    GRID_SYNC();

    DIAG_SCAN(mod, 4 * 17 * 6144 * 4, false, 1); DIAG_SCAN(ws + WS_WIN, (size_t)83 * MiB, true, 2); DIAG_SCAN(ws + WS_TAB + TAB_D1, 640 * 1024, true, 3); DIAG_SCAN(ws + WS_TAB, 96 * 1024, false, 4);
#pragma unroll 1
    for (int l = 0; l < 4; ++l) {
        const bool even = (l & 1) == 0; const int e = l >> 1;
        const bool ctx_after = l < 2;
        const bool ctx_here = l < 3;
        const int Mfull = ctx_here ? MALL : TLAT;
        const int Mres = ctx_after ? MALL : TLAT;
        const float* modl = mod + (size_t)l * 17 * 6144;
        const float* xin_lat = (l == 0) ? A.x : A.out; const float* xin_ctx = (l == 0) ? A.ctx : xc;
        { FRESH_LANE(lane_l); const int tid_l = wave * 64 + lane_l; (void)tid_l; norm_phase(xin_lat, xin_ctx, A.n1g + l * DM, modl, 0, Hb, Mfull, gw, NGW, lane_l); }
        GRID_SYNC();
        DIAG_SCAN(Hb, (size_t)Mfull * DM * 2, true, 10 + 10 * l);
        const bf16_t* mixA; const bf16_t* mixW;
        if (even) {
            { int tg = LANE_ID(); asm volatile("" : "+v"(tg)); tg += wave * 64; pg8::Gemm g{Hb, (const bf16_t*)(ws + WS_WIN) + (size_t)e * INW * DM, Mfull, INW, DM}; pg8::StaticOrder S; S.init(Mfull, INW, G, (int)blockIdx.x);
              EpiInProj E{Pb, rope};
              pg8::gemm_phase<EpiInProj, pg8::StaticOrder, true, true>(lds, g, S, E, tg); }
            GRID_SYNC();
        DIAG_SCAN(Pb, (size_t)Mfull * INW * 2, true, 11 + 10 * l);

#ifndef SKIP_ATT
            { FRESH_LANE(lane_l); const int tid_l = wave * 64 + lane_l; (void)tid_l; attn_phase(lds, Pb, CAT, A.sink + e * 8, ctx_after, G, tid_l, wave, lane_l); }
#endif


#ifndef SKIP_CONV
            { FRESH_LANE(lane_l); const int tid_l = wave * 64 + lane_l; (void)tid_l; conv_phase(Pb, CAT, A.conv_w + e * 3 * 512, Mres, G, tid_l); }
#endif

            GRID_SYNC();
        DIAG_SCAN(CAT, (size_t)Mres * DM * 2, true, 12 + 10 * l);
            mixA = CAT; mixW = (const bf16_t*)(ws + WS_WMIX) + (size_t)e * DM * DM;
        } else {

#ifndef SKIP_FA
            { FRESH_LANE(lane_l); const int tid_l = wave * 64 + lane_l; (void)tid_l; fourier_a(Hb, DC, Z1, Zc, ctx_after, G, wave, lane_l); }
#endif

            GRID_SYNC();
        DIAG_SCAN(Z1, (size_t)128 * MiB, true, 11 + 10 * l); DIAG_SCAN(Z1 + 64 * MiB, (size_t)128 * MiB, true, 12 + 10 * l); DIAG_SCAN(Zc, (size_t)16 * MiB, true, 13 + 10 * l);
#ifdef DIAG2
        if (l == DIAG2_L) diag_max((unsigned*)ws, DIAG2_BUF, DIAG2_BYTES);
#endif

#ifndef SKIP_S1
            { FRESH_LANE(lane_l); const int tid_l = wave * 64 + lane_l; (void)tid_l; fourier_s1(Z1, D1, tw, A1p, G, wave, lane_l); }
#endif

            GRID_SYNC();
        DIAG_SCAN(A1p, (size_t)256 * MiB, true, 14 + 10 * l);

#ifndef SKIP_S2
            { FRESH_LANE(lane_l); const int tid_l = wave * 64 + lane_l; (void)tid_l; fourier_s2(A1p, D2, Zc, DX, FM, ctx_after, G, gw, NGW, wave, lane_l); }
#endif

            GRID_SYNC();
        DIAG_SCAN(FM, (size_t)Mres * DM * 2, true, 15 + 10 * l);
            mixA = FM; mixW = (const bf16_t*)(ws + WS_WF) + (size_t)e * DM * DM;
        }
        { int tg = LANE_ID(); asm volatile("" : "+v"(tg)); tg += wave * 64; pg8::Gemm g{mixA, mixW, Mres, DM, DM}; pg8::StaticOrder S; S.init(Mres, DM, G, (int)blockIdx.x);
          EpiRes E{xin_lat, xin_ctx, A.out, xc, modl, 2};
          pg8::gemm_phase<EpiRes, pg8::StaticOrder, true, true>(lds, g, S, E, tg); }
        GRID_SYNC();
        DIAG_SCAN(A.out, (size_t)TLAT * DM * 4, false, 16 + 10 * l);
        { FRESH_LANE(lane_l); const int tid_l = wave * 64 + lane_l; (void)tid_l; norm_phase(A.out, xc, A.n2g + l * DM, modl, 3, Hb, Mres, gw, NGW, lane_l); }
        GRID_SYNC();
        DIAG_SCAN(Hb, (size_t)Mres * DM * 2, true, 17 + 10 * l);
        { int tg = LANE_ID(); asm volatile("" : "+v"(tg)); tg += wave * 64; pg8::Gemm g{Hb, (const bf16_t*)(ws + WS_WGU) + (size_t)l * 2 * DFF * DM, Mres, 2 * DFF, DM}; pg8::StaticOrder S; S.init(Mres, 2 * DFF, G, (int)blockIdx.x);
          EpiSwiGLU E{ACT};
          pg8::gemm_phase<EpiSwiGLU, pg8::StaticOrder, true, true>(lds, g, S, E, tg); }
        GRID_SYNC();
        DIAG_SCAN(ACT, (size_t)Mres * DFF * 2, true, 18 + 10 * l);
        { int tg = LANE_ID(); asm volatile("" : "+v"(tg)); tg += wave * 64; pg8::Gemm g{ACT, (const bf16_t*)(ws + WS_WD) + (size_t)l * DM * DFF, Mres, DM, DFF}; pg8::StaticOrder S; S.init(Mres, DM, G, (int)blockIdx.x);
          EpiRes E{A.out, xc, A.out, xc, modl, 5};
          pg8::gemm_phase<EpiRes, pg8::StaticOrder, true, true>(lds, g, S, E, tg); }
        GRID_SYNC();
        DIAG_SCAN(A.out, (size_t)TLAT * DM * 4, false, 19 + 10 * l);
    }
    { int lane_f = LANE_ID(); asm volatile("" : "+v"(lane_f)); final_norm_phase(A.out, A.final_g, gw, NGW, lane_f); }
#ifdef DIAG2
    GRID_SYNC();
    if (blockIdx.x == 0 && threadIdx.x == 0) { const unsigned mx = ((volatile unsigned*)ws)[1], nb = ((volatile unsigned*)ws)[2]; A.out[0] = 1000.f * __builtin_bit_cast(float, mx); A.out[1] = nb ? 1e9f + 1000.f * (float)nb : 0.f; }
#endif
#ifdef DIAG
    GRID_SYNC();
    if (blockIdx.x == 0 && threadIdx.x == 0) { const unsigned c = *(volatile unsigned*)ws; A.out[0] = (c == 0x7fffffffu) ? 999000.f : 1000.f * (float)c; }
#endif
}

extern "C" void kernel_launch(void* const* d_in, const int* in_sizes, int n_in, void* d_out, int out_size, void* d_ws, size_t ws_size, hipStream_t stream) {
    static int grid = 0;
    if (grid == 0) {
        if (n_in != 17 || out_size != TLAT * DM || ws_size < WS_END) { fprintf(stderr, "kernel_launch: unexpected shapes (n_in %d, out %d, ws %zu)\n", n_in, out_size, ws_size); grid = -1; return; }
        int dev = 0, cus = 0, per_cu = 0;
        hipGetDevice(&dev); hipDeviceGetAttribute(&cus, hipDeviceAttributeMultiprocessorCount, dev);
        if (hipFuncSetAttribute((const void*)fwd_megakernel, hipFuncAttributeMaxDynamicSharedMemorySize, LDS_BYTES) != hipSuccess) { fprintf(stderr, "kernel_launch: hipFuncSetAttribute failed\n"); grid = -1; return; }
        if (hipOccupancyMaxActiveBlocksPerMultiprocessor(&per_cu, (const void*)fwd_megakernel, NTHR, LDS_BYTES) != hipSuccess || per_cu < 1) { fprintf(stderr, "kernel_launch: occupancy query says %d\n", per_cu); per_cu = 1; }
        (void)hipGetLastError();
        grid = cus * 1;
    }
    if (grid < 0) return;
    Args a{};
    a.x = (const float*)d_in[0]; a.c = (const float*)d_in[1]; a.ctx = (const float*)d_in[2]; a.c_ctx = (const float*)d_in[3]; a.w_ada = (const float*)d_in[4]; a.b_ada = (const float*)d_in[5];
    a.n1g = (const float*)d_in[6]; a.n2g = (const float*)d_in[7]; a.w_in = (const float*)d_in[8]; a.conv_w = (const float*)d_in[9]; a.sink = (const float*)d_in[10]; a.w_mix = (const float*)d_in[11];
    a.w_four = (const float*)d_in[12]; a.w_gate = (const float*)d_in[13]; a.w_up = (const float*)d_in[14]; a.w_down = (const float*)d_in[15]; a.final_g = (const float*)d_in[16];
    a.out = (float*)d_out; a.ws = (unsigned char*)d_ws;
    for (int f = 0; f < 16; ++f) a.invf[f] = pow(10000.0, -(double)f / 16.0);
    void* args[] = {&a};
    hipError_t e = hipLaunchCooperativeKernel((const void*)fwd_megakernel, dim3(grid), dim3(NTHR), args, LDS_BYTES, stream);
    if (e != hipSuccess) fprintf(stderr, "kernel_launch: cooperative launch failed: %s (grid %d)\n", hipGetErrorString(e), grid);
}
```

```cpp
#include <hip/hip_runtime.h>
#include <hip/hip_cooperative_groups.h>
#include <cstdio>
#include <cstdint>
#include <cmath>
namespace cg = cooperative_groups;

namespace pg8 {
#define PG8_LAS __attribute__((address_space(3)))
typedef unsigned short bf16_t;
typedef short bf16x8 __attribute__((ext_vector_type(8)));
typedef float f32x4 __attribute__((ext_vector_type(4)));
typedef unsigned u32x4 __attribute__((ext_vector_type(4)));
constexpr int BM = 256, BK = 64, HALF = 128, HTB = HALF * BK * 2  , STAGE_BYTES = 8 * HTB, NXCD = 8, WGM = 8;

__host__ __device__ __forceinline__ int lds_byte(int r, int c) { const int st = (r >> 4) * 2 + (c >> 5), rr = r & 15, cc = c & 31, ob = rr * 64 + cc * 2; return st * 1024 + (ob ^ (((ob >> 9) & 1) << 5)); }
__host__ __device__ __forceinline__ void stage_rc(int b, int& R, int& C) { const int st = b / 1024, sb = b % 1024, swz = sb ^ (((sb >> 9) & 1) << 5); R = (st >> 1) * 16 + swz / 64; C = (st & 1) * 32 + (swz % 64) / 2; }
__host__ __device__ __forceinline__ int perm32(int rho) { const int n = rho >> 4, i = rho & 15; return 8 * (i >> 2) + 4 * n + (i & 3); }

struct Unit { int pm, pn; };
struct Gemm { const bf16_t* A; const bf16_t* Bt; int M, N, K; };

struct StaticOrder {
    int nM, nN, nwg, G, c;
    __host__ __device__ void init(int M, int N, int G_, int c_) { nM = M / BM; nN = N / BM; nwg = nM * nN; G = G_; c = c_; }
    __host__ __device__ bool next(int i, Unit& u) const {
        const long L = (long)i * G + c; if (L >= nwg) return false;
        int wgid = (int)L; { const int q = nwg / NXCD, r = nwg % NXCD, xcd = wgid % NXCD, off = wgid / NXCD; wgid = (xcd < r ? xcd * (q + 1) : r * (q + 1) + (xcd - r) * q) + off; }
        const int nig = WGM * nN, gid = wgid / nig, fm = gid * WGM, gsz = (nM - fm) < WGM ? (nM - fm) : WGM;
        u.pm = fm + ((wgid % nig) % gsz); u.pn = (wgid % nig) / gsz; return true;
    }
    __device__ __forceinline__ void a_ready(const Unit&) const {}
    __device__ __forceinline__ void done(const Unit&) const {}
};

template <class Epi, class Sched, bool ALIGN_EPI = false, bool SP2 = false>
__device__ __forceinline__ void gemm_phase(PG8_LAS unsigned char* lds, const Gemm g, const Sched& S, const Epi& E, int tid_in) {
    const int tid = tid_in, wid = __builtin_amdgcn_readfirstlane(tid >> 6), lane = tid & 63, wr = wid >> 2, wc = wid & 3, fr = lane & 15, fq = lane >> 4;
    const int K = g.K, nt = K / BK;
    unsigned voffA[2], voffB[2];
#pragma unroll
    for (int i = 0; i < 2; ++i) { int R, C; stage_rc(tid * 16 + i * 8192, R, C); const int Rb = Epi::PERM ? ((R & ~31) + perm32(R & 31)) : R;
        voffA[i] = (unsigned)(R * K + C) * 2u; voffB[i] = (unsigned)(Rb * K + C) * 2u; }
    const size_t kstep = (size_t)(BK * 2);
    const size_t hstep = (size_t)HALF * K * 2;
    const size_t tstep = 2 * hstep;
    const unsigned ldsw = (unsigned)wid * 1024u;
    const int aoff = lds_byte(wr * 64 + fr, fq * 8), boff = lds_byte(wc * 32 + fr, fq * 8);
#define PG8_SA(b, h) (((b) * 2 + (h)) * HTB)
#define PG8_SB(b, h) ((4 + (b) * 2 + (h)) * HTB)
#define PG8_STAGE(bufoff, gbase, voff) do { _Pragma("unroll") for (int _i = 0; _i < 2; ++_i) \
        __builtin_amdgcn_global_load_lds((const unsigned*)((const char*)(gbase) + (voff)[_i]), (PG8_LAS unsigned*)(lds + (bufoff) + ldsw + _i * 8192), 16, 0, 0); } while (0)
#define PG8_LDA(dst, b, h) do { _Pragma("unroll") for (int m = 0; m < 4; ++m) _Pragma("unroll") for (int k = 0; k < 2; ++k) dst[m][k] = *(const PG8_LAS bf16x8*)(lds + PG8_SA(b, h) + aoff + m * 2048 + k * 1024); } while (0)
#define PG8_LDB(dst, b, h) do { _Pragma("unroll") for (int n = 0; n < 2; ++n) _Pragma("unroll") for (int k = 0; k < 2; ++k) dst[n][k] = *(const PG8_LAS bf16x8*)(lds + PG8_SB(b, h) + boff + n * 2048 + k * 1024); } while (0)
#define PG8_MMA(ai, bj, At, Bt) do { __builtin_amdgcn_s_setprio(1); _Pragma("unroll") for (int m = 0; m < 4; ++m) _Pragma("unroll") for (int n = 0; n < 2; ++n) _Pragma("unroll") for (int k = 0; k < 2; ++k) \
        acc[ai][bj][m][n] = __builtin_amdgcn_mfma_f32_16x16x32_bf16(Bt[n][k], At[m][k], acc[ai][bj][m][n], 0, 0, 0); __builtin_amdgcn_s_setprio(0); } while (0)
#define PG8_WAIT_V(n) asm volatile("s_waitcnt vmcnt(" #n ")" ::: "memory")
#define PG8_WAIT_L(n) asm volatile("s_waitcnt lgkmcnt(" #n ")" ::: "memory")
#define PG8_BAR __builtin_amdgcn_s_barrier()
#define PG8_SCHED __builtin_amdgcn_sched_barrier(0)
    Unit cur, nxt; int ui = 0;
    if (!S.next(0, cur)) return;
    f32x4 acc[2][2][4][2];
#pragma unroll
    for (int a = 0; a < 2; ++a)
#pragma unroll
        for (int b = 0; b < 2; ++b)
#pragma unroll
            for (int m = 0; m < 4; ++m)
#pragma unroll
                for (int n = 0; n < 2; ++n) acc[a][b][m][n] = (f32x4){0.f, 0.f, 0.f, 0.f};
    bf16x8 At[4][2], B0[2][2], B1[2][2];
    const char* cA = (const char*)g.A + (size_t)cur.pm * tstep; const char* cB = (const char*)g.Bt + (size_t)cur.pn * tstep;
    S.a_ready(cur);
    if constexpr (SP2) {
        PG8_STAGE(PG8_SB(0, 0), cB, voffB); PG8_STAGE(PG8_SB(0, 1), cB + hstep, voffB); PG8_STAGE(PG8_SA(0, 0), cA, voffA); PG8_STAGE(PG8_SA(0, 1), cA + hstep, voffA);
        if (wr == 1) PG8_BAR;
        PG8_WAIT_V(2); PG8_BAR;
        PG8_STAGE(PG8_SB(1, 0), cB + kstep, voffB); PG8_STAGE(PG8_SA(1, 0), cA + kstep, voffA); PG8_STAGE(PG8_SB(1, 1), cB + hstep + kstep, voffB);
        PG8_WAIT_V(6); PG8_BAR;
    } else {
        PG8_STAGE(PG8_SB(0, 0), cB, voffB); PG8_STAGE(PG8_SA(0, 0), cA, voffA); PG8_STAGE(PG8_SB(0, 1), cB + hstep, voffB); PG8_STAGE(PG8_SA(0, 1), cA + hstep, voffA);
        if (wr == 1) PG8_BAR;
        PG8_WAIT_V(4); PG8_BAR;
        PG8_STAGE(PG8_SB(1, 0), cB + kstep, voffB); PG8_STAGE(PG8_SA(1, 0), cA + kstep, voffA); PG8_STAGE(PG8_SB(1, 1), cB + hstep + kstep, voffB);
        PG8_WAIT_V(6); PG8_BAR;
    }
    for (;;) {
        const bool has_next = S.next(ui + 1, nxt);
        const char* nA = has_next ? (const char*)g.A + (size_t)nxt.pm * tstep : cA; const char* nB = has_next ? (const char*)g.Bt + (size_t)nxt.pn * tstep : cB;
        for (int t = 0; t < nt; t += 2) {
            const bool last = (t == nt - 2);
            const char* a1 = cA + (size_t)(t + 1) * kstep;
            const char* a2 = last ? nA : cA + (size_t)(t + 2) * kstep; const char* b2 = last ? nB : cB + (size_t)(t + 2) * kstep;
            const char* a3 = a2 + kstep; const char* b3 = b2 + kstep;
            if (last && has_next) S.a_ready(nxt);
            if constexpr (SP2) {
            PG8_LDB(B0, 0, 0); PG8_LDB(B1, 0, 1); PG8_SCHED; PG8_LDA(At, 0, 0); PG8_STAGE(PG8_SA(1, 1), a1 + hstep, voffA);
            PG8_WAIT_V(8); PG8_WAIT_L(0); PG8_BAR; PG8_MMA(0, 0, At, B0); PG8_MMA(0, 1, At, B1); PG8_BAR; PG8_SCHED;
            PG8_LDA(At, 0, 1); PG8_STAGE(PG8_SB(0, 0), b2, voffB); PG8_STAGE(PG8_SB(0, 1), b2 + hstep, voffB); PG8_STAGE(PG8_SA(0, 0), a2, voffA);
            PG8_WAIT_V(8); PG8_WAIT_L(0); PG8_BAR; PG8_MMA(1, 0, At, B0); PG8_MMA(1, 1, At, B1); PG8_BAR; PG8_SCHED;
            PG8_LDB(B0, 1, 0); PG8_LDB(B1, 1, 1); PG8_SCHED; PG8_LDA(At, 1, 0); PG8_STAGE(PG8_SA(0, 1), a2 + hstep, voffA);
            PG8_WAIT_V(8); PG8_WAIT_L(0); PG8_BAR; PG8_MMA(0, 0, At, B0); PG8_MMA(0, 1, At, B1); PG8_BAR; PG8_SCHED;
            PG8_LDA(At, 1, 1); PG8_STAGE(PG8_SB(1, 0), b3, voffB); PG8_STAGE(PG8_SB(1, 1), b3 + hstep, voffB); PG8_STAGE(PG8_SA(1, 0), a3, voffA);
            PG8_WAIT_V(8); PG8_WAIT_L(0); PG8_BAR; PG8_MMA(1, 0, At, B0); PG8_MMA(1, 1, At, B1); PG8_BAR; PG8_SCHED;
            } else {
            PG8_LDB(B0, 0, 0); PG8_SCHED; PG8_LDA(At, 0, 0); PG8_STAGE(PG8_SA(1, 1), a1 + hstep, voffA);
            PG8_WAIT_L(8); PG8_BAR; PG8_WAIT_L(0); PG8_MMA(0, 0, At, B0); PG8_BAR; PG8_SCHED;
            PG8_LDB(B1, 0, 1); PG8_STAGE(PG8_SB(0, 0), b2, voffB);
            PG8_BAR; PG8_WAIT_L(0); PG8_MMA(0, 1, At, B1); PG8_BAR;
            PG8_LDA(At, 0, 1); PG8_STAGE(PG8_SA(0, 0), a2, voffA);
            PG8_BAR; PG8_WAIT_L(0); PG8_MMA(1, 0, At, B0); PG8_BAR; PG8_SCHED;
            PG8_STAGE(PG8_SB(0, 1), b2 + hstep, voffB);
            PG8_WAIT_V(6); PG8_BAR; PG8_MMA(1, 1, At, B1); PG8_BAR;
            PG8_LDB(B0, 1, 0); PG8_SCHED; PG8_LDA(At, 1, 0); PG8_STAGE(PG8_SA(0, 1), a2 + hstep, voffA);
            PG8_WAIT_L(8); PG8_BAR; PG8_WAIT_L(0); PG8_MMA(0, 0, At, B0); PG8_BAR; PG8_SCHED;
            PG8_LDB(B1, 1, 1); PG8_STAGE(PG8_SB(1, 0), b3, voffB);
            PG8_BAR; PG8_WAIT_L(0); PG8_MMA(0, 1, At, B1); PG8_BAR;
            PG8_LDA(At, 1, 1); PG8_STAGE(PG8_SA(1, 0), a3, voffA);
            PG8_BAR; PG8_WAIT_L(0); PG8_MMA(1, 0, At, B0); PG8_BAR; PG8_SCHED;
            PG8_STAGE(PG8_SB(1, 1), b3 + hstep, voffB);
            PG8_WAIT_V(6); PG8_BAR; PG8_MMA(1, 1, At, B1); PG8_BAR;
            }
        }
        if constexpr (ALIGN_EPI) { if (wr == 0) PG8_BAR; }
        if constexpr (!Epi::AFTER_DRAIN) { E(acc, cur, wr, wc, fr, fq); S.done(cur); }
        if (!has_next) break;
#pragma unroll
        for (int a = 0; a < 2; ++a)
#pragma unroll
            for (int b = 0; b < 2; ++b)
#pragma unroll
                for (int m = 0; m < 4; ++m)
#pragma unroll
                    for (int n = 0; n < 2; ++n) acc[a][b][m][n] = (f32x4){0.f, 0.f, 0.f, 0.f};
        cur = nxt; cA = nA; cB = nB; ++ui;
        if constexpr (ALIGN_EPI) { if (wr == 1) PG8_BAR; }
    }
    PG8_WAIT_V(0);
    if constexpr (!ALIGN_EPI) { if (wr == 0) PG8_BAR; }
    PG8_BAR;
    if constexpr (Epi::AFTER_DRAIN) { E.fused(acc, cur, wr, wc, fr, fq, lds, wid, lane); S.done(cur); }
#undef PG8_SA
#undef PG8_SB
#undef PG8_STAGE
#undef PG8_LDA
#undef PG8_LDB
#undef PG8_MMA
#undef PG8_WAIT_V
#undef PG8_WAIT_L
#undef PG8_BAR
#undef PG8_SCHED
}
}

#define LAS __attribute__((address_space(3)))
typedef unsigned short bf16_t;
typedef short bf16x8 __attribute__((ext_vector_type(8)));
typedef float f32x4 __attribute__((ext_vector_type(4)));
typedef float f32x16 __attribute__((ext_vector_type(16)));
typedef unsigned u32x4 __attribute__((ext_vector_type(4)));
typedef unsigned u32x2 __attribute__((ext_vector_type(2)));

constexpr int DM = 1024, NBATCH = 16, SEQ = 4096, TLAT = NBATCH * SEQ, LCTX = 256, TCTX = NBATCH * LCTX, MALL = TLAT + TCTX;
constexpr int DFF = 2816, INW = 2304, NWAVES = 8, NTHR = 512;
constexpr int QS = 1536, KS_ = 2048, VS_ = 2176;
constexpr float C2 = 0.125f * 1.4426950408889634f, LOG2E = 1.4426950408889634f;
constexpr size_t MiB = 1u << 20;
constexpr size_t WS_MOD = 1 * MiB, WS_TAB = 3 * MiB, WS_WIN = 4 * MiB, WS_WMIX = 13 * MiB, WS_WF = 17 * MiB, WS_WGU = 21 * MiB, WS_WD = 65 * MiB;
constexpr size_t WS_XC = 88 * MiB, WS_H = 104 * MiB, WS_R = 240 * MiB;
constexpr size_t WS_P = WS_R, WS_CAT = WS_R + 306 * MiB, WS_ACT = WS_R, WS_Z1 = WS_R, WS_ZC = WS_R + 256 * MiB, WS_A1 = WS_R + 272 * MiB, WS_FM = WS_R, WS_END = 1024 * MiB;
constexpr size_t TAB_ROPE = 0, TAB_TW = 64 * 1024, TAB_D1 = 128 * 1024, TAB_D2 = 192 * 1024, TAB_DC = 256 * 1024, TAB_DCTX = 512 * 1024;
constexpr int LDS_BYTES = 147456;

typedef float f32x2_t __attribute__((ext_vector_type(2))); typedef __bf16 bf16x2_t __attribute__((ext_vector_type(2)));
__device__ __forceinline__ unsigned cvt_pk(float lo, float hi) { f32x2_t v = {lo, hi}; bf16x2_t b = __builtin_convertvector(v, bf16x2_t); return __builtin_bit_cast(unsigned, b); }
__device__ __forceinline__ float bf_lo(unsigned w) { return __builtin_bit_cast(float, w << 16); }
__device__ __forceinline__ float bf_hi(unsigned w) { return __builtin_bit_cast(float, w & 0xffff0000u); }
__device__ __forceinline__ float fast_exp2(float x) { return __builtin_amdgcn_exp2f(x); }
__device__ __forceinline__ float fast_rcp(float x) { return __builtin_amdgcn_rcpf(x); }
__device__ __forceinline__ float silu_f(float x) { return x * fast_rcp(1.0f + fast_exp2(-x * LOG2E)); }
#define LDS_WAIT() asm volatile("s_waitcnt lgkmcnt(0)" ::: "memory")

struct Args {
    const float* x; const float* c; const float* ctx; const float* c_ctx; const float* w_ada; const float* b_ada; const float* n1g; const float* n2g;
    const float* w_in; const float* conv_w; const float* sink; const float* w_mix; const float* w_four; const float* w_gate; const float* w_up; const float* w_down; const float* final_g;
    float* out; unsigned char* ws;
    double invf[16];
};

struct EpiInProj {
    static constexpr bool PERM = false, AFTER_DRAIN = false;
    bf16_t* P; const float* rope;
    __device__ __forceinline__ void operator()(const f32x4 (&acc)[2][2][4][2], const pg8::Unit& u, int wr, int wc, int fr, int fq) const {
        const bool lat = u.pm < 256, doq = (u.pn == 6 || u.pn == 7), ropeT = lat && u.pn >= 6;
#pragma unroll
        for (int ai = 0; ai < 2; ++ai)
#pragma unroll
            for (int m = 0; m < 4; ++m) {
                const int row = u.pm * 256 + ai * 128 + wr * 64 + m * 16 + fr;
                f32x4 cv = {1.f, 1.f, 1.f, 1.f}, sv = {0.f, 0.f, 0.f, 0.f};
                if (ropeT) { const int t = row & 4095; const int a = (wc & 1) ? (t & 63) : (t >> 6);
                    const f32x4* rp = (const f32x4*)(rope + (a * 16 + 4 * fq) * 2); const f32x4 c0 = rp[0], c1 = rp[1];
                    cv = (f32x4){c0.x, c0.z, c1.x, c1.z}; sv = (f32x4){c0.y, c0.w, c1.y, c1.w}; }
#pragma unroll
                for (int bj = 0; bj < 2; ++bj) {
                    f32x4 x1 = acc[ai][bj][m][0], x2 = acc[ai][bj][m][1];
                    if (ropeT && !(u.pn == 8 && bj == 1)) { const f32x4 o1 = x1 * cv - x2 * sv, o2 = x2 * cv + x1 * sv; x1 = o1; x2 = o2; }
                    if (doq) { x1 = x1 * C2; x2 = x2 * C2; }
                    bf16_t* p = P + (size_t)row * INW + u.pn * 256 + bj * 128 + wc * 32 + 4 * fq;
                    u32x2 w1, w2; w1.x = cvt_pk(x1[0], x1[1]); w1.y = cvt_pk(x1[2], x1[3]); w2.x = cvt_pk(x2[0], x2[1]); w2.y = cvt_pk(x2[2], x2[3]);
                    *(u32x2*)p = w1; *(u32x2*)(p + 16) = w2;
                }
            }
    }
};
struct EpiRes {
    static constexpr bool PERM = false, AFTER_DRAIN = false;
    const float* in_lat; const float* in_ctx; float* out_lat; float* out_ctx; const float* modl; int gate_idx;
    __device__ __forceinline__ void operator()(const f32x4 (&acc)[2][2][4][2], const pg8::Unit& u, int wr, int wc, int fr, int fq) const {
        const bool lat = u.pm < 256; const int rbase = lat ? u.pm * 256 : u.pm * 256 - TLAT; const int r = lat ? (u.pm >> 4) : 16;
        const float* ip = lat ? in_lat : in_ctx; float* op = lat ? out_lat : out_ctx;
        const float* gate = modl + (r * 6 + gate_idx) * 1024;
#pragma unroll
        for (int ai = 0; ai < 2; ++ai)
#pragma unroll
            for (int m = 0; m < 4; ++m) {
                const int row = rbase + ai * 128 + wr * 64 + m * 16 + fr;
#pragma unroll
                for (int bj = 0; bj < 2; ++bj)
#pragma unroll
                    for (int n = 0; n < 2; ++n) {
                        const int col = u.pn * 256 + bj * 128 + wc * 32 + 16 * n + 4 * fq;
                        const f32x4 gv = *(const f32x4*)(gate + col);
                        const size_t off = (size_t)row * DM + col;
                        const f32x4 xi = *(const f32x4*)(ip + off);
                        *(f32x4*)(op + off) = xi + gv * acc[ai][bj][m][n];
                    }
                if (m & 1) asm volatile("" ::: "memory");
            }
    }
};
struct EpiSwiGLU {
    static constexpr bool PERM = false, AFTER_DRAIN = false;
    bf16_t* ACT;
    __device__ __forceinline__ void operator()(const f32x4 (&acc)[2][2][4][2], const pg8::Unit& u, int wr, int wc, int fr, int fq) const {
#pragma unroll
        for (int ai = 0; ai < 2; ++ai)
#pragma unroll
            for (int m = 0; m < 4; ++m) {
                const int row = u.pm * 256 + ai * 128 + wr * 64 + m * 16 + fr;
#pragma unroll
                for (int bj = 0; bj < 2; ++bj) {
                    const f32x4 g = acc[ai][bj][m][0], v = acc[ai][bj][m][1];
                    const int f = (u.pn * 8 + bj * 4 + wc) * 16 + 4 * fq;
                    u32x2 w; w.x = cvt_pk(silu_f(g[0]) * v[0], silu_f(g[1]) * v[1]); w.y = cvt_pk(silu_f(g[2]) * v[2], silu_f(g[3]) * v[3]);
                    *(u32x2*)(ACT + (size_t)row * DFF + f) = w;
                }
            }
    }
};
struct EpiPlain {
    static constexpr bool PERM = false, AFTER_DRAIN = false;
    bf16_t* O; int ldc;
    __device__ __forceinline__ void operator()(const f32x4 (&acc)[2][2][4][2], const pg8::Unit& u, int wr, int wc, int fr, int fq) const {
#pragma unroll
        for (int ai = 0; ai < 2; ++ai)
#pragma unroll
            for (int m = 0; m < 4; ++m) {
                const int row = u.pm * 256 + ai * 128 + wr * 64 + m * 16 + fr;
#pragma unroll
                for (int bj = 0; bj < 2; ++bj)
#pragma unroll
                    for (int n = 0; n < 2; ++n) {
                        const f32x4 x = acc[ai][bj][m][n]; u32x2 w; w.x = cvt_pk(x[0], x[1]); w.y = cvt_pk(x[2], x[3]);
                        *(u32x2*)(O + (size_t)row * ldc + u.pn * 256 + bj * 128 + wc * 32 + 16 * n + 4 * fq) = w;
                    }
            }
    }
};

__device__ __forceinline__ void sincos_turns(double x, double& s, double& c) {
    x = x - floor(x);
    const double q4 = floor(x * 4.0 + 0.5);
    const double r = x - q4 * 0.25;
    const int q = ((int)q4) & 3;
    const double th = r * 6.283185307179586476925, t2 = th * th;
    const double sp = th * (1.0 + t2 * (-1.0 / 6 + t2 * (1.0 / 120 + t2 * (-1.0 / 5040 + t2 * (1.0 / 362880 + t2 * (-1.0 / 39916800 + t2 * (1.0 / 6227020800.0)))))));
    const double cp = 1.0 + t2 * (-0.5 + t2 * (1.0 / 24 + t2 * (-1.0 / 720 + t2 * (1.0 / 40320 + t2 * (-1.0 / 3628800 + t2 * (1.0 / 479001600.0 + t2 * (-1.0 / 87178291200.0)))))));
    if (q == 0) { s = sp; c = cp; } else if (q == 1) { s = cp; c = -sp; } else if (q == 2) { s = -sp; c = -cp; } else { s = -cp; c = sp; }
}
__device__ __forceinline__ unsigned short f2bf(float f) { return __builtin_bit_cast(unsigned short, (__bf16)f); }

__device__ __forceinline__ void transpose_item(const float* W, int K, int N, bf16_t* WT, int mode, LAS float* scr, int item, int lane) {
    const int nblk = N / 32, kb = item / nblk, nb = item % nblk, k0 = 64 * kb, n0 = 32 * nb;
#pragma unroll 8
    for (int i = 0; i < 32; ++i) { const int kk = 2 * i + (lane >> 5); scr[kk * 33 + (lane & 31)] = W[(size_t)(k0 + kk) * N + n0 + (lane & 31)]; }
    LDS_WAIT(); asm volatile("" ::: "memory");
    const int c = lane & 7;
#pragma unroll
    for (int j = 0; j < 4; ++j) { const int n = (lane >> 3) + 8 * j; const LAS float* s = scr + (8 * c) * 33 + n;
        u32x4 o; o.x = cvt_pk(s[0 * 33], s[1 * 33]); o.y = cvt_pk(s[2 * 33], s[3 * 33]); o.z = cvt_pk(s[4 * 33], s[5 * 33]); o.w = cvt_pk(s[6 * 33], s[7 * 33]);
        const int f = n0 + n; const int orow = (mode == 0) ? f : (((f >> 4) << 5) + (f & 15) + (mode == 2 ? 16 : 0));
        *(u32x4*)(WT + (size_t)orow * K + k0 + 8 * c) = o; }
    LDS_WAIT(); asm volatile("" ::: "memory");
}

__device__ __forceinline__ void prologue(const Args& A, LAS unsigned char* lds, int tid, int wave, int lane, int G) {
    unsigned char* ws = A.ws;
    {
        LAS float* scr = (LAS float*)(lds + wave * 16384);
        const int gw = blockIdx.x * NWAVES + wave, NGW = G * NWAVES;
        constexpr int I_IN = 16 * 72, I_SQ = 16 * 32, I_FF = 16 * 88, I_DN = 44 * 32;
        constexpr int NIT = 2 * I_IN + 4 * I_SQ + 8 * I_FF + 4 * I_DN;
        for (int it = gw; it < NIT; it += NGW) {
            int r = it;
            if (r < 2 * I_IN) { const int e = r / I_IN; transpose_item(A.w_in + (size_t)e * DM * INW, DM, INW, (bf16_t*)(ws + WS_WIN) + (size_t)e * INW * DM, 0, scr, r % I_IN, lane); continue; } r -= 2 * I_IN;
            if (r < 2 * I_SQ) { const int e = r / I_SQ; transpose_item(A.w_mix + (size_t)e * DM * DM, DM, DM, (bf16_t*)(ws + WS_WMIX) + (size_t)e * DM * DM, 0, scr, r % I_SQ, lane); continue; } r -= 2 * I_SQ;
            if (r < 2 * I_SQ) { const int e = r / I_SQ; transpose_item(A.w_four + (size_t)e * DM * DM, DM, DM, (bf16_t*)(ws + WS_WF) + (size_t)e * DM * DM, 0, scr, r % I_SQ, lane); continue; } r -= 2 * I_SQ;
            if (r < 4 * I_FF) { const int l = r / I_FF; transpose_item(A.w_gate + (size_t)l * DM * DFF, DM, DFF, (bf16_t*)(ws + WS_WGU) + (size_t)l * 2 * DFF * DM, 1, scr, r % I_FF, lane); continue; } r -= 4 * I_FF;
            if (r < 4 * I_FF) { const int l = r / I_FF; transpose_item(A.w_up + (size_t)l * DM * DFF, DM, DFF, (bf16_t*)(ws + WS_WGU) + (size_t)l * 2 * DFF * DM, 2, scr, r % I_FF, lane); continue; } r -= 4 * I_FF;
            { const int l = r / I_DN; transpose_item(A.w_down + (size_t)l * DFF * DM, DFF, DM, (bf16_t*)(ws + WS_WD) + (size_t)l * DM * DFF, 0, scr, r % I_DN, lane); }
        }
    }
    {
        const int gt = blockIdx.x * NTHR + tid, NGT = G * NTHR;
        float* rope = (float*)(ws + WS_TAB + TAB_ROPE); float* tw = (float*)(ws + WS_TAB + TAB_TW);
        bf16_t* D1 = (bf16_t*)(ws + WS_TAB + TAB_D1); bf16_t* D2 = (bf16_t*)(ws + WS_TAB + TAB_D2); bf16_t* DC = (bf16_t*)(ws + WS_TAB + TAB_DC); bf16_t* DX = (bf16_t*)(ws + WS_TAB + TAB_DCTX);
        constexpr int N_ROPE = 1024, N_TW = 4096, N_D1 = 16384, N_D2 = 8192, N_DC = 131072, N_DX = 131072;
        for (int i = gt; i < N_ROPE + N_TW + N_D1 + N_D2 + N_DC + N_DX; i += NGT) {
            int r = i; double s, c;
            if (r < N_ROPE) { const int a = r >> 4, f = r & 15; sincos_turns((double)a * A.invf[f] * 0.15915494309189533577, s, c); rope[2 * r] = (float)c; rope[2 * r + 1] = (float)s; continue; } r -= N_ROPE;
            if (r < N_TW) { const int k1 = r >> 6, n2 = r & 63; sincos_turns((double)(k1 * n2) / 4096.0, s, c); tw[2 * r] = (float)c; tw[2 * r + 1] = (float)s; continue; } r -= N_TW;
            if (r < N_D1) { const int row = r >> 7, col = r & 127, k1 = row >> 1, rio = row & 1, rii = col >> 6, n1 = col & 63; sincos_turns((double)((k1 * n1) & 63) / 64.0, s, c);
                const double v = (rio == rii) ? c : (rio == 0 ? s : -s); D1[r] = f2bf((float)(v * 0.125)); continue; } r -= N_D1;
            if (r < N_D2) { const int k2 = r >> 7, col = r & 127, ri = col >> 6, n2 = col & 63; sincos_turns((double)((k2 * n2) & 63) / 64.0, s, c); D2[r] = f2bf((float)((ri ? s : c) * 0.125)); continue; } r -= N_D2;
            if (r < N_DC) { const int row = r >> 8, cc = r & 255, ri = row >> 8, m = row & 255; sincos_turns((double)((m * cc) & 255) / 256.0, s, c); DC[r] = f2bf((float)((ri ? -s : c) * 0.0625)); continue; } r -= N_DC;
            { const int k = r >> 9, col = r & 511, ri = col >> 8, n = col & 255; sincos_turns((double)((k * n) & 255) / 256.0, s, c); DX[r] = f2bf((float)((ri ? s : c) * 0.0625)); }
        }
    }
    __syncthreads();
    {
        LAS float* S = (LAS float*)lds; LAS float* Pp = (LAS float*)(lds + 69632);
        for (int i = tid; i < 17 * 1024; i += NTHR) { const int r = i >> 10, k = i & 1023; const float v = (r < 16) ? A.c[r * 1024 + k] : A.c_ctx[k]; S[i] = v / (1.0f + expf(-v)); }
        __syncthreads();
        float* mod = (float*)(ws + WS_MOD);
        for (int task = blockIdx.x; task < 4 * 96; task += G) {
            const int l = task / 96, j0 = (task % 96) * 64;
            const float* w = A.w_ada + (size_t)l * 1024 * 6144 + j0 + lane;
            float acc[17];
#pragma unroll
            for (int r = 0; r < 17; ++r) acc[r] = 0.f;
#pragma unroll 4
            for (int kk = 0; kk < 128; ++kk) { const int k = wave * 128 + kk; const float wv = w[(size_t)k * 6144];
#pragma unroll
                for (int r = 0; r < 17; ++r) acc[r] += S[r * 1024 + k] * wv; }
#pragma unroll
            for (int r = 0; r < 17; ++r) Pp[(wave * 17 + r) * 64 + lane] = acc[r];
            __syncthreads();
            for (int o = tid; o < 17 * 64; o += NTHR) { const int r = o >> 6, jj = o & 63; float sum = 0.f;
#pragma unroll
                for (int w8 = 0; w8 < 8; ++w8) sum += Pp[(w8 * 17 + r) * 64 + jj];
                mod[(size_t)(l * 17 + r) * 6144 + j0 + jj] = sum + A.b_ada[l * 6144 + j0 + jj]; }
            __syncthreads();
        }
    }
}

__device__ __forceinline__ void norm_phase(const float* lat, const float* ctxp, const float* g, const float* modl, int shift_idx, bf16_t* hout, int M, int gw, int NGW, int lane) {
    constexpr int NR = 4;
    f32x4 gv[4];
#pragma unroll
    for (int j = 0; j < 4; ++j) gv[j] = *(const f32x4*)(g + 4 * lane + 256 * j);
    for (int row0 = gw * NR; row0 < M; row0 += NGW * NR) {
        f32x4 v[NR][4];
#pragma unroll
        for (int q = 0; q < NR; ++q) { const int row = row0 + q; const float* xr = (row < TLAT) ? lat + (size_t)row * DM : ctxp + (size_t)(row - TLAT) * DM;
#pragma unroll
            for (int j = 0; j < 4; ++j) v[q][j] = *(const f32x4*)(xr + 4 * lane + 256 * j); }
        const int r = (row0 < TLAT) ? (row0 >> 12) : 16;
        const float* sh = modl + (r * 6 + shift_idx) * 1024; const float* sc = sh + 1024;
        f32x4 scv[4], shv[4];
#pragma unroll
        for (int j = 0; j < 4; ++j) { scv[j] = *(const f32x4*)(sc + 4 * lane + 256 * j); scv[j] = (scv[j] + 1.0f) * gv[j]; shv[j] = *(const f32x4*)(sh + 4 * lane + 256 * j); }
#pragma unroll
        for (int q = 0; q < NR; ++q) { float ss = 0.f;
#pragma unroll
            for (int j = 0; j < 4; ++j) ss += (v[q][j].x * v[q][j].x + v[q][j].y * v[q][j].y) + (v[q][j].z * v[q][j].z + v[q][j].w * v[q][j].w);
#pragma unroll
            for (int o = 1; o < 64; o <<= 1) ss += __shfl_xor(ss, o);
            const float rstd = 1.0f / sqrtf(ss * (1.0f / DM) + 1e-6f);
#pragma unroll
            for (int j = 0; j < 4; ++j) { const f32x4 o = v[q][j] * rstd * scv[j] + shv[j];
                u32x2 w; w.x = cvt_pk(o.x, o.y); w.y = cvt_pk(o.z, o.w);
                *(u32x2*)(hout + (size_t)(row0 + q) * DM + 4 * lane + 256 * j) = w; } }
    }
}
__device__ __forceinline__ void final_norm_phase(float* xo, const float* g, int gw, int NGW, int lane) {
    constexpr int NR = 4;
    f32x4 gv[4];
#pragma unroll
    for (int j = 0; j < 4; ++j) gv[j] = *(const f32x4*)(g + 4 * lane + 256 * j);
    for (int row0 = gw * NR; row0 < TLAT; row0 += NGW * NR) {
        f32x4 v[NR][4];
#pragma unroll
        for (int q = 0; q < NR; ++q)
#pragma unroll
            for (int j = 0; j < 4; ++j) v[q][j] = *(const f32x4*)(xo + (size_t)(row0 + q) * DM + 4 * lane + 256 * j);
#pragma unroll
        for (int q = 0; q < NR; ++q) { float ss = 0.f;
#pragma unroll
            for (int j = 0; j < 4; ++j) ss += (v[q][j].x * v[q][j].x + v[q][j].y * v[q][j].y) + (v[q][j].z * v[q][j].z + v[q][j].w * v[q][j].w);
#pragma unroll
            for (int o = 1; o < 64; o <<= 1) ss += __shfl_xor(ss, o);
            const float rstd = 1.0f / sqrtf(ss * (1.0f / DM) + 1e-6f);
#pragma unroll
            for (int j = 0; j < 4; ++j) *(f32x4*)(xo + (size_t)(row0 + q) * DM + 4 * lane + 256 * j) = v[q][j] * rstd * gv[j]; }
    }
}

__device__ __forceinline__ int crow(int r, int hi) { return (r & 3) + 8 * (r >> 2) + 4 * hi; }

__device__ __forceinline__ void attn_phase(LAS unsigned char* lds, const bf16_t* P, bf16_t* cat, const float* sink, bool ctxq, int G, int tid, int wave, int lane) {
    constexpr int KROW = 144, VROW = 264;
    LAS unsigned char* Kl = lds; LAS unsigned char* Vl = lds + 128 * KROW;
    const int r32 = lane & 31, hi = lane >> 5, g = wave & 3, qh = wave >> 2;
    const int nitems = 1024 + (ctxq ? 64 : 0);
    for (int it = blockIdx.x; it < nitems; it += G) {
        int b, hk, qb, qr0; const bool isl = it < 1024;
        if (isl) { b = it >> 6; hk = (it >> 5) & 1; qb = it & 31; qr0 = b * SEQ + qb * 128; }
        else { const int j = it - 1024; b = j >> 2; hk = (j >> 1) & 1; qb = j & 1; qr0 = TLAT + b * LCTX + qb * 128; }
        const int crow0 = TLAT + b * LCTX, head = hk * 4 + g;
        bf16x8 qf[2][4];
#pragma unroll
        for (int s = 0; s < 2; ++s)
#pragma unroll
            for (int ks = 0; ks < 4; ++ks) qf[s][ks] = *(const bf16x8*)(P + (size_t)(qr0 + 64 * qh + 32 * s + r32) * INW + QS + head * 64 + 16 * ks + 8 * hi);
        float mrun[2], lrun[2]; f32x16 O[2][2];
        const float sk2 = sink[head] * LOG2E;
#pragma unroll
        for (int s = 0; s < 2; ++s) { mrun[s] = sk2; lrun[s] = 1.0f;
#pragma unroll
            for (int dt = 0; dt < 2; ++dt)
#pragma unroll
                for (int r = 0; r < 16; ++r) O[s][dt][r] = 0.f; }
#pragma unroll 1
        for (int ti = 0; ti < 5; ++ti) {
            int krow0, mtype = 0; bool valid = true;
            if (ti == 0) { krow0 = qr0 - 128; mtype = 1; valid = isl && qb > 0; }
            else if (ti == 1) { krow0 = qr0; valid = isl; }
            else if (ti == 2) { krow0 = qr0 + 128; mtype = 2; valid = isl && qb < 31; }
            else { krow0 = crow0 + (ti - 3) * 128; }
            if (!valid) continue;
            __syncthreads();
#pragma unroll
            for (int i = 0; i < 2; ++i) { const int id = tid + NTHR * i, key = id >> 3, c = id & 7;
                const u32x4 v = *(const u32x4*)(P + (size_t)(krow0 + key) * INW + KS_ + hk * 64 + 8 * c);
                *(LAS u32x4*)(Kl + key * KROW + c * 16) = v; }
#pragma unroll
            for (int i = 0; i < 2; ++i) { const int id = tid + NTHR * i, key = id & 127, c = id >> 7;
                const u32x4 v = *(const u32x4*)(P + (size_t)(krow0 + key) * INW + VS_ + hk * 64 + 8 * c);
                LAS unsigned char* vp = Vl + (8 * c) * VROW + key * 2;
                *(LAS unsigned short*)(vp + 0 * VROW) = (unsigned short)(v.x & 0xffffu); *(LAS unsigned short*)(vp + 1 * VROW) = (unsigned short)(v.x >> 16);
                *(LAS unsigned short*)(vp + 2 * VROW) = (unsigned short)(v.y & 0xffffu); *(LAS unsigned short*)(vp + 3 * VROW) = (unsigned short)(v.y >> 16);
                *(LAS unsigned short*)(vp + 4 * VROW) = (unsigned short)(v.z & 0xffffu); *(LAS unsigned short*)(vp + 5 * VROW) = (unsigned short)(v.z >> 16);
                *(LAS unsigned short*)(vp + 6 * VROW) = (unsigned short)(v.w & 0xffffu); *(LAS unsigned short*)(vp + 7 * VROW) = (unsigned short)(v.w >> 16); }
            __syncthreads();
#pragma unroll
            for (int half = 0; half < 2; ++half)
#pragma unroll
                for (int s = 0; s < 2; ++s) {
                    f32x16 S[2];
#pragma unroll
                    for (int rt = 0; rt < 2; ++rt) {
#pragma unroll
                        for (int r = 0; r < 16; ++r) S[rt][r] = 0.f;
#ifndef DIAG
                        asm volatile("" : "+v"(S[rt]));
#endif
#pragma unroll
                        for (int ks = 0; ks < 4; ++ks) { const bf16x8 kf = *(const LAS bf16x8*)(Kl + (64 * half + 32 * rt + r32) * KROW + (16 * ks + 8 * hi) * 2);
                            S[rt] = __builtin_amdgcn_mfma_f32_32x32x16_bf16(kf, qf[s][ks], S[rt], 0, 0, 0); }
                    }
                    if (mtype != 0) { int il = 64 * qh + 32 * s + r32; asm volatile("" : "+v"(il));
#pragma unroll
                        for (int rt = 0; rt < 2; ++rt)
#pragma unroll
                            for (int r = 0; r < 16; ++r) { const int jl = 64 * half + 32 * rt + crow(r, hi); const bool ok = (mtype == 1) ? (jl >= il) : (jl <= il); if (!ok) S[rt][r] = -INFINITY; } }
                    float tmax = S[0][0];
#pragma unroll
                    for (int rt = 0; rt < 2; ++rt)
#pragma unroll
                        for (int r = 0; r < 16; ++r) tmax = fmaxf(tmax, S[rt][r]);
                    tmax = fmaxf(tmax, __shfl_xor(tmax, 32));
                    const float mnew = fmaxf(mrun[s], tmax), alpha = fast_exp2(mrun[s] - mnew);
                    mrun[s] = mnew;
                    float psum = 0.f;
#pragma unroll
                    for (int rt = 0; rt < 2; ++rt)
#pragma unroll
                        for (int r = 0; r < 16; ++r) { const float p = fast_exp2(S[rt][r] - mnew); S[rt][r] = p; psum += p; }
                    psum += __shfl_xor(psum, 32);
                    lrun[s] = lrun[s] * alpha + psum;
#pragma unroll
                    for (int dt = 0; dt < 2; ++dt)
#pragma unroll
                        for (int r = 0; r < 16; ++r) O[s][dt][r] *= alpha;
#pragma unroll
                    for (int rt = 0; rt < 2; ++rt)
#pragma unroll
                        for (int s2 = 0; s2 < 2; ++s2) {
                            u32x4 pw; pw.x = cvt_pk(S[rt][8 * s2 + 0], S[rt][8 * s2 + 1]); pw.y = cvt_pk(S[rt][8 * s2 + 2], S[rt][8 * s2 + 3]);
                            pw.z = cvt_pk(S[rt][8 * s2 + 4], S[rt][8 * s2 + 5]); pw.w = cvt_pk(S[rt][8 * s2 + 6], S[rt][8 * s2 + 7]);
                            const bf16x8 pf = __builtin_bit_cast(bf16x8, pw);
#pragma unroll
                            for (int dt = 0; dt < 2; ++dt) {
                                const LAS unsigned char* vb = Vl + (32 * dt + r32) * VROW + (64 * half + 32 * rt + 16 * s2 + 4 * hi) * 2;
                                const u32x2 v0 = *(const LAS u32x2*)vb, v1 = *(const LAS u32x2*)(vb + 16);
                                const u32x4 vv = {v0.x, v0.y, v1.x, v1.y};
                                O[s][dt] = __builtin_amdgcn_mfma_f32_32x32x16_bf16(__builtin_bit_cast(bf16x8, vv), pf, O[s][dt], 0, 0, 0);
                            }
                        }
                }
        }
#pragma unroll
        for (int s = 0; s < 2; ++s) { const float inv = 1.0f / lrun[s];
            bf16_t* orow = cat + (size_t)(qr0 + 64 * qh + 32 * s + r32) * DM + 512 + head * 64;
#pragma unroll
            for (int dt = 0; dt < 2; ++dt)
#pragma unroll
                for (int q4 = 0; q4 < 4; ++q4) { u32x2 w; w.x = cvt_pk(O[s][dt][4 * q4 + 0] * inv, O[s][dt][4 * q4 + 1] * inv); w.y = cvt_pk(O[s][dt][4 * q4 + 2] * inv, O[s][dt][4 * q4 + 3] * inv);
                    *(u32x2*)(orow + 32 * dt + 8 * q4 + 4 * hi) = w; } }
    }
    __syncthreads();
}

__device__ __forceinline__ void load_u(const bf16_t* P, int t, int s0, int s1, int c8, float (&u)[8]) {
    if (t < s0 || t >= s1) {
#pragma unroll
        for (int j = 0; j < 8; ++j) u[j] = 0.f;
    } else {
        const u32x4 cv = *(const u32x4*)(P + (size_t)t * INW + 512 + 8 * c8), hv = *(const u32x4*)(P + (size_t)t * INW + 1024 + 8 * c8);
        u[0] = bf_lo(cv.x) * bf_lo(hv.x); u[1] = bf_hi(cv.x) * bf_hi(hv.x); u[2] = bf_lo(cv.y) * bf_lo(hv.y); u[3] = bf_hi(cv.y) * bf_hi(hv.y);
        u[4] = bf_lo(cv.z) * bf_lo(hv.z); u[5] = bf_hi(cv.z) * bf_hi(hv.z); u[6] = bf_lo(cv.w) * bf_lo(hv.w); u[7] = bf_hi(cv.w) * bf_hi(hv.w);
    }
}
__device__ __forceinline__ void conv_phase(const bf16_t* P, bf16_t* cat, const float* cw, int M, int G, int tid) {
    const int c8 = tid & 63, tg = tid >> 6;
    float w0[8], w1[8], w2[8];
#pragma unroll
    for (int j = 0; j < 8; ++j) { w0[j] = cw[8 * c8 + j]; w1[j] = cw[512 + 8 * c8 + j]; w2[j] = cw[1024 + 8 * c8 + j]; }
    for (int it = blockIdx.x; it < M / 128; it += G) {
        const int t0 = it * 128, ts = t0 + 16 * tg;
        int s0, s1; if (t0 < TLAT) { s0 = t0 & ~4095; s1 = s0 + 4096; } else { s0 = TLAT + ((t0 - TLAT) & ~255); s1 = s0 + 256; }
        float up[8], uc[8], un[8];
        load_u(P, ts - 1, s0, s1, c8, up); load_u(P, ts, s0, s1, c8, uc);
#pragma unroll 2
        for (int i = 0; i < 16; ++i) { const int t = ts + i;
            load_u(P, t + 1, s0, s1, c8, un);
            const u32x4 bv = *(const u32x4*)(P + (size_t)t * INW + 8 * c8);
            float bb[8] = {bf_lo(bv.x), bf_hi(bv.x), bf_lo(bv.y), bf_hi(bv.y), bf_lo(bv.z), bf_hi(bv.z), bf_lo(bv.w), bf_hi(bv.w)};
            float o[8];
#pragma unroll
            for (int j = 0; j < 8; ++j) { o[j] = bb[j] * (w0[j] * up[j] + w1[j] * uc[j] + w2[j] * un[j]); up[j] = uc[j]; uc[j] = un[j]; }
            u32x4 w; w.x = cvt_pk(o[0], o[1]); w.y = cvt_pk(o[2], o[3]); w.z = cvt_pk(o[4], o[5]); w.w = cvt_pk(o[6], o[7]);
            *(u32x4*)(cat + (size_t)t * DM + 8 * c8) = w; }
    }
}

template <int MT, int KS> __device__ __forceinline__ void dft_load_a(bf16x8 (&a)[MT][KS], const bf16_t* Mat, int row0, int r32, int hi) {
#pragma unroll
    for (int rt = 0; rt < MT; ++rt)
#pragma unroll
        for (int ks = 0; ks < KS; ++ks) a[rt][ks] = *(const bf16x8*)(Mat + (size_t)(row0 + 32 * rt + r32) * (KS * 16) + 16 * ks + 8 * hi);
}
template <int MT, int KS> __device__ __forceinline__ void dft_mm(f32x16 (&acc)[MT], const bf16x8 (&a)[MT][KS], const bf16_t* vec) {
#pragma unroll
    for (int rt = 0; rt < MT; ++rt)
#pragma unroll
        for (int r = 0; r < 16; ++r) acc[rt][r] = 0.f;
#pragma unroll
    for (int rt = 0; rt < MT; ++rt) asm volatile("" : "+v"(acc[rt]));
    constexpr int KC = 8;
#pragma unroll
    for (int kc = 0; kc < KS / KC; ++kc) {
        bf16x8 b[KC];
#pragma unroll
        for (int i = 0; i < KC; ++i) b[i] = *(const bf16x8*)(vec + 16 * (kc * KC + i));
#pragma unroll
        for (int i = 0; i < KC; ++i)
#pragma unroll
            for (int rt = 0; rt < MT; ++rt) acc[rt] = __builtin_amdgcn_mfma_f32_32x32x16_bf16(a[rt][kc * KC + i], b[i], acc[rt], 0, 0, 0);
    }
}
__device__ __forceinline__ void dft_ld8(bf16x8 (&b)[8], const bf16_t* vec) {
#pragma unroll
    for (int i = 0; i < 8; ++i) b[i] = *(const bf16x8*)(vec + 16 * i);
}
template <int MT> __device__ __forceinline__ void dft_zero(f32x16 (&acc)[MT]) {
#pragma unroll
    for (int rt = 0; rt < MT; ++rt) {
#pragma unroll
        for (int r = 0; r < 16; ++r) acc[rt][r] = 0.f;
        asm volatile("" : "+v"(acc[rt]));
    }
}
template <int MT, int KS, int K0> __device__ __forceinline__ void dft_mma8(f32x16 (&acc)[MT], const bf16x8 (&a)[MT][KS], const bf16x8 (&b)[8]) {
#pragma unroll
    for (int i = 0; i < 8; ++i)
#pragma unroll
        for (int rt = 0; rt < MT; ++rt) acc[rt] = __builtin_amdgcn_mfma_f32_32x32x16_bf16(a[rt][K0 + i], b[i], acc[rt], 0, 0, 0);
}
__device__ __forceinline__ const bf16_t* fa_vec(const bf16_t* H, int tile, int r32, int hi) {
    int token, g;
    if (tile < 8192) { const int n1h = tile & 1, n2 = (tile >> 1) & 63, b = tile >> 9; g = (tile >> 7) & 3; token = b * SEQ + 64 * (32 * n1h + r32) + n2; }
    else { const int tc = tile - 8192, nq = tc & 7, b = tc >> 5; g = (tc >> 3) & 3; token = TLAT + b * LCTX + 32 * nq + r32; }
    return H + (size_t)token * DM + g * 256 + 8 * hi;
}
__device__ __forceinline__ void fourier_a(const bf16_t* H, const bf16_t* DC, bf16_t* Z1, bf16_t* Zc, bool with_ctx, int G, int wave, int lane) {
    const int r32 = lane & 31, hi = lane >> 5, sl = wave;
    bf16x8 a[2][16]; dft_load_a<2, 16>(a, DC, 64 * sl, r32, hi);
    const int ntile = 8192 + (with_ctx ? 512 : 0);
    bf16x8 b0[8], b1[8];
    int tile = blockIdx.x;
    if (tile < ntile) dft_ld8(b0, fa_vec(H, tile, r32, hi));
    for (; tile < ntile; tile += G) {
        dft_ld8(b1, fa_vec(H, tile, r32, hi) + 128);
        f32x16 acc[2]; dft_zero<2>(acc);
        dft_mma8<2, 16, 0>(acc, a, b0);
        if (tile + G < ntile) dft_ld8(b0, fa_vec(H, tile + G, r32, hi));
        dft_mma8<2, 16, 8>(acc, a, b1);
        if (tile < 8192) {
            const int n1h = tile & 1, n2 = (tile >> 1) & 63, g = (tile >> 7) & 3, b = tile >> 9;
            size_t zo = ((((size_t)((b * 4 + g) * 256 + 64 * (sl & 3) + 4 * hi)) * 64 + n2) * 2 + (sl >> 2)) * 64 + 32 * n1h + r32;
            asm volatile("" : "+v"(zo));
#pragma unroll
            for (int rt = 0; rt < 2; ++rt)
#pragma unroll
                for (int r = 0; r < 16; ++r) Z1[zo + (size_t)(32 * rt + (r & 3) + 8 * (r >> 2)) * 8192] = f2bf(acc[rt][r]);
        } else {
            const int tc = tile - 8192, nq = tc & 7, g = (tc >> 3) & 3, b = tc >> 5;
            size_t zo = (((size_t)((b * 4 + g) * 256 + 64 * (sl & 3) + 4 * hi)) * 2 + (sl >> 2)) * 256 + 32 * nq + r32;
            asm volatile("" : "+v"(zo));
#pragma unroll
            for (int rt = 0; rt < 2; ++rt)
#pragma unroll
                for (int r = 0; r < 16; ++r) Zc[zo + (size_t)(32 * rt + (r & 3) + 8 * (r >> 2)) * 512] = f2bf(acc[rt][r]);
        }
    }
}
__device__ __forceinline__ void fourier_s1(const bf16_t* Z1, const bf16_t* D1, const float* tw, bf16_t* A1p, int G, int wave, int lane) {
    const int r32 = lane & 31, hi = lane >> 5, sl = wave & 1;
    bf16x8 a[2][8]; dft_load_a<2, 8>(a, D1, 64 * sl, r32, hi);
    bf16x8 bc[8], bn[8];
    int tile = blockIdx.x * 4 + (wave >> 1); const int step = G * 4;
    if (tile < 32768) dft_ld8(bc, Z1 + ((size_t)tile * 32 + r32) * 128 + 8 * hi);
    for (; tile < 32768; tile += step) {
        if (tile + step < 32768) dft_ld8(bn, Z1 + ((size_t)(tile + step) * 32 + r32) * 128 + 8 * hi);
        f32x16 acc[2]; dft_zero<2>(acc);
        dft_mma8<2, 8, 0>(acc, a, bc);
        const int n2 = 32 * (tile & 1) + r32, bgm = tile >> 1, bg = bgm >> 8, m = bgm & 255;
        size_t ao = ((((size_t)(bg * 64 + 32 * sl + 2 * hi)) * 256 + m) * 2) * 64 + n2;
        int two = 2 * ((32 * sl + 2 * hi) * 64 + n2);
        asm volatile("" : "+v"(ao), "+v"(two));
#pragma unroll
        for (int rt = 0; rt < 2; ++rt)
#pragma unroll
            for (int q4 = 0; q4 < 4; ++q4)
#pragma unroll
                for (int e = 0; e < 2; ++e) { const int dk = 16 * rt + 4 * q4 + e;
                    const float re = acc[rt][4 * q4 + 2 * e], im = acc[rt][4 * q4 + 2 * e + 1];
                    const float2 cs = *(const float2*)(tw + two + dk * 128);
                    const float re2 = re * cs.x + im * cs.y, im2 = im * cs.x - re * cs.y;
                    A1p[ao + (size_t)dk * 32768] = f2bf(re2); A1p[ao + (size_t)dk * 32768 + 64] = f2bf(im2); }
#pragma unroll
        for (int i = 0; i < 8; ++i) bc[i] = bn[i];
    }
}
__device__ __forceinline__ void fourier_s2(const bf16_t* A1p, const bf16_t* D2, const bf16_t* Zc, const bf16_t* DX, bf16_t* FM, bool with_ctx, int G, int gw, int NGW, int wave, int lane) {
    const int r32 = lane & 31, hi = lane >> 5;
    {
        bf16x8 a[2][8]; dft_load_a<2, 8>(a, D2, 0, r32, hi);
        bf16x8 bc[8], bn[8];
        int tile = gw;
        if (tile < 32768) dft_ld8(bc, A1p + ((size_t)tile * 32 + r32) * 128 + 8 * hi);
        for (; tile < 32768; tile += NGW) {
            if (tile + NGW < 32768) dft_ld8(bn, A1p + ((size_t)(tile + NGW) * 32 + r32) * 128 + 8 * hi);
            f32x16 acc[2]; dft_zero<2>(acc);
            dft_mma8<2, 8, 0>(acc, a, bc);
            const int m = 32 * (tile & 7) + r32, k1 = (tile >> 3) & 63, bg = tile >> 9, b = bg >> 2, g = bg & 3;
            size_t fo = (size_t)(b * SEQ + k1 + 256 * hi) * DM + g * 256 + m;
            asm volatile("" : "+v"(fo));
#pragma unroll
            for (int rt = 0; rt < 2; ++rt)
#pragma unroll
                for (int r = 0; r < 16; ++r) FM[fo + (size_t)(32 * rt + (r & 3) + 8 * (r >> 2)) * 65536] = f2bf(acc[rt][r]);
#pragma unroll
            for (int i = 0; i < 8; ++i) bc[i] = bn[i];
        }
    }
    if (with_ctx) {
        for (int tile = blockIdx.x; tile < 512; tile += G) {
            f32x16 acc;
#pragma unroll
            for (int r = 0; r < 16; ++r) acc[r] = 0.f;
            asm volatile("" : "+v"(acc));
            const bf16_t* ap = DX + (size_t)(32 * wave + r32) * 512 + 8 * hi;
            const bf16_t* bp = Zc + ((size_t)tile * 32 + r32) * 512 + 8 * hi;
#pragma unroll 1
            for (int kc = 0; kc < 4; ++kc) {
                bf16x8 av[8], bv[8];
#pragma unroll
                for (int i = 0; i < 8; ++i) { av[i] = *(const bf16x8*)(ap + 16 * (kc * 8 + i)); bv[i] = *(const bf16x8*)(bp + 16 * (kc * 8 + i)); }
#pragma unroll
                for (int i = 0; i < 8; ++i) acc = __builtin_amdgcn_mfma_f32_32x32x16_bf16(av[i], bv[i], acc, 0, 0, 0);
            }
            const int m = 32 * (tile & 7) + r32, bg = tile >> 3, b = bg >> 2, g = bg & 3;
            size_t fo = (size_t)(TLAT + b * LCTX + 32 * wave + 4 * hi) * DM + g * 256 + m;
            asm volatile("" : "+v"(fo));
#pragma unroll
            for (int r = 0; r < 16; ++r) FM[fo + (size_t)((r & 3) + 8 * (r >> 2)) * 1024] = f2bf(acc[r]);
        }
    }
}


#ifdef DIAG
__device__ __forceinline__ void diag_scan(unsigned* ctl, const void* buf, size_t bytes, bool is_bf16, int stage) {
    const size_t n16 = bytes / 16; const u32x4* p = (const u32x4*)buf; bool bad = false;
    int ln = (int)__builtin_amdgcn_mbcnt_hi(~0u, __builtin_amdgcn_mbcnt_lo(~0u, 0u)); asm volatile("" : "+v"(ln)); ln += 64 * __builtin_amdgcn_readfirstlane((int)threadIdx.x >> 6);
    for (size_t i = (size_t)blockIdx.x * NTHR + ln; i < n16; i += (size_t)gridDim.x * NTHR) {
        const u32x4 v = p[i];
        if (is_bf16) { for (int q = 0; q < 4; ++q) { const unsigned w = v[q]; if (((w >> 7) & 0xff) == 0xff || ((w >> 23) & 0xff) == 0xff) bad = true; } }
        else { for (int q = 0; q < 4; ++q) { if (((v[q] >> 23) & 0xff) >= 0xf0) bad = true; } }
    }
    if (bad) atomicMin(ctl, (unsigned)stage);
}
#define DIAG_SCAN(buf, bytes, isbf, stage) diag_scan((unsigned*)ws, buf, bytes, isbf, stage)
#else
#define DIAG_SCAN(buf, bytes, isbf, stage) do {} while (0)
#endif

#ifdef DIAG2
__device__ __forceinline__ void diag_max(unsigned* ctl, const void* buf, size_t bytes) {
    const size_t n16 = bytes / 16; const u32x4* p = (const u32x4*)buf; unsigned mx = 0, nb = 0;
    int ln = (int)__builtin_amdgcn_mbcnt_hi(~0u, __builtin_amdgcn_mbcnt_lo(~0u, 0u)); asm volatile("" : "+v"(ln)); ln += 64 * __builtin_amdgcn_readfirstlane((int)threadIdx.x >> 6);
    for (size_t i = (size_t)blockIdx.x * NTHR + ln; i < n16; i += (size_t)gridDim.x * NTHR) {
        const u32x4 v = p[i];
        for (int q = 0; q < 4; ++q) { const unsigned lo = (v[q] << 16) & 0x7fffffffu, hi = v[q] & 0x7fff0000u;
            if ((lo >> 23) == 0xff) ++nb; else mx = mx > lo ? mx : lo;
            if ((hi >> 23) == 0xff) ++nb; else mx = mx > hi ? mx : hi; }
    }
    atomicMax(ctl + 1, mx); if (nb) atomicAdd(ctl + 2, nb);
}
#endif

#ifdef TSEL
#define TBEG(c) do { if ((TSEL >> (c)) & 1) t0_ = __builtin_amdgcn_s_memrealtime(); } while (0)
#define TEND(c) do { if ((TSEL >> (c)) & 1) tacc_ += __builtin_amdgcn_s_memrealtime() - t0_; } while (0)
#else
#define TBEG(c) do {} while (0)
#define TEND(c) do {} while (0)
#endif
__global__ void __launch_bounds__(NTHR, 2) fwd_megakernel(Args A) {
    extern __shared__ __attribute__((aligned(16))) unsigned char lds_raw[];
    cg::grid_group grid = cg::this_grid();
#define GRID_SYNC() do { asm volatile("s_waitcnt vmcnt(0) lgkmcnt(0)" ::: "memory"); grid.sync(); } while (0)
    LAS unsigned char* lds = (LAS unsigned char*)lds_raw;
    const int wave = __builtin_amdgcn_readfirstlane((int)threadIdx.x >> 6);
#define FRESH_LANE(v) int v = LANE_ID(); asm volatile("" : "+v"(v))
#define LANE_ID() ((int)__builtin_amdgcn_mbcnt_hi(~0u, __builtin_amdgcn_mbcnt_lo(~0u, 0u)))
    const int lane = LANE_ID(), tid = wave * 64 + lane;
    const int G = gridDim.x, gw = blockIdx.x * NWAVES + wave, NGW = G * NWAVES;
    unsigned char* ws = A.ws;
#ifdef TSEL
    unsigned long long t0_ = 0, tacc_ = 0;
#endif
#ifdef DIAG
    if (blockIdx.x == 0 && threadIdx.x == 0) *(unsigned*)ws = 0x7fffffffu;
#endif
#ifdef DIAG2
    if (blockIdx.x == 0 && threadIdx.x == 0) { ((unsigned*)ws)[1] = 0u; ((unsigned*)ws)[2] = 0u; }
#endif
    float* mod = (float*)(ws + WS_MOD);
    const float* rope = (const float*)(ws + WS_TAB + TAB_ROPE); const float* tw = (const float*)(ws + WS_TAB + TAB_TW);
    const bf16_t* D1 = (const bf16_t*)(ws + WS_TAB + TAB_D1); const bf16_t* D2 = (const bf16_t*)(ws + WS_TAB + TAB_D2);
    const bf16_t* DC = (const bf16_t*)(ws + WS_TAB + TAB_DC); const bf16_t* DX = (const bf16_t*)(ws + WS_TAB + TAB_DCTX);
    float* xc = (float*)(ws + WS_XC);
    bf16_t* Hb = (bf16_t*)(ws + WS_H); bf16_t* Pb = (bf16_t*)(ws + WS_P); bf16_t* CAT = (bf16_t*)(ws + WS_CAT); bf16_t* ACT = (bf16_t*)(ws + WS_ACT);
    bf16_t* Z1 = (bf16_t*)(ws + WS_Z1); bf16_t* Zc = (bf16_t*)(ws + WS_ZC); bf16_t* A1p = (bf16_t*)(ws + WS_A1); bf16_t* FM = (bf16_t*)(ws + WS_FM);


#ifndef SKIP_PRO
        TBEG(10);
    prologue(A, lds, tid, wave, lane, G);
#endif

    GRID_SYNC();
        TEND(10);

    DIAG_SCAN(mod, 4 * 17 * 6144 * 4, false, 1); DIAG_SCAN(ws + WS_WIN, (size_t)83 * MiB, true, 2); DIAG_SCAN(ws + WS_TAB + TAB_D1, 640 * 1024, true, 3); DIAG_SCAN(ws + WS_TAB, 96 * 1024, false, 4);
#pragma unroll 1
    for (int l = 0; l < 4; ++l) {
        const bool even = (l & 1) == 0; const int e = l >> 1;
        const bool ctx_after = l < 2;
        const bool ctx_here = l < 3;
        const int Mfull = ctx_here ? MALL : TLAT;
        const int Mres = ctx_after ? MALL : TLAT;
        const float* modl = mod + (size_t)l * 17 * 6144;
        const float* xin_lat = (l == 0) ? A.x : A.out; const float* xin_ctx = (l == 0) ? A.ctx : xc;
        TBEG(4);
        { FRESH_LANE(lane_l); const int tid_l = wave * 64 + lane_l; (void)tid_l; norm_phase(xin_lat, xin_ctx, A.n1g + l * DM, modl, 0, Hb, Mfull, gw, NGW, lane_l); }
        GRID_SYNC();
        TEND(4);
        DIAG_SCAN(Hb, (size_t)Mfull * DM * 2, true, 10 + 10 * l);
        const bf16_t* mixA; const bf16_t* mixW;
        if (even) {
        TBEG(0);
            { int tg = LANE_ID(); asm volatile("" : "+v"(tg)); tg += wave * 64; pg8::Gemm g{Hb, (const bf16_t*)(ws + WS_WIN) + (size_t)e * INW * DM, Mfull, INW, DM}; pg8::StaticOrder S; S.init(Mfull, INW, G, (int)blockIdx.x);
              EpiInProj E{Pb, rope};
              pg8::gemm_phase<EpiInProj, pg8::StaticOrder, true, true>(lds, g, S, E, tg); }
            GRID_SYNC();
        TEND(0);
        DIAG_SCAN(Pb, (size_t)Mfull * INW * 2, true, 11 + 10 * l);

#ifndef SKIP_ATT
        TBEG(5);
            { FRESH_LANE(lane_l); const int tid_l = wave * 64 + lane_l; (void)tid_l; attn_phase(lds, Pb, CAT, A.sink + e * 8, ctx_after, G, tid_l, wave, lane_l); }
        TEND(5);
#endif


#ifndef SKIP_CONV
        TBEG(6);
            { FRESH_LANE(lane_l); const int tid_l = wave * 64 + lane_l; (void)tid_l; conv_phase(Pb, CAT, A.conv_w + e * 3 * 512, Mres, G, tid_l); }
#endif

            GRID_SYNC();
        TEND(6);
        DIAG_SCAN(CAT, (size_t)Mres * DM * 2, true, 12 + 10 * l);
            mixA = CAT; mixW = (const bf16_t*)(ws + WS_WMIX) + (size_t)e * DM * DM;
        } else {

#ifndef SKIP_FA
        TBEG(7);
            { FRESH_LANE(lane_l); const int tid_l = wave * 64 + lane_l; (void)tid_l; fourier_a(Hb, DC, Z1, Zc, ctx_after, G, wave, lane_l); }
#endif

            GRID_SYNC();
        TEND(7);
        DIAG_SCAN(Z1, (size_t)128 * MiB, true, 11 + 10 * l); DIAG_SCAN(Z1 + 64 * MiB, (size_t)128 * MiB, true, 12 + 10 * l); DIAG_SCAN(Zc, (size_t)16 * MiB, true, 13 + 10 * l);
#ifdef DIAG2
        if (l == DIAG2_L) diag_max((unsigned*)ws, DIAG2_BUF, DIAG2_BYTES);
#endif

#ifndef SKIP_S1
        TBEG(8);
            { FRESH_LANE(lane_l); const int tid_l = wave * 64 + lane_l; (void)tid_l; fourier_s1(Z1, D1, tw, A1p, G, wave, lane_l); }
#endif

            GRID_SYNC();
        TEND(8);
        DIAG_SCAN(A1p, (size_t)256 * MiB, true, 14 + 10 * l);

#ifndef SKIP_S2
        TBEG(9);
            { FRESH_LANE(lane_l); const int tid_l = wave * 64 + lane_l; (void)tid_l; fourier_s2(A1p, D2, Zc, DX, FM, ctx_after, G, gw, NGW, wave, lane_l); }
#endif

            GRID_SYNC();
        TEND(9);
        DIAG_SCAN(FM, (size_t)Mres * DM * 2, true, 15 + 10 * l);
            mixA = FM; mixW = (const bf16_t*)(ws + WS_WF) + (size_t)e * DM * DM;
        }
        TBEG(1);
        { int tg = LANE_ID(); asm volatile("" : "+v"(tg)); tg += wave * 64; pg8::Gemm g{mixA, mixW, Mres, DM, DM}; pg8::StaticOrder S; S.init(Mres, DM, G, (int)blockIdx.x);
          EpiRes E{xin_lat, xin_ctx, A.out, xc, modl, 2};
          pg8::gemm_phase<EpiRes, pg8::StaticOrder, true, true>(lds, g, S, E, tg); }
        GRID_SYNC();
        TEND(1);
        DIAG_SCAN(A.out, (size_t)TLAT * DM * 4, false, 16 + 10 * l);
        TBEG(4);
        { FRESH_LANE(lane_l); const int tid_l = wave * 64 + lane_l; (void)tid_l; norm_phase(A.out, xc, A.n2g + l * DM, modl, 3, Hb, Mres, gw, NGW, lane_l); }
        GRID_SYNC();
        TEND(4);
        DIAG_SCAN(Hb, (size_t)Mres * DM * 2, true, 17 + 10 * l);
        TBEG(2);
        { int tg = LANE_ID(); asm volatile("" : "+v"(tg)); tg += wave * 64; pg8::Gemm g{Hb, (const bf16_t*)(ws + WS_WGU) + (size_t)l * 2 * DFF * DM, Mres, 2 * DFF, DM}; pg8::StaticOrder S; S.init(Mres, 2 * DFF, G, (int)blockIdx.x);
          EpiSwiGLU E{ACT};
          pg8::gemm_phase<EpiSwiGLU, pg8::StaticOrder, true, true>(lds, g, S, E, tg); }
        GRID_SYNC();
        TEND(2);
        DIAG_SCAN(ACT, (size_t)Mres * DFF * 2, true, 18 + 10 * l);
        TBEG(3);
        { int tg = LANE_ID(); asm volatile("" : "+v"(tg)); tg += wave * 64; pg8::Gemm g{ACT, (const bf16_t*)(ws + WS_WD) + (size_t)l * DM * DFF, Mres, DM, DFF}; pg8::StaticOrder S; S.init(Mres, DM, G, (int)blockIdx.x);
          EpiRes E{A.out, xc, A.out, xc, modl, 5};
          pg8::gemm_phase<EpiRes, pg8::StaticOrder, true, true>(lds, g, S, E, tg); }
        GRID_SYNC();
        TEND(3);
        DIAG_SCAN(A.out, (size_t)TLAT * DM * 4, false, 19 + 10 * l);
    }
    { int lane_f = LANE_ID(); asm volatile("" : "+v"(lane_f)); final_norm_phase(A.out, A.final_g, gw, NGW, lane_f); }
#ifdef TSEL
    if (blockIdx.x == 0) { const unsigned long long ts_ = __builtin_amdgcn_s_memrealtime(); while (__builtin_amdgcn_s_memrealtime() - ts_ < (unsigned long long)TMULT * tacc_) __builtin_amdgcn_s_sleep(8); }
#endif
#ifdef DIAG2
    GRID_SYNC();
    if (blockIdx.x == 0 && threadIdx.x == 0) { const unsigned mx = ((volatile unsigned*)ws)[1], nb = ((volatile unsigned*)ws)[2]; A.out[0] = 1000.f * __builtin_bit_cast(float, mx); A.out[1] = nb ? 1e9f + 1000.f * (float)nb : 0.f; }
#endif
#ifdef DIAG
    GRID_SYNC();
    if (blockIdx.x == 0 && threadIdx.x == 0) { const unsigned c = *(volatile unsigned*)ws; A.out[0] = (c == 0x7fffffffu) ? 999000.f : 1000.f * (float)c; }
#endif
}

extern "C" void kernel_launch(void* const* d_in, const int* in_sizes, int n_in, void* d_out, int out_size, void* d_ws, size_t ws_size, hipStream_t stream) {
    static int grid = 0;
    if (grid == 0) {
        if (n_in != 17 || out_size != TLAT * DM || ws_size < WS_END) { fprintf(stderr, "kernel_launch: unexpected shapes (n_in %d, out %d, ws %zu)\n", n_in, out_size, ws_size); grid = -1; return; }
        int dev = 0, cus = 0, per_cu = 0;
        hipGetDevice(&dev); hipDeviceGetAttribute(&cus, hipDeviceAttributeMultiprocessorCount, dev);
        if (hipFuncSetAttribute((const void*)fwd_megakernel, hipFuncAttributeMaxDynamicSharedMemorySize, LDS_BYTES) != hipSuccess) { fprintf(stderr, "kernel_launch: hipFuncSetAttribute failed\n"); grid = -1; return; }
        if (hipOccupancyMaxActiveBlocksPerMultiprocessor(&per_cu, (const void*)fwd_megakernel, NTHR, LDS_BYTES) != hipSuccess || per_cu < 1) { fprintf(stderr, "kernel_launch: occupancy query says %d\n", per_cu); per_cu = 1; }
        (void)hipGetLastError();
        grid = cus * 1;
    }
    if (grid < 0) return;
    Args a{};
    a.x = (const float*)d_in[0]; a.c = (const float*)d_in[1]; a.ctx = (const float*)d_in[2]; a.c_ctx = (const float*)d_in[3]; a.w_ada = (const float*)d_in[4]; a.b_ada = (const float*)d_in[5];
    a.n1g = (const float*)d_in[6]; a.n2g = (const float*)d_in[7]; a.w_in = (const float*)d_in[8]; a.conv_w = (const float*)d_in[9]; a.sink = (const float*)d_in[10]; a.w_mix = (const float*)d_in[11];
    a.w_four = (const float*)d_in[12]; a.w_gate = (const float*)d_in[13]; a.w_up = (const float*)d_in[14]; a.w_down = (const float*)d_in[15]; a.final_g = (const float*)d_in[16];
    a.out = (float*)d_out; a.ws = (unsigned char*)d_ws;
    for (int f = 0; f < 16; ++f) a.invf[f] = pow(10000.0, -(double)f / 16.0);
    void* args[] = {&a};
    hipError_t e = hipLaunchCooperativeKernel((const void*)fwd_megakernel, dim3(grid), dim3(NTHR), args, LDS_BYTES, stream);
    if (e != hipSuccess) fprintf(stderr, "kernel_launch: cooperative launch failed: %s (grid %d)\n", hipGetErrorString(e), grid);
}
```

```cpp
#include <hip/hip_runtime.h>
#include <hip/hip_cooperative_groups.h>
#include <cstdio>
#include <cstdint>
#include <cmath>
namespace cg = cooperative_groups;

namespace pg8 {
#define PG8_LAS __attribute__((address_space(3)))
typedef unsigned short bf16_t;
typedef short bf16x8 __attribute__((ext_vector_type(8)));
typedef float f32x4 __attribute__((ext_vector_type(4)));
typedef unsigned u32x4 __attribute__((ext_vector_type(4)));
constexpr int BM = 256, BK = 64, HALF = 128, HTB = HALF * BK * 2  , STAGE_BYTES = 8 * HTB, NXCD = 8, WGM = 8;

__host__ __device__ __forceinline__ int lds_byte(int r, int c) { const int st = (r >> 4) * 2 + (c >> 5), rr = r & 15, cc = c & 31, ob = rr * 64 + cc * 2; return st * 1024 + (ob ^ (((ob >> 9) & 1) << 5)); }
__host__ __device__ __forceinline__ void stage_rc(int b, int& R, int& C) { const int st = b / 1024, sb = b % 1024, swz = sb ^ (((sb >> 9) & 1) << 5); R = (st >> 1) * 16 + swz / 64; C = (st & 1) * 32 + (swz % 64) / 2; }
__host__ __device__ __forceinline__ int perm32(int rho) { const int n = rho >> 4, i = rho & 15; return 8 * (i >> 2) + 4 * n + (i & 3); }

struct Unit { int pm, pn; };
struct Gemm { const bf16_t* A; const bf16_t* Bt; int M, N, K; };

struct StaticOrder {
    int nM, nN, nwg, G, c;
    __host__ __device__ void init(int M, int N, int G_, int c_) { nM = M / BM; nN = N / BM; nwg = nM * nN; G = G_; c = c_; }
    __host__ __device__ bool next(int i, Unit& u) const {
        const long L = (long)i * G + c; if (L >= nwg) return false;
        int wgid = (int)L; { const int q = nwg / NXCD, r = nwg % NXCD, xcd = wgid % NXCD, off = wgid / NXCD; wgid = (xcd < r ? xcd * (q + 1) : r * (q + 1) + (xcd - r) * q) + off; }
        const int nig = WGM * nN, gid = wgid / nig, fm = gid * WGM, gsz = (nM - fm) < WGM ? (nM - fm) : WGM;
        u.pm = fm + ((wgid % nig) % gsz); u.pn = (wgid % nig) / gsz; return true;
    }
    __device__ __forceinline__ void a_ready(const Unit&) const {}
    __device__ __forceinline__ void done(const Unit&) const {}
};

template <class Epi, class Sched, bool ALIGN_EPI = false, bool SP2 = false>
__device__ __forceinline__ void gemm_phase(PG8_LAS unsigned char* lds, const Gemm g, const Sched& S, const Epi& E, int tid_in) {
    const int tid = tid_in, wid = __builtin_amdgcn_readfirstlane(tid >> 6), lane = tid & 63, wr = wid >> 2, wc = wid & 3, fr = lane & 15, fq = lane >> 4;
    const int K = g.K, nt = K / BK;
    unsigned voffA[2], voffB[2];
#pragma unroll
    for (int i = 0; i < 2; ++i) { int R, C; stage_rc(tid * 16 + i * 8192, R, C); const int Rb = Epi::PERM ? ((R & ~31) + perm32(R & 31)) : R;
        voffA[i] = (unsigned)(R * K + C) * 2u; voffB[i] = (unsigned)(Rb * K + C) * 2u; }
    const size_t kstep = (size_t)(BK * 2);
    const size_t hstep = (size_t)HALF * K * 2;
    const size_t tstep = 2 * hstep;
    const unsigned ldsw = (unsigned)wid * 1024u;
    const int aoff = lds_byte(wr * 64 + fr, fq * 8), boff = lds_byte(wc * 32 + fr, fq * 8);
#define PG8_SA(b, h) (((b) * 2 + (h)) * HTB)
#define PG8_SB(b, h) ((4 + (b) * 2 + (h)) * HTB)
#define PG8_STAGE(bufoff, gbase, voff) do { _Pragma("unroll") for (int _i = 0; _i < 2; ++_i) \
        __builtin_amdgcn_global_load_lds((const unsigned*)((const char*)(gbase) + (voff)[_i]), (PG8_LAS unsigned*)(lds + (bufoff) + ldsw + _i * 8192), 16, 0, 0); } while (0)
#define PG8_LDA(dst, b, h) do { _Pragma("unroll") for (int m = 0; m < 4; ++m) _Pragma("unroll") for (int k = 0; k < 2; ++k) dst[m][k] = *(const PG8_LAS bf16x8*)(lds + PG8_SA(b, h) + aoff + m * 2048 + k * 1024); } while (0)
#define PG8_LDB(dst, b, h) do { _Pragma("unroll") for (int n = 0; n < 2; ++n) _Pragma("unroll") for (int k = 0; k < 2; ++k) dst[n][k] = *(const PG8_LAS bf16x8*)(lds + PG8_SB(b, h) + boff + n * 2048 + k * 1024); } while (0)
#define PG8_MMA(ai, bj, At, Bt) do { __builtin_amdgcn_s_setprio(1); _Pragma("unroll") for (int m = 0; m < 4; ++m) _Pragma("unroll") for (int n = 0; n < 2; ++n) _Pragma("unroll") for (int k = 0; k < 2; ++k) \
        acc[ai][bj][m][n] = __builtin_amdgcn_mfma_f32_16x16x32_bf16(Bt[n][k], At[m][k], acc[ai][bj][m][n], 0, 0, 0); __builtin_amdgcn_s_setprio(0); } while (0)
#define PG8_WAIT_V(n) asm volatile("s_waitcnt vmcnt(" #n ")" ::: "memory")
#define PG8_WAIT_L(n) asm volatile("s_waitcnt lgkmcnt(" #n ")" ::: "memory")
#define PG8_BAR __builtin_amdgcn_s_barrier()
#define PG8_SCHED __builtin_amdgcn_sched_barrier(0)
    Unit cur, nxt; int ui = 0;
    if (!S.next(0, cur)) return;
    f32x4 acc[2][2][4][2];
#pragma unroll
    for (int a = 0; a < 2; ++a)
#pragma unroll
        for (int b = 0; b < 2; ++b)
#pragma unroll
            for (int m = 0; m < 4; ++m)
#pragma unroll
                for (int n = 0; n < 2; ++n) acc[a][b][m][n] = (f32x4){0.f, 0.f, 0.f, 0.f};
    bf16x8 At[4][2], B0[2][2], B1[2][2];
    const char* cA = (const char*)g.A + (size_t)cur.pm * tstep; const char* cB = (const char*)g.Bt + (size_t)cur.pn * tstep;
    S.a_ready(cur);
    if constexpr (SP2) {
        PG8_STAGE(PG8_SB(0, 0), cB, voffB); PG8_STAGE(PG8_SB(0, 1), cB + hstep, voffB); PG8_STAGE(PG8_SA(0, 0), cA, voffA); PG8_STAGE(PG8_SA(0, 1), cA + hstep, voffA);
        if (wr == 1) PG8_BAR;
        PG8_WAIT_V(2); PG8_BAR;
        PG8_STAGE(PG8_SB(1, 0), cB + kstep, voffB); PG8_STAGE(PG8_SA(1, 0), cA + kstep, voffA); PG8_STAGE(PG8_SB(1, 1), cB + hstep + kstep, voffB);
        PG8_WAIT_V(6); PG8_BAR;
    } else {
        PG8_STAGE(PG8_SB(0, 0), cB, voffB); PG8_STAGE(PG8_SA(0, 0), cA, voffA); PG8_STAGE(PG8_SB(0, 1), cB + hstep, voffB); PG8_STAGE(PG8_SA(0, 1), cA + hstep, voffA);
        if (wr == 1) PG8_BAR;
        PG8_WAIT_V(4); PG8_BAR;
        PG8_STAGE(PG8_SB(1, 0), cB + kstep, voffB); PG8_STAGE(PG8_SA(1, 0), cA + kstep, voffA); PG8_STAGE(PG8_SB(1, 1), cB + hstep + kstep, voffB);
        PG8_WAIT_V(6); PG8_BAR;
    }
    for (;;) {
        const bool has_next = S.next(ui + 1, nxt);
        const char* nA = has_next ? (const char*)g.A + (size_t)nxt.pm * tstep : cA; const char* nB = has_next ? (const char*)g.Bt + (size_t)nxt.pn * tstep : cB;
        for (int t = 0; t < nt; t += 2) {
            const bool last = (t == nt - 2);
            const char* a1 = cA + (size_t)(t + 1) * kstep;
            const char* a2 = last ? nA : cA + (size_t)(t + 2) * kstep; const char* b2 = last ? nB : cB + (size_t)(t + 2) * kstep;
            const char* a3 = a2 + kstep; const char* b3 = b2 + kstep;
            if (last && has_next) S.a_ready(nxt);
            if constexpr (SP2) {
            PG8_LDB(B0, 0, 0); PG8_LDB(B1, 0, 1); PG8_SCHED; PG8_LDA(At, 0, 0); PG8_STAGE(PG8_SA(1, 1), a1 + hstep, voffA);
            PG8_WAIT_V(8); PG8_WAIT_L(0); PG8_BAR; PG8_MMA(0, 0, At, B0); PG8_MMA(0, 1, At, B1); PG8_BAR; PG8_SCHED;
            PG8_LDA(At, 0, 1); PG8_STAGE(PG8_SB(0, 0), b2, voffB); PG8_STAGE(PG8_SB(0, 1), b2 + hstep, voffB); PG8_STAGE(PG8_SA(0, 0), a2, voffA);
            PG8_WAIT_V(8); PG8_WAIT_L(0); PG8_BAR; PG8_MMA(1, 0, At, B0); PG8_MMA(1, 1, At, B1); PG8_BAR; PG8_SCHED;
            PG8_LDB(B0, 1, 0); PG8_LDB(B1, 1, 1); PG8_SCHED; PG8_LDA(At, 1, 0); PG8_STAGE(PG8_SA(0, 1), a2 + hstep, voffA);
            PG8_WAIT_V(8); PG8_WAIT_L(0); PG8_BAR; PG8_MMA(0, 0, At, B0); PG8_MMA(0, 1, At, B1); PG8_BAR; PG8_SCHED;
            PG8_LDA(At, 1, 1); PG8_STAGE(PG8_SB(1, 0), b3, voffB); PG8_STAGE(PG8_SB(1, 1), b3 + hstep, voffB); PG8_STAGE(PG8_SA(1, 0), a3, voffA);
            PG8_WAIT_V(8); PG8_WAIT_L(0); PG8_BAR; PG8_MMA(1, 0, At, B0); PG8_MMA(1, 1, At, B1); PG8_BAR; PG8_SCHED;
            } else {
            PG8_LDB(B0, 0, 0); PG8_SCHED; PG8_LDA(At, 0, 0); PG8_STAGE(PG8_SA(1, 1), a1 + hstep, voffA);
            PG8_WAIT_L(8); PG8_BAR; PG8_WAIT_L(0); PG8_MMA(0, 0, At, B0); PG8_BAR; PG8_SCHED;
            PG8_LDB(B1, 0, 1); PG8_STAGE(PG8_SB(0, 0), b2, voffB);
            PG8_BAR; PG8_WAIT_L(0); PG8_MMA(0, 1, At, B1); PG8_BAR;
            PG8_LDA(At, 0, 1); PG8_STAGE(PG8_SA(0, 0), a2, voffA);
            PG8_BAR; PG8_WAIT_L(0); PG8_MMA(1, 0, At, B0); PG8_BAR; PG8_SCHED;
            PG8_STAGE(PG8_SB(0, 1), b2 + hstep, voffB);
            PG8_WAIT_V(6); PG8_BAR; PG8_MMA(1, 1, At, B1); PG8_BAR;
            PG8_LDB(B0, 1, 0); PG8_SCHED; PG8_LDA(At, 1, 0); PG8_STAGE(PG8_SA(0, 1), a2 + hstep, voffA);
            PG8_WAIT_L(8); PG8_BAR; PG8_WAIT_L(0); PG8_MMA(0, 0, At, B0); PG8_BAR; PG8_SCHED;
            PG8_LDB(B1, 1, 1); PG8_STAGE(PG8_SB(1, 0), b3, voffB);
            PG8_BAR; PG8_WAIT_L(0); PG8_MMA(0, 1, At, B1); PG8_BAR;
            PG8_LDA(At, 1, 1); PG8_STAGE(PG8_SA(1, 0), a3, voffA);
            PG8_BAR; PG8_WAIT_L(0); PG8_MMA(1, 0, At, B0); PG8_BAR; PG8_SCHED;
            PG8_STAGE(PG8_SB(1, 1), b3 + hstep, voffB);
            PG8_WAIT_V(6); PG8_BAR; PG8_MMA(1, 1, At, B1); PG8_BAR;
            }
        }
        if constexpr (ALIGN_EPI) { if (wr == 0) PG8_BAR; }
        if constexpr (!Epi::AFTER_DRAIN) { E(acc, cur, wr, wc, fr, fq); S.done(cur); }
        if (!has_next) break;
#pragma unroll
        for (int a = 0; a < 2; ++a)
#pragma unroll
            for (int b = 0; b < 2; ++b)
#pragma unroll
                for (int m = 0; m < 4; ++m)
#pragma unroll
                    for (int n = 0; n < 2; ++n) acc[a][b][m][n] = (f32x4){0.f, 0.f, 0.f, 0.f};
        cur = nxt; cA = nA; cB = nB; ++ui;
        if constexpr (ALIGN_EPI) { if (wr == 1) PG8_BAR; }
    }
    PG8_WAIT_V(0);
    if constexpr (!ALIGN_EPI) { if (wr == 0) PG8_BAR; }
    PG8_BAR;
    if constexpr (Epi::AFTER_DRAIN) { E.fused(acc, cur, wr, wc, fr, fq, lds, wid, lane); S.done(cur); }
#undef PG8_SA
#undef PG8_SB
#undef PG8_STAGE
#undef PG8_LDA
#undef PG8_LDB
#undef PG8_MMA
#undef PG8_WAIT_V
#undef PG8_WAIT_L
#undef PG8_BAR
#undef PG8_SCHED
}
}

#define LAS __attribute__((address_space(3)))
typedef unsigned short bf16_t;
typedef short bf16x8 __attribute__((ext_vector_type(8)));
typedef float f32x4 __attribute__((ext_vector_type(4)));
typedef float f32x16 __attribute__((ext_vector_type(16)));
typedef unsigned u32x4 __attribute__((ext_vector_type(4)));
typedef unsigned u32x2 __attribute__((ext_vector_type(2)));

constexpr int DM = 1024, NBATCH = 16, SEQ = 4096, TLAT = NBATCH * SEQ, LCTX = 256, TCTX = NBATCH * LCTX, MALL = TLAT + TCTX;
constexpr int DFF = 2816, INW = 2304, NWAVES = 8, NTHR = 512;
constexpr int QS = 1536, KS_ = 2048, VS_ = 2176;
constexpr float C2 = 0.125f * 1.4426950408889634f, LOG2E = 1.4426950408889634f;
constexpr size_t MiB = 1u << 20;
constexpr size_t WS_MOD = 1 * MiB, WS_TAB = 3 * MiB, WS_WIN = 4 * MiB, WS_WMIX = 13 * MiB, WS_WF = 17 * MiB, WS_WGU = 21 * MiB, WS_WD = 65 * MiB;
constexpr size_t WS_XC = 88 * MiB, WS_H = 104 * MiB, WS_R = 240 * MiB;
constexpr size_t WS_P = WS_R, WS_CAT = WS_R + 306 * MiB, WS_ACT = WS_R, WS_Z1 = WS_R, WS_ZC = WS_R + 256 * MiB, WS_A1 = WS_R + 272 * MiB, WS_FM = WS_R, WS_END = 1024 * MiB;
constexpr size_t TAB_ROPE = 0, TAB_TW = 64 * 1024, TAB_D1 = 128 * 1024, TAB_D2 = 192 * 1024, TAB_DC = 256 * 1024, TAB_DCTX = 512 * 1024;
constexpr int LDS_BYTES = 147456;

typedef float f32x2_t __attribute__((ext_vector_type(2))); typedef __bf16 bf16x2_t __attribute__((ext_vector_type(2)));
__device__ __forceinline__ unsigned cvt_pk(float lo, float hi) { f32x2_t v = {lo, hi}; bf16x2_t b = __builtin_convertvector(v, bf16x2_t); return __builtin_bit_cast(unsigned, b); }
__device__ __forceinline__ float bf_lo(unsigned w) { return __builtin_bit_cast(float, w << 16); }
__device__ __forceinline__ float bf_hi(unsigned w) { return __builtin_bit_cast(float, w & 0xffff0000u); }
__device__ __forceinline__ float fast_exp2(float x) { return __builtin_amdgcn_exp2f(x); }
__device__ __forceinline__ float fast_rcp(float x) { return __builtin_amdgcn_rcpf(x); }
__device__ __forceinline__ float silu_f(float x) { return x * fast_rcp(1.0f + fast_exp2(-x * LOG2E)); }
#define LDS_WAIT() asm volatile("s_waitcnt lgkmcnt(0)" ::: "memory")

struct Args {
    const float* x; const float* c; const float* ctx; const float* c_ctx; const float* w_ada; const float* b_ada; const float* n1g; const float* n2g;
    const float* w_in; const float* conv_w; const float* sink; const float* w_mix; const float* w_four; const float* w_gate; const float* w_up; const float* w_down; const float* final_g;
    float* out; unsigned char* ws;
    double invf[16];
};

struct EpiInProj {
    static constexpr bool PERM = false, AFTER_DRAIN = false;
    bf16_t* P; const float* rope;
    __device__ __forceinline__ void operator()(const f32x4 (&acc)[2][2][4][2], const pg8::Unit& u, int wr, int wc, int fr, int fq) const {
        const bool lat = u.pm < 256, doq = (u.pn == 6 || u.pn == 7), ropeT = lat && u.pn >= 6;
#pragma unroll
        for (int ai = 0; ai < 2; ++ai)
#pragma unroll
            for (int m = 0; m < 4; ++m) {
                const int row = u.pm * 256 + ai * 128 + wr * 64 + m * 16 + fr;
                f32x4 cv = {1.f, 1.f, 1.f, 1.f}, sv = {0.f, 0.f, 0.f, 0.f};
                if (ropeT) { const int t = row & 4095; const int a = (wc & 1) ? (t & 63) : (t >> 6);
                    const f32x4* rp = (const f32x4*)(rope + (a * 16 + 4 * fq) * 2); const f32x4 c0 = rp[0], c1 = rp[1];
                    cv = (f32x4){c0.x, c0.z, c1.x, c1.z}; sv = (f32x4){c0.y, c0.w, c1.y, c1.w}; }
#pragma unroll
                for (int bj = 0; bj < 2; ++bj) {
                    f32x4 x1 = acc[ai][bj][m][0], x2 = acc[ai][bj][m][1];
                    if (ropeT && !(u.pn == 8 && bj == 1)) { const f32x4 o1 = x1 * cv - x2 * sv, o2 = x2 * cv + x1 * sv; x1 = o1; x2 = o2; }
                    if (doq) { x1 = x1 * C2; x2 = x2 * C2; }
                    bf16_t* p = P + (size_t)row * INW + u.pn * 256 + bj * 128 + wc * 32 + 4 * fq;
                    u32x2 w1, w2; w1.x = cvt_pk(x1[0], x1[1]); w1.y = cvt_pk(x1[2], x1[3]); w2.x = cvt_pk(x2[0], x2[1]); w2.y = cvt_pk(x2[2], x2[3]);
                    *(u32x2*)p = w1; *(u32x2*)(p + 16) = w2;
                }
            }
    }
};
struct EpiRes {
    static constexpr bool PERM = false, AFTER_DRAIN = false;
    const float* in_lat; const float* in_ctx; float* out_lat; float* out_ctx; const float* modl; int gate_idx;
    __device__ __forceinline__ void operator()(const f32x4 (&acc)[2][2][4][2], const pg8::Unit& u, int wr, int wc, int fr, int fq) const {
        const bool lat = u.pm < 256; const int rbase = lat ? u.pm * 256 : u.pm * 256 - TLAT; const int r = lat ? (u.pm >> 4) : 16;
        const float* ip = lat ? in_lat : in_ctx; float* op = lat ? out_lat : out_ctx;
        const float* gate = modl + (r * 6 + gate_idx) * 1024;
#pragma unroll
        for (int ai = 0; ai < 2; ++ai)
#pragma unroll
            for (int m = 0; m < 4; ++m) {
                const int row = rbase + ai * 128 + wr * 64 + m * 16 + fr;
#pragma unroll
                for (int bj = 0; bj < 2; ++bj)
#pragma unroll
                    for (int n = 0; n < 2; ++n) {
                        const int col = u.pn * 256 + bj * 128 + wc * 32 + 16 * n + 4 * fq;
                        const f32x4 gv = *(const f32x4*)(gate + col);
                        const size_t off = (size_t)row * DM + col;
                        const f32x4 xi = *(const f32x4*)(ip + off);
                        *(f32x4*)(op + off) = xi + gv * acc[ai][bj][m][n];
                    }
                if (m & 1) asm volatile("" ::: "memory");
            }
    }
};
struct EpiSwiGLU {
    static constexpr bool PERM = false, AFTER_DRAIN = false;
    bf16_t* ACT;
    __device__ __forceinline__ void operator()(const f32x4 (&acc)[2][2][4][2], const pg8::Unit& u, int wr, int wc, int fr, int fq) const {
#pragma unroll
        for (int ai = 0; ai < 2; ++ai)
#pragma unroll
            for (int m = 0; m < 4; ++m) {
                const int row = u.pm * 256 + ai * 128 + wr * 64 + m * 16 + fr;
#pragma unroll
                for (int bj = 0; bj < 2; ++bj) {
                    const f32x4 g = acc[ai][bj][m][0], v = acc[ai][bj][m][1];
                    const int f = (u.pn * 8 + bj * 4 + wc) * 16 + 4 * fq;
                    u32x2 w; w.x = cvt_pk(silu_f(g[0]) * v[0], silu_f(g[1]) * v[1]); w.y = cvt_pk(silu_f(g[2]) * v[2], silu_f(g[3]) * v[3]);
                    *(u32x2*)(ACT + (size_t)row * DFF + f) = w;
                }
            }
    }
};
struct EpiPlain {
    static constexpr bool PERM = false, AFTER_DRAIN = false;
    bf16_t* O; int ldc;
    __device__ __forceinline__ void operator()(const f32x4 (&acc)[2][2][4][2], const pg8::Unit& u, int wr, int wc, int fr, int fq) const {
#pragma unroll
        for (int ai = 0; ai < 2; ++ai)
#pragma unroll
            for (int m = 0; m < 4; ++m) {
                const int row = u.pm * 256 + ai * 128 + wr * 64 + m * 16 + fr;
#pragma unroll
                for (int bj = 0; bj < 2; ++bj)
#pragma unroll
                    for (int n = 0; n < 2; ++n) {
                        const f32x4 x = acc[ai][bj][m][n]; u32x2 w; w.x = cvt_pk(x[0], x[1]); w.y = cvt_pk(x[2], x[3]);
                        *(u32x2*)(O + (size_t)row * ldc + u.pn * 256 + bj * 128 + wc * 32 + 16 * n + 4 * fq) = w;
                    }
            }
    }
};

__device__ __forceinline__ void sincos_turns(double x, double& s, double& c) {
    x = x - floor(x);
    const double q4 = floor(x * 4.0 + 0.5);
    const double r = x - q4 * 0.25;
    const int q = ((int)q4) & 3;
    const double th = r * 6.283185307179586476925, t2 = th * th;
    const double sp = th * (1.0 + t2 * (-1.0 / 6 + t2 * (1.0 / 120 + t2 * (-1.0 / 5040 + t2 * (1.0 / 362880 + t2 * (-1.0 / 39916800 + t2 * (1.0 / 6227020800.0)))))));
    const double cp = 1.0 + t2 * (-0.5 + t2 * (1.0 / 24 + t2 * (-1.0 / 720 + t2 * (1.0 / 40320 + t2 * (-1.0 / 3628800 + t2 * (1.0 / 479001600.0 + t2 * (-1.0 / 87178291200.0)))))));
    if (q == 0) { s = sp; c = cp; } else if (q == 1) { s = cp; c = -sp; } else if (q == 2) { s = -sp; c = -cp; } else { s = -cp; c = sp; }
}
__device__ __forceinline__ unsigned short f2bf(float f) { return __builtin_bit_cast(unsigned short, (__bf16)f); }

__device__ __forceinline__ void transpose_item(const float* W, int K, int N, bf16_t* WT, int mode, LAS float* scr, int item, int lane) {
    const int nblk = N / 32, kb = item / nblk, nb = item % nblk, k0 = 64 * kb, n0 = 32 * nb;
#pragma unroll 8
    for (int i = 0; i < 32; ++i) { const int kk = 2 * i + (lane >> 5); scr[kk * 33 + (lane & 31)] = W[(size_t)(k0 + kk) * N + n0 + (lane & 31)]; }
    LDS_WAIT(); asm volatile("" ::: "memory");
    const int c = lane & 7;
#pragma unroll
    for (int j = 0; j < 4; ++j) { const int n = (lane >> 3) + 8 * j; const LAS float* s = scr + (8 * c) * 33 + n;
        u32x4 o; o.x = cvt_pk(s[0 * 33], s[1 * 33]); o.y = cvt_pk(s[2 * 33], s[3 * 33]); o.z = cvt_pk(s[4 * 33], s[5 * 33]); o.w = cvt_pk(s[6 * 33], s[7 * 33]);
        const int f = n0 + n; const int orow = (mode == 0) ? f : (((f >> 4) << 5) + (f & 15) + (mode == 2 ? 16 : 0));
        *(u32x4*)(WT + (size_t)orow * K + k0 + 8 * c) = o; }
    LDS_WAIT(); asm volatile("" ::: "memory");
}

__device__ __forceinline__ void prologue(const Args& A, LAS unsigned char* lds, int tid, int wave, int lane, int G) {
    unsigned char* ws = A.ws;
    {
        LAS float* scr = (LAS float*)(lds + wave * 16384);
        const int gw = blockIdx.x * NWAVES + wave, NGW = G * NWAVES;
        constexpr int I_IN = 16 * 72, I_SQ = 16 * 32, I_FF = 16 * 88, I_DN = 44 * 32;
        constexpr int NIT = 2 * I_IN + 4 * I_SQ + 8 * I_FF + 4 * I_DN;
        for (int it = gw; it < NIT; it += NGW) {
            int r = it;
            if (r < 2 * I_IN) { const int e = r / I_IN; transpose_item(A.w_in + (size_t)e * DM * INW, DM, INW, (bf16_t*)(ws + WS_WIN) + (size_t)e * INW * DM, 0, scr, r % I_IN, lane); continue; } r -= 2 * I_IN;
            if (r < 2 * I_SQ) { const int e = r / I_SQ; transpose_item(A.w_mix + (size_t)e * DM * DM, DM, DM, (bf16_t*)(ws + WS_WMIX) + (size_t)e * DM * DM, 0, scr, r % I_SQ, lane); continue; } r -= 2 * I_SQ;
            if (r < 2 * I_SQ) { const int e = r / I_SQ; transpose_item(A.w_four + (size_t)e * DM * DM, DM, DM, (bf16_t*)(ws + WS_WF) + (size_t)e * DM * DM, 0, scr, r % I_SQ, lane); continue; } r -= 2 * I_SQ;
            if (r < 4 * I_FF) { const int l = r / I_FF; transpose_item(A.w_gate + (size_t)l * DM * DFF, DM, DFF, (bf16_t*)(ws + WS_WGU) + (size_t)l * 2 * DFF * DM, 1, scr, r % I_FF, lane); continue; } r -= 4 * I_FF;
            if (r < 4 * I_FF) { const int l = r / I_FF; transpose_item(A.w_up + (size_t)l * DM * DFF, DM, DFF, (bf16_t*)(ws + WS_WGU) + (size_t)l * 2 * DFF * DM, 2, scr, r % I_FF, lane); continue; } r -= 4 * I_FF;
            { const int l = r / I_DN; transpose_item(A.w_down + (size_t)l * DFF * DM, DFF, DM, (bf16_t*)(ws + WS_WD) + (size_t)l * DM * DFF, 0, scr, r % I_DN, lane); }
        }
    }
    {
        const int gt = blockIdx.x * NTHR + tid, NGT = G * NTHR;
        float* rope = (float*)(ws + WS_TAB + TAB_ROPE); float* tw = (float*)(ws + WS_TAB + TAB_TW);
        bf16_t* D1 = (bf16_t*)(ws + WS_TAB + TAB_D1); bf16_t* D2 = (bf16_t*)(ws + WS_TAB + TAB_D2); bf16_t* DC = (bf16_t*)(ws + WS_TAB + TAB_DC); bf16_t* DX = (bf16_t*)(ws + WS_TAB + TAB_DCTX);
        constexpr int N_ROPE = 1024, N_TW = 4096, N_D1 = 16384, N_D2 = 8192, N_DC = 131072, N_DX = 131072;
        for (int i = gt; i < N_ROPE + N_TW + N_D1 + N_D2 + N_DC + N_DX; i += NGT) {
            int r = i; double s, c;
            if (r < N_ROPE) { const int a = r >> 4, f = r & 15; sincos_turns((double)a * A.invf[f] * 0.15915494309189533577, s, c); rope[2 * r] = (float)c; rope[2 * r + 1] = (float)s; continue; } r -= N_ROPE;
            if (r < N_TW) { const int k1 = r >> 6, n2 = r & 63; sincos_turns((double)(k1 * n2) / 4096.0, s, c); tw[2 * r] = (float)c; tw[2 * r + 1] = (float)s; continue; } r -= N_TW;
            if (r < N_D1) { const int row = r >> 7, col = r & 127, k1 = row >> 1, rio = row & 1, rii = col >> 6, n1 = col & 63; sincos_turns((double)((k1 * n1) & 63) / 64.0, s, c);
                const double v = (rio == rii) ? c : (rio == 0 ? s : -s); D1[r] = f2bf((float)(v * 0.125)); continue; } r -= N_D1;
            if (r < N_D2) { const int k2 = r >> 7, col = r & 127, ri = col >> 6, n2 = col & 63; sincos_turns((double)((k2 * n2) & 63) / 64.0, s, c); D2[r] = f2bf((float)((ri ? s : c) * 0.125)); continue; } r -= N_D2;
            if (r < N_DC) { const int row = r >> 8, cc = r & 255, ri = row >> 8, m = row & 255; sincos_turns((double)((m * cc) & 255) / 256.0, s, c); DC[r] = f2bf((float)((ri ? -s : c) * 0.0625)); continue; } r -= N_DC;
            { const int k = r >> 9, col = r & 511, ri = col >> 8, n = col & 255; sincos_turns((double)((k * n) & 255) / 256.0, s, c); DX[r] = f2bf((float)((ri ? s : c) * 0.0625)); }
        }
    }
    __syncthreads();
    {
        LAS float* S = (LAS float*)lds; LAS float* Pp = (LAS float*)(lds + 69632);
        for (int i = tid; i < 17 * 1024; i += NTHR) { const int r = i >> 10, k = i & 1023; const float v = (r < 16) ? A.c[r * 1024 + k] : A.c_ctx[k]; S[i] = v / (1.0f + expf(-v)); }
        __syncthreads();
        float* mod = (float*)(ws + WS_MOD);
        for (int task = blockIdx.x; task < 4 * 96; task += G) {
            const int l = task / 96, j0 = (task % 96) * 64;
            const float* w = A.w_ada + (size_t)l * 1024 * 6144 + j0 + lane;
            float acc[17];
#pragma unroll
            for (int r = 0; r < 17; ++r) acc[r] = 0.f;
#pragma unroll 4
            for (int kk = 0; kk < 128; ++kk) { const int k = wave * 128 + kk; const float wv = w[(size_t)k * 6144];
#pragma unroll
                for (int r = 0; r < 17; ++r) acc[r] += S[r * 1024 + k] * wv; }
#pragma unroll
            for (int r = 0; r < 17; ++r) Pp[(wave * 17 + r) * 64 + lane] = acc[r];
            __syncthreads();
            for (int o = tid; o < 17 * 64; o += NTHR) { const int r = o >> 6, jj = o & 63; float sum = 0.f;
#pragma unroll
                for (int w8 = 0; w8 < 8; ++w8) sum += Pp[(w8 * 17 + r) * 64 + jj];
                mod[(size_t)(l * 17 + r) * 6144 + j0 + jj] = sum + A.b_ada[l * 6144 + j0 + jj]; }
            __syncthreads();
        }
    }
}

__device__ __forceinline__ void norm_phase(const float* lat, const float* ctxp, const float* g, const float* modl, int shift_idx, bf16_t* hout, int M, int gw, int NGW, int lane) {
    constexpr int NR = 4;
    f32x4 gv[4];
#pragma unroll
    for (int j = 0; j < 4; ++j) gv[j] = *(const f32x4*)(g + 4 * lane + 256 * j);
    for (int row0 = gw * NR; row0 < M; row0 += NGW * NR) {
        f32x4 v[NR][4];
#pragma unroll
        for (int q = 0; q < NR; ++q) { const int row = row0 + q; const float* xr = (row < TLAT) ? lat + (size_t)row * DM : ctxp + (size_t)(row - TLAT) * DM;
#pragma unroll
            for (int j = 0; j < 4; ++j) v[q][j] = *(const f32x4*)(xr + 4 * lane + 256 * j); }
        const int r = (row0 < TLAT) ? (row0 >> 12) : 16;
        const float* sh = modl + (r * 6 + shift_idx) * 1024; const float* sc = sh + 1024;
        f32x4 scv[4], shv[4];
#pragma unroll
        for (int j = 0; j < 4; ++j) { scv[j] = *(const f32x4*)(sc + 4 * lane + 256 * j); scv[j] = (scv[j] + 1.0f) * gv[j]; shv[j] = *(const f32x4*)(sh + 4 * lane + 256 * j); }
#pragma unroll
        for (int q = 0; q < NR; ++q) { float ss = 0.f;
#pragma unroll
            for (int j = 0; j < 4; ++j) ss += (v[q][j].x * v[q][j].x + v[q][j].y * v[q][j].y) + (v[q][j].z * v[q][j].z + v[q][j].w * v[q][j].w);
#pragma unroll
            for (int o = 1; o < 64; o <<= 1) ss += __shfl_xor(ss, o);
            const float rstd = 1.0f / sqrtf(ss * (1.0f / DM) + 1e-6f);
#pragma unroll
            for (int j = 0; j < 4; ++j) { const f32x4 o = v[q][j] * rstd * scv[j] + shv[j];
                u32x2 w; w.x = cvt_pk(o.x, o.y); w.y = cvt_pk(o.z, o.w);
                *(u32x2*)(hout + (size_t)(row0 + q) * DM + 4 * lane + 256 * j) = w; } }
    }
}
__device__ __forceinline__ void final_norm_phase(float* xo, const float* g, int gw, int NGW, int lane) {
    constexpr int NR = 4;
    f32x4 gv[4];
#pragma unroll
    for (int j = 0; j < 4; ++j) gv[j] = *(const f32x4*)(g + 4 * lane + 256 * j);
    for (int row0 = gw * NR; row0 < TLAT; row0 += NGW * NR) {
        f32x4 v[NR][4];
#pragma unroll
        for (int q = 0; q < NR; ++q)
#pragma unroll
            for (int j = 0; j < 4; ++j) v[q][j] = *(const f32x4*)(xo + (size_t)(row0 + q) * DM + 4 * lane + 256 * j);
#pragma unroll
        for (int q = 0; q < NR; ++q) { float ss = 0.f;
#pragma unroll
            for (int j = 0; j < 4; ++j) ss += (v[q][j].x * v[q][j].x + v[q][j].y * v[q][j].y) + (v[q][j].z * v[q][j].z + v[q][j].w * v[q][j].w);
#pragma unroll
            for (int o = 1; o < 64; o <<= 1) ss += __shfl_xor(ss, o);
            const float rstd = 1.0f / sqrtf(ss * (1.0f / DM) + 1e-6f);
#pragma unroll
            for (int j = 0; j < 4; ++j) *(f32x4*)(xo + (size_t)(row0 + q) * DM + 4 * lane + 256 * j) = v[q][j] * rstd * gv[j]; }
    }
}

__device__ __forceinline__ int crow(int r, int hi) { return (r & 3) + 8 * (r >> 2) + 4 * hi; }

__device__ __forceinline__ void attn_phase(LAS unsigned char* lds, const bf16_t* P, bf16_t* cat, const float* sink, bool ctxq, int G, int tid, int wave, int lane) {
    constexpr int KROW = 144, VROW = 264;
    LAS unsigned char* Kl = lds; LAS unsigned char* Vl = lds + 128 * KROW;
    const int r32 = lane & 31, hi = lane >> 5, g = wave & 3, qh = wave >> 2;
    const int nitems = 1024 + (ctxq ? 64 : 0);
    for (int it = blockIdx.x; it < nitems; it += G) {
        int b, hk, qb, qr0; const bool isl = it < 1024;
        if (isl) { b = it >> 6; hk = (it >> 5) & 1; qb = it & 31; qr0 = b * SEQ + qb * 128; }
        else { const int j = it - 1024; b = j >> 2; hk = (j >> 1) & 1; qb = j & 1; qr0 = TLAT + b * LCTX + qb * 128; }
        const int crow0 = TLAT + b * LCTX, head = hk * 4 + g;
        bf16x8 qf[2][4];
#pragma unroll
        for (int s = 0; s < 2; ++s)
#pragma unroll
            for (int ks = 0; ks < 4; ++ks) qf[s][ks] = *(const bf16x8*)(P + (size_t)(qr0 + 64 * qh + 32 * s + r32) * INW + QS + head * 64 + 16 * ks + 8 * hi);
        float mrun[2], lrun[2]; f32x16 O[2][2];
        const float sk2 = sink[head] * LOG2E;
#pragma unroll
        for (int s = 0; s < 2; ++s) { mrun[s] = sk2; lrun[s] = 1.0f;
#pragma unroll
            for (int dt = 0; dt < 2; ++dt)
#pragma unroll
                for (int r = 0; r < 16; ++r) O[s][dt][r] = 0.f; }
#pragma unroll 1
        for (int ti = 0; ti < 5; ++ti) {
            int krow0, mtype = 0; bool valid = true;
            if (ti == 0) { krow0 = qr0 - 128; mtype = 1; valid = isl && qb > 0; }
            else if (ti == 1) { krow0 = qr0; valid = isl; }
            else if (ti == 2) { krow0 = qr0 + 128; mtype = 2; valid = isl && qb < 31; }
            else { krow0 = crow0 + (ti - 3) * 128; }
            if (!valid) continue;
            __syncthreads();
#pragma unroll
            for (int i = 0; i < 2; ++i) { const int id = tid + NTHR * i, key = id >> 3, c = id & 7;
                const u32x4 v = *(const u32x4*)(P + (size_t)(krow0 + key) * INW + KS_ + hk * 64 + 8 * c);
                *(LAS u32x4*)(Kl + key * KROW + c * 16) = v; }
#pragma unroll
            for (int i = 0; i < 2; ++i) { const int id = tid + NTHR * i, key = id & 127, c = id >> 7;
                const u32x4 v = *(const u32x4*)(P + (size_t)(krow0 + key) * INW + VS_ + hk * 64 + 8 * c);
                LAS unsigned char* vp = Vl + (8 * c) * VROW + key * 2;
                *(LAS unsigned short*)(vp + 0 * VROW) = (unsigned short)(v.x & 0xffffu); *(LAS unsigned short*)(vp + 1 * VROW) = (unsigned short)(v.x >> 16);
                *(LAS unsigned short*)(vp + 2 * VROW) = (unsigned short)(v.y & 0xffffu); *(LAS unsigned short*)(vp + 3 * VROW) = (unsigned short)(v.y >> 16);
                *(LAS unsigned short*)(vp + 4 * VROW) = (unsigned short)(v.z & 0xffffu); *(LAS unsigned short*)(vp + 5 * VROW) = (unsigned short)(v.z >> 16);
                *(LAS unsigned short*)(vp + 6 * VROW) = (unsigned short)(v.w & 0xffffu); *(LAS unsigned short*)(vp + 7 * VROW) = (unsigned short)(v.w >> 16); }
            __syncthreads();
#pragma unroll
            for (int half = 0; half < 2; ++half)
#pragma unroll
                for (int s = 0; s < 2; ++s) {
                    f32x16 S[2];
#pragma unroll
                    for (int rt = 0; rt < 2; ++rt) {
#pragma unroll
                        for (int r = 0; r < 16; ++r) S[rt][r] = 0.f;
#ifndef DIAG
                        asm volatile("" : "+v"(S[rt]));
#endif
#pragma unroll
                        for (int ks = 0; ks < 4; ++ks) { const bf16x8 kf = *(const LAS bf16x8*)(Kl + (64 * half + 32 * rt + r32) * KROW + (16 * ks + 8 * hi) * 2);
                            S[rt] = __builtin_amdgcn_mfma_f32_32x32x16_bf16(kf, qf[s][ks], S[rt], 0, 0, 0); }
                    }
                    if (mtype != 0) { int il = 64 * qh + 32 * s + r32; asm volatile("" : "+v"(il));
#pragma unroll
                        for (int rt = 0; rt < 2; ++rt)
#pragma unroll
                            for (int r = 0; r < 16; ++r) { const int jl = 64 * half + 32 * rt + crow(r, hi); const bool ok = (mtype == 1) ? (jl >= il) : (jl <= il); if (!ok) S[rt][r] = -INFINITY; } }
                    float tmax = S[0][0];
#pragma unroll
                    for (int rt = 0; rt < 2; ++rt)
#pragma unroll
                        for (int r = 0; r < 16; ++r) tmax = fmaxf(tmax, S[rt][r]);
                    tmax = fmaxf(tmax, __shfl_xor(tmax, 32));
                    const float mnew = fmaxf(mrun[s], tmax), alpha = fast_exp2(mrun[s] - mnew);
                    mrun[s] = mnew;
                    float psum = 0.f;
#pragma unroll
                    for (int rt = 0; rt < 2; ++rt)
#pragma unroll
                        for (int r = 0; r < 16; ++r) { const float p = fast_exp2(S[rt][r] - mnew); S[rt][r] = p; psum += p; }
                    psum += __shfl_xor(psum, 32);
                    lrun[s] = lrun[s] * alpha + psum;
#pragma unroll
                    for (int dt = 0; dt < 2; ++dt)
#pragma unroll
                        for (int r = 0; r < 16; ++r) O[s][dt][r] *= alpha;
#pragma unroll
                    for (int rt = 0; rt < 2; ++rt)
#pragma unroll
                        for (int s2 = 0; s2 < 2; ++s2) {
                            u32x4 pw; pw.x = cvt_pk(S[rt][8 * s2 + 0], S[rt][8 * s2 + 1]); pw.y = cvt_pk(S[rt][8 * s2 + 2], S[rt][8 * s2 + 3]);
                            pw.z = cvt_pk(S[rt][8 * s2 + 4], S[rt][8 * s2 + 5]); pw.w = cvt_pk(S[rt][8 * s2 + 6], S[rt][8 * s2 + 7]);
                            const bf16x8 pf = __builtin_bit_cast(bf16x8, pw);
#pragma unroll
                            for (int dt = 0; dt < 2; ++dt) {
                                const LAS unsigned char* vb = Vl + (32 * dt + r32) * VROW + (64 * half + 32 * rt + 16 * s2 + 4 * hi) * 2;
                                const u32x2 v0 = *(const LAS u32x2*)vb, v1 = *(const LAS u32x2*)(vb + 16);
                                const u32x4 vv = {v0.x, v0.y, v1.x, v1.y};
                                O[s][dt] = __builtin_amdgcn_mfma_f32_32x32x16_bf16(__builtin_bit_cast(bf16x8, vv), pf, O[s][dt], 0, 0, 0);
                            }
                        }
                }
        }
#pragma unroll
        for (int s = 0; s < 2; ++s) { const float inv = 1.0f / lrun[s];
            bf16_t* orow = cat + (size_t)(qr0 + 64 * qh + 32 * s + r32) * DM + 512 + head * 64;
#pragma unroll
            for (int dt = 0; dt < 2; ++dt)
#pragma unroll
                for (int q4 = 0; q4 < 4; ++q4) { u32x2 w; w.x = cvt_pk(O[s][dt][4 * q4 + 0] * inv, O[s][dt][4 * q4 + 1] * inv); w.y = cvt_pk(O[s][dt][4 * q4 + 2] * inv, O[s][dt][4 * q4 + 3] * inv);
                    *(u32x2*)(orow + 32 * dt + 8 * q4 + 4 * hi) = w; } }
    }
    __syncthreads();
}

__device__ __forceinline__ void load_u(const bf16_t* P, int t, int s0, int s1, int c8, float (&u)[8]) {
    if (t < s0 || t >= s1) {
#pragma unroll
        for (int j = 0; j < 8; ++j) u[j] = 0.f;
    } else {
        const u32x4 cv = *(const u32x4*)(P + (size_t)t * INW + 512 + 8 * c8), hv = *(const u32x4*)(P + (size_t)t * INW + 1024 + 8 * c8);
        u[0] = bf_lo(cv.x) * bf_lo(hv.x); u[1] = bf_hi(cv.x) * bf_hi(hv.x); u[2] = bf_lo(cv.y) * bf_lo(hv.y); u[3] = bf_hi(cv.y) * bf_hi(hv.y);
        u[4] = bf_lo(cv.z) * bf_lo(hv.z); u[5] = bf_hi(cv.z) * bf_hi(hv.z); u[6] = bf_lo(cv.w) * bf_lo(hv.w); u[7] = bf_hi(cv.w) * bf_hi(hv.w);
    }
}
__device__ __forceinline__ void conv_phase(const bf16_t* P, bf16_t* cat, const float* cw, int M, int G, int tid) {
    const int c8 = tid & 63, tg = tid >> 6;
    float w0[8], w1[8], w2[8];
#pragma unroll
    for (int j = 0; j < 8; ++j) { w0[j] = cw[8 * c8 + j]; w1[j] = cw[512 + 8 * c8 + j]; w2[j] = cw[1024 + 8 * c8 + j]; }
    for (int it = blockIdx.x; it < M / 128; it += G) {
        const int t0 = it * 128, ts = t0 + 16 * tg;
        int s0, s1; if (t0 < TLAT) { s0 = t0 & ~4095; s1 = s0 + 4096; } else { s0 = TLAT + ((t0 - TLAT) & ~255); s1 = s0 + 256; }
        float up[8], uc[8], un[8];
        load_u(P, ts - 1, s0, s1, c8, up); load_u(P, ts, s0, s1, c8, uc);
#pragma unroll 2
        for (int i = 0; i < 16; ++i) { const int t = ts + i;
            load_u(P, t + 1, s0, s1, c8, un);
            const u32x4 bv = *(const u32x4*)(P + (size_t)t * INW + 8 * c8);
            float bb[8] = {bf_lo(bv.x), bf_hi(bv.x), bf_lo(bv.y), bf_hi(bv.y), bf_lo(bv.z), bf_hi(bv.z), bf_lo(bv.w), bf_hi(bv.w)};
            float o[8];
#pragma unroll
            for (int j = 0; j < 8; ++j) { o[j] = bb[j] * (w0[j] * up[j] + w1[j] * uc[j] + w2[j] * un[j]); up[j] = uc[j]; uc[j] = un[j]; }
            u32x4 w; w.x = cvt_pk(o[0], o[1]); w.y = cvt_pk(o[2], o[3]); w.z = cvt_pk(o[4], o[5]); w.w = cvt_pk(o[6], o[7]);
            *(u32x4*)(cat + (size_t)t * DM + 8 * c8) = w; }
    }
}

template <int MT, int KS> __device__ __forceinline__ void dft_load_a(bf16x8 (&a)[MT][KS], const bf16_t* Mat, int row0, int r32, int hi) {
#pragma unroll
    for (int rt = 0; rt < MT; ++rt)
#pragma unroll
        for (int ks = 0; ks < KS; ++ks) a[rt][ks] = *(const bf16x8*)(Mat + (size_t)(row0 + 32 * rt + r32) * (KS * 16) + 16 * ks + 8 * hi);
}
template <int MT, int KS> __device__ __forceinline__ void dft_mm(f32x16 (&acc)[MT], const bf16x8 (&a)[MT][KS], const bf16_t* vec) {
#pragma unroll
    for (int rt = 0; rt < MT; ++rt)
#pragma unroll
        for (int r = 0; r < 16; ++r) acc[rt][r] = 0.f;
#pragma unroll
    for (int rt = 0; rt < MT; ++rt) asm volatile("" : "+v"(acc[rt]));
    constexpr int KC = 8;
#pragma unroll
    for (int kc = 0; kc < KS / KC; ++kc) {
        bf16x8 b[KC];
#pragma unroll
        for (int i = 0; i < KC; ++i) b[i] = *(const bf16x8*)(vec + 16 * (kc * KC + i));
#pragma unroll
        for (int i = 0; i < KC; ++i)
#pragma unroll
            for (int rt = 0; rt < MT; ++rt) acc[rt] = __builtin_amdgcn_mfma_f32_32x32x16_bf16(a[rt][kc * KC + i], b[i], acc[rt], 0, 0, 0);
    }
}
__device__ __forceinline__ void store_pair(bf16_t* base, size_t zoo, unsigned cA, unsigned cB, float va, float vb, bool odd) {
    const float keep = odd ? vb : va, send = odd ? va : vb;
    const float got = __builtin_bit_cast(float, __builtin_amdgcn_mov_dpp(__builtin_bit_cast(int, send), 0xB1, 0xf, 0xf, true));
    const unsigned w = odd ? cvt_pk(got, keep) : cvt_pk(keep, got);
    *(unsigned*)(base + zoo + (odd ? cB : cA)) = w;
}
__device__ __forceinline__ void dft_ld8(bf16x8 (&b)[8], const bf16_t* vec) {
#pragma unroll
    for (int i = 0; i < 8; ++i) b[i] = *(const bf16x8*)(vec + 16 * i);
}
template <int MT> __device__ __forceinline__ void dft_zero(f32x16 (&acc)[MT]) {
#pragma unroll
    for (int rt = 0; rt < MT; ++rt) {
#pragma unroll
        for (int r = 0; r < 16; ++r) acc[rt][r] = 0.f;
        asm volatile("" : "+v"(acc[rt]));
    }
}
template <int MT, int KS, int K0> __device__ __forceinline__ void dft_mma8(f32x16 (&acc)[MT], const bf16x8 (&a)[MT][KS], const bf16x8 (&b)[8]) {
#pragma unroll
    for (int i = 0; i < 8; ++i)
#pragma unroll
        for (int rt = 0; rt < MT; ++rt) acc[rt] = __builtin_amdgcn_mfma_f32_32x32x16_bf16(a[rt][K0 + i], b[i], acc[rt], 0, 0, 0);
}
__device__ __forceinline__ const bf16_t* fa_vec(const bf16_t* H, int tile, int r32, int hi) {
    int token, g;
    if (tile < 8192) { const int n1h = tile & 1, n2 = (tile >> 1) & 63, b = tile >> 9; g = (tile >> 7) & 3; token = b * SEQ + 64 * (32 * n1h + r32) + n2; }
    else { const int tc = tile - 8192, nq = tc & 7, b = tc >> 5; g = (tc >> 3) & 3; token = TLAT + b * LCTX + 32 * nq + r32; }
    return H + (size_t)token * DM + g * 256 + 8 * hi;
}
__device__ __forceinline__ int fa_token(int tile, int row) {
    if (tile < 8192) { const int n1h = tile & 1, n2 = (tile >> 1) & 63, b = tile >> 9; return b * SEQ + 64 * (32 * n1h + row) + n2; }
    const int tc = tile - 8192, nq = tc & 7, b = tc >> 5; return TLAT + b * LCTX + 32 * nq + row;
}
__device__ __forceinline__ void fourier_a(LAS unsigned char* lds, const bf16_t* H, const bf16_t* DC, bf16_t* Z1, bf16_t* Zc, bool with_ctx, int G, int vcu, int wave, int lane) {
    constexpr int ROWB = 528, BUFB = 32 * ROWB;
    const int r32 = lane & 31, hi = lane >> 5, sl = wave, tid = wave * 64 + lane; const bool odd = lane & 1;
    bf16x8 a[2][16]; dft_load_a<2, 16>(a, DC, 64 * sl, r32, hi);
    const int ntile = 8192 + (with_ctx ? 512 : 0);
    const int srow0 = tid >> 5, sch = tid & 31;
    u32x4 s0, s1;
    int tile = vcu, cur = 0;
    if (tile < ntile) { const int g = (tile < 8192) ? (tile >> 7) & 3 : ((tile - 8192) >> 3) & 3;
        s0 = *(const u32x4*)(H + (size_t)fa_token(tile, srow0) * DM + g * 256 + sch * 8); s1 = *(const u32x4*)(H + (size_t)fa_token(tile, srow0 + 16) * DM + g * 256 + sch * 8); }
    for (; tile < ntile; tile += G) {
        LAS unsigned char* buf = lds + cur * BUFB;
        *(LAS u32x4*)(buf + srow0 * ROWB + sch * 16) = s0; *(LAS u32x4*)(buf + (srow0 + 16) * ROWB + sch * 16) = s1;
        __syncthreads();
        if (tile + G < ntile) { const int tn = tile + G; const int g = (tn < 8192) ? (tn >> 7) & 3 : ((tn - 8192) >> 3) & 3;
            s0 = *(const u32x4*)(H + (size_t)fa_token(tn, srow0) * DM + g * 256 + sch * 8); s1 = *(const u32x4*)(H + (size_t)fa_token(tn, srow0 + 16) * DM + g * 256 + sch * 8); }
        asm volatile("" ::: "memory");
        f32x16 acc[2]; dft_zero<2>(acc);
        const LAS unsigned char* bp = buf + r32 * ROWB + hi * 16;
#pragma unroll
        for (int ks = 0; ks < 16; ++ks) { const bf16x8 bf = *(const LAS bf16x8*)(bp + ks * 32);
#pragma unroll
            for (int rt = 0; rt < 2; ++rt) acc[rt] = __builtin_amdgcn_mfma_f32_32x32x16_bf16(a[rt][ks], bf, acc[rt], 0, 0, 0); }
        if (tile < 8192) {
            const int n1h = tile & 1, n2 = (tile >> 1) & 63, g = (tile >> 7) & 3, b = tile >> 9;
            size_t zo = ((((size_t)((b * 4 + g) * 256 + 64 * (sl & 3) + 4 * hi)) * 64 + n2) * 2 + (sl >> 2)) * 64 + 32 * n1h + (r32 & ~1);
            asm volatile("" : "+v"(zo));
#pragma unroll
            for (int rt = 0; rt < 2; ++rt)
#pragma unroll
                for (int r = 0; r < 16; r += 2) store_pair(Z1, zo, (unsigned)(32 * rt + (r & 3) + 8 * (r >> 2)) * 8192u, (unsigned)(32 * rt + ((r + 1) & 3) + 8 * (r >> 2)) * 8192u, acc[rt][r], acc[rt][r + 1], odd);
        } else {
            const int tc = tile - 8192, nq = tc & 7, g = (tc >> 3) & 3, b = tc >> 5;
            size_t zo = (((size_t)((b * 4 + g) * 256 + 64 * (sl & 3) + 4 * hi)) * 2 + (sl >> 2)) * 256 + 32 * nq + (r32 & ~1);
            asm volatile("" : "+v"(zo));
#pragma unroll
            for (int rt = 0; rt < 2; ++rt)
#pragma unroll
                for (int r = 0; r < 16; r += 2) store_pair(Zc, zo, (unsigned)(32 * rt + (r & 3) + 8 * (r >> 2)) * 512u, (unsigned)(32 * rt + ((r + 1) & 3) + 8 * (r >> 2)) * 512u, acc[rt][r], acc[rt][r + 1], odd);
        }
        asm volatile("" ::: "memory");
        cur ^= 1;
    }
    __syncthreads();
}
template <int VAR> __device__ __forceinline__ void fourier_s1(const bf16_t* Z1, const bf16_t* D1, const float* tw, bf16_t* A1p, int G, int vcu, int wave, int lane) {
    const int r32 = lane & 31, hi = lane >> 5, sl = wave & 1; const bool odd = lane & 1;
    bf16x8 a[2][8]; dft_load_a<2, 8>(a, D1, 64 * sl, r32, hi);
    int tile = vcu * 4 + (wave >> 1); const int step = G * 4;
    const int n2 = 32 * (tile & 1) + r32;
    float2 twr[16];
#pragma unroll
    for (int rt = 0; rt < 2; ++rt)
#pragma unroll
        for (int q4 = 0; q4 < 4; ++q4)
#pragma unroll
            for (int e = 0; e < 2; ++e) twr[rt * 8 + q4 * 2 + e] = *(const float2*)(tw + 2 * ((32 * sl + 2 * hi + 16 * rt + 4 * q4 + e) * 64 + n2));
    bf16x8 bc[8], bn[8];
    if (tile < 32768) dft_ld8(bc, Z1 + ((size_t)tile * 32 + r32) * 128 + 8 * hi);
    for (; tile < 32768; tile += step) {
        asm volatile("" ::: "memory");
        if (tile + step < 32768) dft_ld8(bn, Z1 + ((size_t)(tile + step) * 32 + r32) * 128 + 8 * hi);
        asm volatile("" ::: "memory");
        f32x16 acc[2]; dft_zero<2>(acc);
        dft_mma8<2, 8, 0>(acc, a, bc);
        const int bgm = tile >> 1, bg = bgm >> 8, m = bgm & 255;
        size_t ao = ((((size_t)(bg * 64 + 32 * sl + 2 * hi)) * 256 + m) * 2) * 64 + (n2 & ~1);
        asm volatile("" : "+v"(ao));
#pragma unroll
        for (int rt = 0; rt < 2; ++rt)
#pragma unroll
            for (int q4 = 0; q4 < 4; ++q4)
#pragma unroll
                for (int e = 0; e < 2; ++e) { const int dk = 16 * rt + 4 * q4 + e;
                    const float re = acc[rt][4 * q4 + 2 * e], im = acc[rt][4 * q4 + 2 * e + 1];
                    const float2 cs = twr[rt * 8 + q4 * 2 + e];
                    const float re2 = re * cs.x + im * cs.y, im2 = im * cs.x - re * cs.y;
                    store_pair(A1p, ao, (unsigned)dk * 32768u, (unsigned)dk * 32768u + 64u, re2, im2, odd); }
        asm volatile("" ::: "memory");
#pragma unroll
        for (int i = 0; i < 8; ++i) bc[i] = bn[i];
    }
}
__device__ __forceinline__ void fourier_s2(const bf16_t* A1p, const bf16_t* D2, const bf16_t* Zc, const bf16_t* DX, bf16_t* FM, bool with_ctx, int G, int vcu, int gw, int NGW, int wave, int lane) {
    const int r32 = lane & 31, hi = lane >> 5; const bool odd = lane & 1;
    {
        bf16x8 a[2][8]; dft_load_a<2, 8>(a, D2, 0, r32, hi);
        bf16x8 bc[8], bn[8];
        int tile = gw;
        if (tile < 32768) dft_ld8(bc, A1p + ((size_t)tile * 32 + r32) * 128 + 8 * hi);
        for (; tile < 32768; tile += NGW) {
            asm volatile("" ::: "memory");
            if (tile + NGW < 32768) dft_ld8(bn, A1p + ((size_t)(tile + NGW) * 32 + r32) * 128 + 8 * hi);
            asm volatile("" ::: "memory");
            f32x16 acc[2]; dft_zero<2>(acc);
            dft_mma8<2, 8, 0>(acc, a, bc);
            const int m = 32 * (tile & 7) + r32, k1 = (tile >> 3) & 63, bg = tile >> 9, b = bg >> 2, g = bg & 3;
            size_t fo = (size_t)(b * SEQ + k1 + 256 * hi) * DM + g * 256 + (m & ~1);
            asm volatile("" : "+v"(fo));
#pragma unroll
            for (int rt = 0; rt < 2; ++rt)
#pragma unroll
                for (int r = 0; r < 16; r += 2) store_pair(FM, fo, (unsigned)(32 * rt + (r & 3) + 8 * (r >> 2)) * 65536u, (unsigned)(32 * rt + ((r + 1) & 3) + 8 * (r >> 2)) * 65536u, acc[rt][r], acc[rt][r + 1], odd);
            asm volatile("" ::: "memory");
#pragma unroll
            for (int i = 0; i < 8; ++i) bc[i] = bn[i];
        }
    }
    if (with_ctx) {
        for (int tile = vcu; tile < 512; tile += G) {
            f32x16 acc;
#pragma unroll
            for (int r = 0; r < 16; ++r) acc[r] = 0.f;
            asm volatile("" : "+v"(acc));
            const bf16_t* ap = DX + (size_t)(32 * wave + r32) * 512 + 8 * hi;
            const bf16_t* bp = Zc + ((size_t)tile * 32 + r32) * 512 + 8 * hi;
#pragma unroll 1
            for (int kc = 0; kc < 4; ++kc) {
                bf16x8 av[8], bv[8];
#pragma unroll
                for (int i = 0; i < 8; ++i) { av[i] = *(const bf16x8*)(ap + 16 * (kc * 8 + i)); bv[i] = *(const bf16x8*)(bp + 16 * (kc * 8 + i)); }
#pragma unroll
                for (int i = 0; i < 8; ++i) acc = __builtin_amdgcn_mfma_f32_32x32x16_bf16(av[i], bv[i], acc, 0, 0, 0);
            }
            const int m = 32 * (tile & 7) + r32, bg = tile >> 3, b = bg >> 2, g = bg & 3;
            size_t fo = (size_t)(TLAT + b * LCTX + 32 * wave + 4 * hi) * DM + g * 256 + (m & ~1);
            asm volatile("" : "+v"(fo));
#pragma unroll
            for (int r = 0; r < 16; r += 2) store_pair(FM, fo, (unsigned)((r & 3) + 8 * (r >> 2)) * 1024u, (unsigned)(((r + 1) & 3) + 8 * (r >> 2)) * 1024u, acc[r], acc[r + 1], odd);
        }
    }
}


#ifdef DIAG
__device__ __forceinline__ void diag_scan(unsigned* ctl, const void* buf, size_t bytes, bool is_bf16, int stage) {
    const size_t n16 = bytes / 16; const u32x4* p = (const u32x4*)buf; bool bad = false;
    int ln = (int)__builtin_amdgcn_mbcnt_hi(~0u, __builtin_amdgcn_mbcnt_lo(~0u, 0u)); asm volatile("" : "+v"(ln)); ln += 64 * __builtin_amdgcn_readfirstlane((int)threadIdx.x >> 6);
    for (size_t i = (size_t)blockIdx.x * NTHR + ln; i < n16; i += (size_t)gridDim.x * NTHR) {
        const u32x4 v = p[i];
        if (is_bf16) { for (int q = 0; q < 4; ++q) { const unsigned w = v[q]; if (((w >> 7) & 0xff) == 0xff || ((w >> 23) & 0xff) == 0xff) bad = true; } }
        else { for (int q = 0; q < 4; ++q) { if (((v[q] >> 23) & 0xff) >= 0xf0) bad = true; } }
    }
    if (bad) atomicMin(ctl, (unsigned)stage);
}
#define DIAG_SCAN(buf, bytes, isbf, stage) diag_scan((unsigned*)ws, buf, bytes, isbf, stage)
#else
#define DIAG_SCAN(buf, bytes, isbf, stage) do {} while (0)
#endif

#ifdef DIAG2
__device__ __forceinline__ void diag_max(unsigned* ctl, const void* buf, size_t bytes) {
    const size_t n16 = bytes / 16; const u32x4* p = (const u32x4*)buf; unsigned mx = 0, nb = 0;
    int ln = (int)__builtin_amdgcn_mbcnt_hi(~0u, __builtin_amdgcn_mbcnt_lo(~0u, 0u)); asm volatile("" : "+v"(ln)); ln += 64 * __builtin_amdgcn_readfirstlane((int)threadIdx.x >> 6);
    for (size_t i = (size_t)blockIdx.x * NTHR + ln; i < n16; i += (size_t)gridDim.x * NTHR) {
        const u32x4 v = p[i];
        for (int q = 0; q < 4; ++q) { const unsigned lo = (v[q] << 16) & 0x7fffffffu, hi = v[q] & 0x7fff0000u;
            if ((lo >> 23) == 0xff) ++nb; else mx = mx > lo ? mx : lo;
            if ((hi >> 23) == 0xff) ++nb; else mx = mx > hi ? mx : hi; }
    }
    atomicMax(ctl + 1, mx); if (nb) atomicAdd(ctl + 2, nb);
}
#endif

#ifdef TSEL
#define TBEG(c) do { if ((TSEL >> (c)) & 1) t0_ = __builtin_amdgcn_s_memrealtime(); } while (0)
#define TEND(c) do { if ((TSEL >> (c)) & 1) tacc_ += __builtin_amdgcn_s_memrealtime() - t0_; } while (0)
#else
#define TBEG(c) do {} while (0)
#define TEND(c) do {} while (0)
#endif
__global__ void __launch_bounds__(NTHR, 2) fwd_megakernel(Args A) {
    extern __shared__ __attribute__((aligned(16))) unsigned char lds_raw[];
    cg::grid_group grid = cg::this_grid();
#define GRID_SYNC() do { asm volatile("s_waitcnt vmcnt(0) lgkmcnt(0)" ::: "memory"); grid.sync(); } while (0)
    LAS unsigned char* lds = (LAS unsigned char*)lds_raw;
    const int wave = __builtin_amdgcn_readfirstlane((int)threadIdx.x >> 6);
#define FRESH_LANE(v) int v = LANE_ID(); asm volatile("" : "+v"(v))
#define LANE_ID() ((int)__builtin_amdgcn_mbcnt_hi(~0u, __builtin_amdgcn_mbcnt_lo(~0u, 0u)))
    const int lane = LANE_ID(), tid = wave * 64 + lane;
    const int G = gridDim.x, gw = blockIdx.x * NWAVES + wave, NGW = G * NWAVES;
    const int vcu = (G % 8 == 0) ? ((int)blockIdx.x % 8) * (G / 8) + (int)blockIdx.x / 8 : (int)blockIdx.x;
    const int gwv = vcu * NWAVES + wave;
    unsigned char* ws = A.ws;
#ifdef TSEL
    unsigned long long t0_ = 0, tacc_ = 0;
#endif
#ifdef DIAG
    if (blockIdx.x == 0 && threadIdx.x == 0) *(unsigned*)ws = 0x7fffffffu;
#endif
#ifdef DIAG2
    if (blockIdx.x == 0 && threadIdx.x == 0) { ((unsigned*)ws)[1] = 0u; ((unsigned*)ws)[2] = 0u; }
#endif
    float* mod = (float*)(ws + WS_MOD);
    const float* rope = (const float*)(ws + WS_TAB + TAB_ROPE); const float* tw = (const float*)(ws + WS_TAB + TAB_TW);
    const bf16_t* D1 = (const bf16_t*)(ws + WS_TAB + TAB_D1); const bf16_t* D2 = (const bf16_t*)(ws + WS_TAB + TAB_D2);
    const bf16_t* DC = (const bf16_t*)(ws + WS_TAB + TAB_DC); const bf16_t* DX = (const bf16_t*)(ws + WS_TAB + TAB_DCTX);
    float* xc = (float*)(ws + WS_XC);
    bf16_t* Hb = (bf16_t*)(ws + WS_H); bf16_t* Pb = (bf16_t*)(ws + WS_P); bf16_t* CAT = (bf16_t*)(ws + WS_CAT); bf16_t* ACT = (bf16_t*)(ws + WS_ACT);
    bf16_t* Z1 = (bf16_t*)(ws + WS_Z1); bf16_t* Zc = (bf16_t*)(ws + WS_ZC); bf16_t* A1p = (bf16_t*)(ws + WS_A1); bf16_t* FM = (bf16_t*)(ws + WS_FM);


#ifndef SKIP_PRO
        TBEG(10);
    prologue(A, lds, tid, wave, lane, G);
#endif

    GRID_SYNC();
        TEND(10);

    DIAG_SCAN(mod, 4 * 17 * 6144 * 4, false, 1); DIAG_SCAN(ws + WS_WIN, (size_t)83 * MiB, true, 2); DIAG_SCAN(ws + WS_TAB + TAB_D1, 640 * 1024, true, 3); DIAG_SCAN(ws + WS_TAB, 96 * 1024, false, 4);
#pragma unroll 1
    for (int l = 0; l < 4; ++l) {
        const bool even = (l & 1) == 0; const int e = l >> 1;
        const bool ctx_after = l < 2;
        const bool ctx_here = l < 3;
        const int Mfull = ctx_here ? MALL : TLAT;
        const int Mres = ctx_after ? MALL : TLAT;
        const float* modl = mod + (size_t)l * 17 * 6144;
        const float* xin_lat = (l == 0) ? A.x : A.out; const float* xin_ctx = (l == 0) ? A.ctx : xc;
        TBEG(4);
        { FRESH_LANE(lane_l); const int tid_l = wave * 64 + lane_l; (void)tid_l; norm_phase(xin_lat, xin_ctx, A.n1g + l * DM, modl, 0, Hb, Mfull, gw, NGW, lane_l); }
        GRID_SYNC();
        TEND(4);
        DIAG_SCAN(Hb, (size_t)Mfull * DM * 2, true, 10 + 10 * l);
        const bf16_t* mixA; const bf16_t* mixW;
        if (even) {
        TBEG(0);
            { int tg = LANE_ID(); asm volatile("" : "+v"(tg)); tg += wave * 64; pg8::Gemm g{Hb, (const bf16_t*)(ws + WS_WIN) + (size_t)e * INW * DM, Mfull, INW, DM}; pg8::StaticOrder S; S.init(Mfull, INW, G, (int)blockIdx.x);
              EpiInProj E{Pb, rope};
              pg8::gemm_phase<EpiInProj, pg8::StaticOrder, true, true>(lds, g, S, E, tg); }
            GRID_SYNC();
        TEND(0);
        DIAG_SCAN(Pb, (size_t)Mfull * INW * 2, true, 11 + 10 * l);

#ifndef SKIP_ATT
        TBEG(5);
            { FRESH_LANE(lane_l); const int tid_l = wave * 64 + lane_l; (void)tid_l; attn_phase(lds, Pb, CAT, A.sink + e * 8, ctx_after, G, tid_l, wave, lane_l); }
        TEND(5);
#endif


#ifndef SKIP_CONV
        TBEG(6);
            { FRESH_LANE(lane_l); const int tid_l = wave * 64 + lane_l; (void)tid_l; conv_phase(Pb, CAT, A.conv_w + e * 3 * 512, Mres, G, tid_l); }
#endif

            GRID_SYNC();
        TEND(6);
        DIAG_SCAN(CAT, (size_t)Mres * DM * 2, true, 12 + 10 * l);
            mixA = CAT; mixW = (const bf16_t*)(ws + WS_WMIX) + (size_t)e * DM * DM;
        } else {

#ifndef SKIP_FA
        TBEG(7);
            { FRESH_LANE(lane_l); const int tid_l = wave * 64 + lane_l; (void)tid_l; fourier_a(lds, Hb, DC, Z1, Zc, ctx_after, G, vcu, wave, lane_l); }
#endif

            GRID_SYNC();
        TEND(7);
        DIAG_SCAN(Z1, (size_t)128 * MiB, true, 11 + 10 * l); DIAG_SCAN(Z1 + 64 * MiB, (size_t)128 * MiB, true, 12 + 10 * l); DIAG_SCAN(Zc, (size_t)16 * MiB, true, 13 + 10 * l);
#ifdef DIAG2
        if (l == DIAG2_L) diag_max((unsigned*)ws, DIAG2_BUF, DIAG2_BYTES);
#endif

#ifndef SKIP_S1
        TBEG(8);
            { FRESH_LANE(lane_l); const int tid_l = wave * 64 + lane_l; (void)tid_l; fourier_s1<0>(Z1, D1, tw, A1p, G, vcu, wave, lane_l); }
#endif

            GRID_SYNC();
        TEND(8);
        DIAG_SCAN(A1p, (size_t)256 * MiB, true, 14 + 10 * l);

#ifndef SKIP_S2
        TBEG(9);
            { FRESH_LANE(lane_l); const int tid_l = wave * 64 + lane_l; (void)tid_l; fourier_s2(A1p, D2, Zc, DX, FM, ctx_after, G, vcu, gwv, NGW, wave, lane_l); }
#endif

            GRID_SYNC();
        TEND(9);
        DIAG_SCAN(FM, (size_t)Mres * DM * 2, true, 15 + 10 * l);
            mixA = FM; mixW = (const bf16_t*)(ws + WS_WF) + (size_t)e * DM * DM;
        }
        TBEG(1);
        { int tg = LANE_ID(); asm volatile("" : "+v"(tg)); tg += wave * 64; pg8::Gemm g{mixA, mixW, Mres, DM, DM}; pg8::StaticOrder S; S.init(Mres, DM, G, (int)blockIdx.x);
          EpiRes E{xin_lat, xin_ctx, A.out, xc, modl, 2};
          pg8::gemm_phase<EpiRes, pg8::StaticOrder, true, true>(lds, g, S, E, tg); }
        GRID_SYNC();
        TEND(1);
        DIAG_SCAN(A.out, (size_t)TLAT * DM * 4, false, 16 + 10 * l);
        TBEG(4);
        { FRESH_LANE(lane_l); const int tid_l = wave * 64 + lane_l; (void)tid_l; norm_phase(A.out, xc, A.n2g + l * DM, modl, 3, Hb, Mres, gw, NGW, lane_l); }
        GRID_SYNC();
        TEND(4);
        DIAG_SCAN(Hb, (size_t)Mres * DM * 2, true, 17 + 10 * l);
        TBEG(2);
        { int tg = LANE_ID(); asm volatile("" : "+v"(tg)); tg += wave * 64; pg8::Gemm g{Hb, (const bf16_t*)(ws + WS_WGU) + (size_t)l * 2 * DFF * DM, Mres, 2 * DFF, DM}; pg8::StaticOrder S; S.init(Mres, 2 * DFF, G, (int)blockIdx.x);
          EpiSwiGLU E{ACT};
          pg8::gemm_phase<EpiSwiGLU, pg8::StaticOrder, true, true>(lds, g, S, E, tg); }
        GRID_SYNC();
        TEND(2);
        DIAG_SCAN(ACT, (size_t)Mres * DFF * 2, true, 18 + 10 * l);
        TBEG(3);
        { int tg = LANE_ID(); asm volatile("" : "+v"(tg)); tg += wave * 64; pg8::Gemm g{ACT, (const bf16_t*)(ws + WS_WD) + (size_t)l * DM * DFF, Mres, DM, DFF}; pg8::StaticOrder S; S.init(Mres, DM, G, (int)blockIdx.x);
          EpiRes E{A.out, xc, A.out, xc, modl, 5};
          pg8::gemm_phase<EpiRes, pg8::StaticOrder, true, true>(lds, g, S, E, tg); }
        GRID_SYNC();
        TEND(3);
        DIAG_SCAN(A.out, (size_t)TLAT * DM * 4, false, 19 + 10 * l);
    }
    { int lane_f = LANE_ID(); asm volatile("" : "+v"(lane_f)); final_norm_phase(A.out, A.final_g, gw, NGW, lane_f); }
#ifdef TSEL
    if (blockIdx.x == 0) { const unsigned long long ts_ = __builtin_amdgcn_s_memrealtime(); while (__builtin_amdgcn_s_memrealtime() - ts_ < (unsigned long long)TMULT * tacc_) __builtin_amdgcn_s_sleep(8); }
#endif
#ifdef DIAG2
    GRID_SYNC();
    if (blockIdx.x == 0 && threadIdx.x == 0) { const unsigned mx = ((volatile unsigned*)ws)[1], nb = ((volatile unsigned*)ws)[2]; A.out[0] = 1000.f * __builtin_bit_cast(float, mx); A.out[1] = nb ? 1e9f + 1000.f * (float)nb : 0.f; }
#endif
#ifdef DIAG
    GRID_SYNC();
    if (blockIdx.x == 0 && threadIdx.x == 0) { const unsigned c = *(volatile unsigned*)ws; A.out[0] = (c == 0x7fffffffu) ? 999000.f : 1000.f * (float)c; }
#endif
}

extern "C" void kernel_launch(void* const* d_in, const int* in_sizes, int n_in, void* d_out, int out_size, void* d_ws, size_t ws_size, hipStream_t stream) {
    static int grid = 0;
    if (grid == 0) {
        if (n_in != 17 || out_size != TLAT * DM || ws_size < WS_END) { fprintf(stderr, "kernel_launch: unexpected shapes (n_in %d, out %d, ws %zu)\n", n_in, out_size, ws_size); grid = -1; return; }
        int dev = 0, cus = 0, per_cu = 0;
        hipGetDevice(&dev); hipDeviceGetAttribute(&cus, hipDeviceAttributeMultiprocessorCount, dev);
        if (hipFuncSetAttribute((const void*)fwd_megakernel, hipFuncAttributeMaxDynamicSharedMemorySize, LDS_BYTES) != hipSuccess) { fprintf(stderr, "kernel_launch: hipFuncSetAttribute failed\n"); grid = -1; return; }
        if (hipOccupancyMaxActiveBlocksPerMultiprocessor(&per_cu, (const void*)fwd_megakernel, NTHR, LDS_BYTES) != hipSuccess || per_cu < 1) { fprintf(stderr, "kernel_launch: occupancy query says %d\n", per_cu); per_cu = 1; }
        (void)hipGetLastError();
        grid = cus * 1;
    }
    if (grid < 0) return;
    Args a{};
    a.x = (const float*)d_in[0]; a.c = (const float*)d_in[1]; a.ctx = (const float*)d_in[2]; a.c_ctx = (const float*)d_in[3]; a.w_ada = (const float*)d_in[4]; a.b_ada = (const float*)d_in[5];
    a.n1g = (const float*)d_in[6]; a.n2g = (const float*)d_in[7]; a.w_in = (const float*)d_in[8]; a.conv_w = (const float*)d_in[9]; a.sink = (const float*)d_in[10]; a.w_mix = (const float*)d_in[11];
    a.w_four = (const float*)d_in[12]; a.w_gate = (const float*)d_in[13]; a.w_up = (const float*)d_in[14]; a.w_down = (const float*)d_in[15]; a.final_g = (const float*)d_in[16];
    a.out = (float*)d_out; a.ws = (unsigned char*)d_ws;
    for (int f = 0; f < 16; ++f) a.invf[f] = pow(10000.0, -(double)f / 16.0);
    void* args[] = {&a};
    hipError_t e = hipLaunchCooperativeKernel((const void*)fwd_megakernel, dim3(grid), dim3(NTHR), args, LDS_BYTES, stream);
    if (e != hipSuccess) fprintf(stderr, "kernel_launch: cooperative launch failed: %s (grid %d)\n", hipGetErrorString(e), grid);
}
```

```cpp
#include <hip/hip_runtime.h>
#include <hip/hip_cooperative_groups.h>
#include <cstdio>
#include <cstdint>
#include <cmath>
namespace cg = cooperative_groups;

namespace pg8 {
#define PG8_LAS __attribute__((address_space(3)))
typedef unsigned short bf16_t;
typedef short bf16x8 __attribute__((ext_vector_type(8)));
typedef float f32x4 __attribute__((ext_vector_type(4)));
typedef unsigned u32x4 __attribute__((ext_vector_type(4)));
constexpr int BM = 256, BK = 64, HALF = 128, HTB = HALF * BK * 2  , STAGE_BYTES = 8 * HTB, NXCD = 8, WGM = 8;

__host__ __device__ __forceinline__ int lds_byte(int r, int c) { const int st = (r >> 4) * 2 + (c >> 5), rr = r & 15, cc = c & 31, ob = rr * 64 + cc * 2; return st * 1024 + (ob ^ (((ob >> 9) & 1) << 5)); }
__host__ __device__ __forceinline__ void stage_rc(int b, int& R, int& C) { const int st = b / 1024, sb = b % 1024, swz = sb ^ (((sb >> 9) & 1) << 5); R = (st >> 1) * 16 + swz / 64; C = (st & 1) * 32 + (swz % 64) / 2; }
__host__ __device__ __forceinline__ int perm32(int rho) { const int n = rho >> 4, i = rho & 15; return 8 * (i >> 2) + 4 * n + (i & 3); }

struct Unit { int pm, pn; };
struct Gemm { const bf16_t* A; const bf16_t* Bt; int M, N, K; };

struct StaticOrder {
    int nM, nN, nwg, G, c;
    __host__ __device__ void init(int M, int N, int G_, int c_) { nM = M / BM; nN = N / BM; nwg = nM * nN; G = G_; c = c_; }
    __host__ __device__ bool next(int i, Unit& u) const {
        const long L = (long)i * G + c; if (L >= nwg) return false;
        int wgid = (int)L; { const int q = nwg / NXCD, r = nwg % NXCD, xcd = wgid % NXCD, off = wgid / NXCD; wgid = (xcd < r ? xcd * (q + 1) : r * (q + 1) + (xcd - r) * q) + off; }
        const int nig = WGM * nN, gid = wgid / nig, fm = gid * WGM, gsz = (nM - fm) < WGM ? (nM - fm) : WGM;
        u.pm = fm + ((wgid % nig) % gsz); u.pn = (wgid % nig) / gsz; return true;
    }
    __device__ __forceinline__ void a_ready(const Unit&) const {}
    __device__ __forceinline__ void done(const Unit&) const {}
};

template <class Epi, class Sched, bool ALIGN_EPI = false, bool SP2 = false>
__device__ __forceinline__ void gemm_phase(PG8_LAS unsigned char* lds, const Gemm g, const Sched& S, const Epi& E, int tid_in) {
    const int tid = tid_in, wid = __builtin_amdgcn_readfirstlane(tid >> 6), lane = tid & 63, wr = wid >> 2, wc = wid & 3, fr = lane & 15, fq = lane >> 4;
    const int K = g.K, nt = K / BK;
    unsigned voffA[2], voffB[2];
#pragma unroll
    for (int i = 0; i < 2; ++i) { int R, C; stage_rc(tid * 16 + i * 8192, R, C); const int Rb = Epi::PERM ? ((R & ~31) + perm32(R & 31)) : R;
        voffA[i] = (unsigned)(R * K + C) * 2u; voffB[i] = (unsigned)(Rb * K + C) * 2u; }
    const size_t kstep = (size_t)(BK * 2);
    const size_t hstep = (size_t)HALF * K * 2;
    const size_t tstep = 2 * hstep;
    const unsigned ldsw = (unsigned)wid * 1024u;
    const int aoff = lds_byte(wr * 64 + fr, fq * 8), boff = lds_byte(wc * 32 + fr, fq * 8);
#define PG8_SA(b, h) (((b) * 2 + (h)) * HTB)
#define PG8_SB(b, h) ((4 + (b) * 2 + (h)) * HTB)
#define PG8_STAGE(bufoff, gbase, voff) do { _Pragma("unroll") for (int _i = 0; _i < 2; ++_i) \
        __builtin_amdgcn_global_load_lds((const unsigned*)((const char*)(gbase) + (voff)[_i]), (PG8_LAS unsigned*)(lds + (bufoff) + ldsw + _i * 8192), 16, 0, 0); } while (0)
#define PG8_LDA(dst, b, h) do { _Pragma("unroll") for (int m = 0; m < 4; ++m) _Pragma("unroll") for (int k = 0; k < 2; ++k) dst[m][k] = *(const PG8_LAS bf16x8*)(lds + PG8_SA(b, h) + aoff + m * 2048 + k * 1024); } while (0)
#define PG8_LDB(dst, b, h) do { _Pragma("unroll") for (int n = 0; n < 2; ++n) _Pragma("unroll") for (int k = 0; k < 2; ++k) dst[n][k] = *(const PG8_LAS bf16x8*)(lds + PG8_SB(b, h) + boff + n * 2048 + k * 1024); } while (0)
#define PG8_MMA(ai, bj, At, Bt) do { __builtin_amdgcn_s_setprio(1); _Pragma("unroll") for (int m = 0; m < 4; ++m) _Pragma("unroll") for (int n = 0; n < 2; ++n) _Pragma("unroll") for (int k = 0; k < 2; ++k) \
        acc[ai][bj][m][n] = __builtin_amdgcn_mfma_f32_16x16x32_bf16(Bt[n][k], At[m][k], acc[ai][bj][m][n], 0, 0, 0); __builtin_amdgcn_s_setprio(0); } while (0)
#define PG8_WAIT_V(n) asm volatile("s_waitcnt vmcnt(" #n ")" ::: "memory")
#define PG8_WAIT_L(n) asm volatile("s_waitcnt lgkmcnt(" #n ")" ::: "memory")
#define PG8_BAR __builtin_amdgcn_s_barrier()
#define PG8_SCHED __builtin_amdgcn_sched_barrier(0)
    Unit cur, nxt; int ui = 0;
    if (!S.next(0, cur)) return;
    f32x4 acc[2][2][4][2];
#pragma unroll
    for (int a = 0; a < 2; ++a)
#pragma unroll
        for (int b = 0; b < 2; ++b)
#pragma unroll
            for (int m = 0; m < 4; ++m)
#pragma unroll
                for (int n = 0; n < 2; ++n) acc[a][b][m][n] = (f32x4){0.f, 0.f, 0.f, 0.f};
    bf16x8 At[4][2], B0[2][2], B1[2][2];
    const char* cA = (const char*)g.A + (size_t)cur.pm * tstep; const char* cB = (const char*)g.Bt + (size_t)cur.pn * tstep;
    S.a_ready(cur);
    if constexpr (SP2) {
        PG8_STAGE(PG8_SB(0, 0), cB, voffB); PG8_STAGE(PG8_SB(0, 1), cB + hstep, voffB); PG8_STAGE(PG8_SA(0, 0), cA, voffA); PG8_STAGE(PG8_SA(0, 1), cA + hstep, voffA);
        if (wr == 1) PG8_BAR;
        PG8_WAIT_V(2); PG8_BAR;
        PG8_STAGE(PG8_SB(1, 0), cB + kstep, voffB); PG8_STAGE(PG8_SA(1, 0), cA + kstep, voffA); PG8_STAGE(PG8_SB(1, 1), cB + hstep + kstep, voffB);
        PG8_WAIT_V(6); PG8_BAR;
    } else {
        PG8_STAGE(PG8_SB(0, 0), cB, voffB); PG8_STAGE(PG8_SA(0, 0), cA, voffA); PG8_STAGE(PG8_SB(0, 1), cB + hstep, voffB); PG8_STAGE(PG8_SA(0, 1), cA + hstep, voffA);
        if (wr == 1) PG8_BAR;
        PG8_WAIT_V(4); PG8_BAR;
        PG8_STAGE(PG8_SB(1, 0), cB + kstep, voffB); PG8_STAGE(PG8_SA(1, 0), cA + kstep, voffA); PG8_STAGE(PG8_SB(1, 1), cB + hstep + kstep, voffB);
        PG8_WAIT_V(6); PG8_BAR;
    }
    for (;;) {
        const bool has_next = S.next(ui + 1, nxt);
        const char* nA = has_next ? (const char*)g.A + (size_t)nxt.pm * tstep : cA; const char* nB = has_next ? (const char*)g.Bt + (size_t)nxt.pn * tstep : cB;
        for (int t = 0; t < nt; t += 2) {
            const bool last = (t == nt - 2);
            const char* a1 = cA + (size_t)(t + 1) * kstep;
            const char* a2 = last ? nA : cA + (size_t)(t + 2) * kstep; const char* b2 = last ? nB : cB + (size_t)(t + 2) * kstep;
            const char* a3 = a2 + kstep; const char* b3 = b2 + kstep;
            if (last && has_next) S.a_ready(nxt);
            if constexpr (SP2) {
            PG8_LDB(B0, 0, 0); PG8_LDB(B1, 0, 1); PG8_SCHED; PG8_LDA(At, 0, 0); PG8_STAGE(PG8_SA(1, 1), a1 + hstep, voffA);
            PG8_WAIT_V(8); PG8_WAIT_L(0); PG8_BAR; PG8_MMA(0, 0, At, B0); PG8_MMA(0, 1, At, B1); PG8_BAR; PG8_SCHED;
            PG8_LDA(At, 0, 1); PG8_STAGE(PG8_SB(0, 0), b2, voffB); PG8_STAGE(PG8_SB(0, 1), b2 + hstep, voffB); PG8_STAGE(PG8_SA(0, 0), a2, voffA);
            PG8_WAIT_V(8); PG8_WAIT_L(0); PG8_BAR; PG8_MMA(1, 0, At, B0); PG8_MMA(1, 1, At, B1); PG8_BAR; PG8_SCHED;
            PG8_LDB(B0, 1, 0); PG8_LDB(B1, 1, 1); PG8_SCHED; PG8_LDA(At, 1, 0); PG8_STAGE(PG8_SA(0, 1), a2 + hstep, voffA);
            PG8_WAIT_V(8); PG8_WAIT_L(0); PG8_BAR; PG8_MMA(0, 0, At, B0); PG8_MMA(0, 1, At, B1); PG8_BAR; PG8_SCHED;
            PG8_LDA(At, 1, 1); PG8_STAGE(PG8_SB(1, 0), b3, voffB); PG8_STAGE(PG8_SB(1, 1), b3 + hstep, voffB); PG8_STAGE(PG8_SA(1, 0), a3, voffA);
            PG8_WAIT_V(8); PG8_WAIT_L(0); PG8_BAR; PG8_MMA(1, 0, At, B0); PG8_MMA(1, 1, At, B1); PG8_BAR; PG8_SCHED;
            } else {
            PG8_LDB(B0, 0, 0); PG8_SCHED; PG8_LDA(At, 0, 0); PG8_STAGE(PG8_SA(1, 1), a1 + hstep, voffA);
            PG8_WAIT_L(8); PG8_BAR; PG8_WAIT_L(0); PG8_MMA(0, 0, At, B0); PG8_BAR; PG8_SCHED;
            PG8_LDB(B1, 0, 1); PG8_STAGE(PG8_SB(0, 0), b2, voffB);
            PG8_BAR; PG8_WAIT_L(0); PG8_MMA(0, 1, At, B1); PG8_BAR;
            PG8_LDA(At, 0, 1); PG8_STAGE(PG8_SA(0, 0), a2, voffA);
            PG8_BAR; PG8_WAIT_L(0); PG8_MMA(1, 0, At, B0); PG8_BAR; PG8_SCHED;
            PG8_STAGE(PG8_SB(0, 1), b2 + hstep, voffB);
            PG8_WAIT_V(6); PG8_BAR; PG8_MMA(1, 1, At, B1); PG8_BAR;
            PG8_LDB(B0, 1, 0); PG8_SCHED; PG8_LDA(At, 1, 0); PG8_STAGE(PG8_SA(0, 1), a2 + hstep, voffA);
            PG8_WAIT_L(8); PG8_BAR; PG8_WAIT_L(0); PG8_MMA(0, 0, At, B0); PG8_BAR; PG8_SCHED;
            PG8_LDB(B1, 1, 1); PG8_STAGE(PG8_SB(1, 0), b3, voffB);
            PG8_BAR; PG8_WAIT_L(0); PG8_MMA(0, 1, At, B1); PG8_BAR;
            PG8_LDA(At, 1, 1); PG8_STAGE(PG8_SA(1, 0), a3, voffA);
            PG8_BAR; PG8_WAIT_L(0); PG8_MMA(1, 0, At, B0); PG8_BAR; PG8_SCHED;
            PG8_STAGE(PG8_SB(1, 1), b3 + hstep, voffB);
            PG8_WAIT_V(6); PG8_BAR; PG8_MMA(1, 1, At, B1); PG8_BAR;
            }
        }
        if constexpr (ALIGN_EPI) { if (wr == 0) PG8_BAR; }
        if constexpr (!Epi::AFTER_DRAIN) { E(acc, cur, wr, wc, fr, fq); S.done(cur); }
        if (!has_next) break;
#pragma unroll
        for (int a = 0; a < 2; ++a)
#pragma unroll
            for (int b = 0; b < 2; ++b)
#pragma unroll
                for (int m = 0; m < 4; ++m)
#pragma unroll
                    for (int n = 0; n < 2; ++n) acc[a][b][m][n] = (f32x4){0.f, 0.f, 0.f, 0.f};
        cur = nxt; cA = nA; cB = nB; ++ui;
        if constexpr (ALIGN_EPI) { if (wr == 1) PG8_BAR; }
    }
    PG8_WAIT_V(0);
    if constexpr (!ALIGN_EPI) { if (wr == 0) PG8_BAR; }
    PG8_BAR;
    if constexpr (Epi::AFTER_DRAIN) { E.fused(acc, cur, wr, wc, fr, fq, lds, wid, lane); S.done(cur); }
#undef PG8_SA
#undef PG8_SB
#undef PG8_STAGE
#undef PG8_LDA
#undef PG8_LDB
#undef PG8_MMA
#undef PG8_WAIT_V
#undef PG8_WAIT_L
#undef PG8_BAR
#undef PG8_SCHED
}
}

#define LAS __attribute__((address_space(3)))
typedef unsigned short bf16_t;
typedef short bf16x8 __attribute__((ext_vector_type(8)));
typedef float f32x4 __attribute__((ext_vector_type(4)));
typedef float f32x16 __attribute__((ext_vector_type(16)));
typedef unsigned u32x4 __attribute__((ext_vector_type(4)));
typedef unsigned u32x2 __attribute__((ext_vector_type(2)));

constexpr int DM = 1024, NBATCH = 16, SEQ = 4096, TLAT = NBATCH * SEQ, LCTX = 256, TCTX = NBATCH * LCTX, MALL = TLAT + TCTX;
constexpr int DFF = 2816, INW = 2304, NWAVES = 8, NTHR = 512;
constexpr int QS = 1536, KS_ = 2048, VS_ = 2176;
constexpr float C2 = 0.125f * 1.4426950408889634f, LOG2E = 1.4426950408889634f;
constexpr size_t MiB = 1u << 20;
constexpr size_t WS_MOD = 1 * MiB, WS_TAB = 3 * MiB, WS_WIN = 4 * MiB, WS_WMIX = 13 * MiB, WS_WF = 17 * MiB, WS_WGU = 21 * MiB, WS_WD = 65 * MiB;
constexpr size_t WS_XC = 88 * MiB, WS_H = 104 * MiB, WS_R = 240 * MiB;
constexpr size_t WS_P = WS_R, WS_CAT = WS_R + 306 * MiB, WS_ACT = WS_R, WS_Z1 = WS_R, WS_ZC = WS_R + 256 * MiB, WS_A1 = WS_R + 272 * MiB, WS_FM = WS_R, WS_END = 1024 * MiB;
constexpr size_t TAB_ROPE = 0, TAB_TW = 64 * 1024, TAB_D1 = 128 * 1024, TAB_D2 = 192 * 1024, TAB_DC = 256 * 1024, TAB_DCTX = 512 * 1024;
constexpr int LDS_BYTES = 147456;

typedef float f32x2_t __attribute__((ext_vector_type(2))); typedef __bf16 bf16x2_t __attribute__((ext_vector_type(2)));
__device__ __forceinline__ unsigned cvt_pk(float lo, float hi) { f32x2_t v = {lo, hi}; bf16x2_t b = __builtin_convertvector(v, bf16x2_t); return __builtin_bit_cast(unsigned, b); }
__device__ __forceinline__ float bf_lo(unsigned w) { return __builtin_bit_cast(float, w << 16); }
__device__ __forceinline__ float bf_hi(unsigned w) { return __builtin_bit_cast(float, w & 0xffff0000u); }
__device__ __forceinline__ float fast_exp2(float x) { return __builtin_amdgcn_exp2f(x); }
__device__ __forceinline__ float fast_rcp(float x) { return __builtin_amdgcn_rcpf(x); }
__device__ __forceinline__ float silu_f(float x) { return x * fast_rcp(1.0f + fast_exp2(-x * LOG2E)); }
#define LDS_WAIT() asm volatile("s_waitcnt lgkmcnt(0)" ::: "memory")

struct Args {
    const float* x; const float* c; const float* ctx; const float* c_ctx; const float* w_ada; const float* b_ada; const float* n1g; const float* n2g;
    const float* w_in; const float* conv_w; const float* sink; const float* w_mix; const float* w_four; const float* w_gate; const float* w_up; const float* w_down; const float* final_g;
    float* out; unsigned char* ws;
    double invf[16];
};

struct EpiInProj {
    static constexpr bool PERM = false, AFTER_DRAIN = false;
    bf16_t* P; const float* rope;
    __device__ __forceinline__ void operator()(const f32x4 (&acc)[2][2][4][2], const pg8::Unit& u, int wr, int wc, int fr, int fq) const {
        const bool lat = u.pm < 256, doq = (u.pn == 6 || u.pn == 7), ropeT = lat && u.pn >= 6;
#pragma unroll
        for (int ai = 0; ai < 2; ++ai)
#pragma unroll
            for (int m = 0; m < 4; ++m) {
                const int row = u.pm * 256 + ai * 128 + wr * 64 + m * 16 + fr;
                f32x4 cv = {1.f, 1.f, 1.f, 1.f}, sv = {0.f, 0.f, 0.f, 0.f};
                if (ropeT) { const int t = row & 4095; const int a = (wc & 1) ? (t & 63) : (t >> 6);
                    const f32x4* rp = (const f32x4*)(rope + (a * 16 + 4 * fq) * 2); const f32x4 c0 = rp[0], c1 = rp[1];
                    cv = (f32x4){c0.x, c0.z, c1.x, c1.z}; sv = (f32x4){c0.y, c0.w, c1.y, c1.w}; }
#pragma unroll
                for (int bj = 0; bj < 2; ++bj) {
                    f32x4 x1 = acc[ai][bj][m][0], x2 = acc[ai][bj][m][1];
                    if (ropeT && !(u.pn == 8 && bj == 1)) { const f32x4 o1 = x1 * cv - x2 * sv, o2 = x2 * cv + x1 * sv; x1 = o1; x2 = o2; }
                    if (doq) { x1 = x1 * C2; x2 = x2 * C2; }
                    bf16_t* p = P + (size_t)row * INW + u.pn * 256 + bj * 128 + wc * 32 + 4 * fq;
                    u32x2 w1, w2; w1.x = cvt_pk(x1[0], x1[1]); w1.y = cvt_pk(x1[2], x1[3]); w2.x = cvt_pk(x2[0], x2[1]); w2.y = cvt_pk(x2[2], x2[3]);
                    *(u32x2*)p = w1; *(u32x2*)(p + 16) = w2;
                }
            }
    }
};
struct EpiRes {
    static constexpr bool PERM = false, AFTER_DRAIN = false;
    const float* in_lat; const float* in_ctx; float* out_lat; float* out_ctx; const float* modl; int gate_idx;
    __device__ __forceinline__ void operator()(const f32x4 (&acc)[2][2][4][2], const pg8::Unit& u, int wr, int wc, int fr, int fq) const {
        const bool lat = u.pm < 256; const int rbase = lat ? u.pm * 256 : u.pm * 256 - TLAT; const int r = lat ? (u.pm >> 4) : 16;
        const float* ip = lat ? in_lat : in_ctx; float* op = lat ? out_lat : out_ctx;
        const float* gate = modl + (r * 6 + gate_idx) * 1024;
        const int col0 = u.pn * 256 + wc * 32 + 4 * fq;
        f32x4 gv[2][2];
#pragma unroll
        for (int bj = 0; bj < 2; ++bj)
#pragma unroll
            for (int n = 0; n < 2; ++n) gv[bj][n] = *(const f32x4*)(gate + col0 + bj * 128 + 16 * n);
        const size_t off0 = (size_t)(rbase + wr * 64 + fr) * DM + col0;
        f32x4 xb[2][2][2];
#pragma unroll
        for (int bj = 0; bj < 2; ++bj)
#pragma unroll
            for (int n = 0; n < 2; ++n) xb[0][bj][n] = *(const f32x4*)(ip + off0 + bj * 128 + 16 * n);
#pragma unroll
        for (int grp = 0; grp < 8; ++grp) {
            const int ai = grp >> 2, m = grp & 3, cb = grp & 1;
            const size_t off = off0 + (size_t)(ai * 128 + m * 16) * DM;
            if (grp < 7) { const int ai2 = (grp + 1) >> 2, m2 = (grp + 1) & 3; const size_t offn = off0 + (size_t)(ai2 * 128 + m2 * 16) * DM;
#pragma unroll
                for (int bj = 0; bj < 2; ++bj)
#pragma unroll
                    for (int n = 0; n < 2; ++n) xb[cb ^ 1][bj][n] = *(const f32x4*)(ip + offn + bj * 128 + 16 * n); }
            asm volatile("" ::: "memory");
#pragma unroll
            for (int bj = 0; bj < 2; ++bj)
#pragma unroll
                for (int n = 0; n < 2; ++n) *(f32x4*)(op + off + bj * 128 + 16 * n) = xb[cb][bj][n] + gv[bj][n] * acc[ai][bj][m][n];
            asm volatile("" ::: "memory");
        }
    }
};
struct EpiSwiGLU {
    static constexpr bool PERM = false, AFTER_DRAIN = false;
    bf16_t* ACT;
    __device__ __forceinline__ void operator()(const f32x4 (&acc)[2][2][4][2], const pg8::Unit& u, int wr, int wc, int fr, int fq) const {
#pragma unroll
        for (int ai = 0; ai < 2; ++ai)
#pragma unroll
            for (int m = 0; m < 4; ++m) {
                const int row = u.pm * 256 + ai * 128 + wr * 64 + m * 16 + fr;
#pragma unroll
                for (int bj = 0; bj < 2; ++bj) {
                    const f32x4 g = acc[ai][bj][m][0], v = acc[ai][bj][m][1];
                    const int f = (u.pn * 8 + bj * 4 + wc) * 16 + 4 * fq;
                    u32x2 w; w.x = cvt_pk(silu_f(g[0]) * v[0], silu_f(g[1]) * v[1]); w.y = cvt_pk(silu_f(g[2]) * v[2], silu_f(g[3]) * v[3]);
                    *(u32x2*)(ACT + (size_t)row * DFF + f) = w;
                }
            }
    }
};
struct EpiPlain {
    static constexpr bool PERM = false, AFTER_DRAIN = false;
    bf16_t* O; int ldc;
    __device__ __forceinline__ void operator()(const f32x4 (&acc)[2][2][4][2], const pg8::Unit& u, int wr, int wc, int fr, int fq) const {
#pragma unroll
        for (int ai = 0; ai < 2; ++ai)
#pragma unroll
            for (int m = 0; m < 4; ++m) {
                const int row = u.pm * 256 + ai * 128 + wr * 64 + m * 16 + fr;
#pragma unroll
                for (int bj = 0; bj < 2; ++bj)
#pragma unroll
                    for (int n = 0; n < 2; ++n) {
                        const f32x4 x = acc[ai][bj][m][n]; u32x2 w; w.x = cvt_pk(x[0], x[1]); w.y = cvt_pk(x[2], x[3]);
                        *(u32x2*)(O + (size_t)row * ldc + u.pn * 256 + bj * 128 + wc * 32 + 16 * n + 4 * fq) = w;
                    }
            }
    }
};

__device__ __forceinline__ void sincos_turns(double x, double& s, double& c) {
    x = x - floor(x);
    const double q4 = floor(x * 4.0 + 0.5);
    const double r = x - q4 * 0.25;
    const int q = ((int)q4) & 3;
    const double th = r * 6.283185307179586476925, t2 = th * th;
    const double sp = th * (1.0 + t2 * (-1.0 / 6 + t2 * (1.0 / 120 + t2 * (-1.0 / 5040 + t2 * (1.0 / 362880 + t2 * (-1.0 / 39916800 + t2 * (1.0 / 6227020800.0)))))));
    const double cp = 1.0 + t2 * (-0.5 + t2 * (1.0 / 24 + t2 * (-1.0 / 720 + t2 * (1.0 / 40320 + t2 * (-1.0 / 3628800 + t2 * (1.0 / 479001600.0 + t2 * (-1.0 / 87178291200.0)))))));
    if (q == 0) { s = sp; c = cp; } else if (q == 1) { s = cp; c = -sp; } else if (q == 2) { s = -sp; c = -cp; } else { s = -cp; c = sp; }
}
__device__ __forceinline__ unsigned short f2bf(float f) { return __builtin_bit_cast(unsigned short, (__bf16)f); }

__device__ __forceinline__ void transpose_item(const float* W, int K, int N, bf16_t* WT, int mode, LAS float* scr, int item, int lane) {
    const int nblk = N / 32, kb = item / nblk, nb = item % nblk, k0 = 64 * kb, n0 = 32 * nb;
#pragma unroll 8
    for (int i = 0; i < 32; ++i) { const int kk = 2 * i + (lane >> 5); scr[kk * 33 + (lane & 31)] = W[(size_t)(k0 + kk) * N + n0 + (lane & 31)]; }
    LDS_WAIT(); asm volatile("" ::: "memory");
    const int c = lane & 7;
#pragma unroll
    for (int j = 0; j < 4; ++j) { const int n = (lane >> 3) + 8 * j; const LAS float* s = scr + (8 * c) * 33 + n;
        u32x4 o; o.x = cvt_pk(s[0 * 33], s[1 * 33]); o.y = cvt_pk(s[2 * 33], s[3 * 33]); o.z = cvt_pk(s[4 * 33], s[5 * 33]); o.w = cvt_pk(s[6 * 33], s[7 * 33]);
        const int f = n0 + n; const int orow = (mode == 0) ? f : (((f >> 4) << 5) + (f & 15) + (mode == 2 ? 16 : 0));
        *(u32x4*)(WT + (size_t)orow * K + k0 + 8 * c) = o; }
    LDS_WAIT(); asm volatile("" ::: "memory");
}

__device__ __forceinline__ void prologue(const Args& A, LAS unsigned char* lds, int tid, int wave, int lane, int G) {
    unsigned char* ws = A.ws;
    {
        LAS float* scr = (LAS float*)(lds + wave * 16384);
        const int gw = blockIdx.x * NWAVES + wave, NGW = G * NWAVES;
        constexpr int I_IN = 16 * 72, I_SQ = 16 * 32, I_FF = 16 * 88, I_DN = 44 * 32;
        constexpr int NIT = 2 * I_IN + 4 * I_SQ + 8 * I_FF + 4 * I_DN;
        for (int it = gw; it < NIT; it += NGW) {
            int r = it;
            if (r < 2 * I_IN) { const int e = r / I_IN; transpose_item(A.w_in + (size_t)e * DM * INW, DM, INW, (bf16_t*)(ws + WS_WIN) + (size_t)e * INW * DM, 0, scr, r % I_IN, lane); continue; } r -= 2 * I_IN;
            if (r < 2 * I_SQ) { const int e = r / I_SQ; transpose_item(A.w_mix + (size_t)e * DM * DM, DM, DM, (bf16_t*)(ws + WS_WMIX) + (size_t)e * DM * DM, 0, scr, r % I_SQ, lane); continue; } r -= 2 * I_SQ;
            if (r < 2 * I_SQ) { const int e = r / I_SQ; transpose_item(A.w_four + (size_t)e * DM * DM, DM, DM, (bf16_t*)(ws + WS_WF) + (size_t)e * DM * DM, 0, scr, r % I_SQ, lane); continue; } r -= 2 * I_SQ;
            if (r < 4 * I_FF) { const int l = r / I_FF; transpose_item(A.w_gate + (size_t)l * DM * DFF, DM, DFF, (bf16_t*)(ws + WS_WGU) + (size_t)l * 2 * DFF * DM, 1, scr, r % I_FF, lane); continue; } r -= 4 * I_FF;
            if (r < 4 * I_FF) { const int l = r / I_FF; transpose_item(A.w_up + (size_t)l * DM * DFF, DM, DFF, (bf16_t*)(ws + WS_WGU) + (size_t)l * 2 * DFF * DM, 2, scr, r % I_FF, lane); continue; } r -= 4 * I_FF;
            { const int l = r / I_DN; transpose_item(A.w_down + (size_t)l * DFF * DM, DFF, DM, (bf16_t*)(ws + WS_WD) + (size_t)l * DM * DFF, 0, scr, r % I_DN, lane); }
        }
    }
    {
        const int gt = blockIdx.x * NTHR + tid, NGT = G * NTHR;
        float* rope = (float*)(ws + WS_TAB + TAB_ROPE); float* tw = (float*)(ws + WS_TAB + TAB_TW);
        bf16_t* D1 = (bf16_t*)(ws + WS_TAB + TAB_D1); bf16_t* D2 = (bf16_t*)(ws + WS_TAB + TAB_D2); bf16_t* DC = (bf16_t*)(ws + WS_TAB + TAB_DC); bf16_t* DX = (bf16_t*)(ws + WS_TAB + TAB_DCTX);
        constexpr int N_ROPE = 1024, N_TW = 4096, N_D1 = 16384, N_D2 = 8192, N_DC = 131072, N_DX = 131072;
        for (int i = gt; i < N_ROPE + N_TW + N_D1 + N_D2 + N_DC + N_DX; i += NGT) {
            int r = i; double s, c;
            if (r < N_ROPE) { const int a = r >> 4, f = r & 15; sincos_turns((double)a * A.invf[f] * 0.15915494309189533577, s, c); rope[2 * r] = (float)c; rope[2 * r + 1] = (float)s; continue; } r -= N_ROPE;
            if (r < N_TW) { const int k1 = r >> 6, n2 = r & 63; sincos_turns((double)(k1 * n2) / 4096.0, s, c); tw[2 * r] = (float)c; tw[2 * r + 1] = (float)s; continue; } r -= N_TW;
            if (r < N_D1) { const int row = r >> 7, col = r & 127, k1 = row >> 1, rio = row & 1, rii = col >> 6, n1 = col & 63; sincos_turns((double)((k1 * n1) & 63) / 64.0, s, c);
                const double v = (rio == rii) ? c : (rio == 0 ? s : -s); D1[r] = f2bf((float)(v * 0.125)); continue; } r -= N_D1;
            if (r < N_D2) { const int k2 = r >> 7, col = r & 127, ri = col >> 6, n2 = col & 63; sincos_turns((double)((k2 * n2) & 63) / 64.0, s, c); D2[r] = f2bf((float)((ri ? s : c) * 0.125)); continue; } r -= N_D2;
            if (r < N_DC) { const int row = r >> 8, cc = r & 255, ri = row >> 8, m = row & 255; sincos_turns((double)((m * cc) & 255) / 256.0, s, c); DC[r] = f2bf((float)((ri ? -s : c) * 0.0625)); continue; } r -= N_DC;
            { const int k = r >> 9, col = r & 511, ri = col >> 8, n = col & 255; sincos_turns((double)((k * n) & 255) / 256.0, s, c); DX[r] = f2bf((float)((ri ? s : c) * 0.0625)); }
        }
    }
    __syncthreads();
    {
        LAS float* S = (LAS float*)lds; LAS float* Pp = (LAS float*)(lds + 69632);
        for (int i = tid; i < 17 * 1024; i += NTHR) { const int r = i >> 10, k = i & 1023; const float v = (r < 16) ? A.c[r * 1024 + k] : A.c_ctx[k]; S[i] = v / (1.0f + expf(-v)); }
        __syncthreads();
        float* mod = (float*)(ws + WS_MOD);
        for (int task = blockIdx.x; task < 4 * 96; task += G) {
            const int l = task / 96, j0 = (task % 96) * 64;
            const float* w = A.w_ada + (size_t)l * 1024 * 6144 + j0 + lane;
            float acc[17];
#pragma unroll
            for (int r = 0; r < 17; ++r) acc[r] = 0.f;
#pragma unroll 4
            for (int kk = 0; kk < 128; ++kk) { const int k = wave * 128 + kk; const float wv = w[(size_t)k * 6144];
#pragma unroll
                for (int r = 0; r < 17; ++r) acc[r] += S[r * 1024 + k] * wv; }
#pragma unroll
            for (int r = 0; r < 17; ++r) Pp[(wave * 17 + r) * 64 + lane] = acc[r];
            __syncthreads();
            for (int o = tid; o < 17 * 64; o += NTHR) { const int r = o >> 6, jj = o & 63; float sum = 0.f;
#pragma unroll
                for (int w8 = 0; w8 < 8; ++w8) sum += Pp[(w8 * 17 + r) * 64 + jj];
                mod[(size_t)(l * 17 + r) * 6144 + j0 + jj] = sum + A.b_ada[l * 6144 + j0 + jj]; }
            __syncthreads();
        }
    }
}

__device__ __forceinline__ const float* norm_rowp(const float* lat, const float* ctxp, int row) { return (row < TLAT) ? lat + (size_t)row * DM : ctxp + (size_t)(row - TLAT) * DM; }
__device__ __forceinline__ void norm_phase(const float* lat, const float* ctxp, const float* g, const float* modl, int shift_idx, bf16_t* hout, int M, int gw, int NGW, int lane) {
    constexpr int NR = 2;
    const int rpw = M / NGW, rbeg = gw * rpw, rend = rbeg + rpw;
    f32x4 gv[4];
#pragma unroll
    for (int j = 0; j < 4; ++j) gv[j] = *(const f32x4*)(g + 4 * lane + 256 * j);
    f32x4 vc[NR][4], vn[NR][4], scv[4], shv[4]; int rcur = -1;
#pragma unroll
    for (int q = 0; q < NR; ++q)
#pragma unroll
        for (int j = 0; j < 4; ++j) vc[q][j] = *(const f32x4*)(norm_rowp(lat, ctxp, rbeg + q) + 4 * lane + 256 * j);
    for (int row0 = rbeg; row0 < rend; row0 += NR) {
        const int r = (row0 < TLAT) ? (row0 >> 12) : 16;
        if (r != rcur) { rcur = r; const float* sh = modl + (r * 6 + shift_idx) * 1024; const float* sc = sh + 1024;
#pragma unroll
            for (int j = 0; j < 4; ++j) { scv[j] = (*(const f32x4*)(sc + 4 * lane + 256 * j) + 1.0f) * gv[j]; shv[j] = *(const f32x4*)(sh + 4 * lane + 256 * j); } }
        if (row0 + NR < rend) {
#pragma unroll
            for (int q = 0; q < NR; ++q)
#pragma unroll
                for (int j = 0; j < 4; ++j) vn[q][j] = *(const f32x4*)(norm_rowp(lat, ctxp, row0 + NR + q) + 4 * lane + 256 * j); }
        asm volatile("" ::: "memory");
#pragma unroll
        for (int q = 0; q < NR; ++q) { float ss = 0.f;
#pragma unroll
            for (int j = 0; j < 4; ++j) ss += (vc[q][j].x * vc[q][j].x + vc[q][j].y * vc[q][j].y) + (vc[q][j].z * vc[q][j].z + vc[q][j].w * vc[q][j].w);
#pragma unroll
            for (int o = 1; o < 64; o <<= 1) ss += __shfl_xor(ss, o);
            const float rstd = 1.0f / sqrtf(ss * (1.0f / DM) + 1e-6f);
#pragma unroll
            for (int j = 0; j < 4; ++j) { const f32x4 o = vc[q][j] * rstd * scv[j] + shv[j];
                u32x2 w; w.x = cvt_pk(o.x, o.y); w.y = cvt_pk(o.z, o.w);
                *(u32x2*)(hout + (size_t)(row0 + q) * DM + 4 * lane + 256 * j) = w; } }
        asm volatile("" ::: "memory");
#pragma unroll
        for (int q = 0; q < NR; ++q)
#pragma unroll
            for (int j = 0; j < 4; ++j) vc[q][j] = vn[q][j];
    }
}
__device__ __forceinline__ void final_norm_phase(float* xo, const float* g, int gw, int NGW, int lane) {
    constexpr int NR = 2;
    const int rpw = TLAT / NGW, rbeg = gw * rpw, rend = rbeg + rpw;
    f32x4 gv[4];
#pragma unroll
    for (int j = 0; j < 4; ++j) gv[j] = *(const f32x4*)(g + 4 * lane + 256 * j);
    f32x4 vc[NR][4], vn[NR][4];
#pragma unroll
    for (int q = 0; q < NR; ++q)
#pragma unroll
        for (int j = 0; j < 4; ++j) vc[q][j] = *(const f32x4*)(xo + (size_t)(rbeg + q) * DM + 4 * lane + 256 * j);
    for (int row0 = rbeg; row0 < rend; row0 += NR) {
        if (row0 + NR < rend) {
#pragma unroll
            for (int q = 0; q < NR; ++q)
#pragma unroll
                for (int j = 0; j < 4; ++j) vn[q][j] = *(const f32x4*)(xo + (size_t)(row0 + NR + q) * DM + 4 * lane + 256 * j); }
        asm volatile("" ::: "memory");
#pragma unroll
        for (int q = 0; q < NR; ++q) { float ss = 0.f;
#pragma unroll
            for (int j = 0; j < 4; ++j) ss += (vc[q][j].x * vc[q][j].x + vc[q][j].y * vc[q][j].y) + (vc[q][j].z * vc[q][j].z + vc[q][j].w * vc[q][j].w);
#pragma unroll
            for (int o = 1; o < 64; o <<= 1) ss += __shfl_xor(ss, o);
            const float rstd = 1.0f / sqrtf(ss * (1.0f / DM) + 1e-6f);
#pragma unroll
            for (int j = 0; j < 4; ++j) *(f32x4*)(xo + (size_t)(row0 + q) * DM + 4 * lane + 256 * j) = vc[q][j] * rstd * gv[j]; }
        asm volatile("" ::: "memory");
#pragma unroll
        for (int q = 0; q < NR; ++q)
#pragma unroll
            for (int j = 0; j < 4; ++j) vc[q][j] = vn[q][j];
    }
}

__device__ __forceinline__ int crow(int r, int hi) { return (r & 3) + 8 * (r >> 2) + 4 * hi; }

__device__ __forceinline__ void attn_phase(LAS unsigned char* lds, const bf16_t* P, bf16_t* cat, const float* sink, bool ctxq, int G, int tid, int wave, int lane) {
    constexpr int KROW = 144, VROW = 264;
    LAS unsigned char* Kl = lds; LAS unsigned char* Vl = lds + 128 * KROW;
    const int r32 = lane & 31, hi = lane >> 5, g = wave & 3, qh = wave >> 2;
    const int nitems = 1024 + (ctxq ? 64 : 0);
    for (int it = blockIdx.x; it < nitems; it += G) {
        int b, hk, qb, qr0; const bool isl = it < 1024;
        if (isl) { b = it >> 6; hk = (it >> 5) & 1; qb = it & 31; qr0 = b * SEQ + qb * 128; }
        else { const int j = it - 1024; b = j >> 2; hk = (j >> 1) & 1; qb = j & 1; qr0 = TLAT + b * LCTX + qb * 128; }
        const int crow0 = TLAT + b * LCTX, head = hk * 4 + g;
        bf16x8 qf[2][4];
#pragma unroll
        for (int s = 0; s < 2; ++s)
#pragma unroll
            for (int ks = 0; ks < 4; ++ks) qf[s][ks] = *(const bf16x8*)(P + (size_t)(qr0 + 64 * qh + 32 * s + r32) * INW + QS + head * 64 + 16 * ks + 8 * hi);
        float mrun[2], lrun[2]; f32x16 O[2][2];
        const float sk2 = sink[head] * LOG2E;
#pragma unroll
        for (int s = 0; s < 2; ++s) { mrun[s] = sk2; lrun[s] = 1.0f;
#pragma unroll
            for (int dt = 0; dt < 2; ++dt)
#pragma unroll
                for (int r = 0; r < 16; ++r) O[s][dt][r] = 0.f; }
#pragma unroll 1
        for (int ti = 0; ti < 5; ++ti) {
            int krow0, mtype = 0; bool valid = true;
            if (ti == 0) { krow0 = qr0 - 128; mtype = 1; valid = isl && qb > 0; }
            else if (ti == 1) { krow0 = qr0; valid = isl; }
            else if (ti == 2) { krow0 = qr0 + 128; mtype = 2; valid = isl && qb < 31; }
            else { krow0 = crow0 + (ti - 3) * 128; }
            if (!valid) continue;
            __syncthreads();
#pragma unroll
            for (int i = 0; i < 2; ++i) { const int id = tid + NTHR * i, key = id >> 3, c = id & 7;
                const u32x4 v = *(const u32x4*)(P + (size_t)(krow0 + key) * INW + KS_ + hk * 64 + 8 * c);
                *(LAS u32x4*)(Kl + key * KROW + c * 16) = v; }
#pragma unroll
            for (int i = 0; i < 2; ++i) { const int id = tid + NTHR * i, key = id & 127, c = id >> 7;
                const u32x4 v = *(const u32x4*)(P + (size_t)(krow0 + key) * INW + VS_ + hk * 64 + 8 * c);
                LAS unsigned char* vp = Vl + (8 * c) * VROW + key * 2;
                *(LAS unsigned short*)(vp + 0 * VROW) = (unsigned short)(v.x & 0xffffu); *(LAS unsigned short*)(vp + 1 * VROW) = (unsigned short)(v.x >> 16);
                *(LAS unsigned short*)(vp + 2 * VROW) = (unsigned short)(v.y & 0xffffu); *(LAS unsigned short*)(vp + 3 * VROW) = (unsigned short)(v.y >> 16);
                *(LAS unsigned short*)(vp + 4 * VROW) = (unsigned short)(v.z & 0xffffu); *(LAS unsigned short*)(vp + 5 * VROW) = (unsigned short)(v.z >> 16);
                *(LAS unsigned short*)(vp + 6 * VROW) = (unsigned short)(v.w & 0xffffu); *(LAS unsigned short*)(vp + 7 * VROW) = (unsigned short)(v.w >> 16); }
            __syncthreads();
#pragma unroll
            for (int half = 0; half < 2; ++half)
#pragma unroll
                for (int s = 0; s < 2; ++s) {
                    f32x16 S[2];
#pragma unroll
                    for (int rt = 0; rt < 2; ++rt) {
#pragma unroll
                        for (int r = 0; r < 16; ++r) S[rt][r] = 0.f;
#ifndef DIAG
                        asm volatile("" : "+v"(S[rt]));
#endif
#pragma unroll
                        for (int ks = 0; ks < 4; ++ks) { const bf16x8 kf = *(const LAS bf16x8*)(Kl + (64 * half + 32 * rt + r32) * KROW + (16 * ks + 8 * hi) * 2);
                            S[rt] = __builtin_amdgcn_mfma_f32_32x32x16_bf16(kf, qf[s][ks], S[rt], 0, 0, 0); }
                    }
                    if (mtype != 0) { int il = 64 * qh + 32 * s + r32; asm volatile("" : "+v"(il));
#pragma unroll
                        for (int rt = 0; rt < 2; ++rt)
#pragma unroll
                            for (int r = 0; r < 16; ++r) { const int jl = 64 * half + 32 * rt + crow(r, hi); const bool ok = (mtype == 1) ? (jl >= il) : (jl <= il); if (!ok) S[rt][r] = -INFINITY; } }
                    float tmax = S[0][0];
#pragma unroll
                    for (int rt = 0; rt < 2; ++rt)
#pragma unroll
                        for (int r = 0; r < 16; ++r) tmax = fmaxf(tmax, S[rt][r]);
                    tmax = fmaxf(tmax, __shfl_xor(tmax, 32));
                    const float mnew = fmaxf(mrun[s], tmax), alpha = fast_exp2(mrun[s] - mnew);
                    mrun[s] = mnew;
                    float psum = 0.f;
#pragma unroll
                    for (int rt = 0; rt < 2; ++rt)
#pragma unroll
                        for (int r = 0; r < 16; ++r) { const float p = fast_exp2(S[rt][r] - mnew); S[rt][r] = p; psum += p; }
                    psum += __shfl_xor(psum, 32);
                    lrun[s] = lrun[s] * alpha + psum;
#pragma unroll
                    for (int dt = 0; dt < 2; ++dt)
#pragma unroll
                        for (int r = 0; r < 16; ++r) O[s][dt][r] *= alpha;
#pragma unroll
                    for (int rt = 0; rt < 2; ++rt)
#pragma unroll
                        for (int s2 = 0; s2 < 2; ++s2) {
                            u32x4 pw; pw.x = cvt_pk(S[rt][8 * s2 + 0], S[rt][8 * s2 + 1]); pw.y = cvt_pk(S[rt][8 * s2 + 2], S[rt][8 * s2 + 3]);
                            pw.z = cvt_pk(S[rt][8 * s2 + 4], S[rt][8 * s2 + 5]); pw.w = cvt_pk(S[rt][8 * s2 + 6], S[rt][8 * s2 + 7]);
                            const bf16x8 pf = __builtin_bit_cast(bf16x8, pw);
#pragma unroll
                            for (int dt = 0; dt < 2; ++dt) {
                                const LAS unsigned char* vb = Vl + (32 * dt + r32) * VROW + (64 * half + 32 * rt + 16 * s2 + 4 * hi) * 2;
                                const u32x2 v0 = *(const LAS u32x2*)vb, v1 = *(const LAS u32x2*)(vb + 16);
                                const u32x4 vv = {v0.x, v0.y, v1.x, v1.y};
                                O[s][dt] = __builtin_amdgcn_mfma_f32_32x32x16_bf16(__builtin_bit_cast(bf16x8, vv), pf, O[s][dt], 0, 0, 0);
                            }
                        }
                }
        }
#pragma unroll
        for (int s = 0; s < 2; ++s) { const float inv = 1.0f / lrun[s];
            bf16_t* orow = cat + (size_t)(qr0 + 64 * qh + 32 * s + r32) * DM + 512 + head * 64;
#pragma unroll
            for (int dt = 0; dt < 2; ++dt)
#pragma unroll
                for (int q4 = 0; q4 < 4; ++q4) { u32x2 w; w.x = cvt_pk(O[s][dt][4 * q4 + 0] * inv, O[s][dt][4 * q4 + 1] * inv); w.y = cvt_pk(O[s][dt][4 * q4 + 2] * inv, O[s][dt][4 * q4 + 3] * inv);
                    *(u32x2*)(orow + 32 * dt + 8 * q4 + 4 * hi) = w; } }
    }
    __syncthreads();
}

__device__ __forceinline__ void load_u(const bf16_t* P, int t, int s0, int s1, int c8, float (&u)[8]) {
    if (t < s0 || t >= s1) {
#pragma unroll
        for (int j = 0; j < 8; ++j) u[j] = 0.f;
    } else {
        const u32x4 cv = *(const u32x4*)(P + (size_t)t * INW + 512 + 8 * c8), hv = *(const u32x4*)(P + (size_t)t * INW + 1024 + 8 * c8);
        u[0] = bf_lo(cv.x) * bf_lo(hv.x); u[1] = bf_hi(cv.x) * bf_hi(hv.x); u[2] = bf_lo(cv.y) * bf_lo(hv.y); u[3] = bf_hi(cv.y) * bf_hi(hv.y);
        u[4] = bf_lo(cv.z) * bf_lo(hv.z); u[5] = bf_hi(cv.z) * bf_hi(hv.z); u[6] = bf_lo(cv.w) * bf_lo(hv.w); u[7] = bf_hi(cv.w) * bf_hi(hv.w);
    }
}
__device__ __forceinline__ void conv_phase(const bf16_t* P, bf16_t* cat, const float* cw, int M, int G, int tid) {
    const int c8 = tid & 63, tg = tid >> 6;
    float w0[8], w1[8], w2[8];
#pragma unroll
    for (int j = 0; j < 8; ++j) { w0[j] = cw[8 * c8 + j]; w1[j] = cw[512 + 8 * c8 + j]; w2[j] = cw[1024 + 8 * c8 + j]; }
    for (int it = blockIdx.x; it < M / 128; it += G) {
        const int t0 = it * 128, ts = t0 + 16 * tg;
        int s0, s1; if (t0 < TLAT) { s0 = t0 & ~4095; s1 = s0 + 4096; } else { s0 = TLAT + ((t0 - TLAT) & ~255); s1 = s0 + 256; }
        float up[8], uc[8], un[8];
        load_u(P, ts - 1, s0, s1, c8, up); load_u(P, ts, s0, s1, c8, uc);
#pragma unroll 2
        for (int i = 0; i < 16; ++i) { const int t = ts + i;
            load_u(P, t + 1, s0, s1, c8, un);
            const u32x4 bv = *(const u32x4*)(P + (size_t)t * INW + 8 * c8);
            float bb[8] = {bf_lo(bv.x), bf_hi(bv.x), bf_lo(bv.y), bf_hi(bv.y), bf_lo(bv.z), bf_hi(bv.z), bf_lo(bv.w), bf_hi(bv.w)};
            float o[8];
#pragma unroll
            for (int j = 0; j < 8; ++j) { o[j] = bb[j] * (w0[j] * up[j] + w1[j] * uc[j] + w2[j] * un[j]); up[j] = uc[j]; uc[j] = un[j]; }
            u32x4 w; w.x = cvt_pk(o[0], o[1]); w.y = cvt_pk(o[2], o[3]); w.z = cvt_pk(o[4], o[5]); w.w = cvt_pk(o[6], o[7]);
            *(u32x4*)(cat + (size_t)t * DM + 8 * c8) = w; }
    }
}

template <int MT, int KS> __device__ __forceinline__ void dft_load_a(bf16x8 (&a)[MT][KS], const bf16_t* Mat, int row0, int r32, int hi) {
#pragma unroll
    for (int rt = 0; rt < MT; ++rt)
#pragma unroll
        for (int ks = 0; ks < KS; ++ks) a[rt][ks] = *(const bf16x8*)(Mat + (size_t)(row0 + 32 * rt + r32) * (KS * 16) + 16 * ks + 8 * hi);
}
template <int MT, int KS> __device__ __forceinline__ void dft_mm(f32x16 (&acc)[MT], const bf16x8 (&a)[MT][KS], const bf16_t* vec) {
#pragma unroll
    for (int rt = 0; rt < MT; ++rt)
#pragma unroll
        for (int r = 0; r < 16; ++r) acc[rt][r] = 0.f;
#pragma unroll
    for (int rt = 0; rt < MT; ++rt) asm volatile("" : "+v"(acc[rt]));
    constexpr int KC = 8;
#pragma unroll
    for (int kc = 0; kc < KS / KC; ++kc) {
        bf16x8 b[KC];
#pragma unroll
        for (int i = 0; i < KC; ++i) b[i] = *(const bf16x8*)(vec + 16 * (kc * KC + i));
#pragma unroll
        for (int i = 0; i < KC; ++i)
#pragma unroll
            for (int rt = 0; rt < MT; ++rt) acc[rt] = __builtin_amdgcn_mfma_f32_32x32x16_bf16(a[rt][kc * KC + i], b[i], acc[rt], 0, 0, 0);
    }
}
__device__ __forceinline__ void store_pair(bf16_t* base, size_t zoo, unsigned cA, unsigned cB, float va, float vb, bool odd) {
    const float keep = odd ? vb : va, send = odd ? va : vb;
    const float got = __builtin_bit_cast(float, __builtin_amdgcn_mov_dpp(__builtin_bit_cast(int, send), 0xB1, 0xf, 0xf, true));
    const unsigned w = odd ? cvt_pk(got, keep) : cvt_pk(keep, got);
    *(unsigned*)(base + zoo + (odd ? cB : cA)) = w;
}
__device__ __forceinline__ void dft_ld8(bf16x8 (&b)[8], const bf16_t* vec) {
#pragma unroll
    for (int i = 0; i < 8; ++i) b[i] = *(const bf16x8*)(vec + 16 * i);
}
template <int MT> __device__ __forceinline__ void dft_zero(f32x16 (&acc)[MT]) {
#pragma unroll
    for (int rt = 0; rt < MT; ++rt) {
#pragma unroll
        for (int r = 0; r < 16; ++r) acc[rt][r] = 0.f;
        asm volatile("" : "+v"(acc[rt]));
    }
}
template <int MT, int KS, int K0> __device__ __forceinline__ void dft_mma8(f32x16 (&acc)[MT], const bf16x8 (&a)[MT][KS], const bf16x8 (&b)[8]) {
#pragma unroll
    for (int i = 0; i < 8; ++i)
#pragma unroll
        for (int rt = 0; rt < MT; ++rt) acc[rt] = __builtin_amdgcn_mfma_f32_32x32x16_bf16(a[rt][K0 + i], b[i], acc[rt], 0, 0, 0);
}
__device__ __forceinline__ const bf16_t* fa_vec(const bf16_t* H, int tile, int r32, int hi) {
    int token, g;
    if (tile < 8192) { const int n1h = tile & 1, n2 = (tile >> 1) & 63, b = tile >> 9; g = (tile >> 7) & 3; token = b * SEQ + 64 * (32 * n1h + r32) + n2; }
    else { const int tc = tile - 8192, nq = tc & 7, b = tc >> 5; g = (tc >> 3) & 3; token = TLAT + b * LCTX + 32 * nq + r32; }
    return H + (size_t)token * DM + g * 256 + 8 * hi;
}
__device__ __forceinline__ int fa_token(int tile, int row) {
    if (tile < 8192) { const int n1h = tile & 1, n2 = (tile >> 1) & 63, b = tile >> 9; return b * SEQ + 64 * (32 * n1h + row) + n2; }
    const int tc = tile - 8192, nq = tc & 7, b = tc >> 5; return TLAT + b * LCTX + 32 * nq + row;
}
__device__ __forceinline__ void fourier_a(LAS unsigned char* lds, const bf16_t* H, const bf16_t* DC, bf16_t* Z1, bf16_t* Zc, bool with_ctx, int G, int vcu, int wave, int lane) {
    constexpr int ROWB = 528, BUFB = 32 * ROWB;
    const int r32 = lane & 31, hi = lane >> 5, sl = wave, tid = wave * 64 + lane; const bool odd = lane & 1;
    bf16x8 a[2][16]; dft_load_a<2, 16>(a, DC, 64 * sl, r32, hi);
    const int ntile = 8192 + (with_ctx ? 512 : 0);
    const int srow0 = tid >> 5, sch = tid & 31;
    u32x4 s0, s1;
    int tile = vcu, cur = 0;
    if (tile < ntile) { const int g = (tile < 8192) ? (tile >> 7) & 3 : ((tile - 8192) >> 3) & 3;
        s0 = *(const u32x4*)(H + (size_t)fa_token(tile, srow0) * DM + g * 256 + sch * 8); s1 = *(const u32x4*)(H + (size_t)fa_token(tile, srow0 + 16) * DM + g * 256 + sch * 8); }
    for (; tile < ntile; tile += G) {
        LAS unsigned char* buf = lds + cur * BUFB;
        *(LAS u32x4*)(buf + srow0 * ROWB + sch * 16) = s0; *(LAS u32x4*)(buf + (srow0 + 16) * ROWB + sch * 16) = s1;
        __syncthreads();
        if (tile + G < ntile) { const int tn = tile + G; const int g = (tn < 8192) ? (tn >> 7) & 3 : ((tn - 8192) >> 3) & 3;
            s0 = *(const u32x4*)(H + (size_t)fa_token(tn, srow0) * DM + g * 256 + sch * 8); s1 = *(const u32x4*)(H + (size_t)fa_token(tn, srow0 + 16) * DM + g * 256 + sch * 8); }
        asm volatile("" ::: "memory");
        f32x16 acc[2]; dft_zero<2>(acc);
        const LAS unsigned char* bp = buf + r32 * ROWB + hi * 16;
#pragma unroll
        for (int ks = 0; ks < 16; ++ks) { const bf16x8 bf = *(const LAS bf16x8*)(bp + ks * 32);
#pragma unroll
            for (int rt = 0; rt < 2; ++rt) acc[rt] = __builtin_amdgcn_mfma_f32_32x32x16_bf16(a[rt][ks], bf, acc[rt], 0, 0, 0); }
        if (tile < 8192) {
            const int n1h = tile & 1, n2 = (tile >> 1) & 63, g = (tile >> 7) & 3, b = tile >> 9;
            size_t zo = ((((size_t)((b * 4 + g) * 256 + 64 * (sl & 3) + 4 * hi)) * 64 + n2) * 2 + (sl >> 2)) * 64 + 32 * n1h + (r32 & ~1);
            asm volatile("" : "+v"(zo));
#pragma unroll
            for (int rt = 0; rt < 2; ++rt)
#pragma unroll
                for (int r = 0; r < 16; r += 2) store_pair(Z1, zo, (unsigned)(32 * rt + (r & 3) + 8 * (r >> 2)) * 8192u, (unsigned)(32 * rt + ((r + 1) & 3) + 8 * (r >> 2)) * 8192u, acc[rt][r], acc[rt][r + 1], odd);
        } else {
            const int tc = tile - 8192, nq = tc & 7, g = (tc >> 3) & 3, b = tc >> 5;
            size_t zo = (((size_t)((b * 4 + g) * 256 + 64 * (sl & 3) + 4 * hi)) * 2 + (sl >> 2)) * 256 + 32 * nq + (r32 & ~1);
            asm volatile("" : "+v"(zo));
#pragma unroll
            for (int rt = 0; rt < 2; ++rt)
#pragma unroll
                for (int r = 0; r < 16; r += 2) store_pair(Zc, zo, (unsigned)(32 * rt + (r & 3) + 8 * (r >> 2)) * 512u, (unsigned)(32 * rt + ((r + 1) & 3) + 8 * (r >> 2)) * 512u, acc[rt][r], acc[rt][r + 1], odd);
        }
        asm volatile("" ::: "memory");
        cur ^= 1;
    }
    __syncthreads();
}
template <int VAR> __device__ __forceinline__ void fourier_s1(const bf16_t* Z1, const bf16_t* D1, const float* tw, bf16_t* A1p, int G, int vcu, int wave, int lane) {
    const int r32 = lane & 31, hi = lane >> 5, sl = wave & 1; const bool odd = lane & 1;
    bf16x8 a[2][8]; dft_load_a<2, 8>(a, D1, 64 * sl, r32, hi);
    int tile = vcu * 4 + (wave >> 1); const int step = G * 4;
    const int n2 = 32 * (tile & 1) + r32;
    float2 twr[16];
#pragma unroll
    for (int rt = 0; rt < 2; ++rt)
#pragma unroll
        for (int q4 = 0; q4 < 4; ++q4)
#pragma unroll
            for (int e = 0; e < 2; ++e) twr[rt * 8 + q4 * 2 + e] = *(const float2*)(tw + 2 * ((32 * sl + 2 * hi + 16 * rt + 4 * q4 + e) * 64 + n2));
    bf16x8 bc[8], bn[8];
    if (tile < 32768) dft_ld8(bc, Z1 + ((size_t)tile * 32 + r32) * 128 + 8 * hi);
    for (; tile < 32768; tile += step) {
        asm volatile("" ::: "memory");
        if (tile + step < 32768) dft_ld8(bn, Z1 + ((size_t)(tile + step) * 32 + r32) * 128 + 8 * hi);
        asm volatile("" ::: "memory");
        f32x16 acc[2]; dft_zero<2>(acc);
        dft_mma8<2, 8, 0>(acc, a, bc);
        const int bgm = tile >> 1, bg = bgm >> 8, m = bgm & 255;
        size_t ao = ((((size_t)(bg * 64 + 32 * sl + 2 * hi)) * 256 + m) * 2) * 64 + (n2 & ~1);
        asm volatile("" : "+v"(ao));
#pragma unroll
        for (int rt = 0; rt < 2; ++rt)
#pragma unroll
            for (int q4 = 0; q4 < 4; ++q4)
#pragma unroll
                for (int e = 0; e < 2; ++e) { const int dk = 16 * rt + 4 * q4 + e;
                    const float re = acc[rt][4 * q4 + 2 * e], im = acc[rt][4 * q4 + 2 * e + 1];
                    const float2 cs = twr[rt * 8 + q4 * 2 + e];
                    const float re2 = re * cs.x + im * cs.y, im2 = im * cs.x - re * cs.y;
                    store_pair(A1p, ao, (unsigned)dk * 32768u, (unsigned)dk * 32768u + 64u, re2, im2, odd); }
        asm volatile("" ::: "memory");
#pragma unroll
        for (int i = 0; i < 8; ++i) bc[i] = bn[i];
    }
}
__device__ __forceinline__ void fourier_s2(const bf16_t* A1p, const bf16_t* D2, const bf16_t* Zc, const bf16_t* DX, bf16_t* FM, bool with_ctx, int G, int vcu, int gw, int NGW, int wave, int lane) {
    const int r32 = lane & 31, hi = lane >> 5; const bool odd = lane & 1;
    {
        bf16x8 a[2][8]; dft_load_a<2, 8>(a, D2, 0, r32, hi);
        bf16x8 bc[8], bn[8];
        int tile = gw;
        if (tile < 32768) dft_ld8(bc, A1p + ((size_t)tile * 32 + r32) * 128 + 8 * hi);
        for (; tile < 32768; tile += NGW) {
            asm volatile("" ::: "memory");
            if (tile + NGW < 32768) dft_ld8(bn, A1p + ((size_t)(tile + NGW) * 32 + r32) * 128 + 8 * hi);
            asm volatile("" ::: "memory");
            f32x16 acc[2]; dft_zero<2>(acc);
            dft_mma8<2, 8, 0>(acc, a, bc);
            const int m = 32 * (tile & 7) + r32, k1 = (tile >> 3) & 63, bg = tile >> 9, b = bg >> 2, g = bg & 3;
            size_t fo = (size_t)(b * SEQ + k1 + 256 * hi) * DM + g * 256 + (m & ~1);
            asm volatile("" : "+v"(fo));
#pragma unroll
            for (int rt = 0; rt < 2; ++rt)
#pragma unroll
                for (int r = 0; r < 16; r += 2) store_pair(FM, fo, (unsigned)(32 * rt + (r & 3) + 8 * (r >> 2)) * 65536u, (unsigned)(32 * rt + ((r + 1) & 3) + 8 * (r >> 2)) * 65536u, acc[rt][r], acc[rt][r + 1], odd);
            asm volatile("" ::: "memory");
#pragma unroll
            for (int i = 0; i < 8; ++i) bc[i] = bn[i];
        }
    }
    if (with_ctx) {
        for (int tile = vcu; tile < 512; tile += G) {
            f32x16 acc;
#pragma unroll
            for (int r = 0; r < 16; ++r) acc[r] = 0.f;
            asm volatile("" : "+v"(acc));
            const bf16_t* ap = DX + (size_t)(32 * wave + r32) * 512 + 8 * hi;
            const bf16_t* bp = Zc + ((size_t)tile * 32 + r32) * 512 + 8 * hi;
#pragma unroll 1
            for (int kc = 0; kc < 4; ++kc) {
                bf16x8 av[8], bv[8];
#pragma unroll
                for (int i = 0; i < 8; ++i) { av[i] = *(const bf16x8*)(ap + 16 * (kc * 8 + i)); bv[i] = *(const bf16x8*)(bp + 16 * (kc * 8 + i)); }
#pragma unroll
                for (int i = 0; i < 8; ++i) acc = __builtin_amdgcn_mfma_f32_32x32x16_bf16(av[i], bv[i], acc, 0, 0, 0);
            }
            const int m = 32 * (tile & 7) + r32, bg = tile >> 3, b = bg >> 2, g = bg & 3;
            size_t fo = (size_t)(TLAT + b * LCTX + 32 * wave + 4 * hi) * DM + g * 256 + (m & ~1);
            asm volatile("" : "+v"(fo));
#pragma unroll
            for (int r = 0; r < 16; r += 2) store_pair(FM, fo, (unsigned)((r & 3) + 8 * (r >> 2)) * 1024u, (unsigned)(((r + 1) & 3) + 8 * (r >> 2)) * 1024u, acc[r], acc[r + 1], odd);
        }
    }
}


#ifdef DIAG
__device__ __forceinline__ void diag_scan(unsigned* ctl, const void* buf, size_t bytes, bool is_bf16, int stage) {
    const size_t n16 = bytes / 16; const u32x4* p = (const u32x4*)buf; bool bad = false;
    int ln = (int)__builtin_amdgcn_mbcnt_hi(~0u, __builtin_amdgcn_mbcnt_lo(~0u, 0u)); asm volatile("" : "+v"(ln)); ln += 64 * __builtin_amdgcn_readfirstlane((int)threadIdx.x >> 6);
    for (size_t i = (size_t)blockIdx.x * NTHR + ln; i < n16; i += (size_t)gridDim.x * NTHR) {
        const u32x4 v = p[i];
        if (is_bf16) { for (int q = 0; q < 4; ++q) { const unsigned w = v[q]; if (((w >> 7) & 0xff) == 0xff || ((w >> 23) & 0xff) == 0xff) bad = true; } }
        else { for (int q = 0; q < 4; ++q) { if (((v[q] >> 23) & 0xff) >= 0xf0) bad = true; } }
    }
    if (bad) atomicMin(ctl, (unsigned)stage);
}
#define DIAG_SCAN(buf, bytes, isbf, stage) diag_scan((unsigned*)ws, buf, bytes, isbf, stage)
#else
#define DIAG_SCAN(buf, bytes, isbf, stage) do {} while (0)
#endif

#ifdef DIAG2
__device__ __forceinline__ void diag_max(unsigned* ctl, const void* buf, size_t bytes) {
    const size_t n16 = bytes / 16; const u32x4* p = (const u32x4*)buf; unsigned mx = 0, nb = 0;
    int ln = (int)__builtin_amdgcn_mbcnt_hi(~0u, __builtin_amdgcn_mbcnt_lo(~0u, 0u)); asm volatile("" : "+v"(ln)); ln += 64 * __builtin_amdgcn_readfirstlane((int)threadIdx.x >> 6);
    for (size_t i = (size_t)blockIdx.x * NTHR + ln; i < n16; i += (size_t)gridDim.x * NTHR) {
        const u32x4 v = p[i];
        for (int q = 0; q < 4; ++q) { const unsigned lo = (v[q] << 16) & 0x7fffffffu, hi = v[q] & 0x7fff0000u;
            if ((lo >> 23) == 0xff) ++nb; else mx = mx > lo ? mx : lo;
            if ((hi >> 23) == 0xff) ++nb; else mx = mx > hi ? mx : hi; }
    }
    atomicMax(ctl + 1, mx); if (nb) atomicAdd(ctl + 2, nb);
}
#endif

#ifdef TSEL
#define TBEG(c) do { if ((TSEL >> (c)) & 1) t0_ = __builtin_amdgcn_s_memrealtime(); } while (0)
#define TEND(c) do { if ((TSEL >> (c)) & 1) tacc_ += __builtin_amdgcn_s_memrealtime() - t0_; } while (0)
#else
#define TBEG(c) do {} while (0)
#define TEND(c) do {} while (0)
#endif
__global__ void __launch_bounds__(NTHR, 2) fwd_megakernel(Args A) {
    extern __shared__ __attribute__((aligned(16))) unsigned char lds_raw[];
    cg::grid_group grid = cg::this_grid();
#define GRID_SYNC() do { asm volatile("s_waitcnt vmcnt(0) lgkmcnt(0)" ::: "memory"); grid.sync(); } while (0)
    LAS unsigned char* lds = (LAS unsigned char*)lds_raw;
    const int wave = __builtin_amdgcn_readfirstlane((int)threadIdx.x >> 6);
#define FRESH_LANE(v) int v = LANE_ID(); asm volatile("" : "+v"(v))
#define LANE_ID() ((int)__builtin_amdgcn_mbcnt_hi(~0u, __builtin_amdgcn_mbcnt_lo(~0u, 0u)))
    const int lane = LANE_ID(), tid = wave * 64 + lane;
    const int G = gridDim.x, gw = blockIdx.x * NWAVES + wave, NGW = G * NWAVES;
    const int vcu = (G % 8 == 0) ? ((int)blockIdx.x % 8) * (G / 8) + (int)blockIdx.x / 8 : (int)blockIdx.x;
    const int gwv = vcu * NWAVES + wave;
    unsigned char* ws = A.ws;
#ifdef TSEL
    unsigned long long t0_ = 0, tacc_ = 0;
#endif
#ifdef DIAG
    if (blockIdx.x == 0 && threadIdx.x == 0) *(unsigned*)ws = 0x7fffffffu;
#endif
#ifdef DIAG2
    if (blockIdx.x == 0 && threadIdx.x == 0) { ((unsigned*)ws)[1] = 0u; ((unsigned*)ws)[2] = 0u; }
#endif
    float* mod = (float*)(ws + WS_MOD);
    const float* rope = (const float*)(ws + WS_TAB + TAB_ROPE); const float* tw = (const float*)(ws + WS_TAB + TAB_TW);
    const bf16_t* D1 = (const bf16_t*)(ws + WS_TAB + TAB_D1); const bf16_t* D2 = (const bf16_t*)(ws + WS_TAB + TAB_D2);
    const bf16_t* DC = (const bf16_t*)(ws + WS_TAB + TAB_DC); const bf16_t* DX = (const bf16_t*)(ws + WS_TAB + TAB_DCTX);
    float* xc = (float*)(ws + WS_XC);
    bf16_t* Hb = (bf16_t*)(ws + WS_H); bf16_t* Pb = (bf16_t*)(ws + WS_P); bf16_t* CAT = (bf16_t*)(ws + WS_CAT); bf16_t* ACT = (bf16_t*)(ws + WS_ACT);
    bf16_t* Z1 = (bf16_t*)(ws + WS_Z1); bf16_t* Zc = (bf16_t*)(ws + WS_ZC); bf16_t* A1p = (bf16_t*)(ws + WS_A1); bf16_t* FM = (bf16_t*)(ws + WS_FM);


#ifndef SKIP_PRO
        TBEG(10);
    prologue(A, lds, tid, wave, lane, G);
#endif

    GRID_SYNC();
        TEND(10);

    DIAG_SCAN(mod, 4 * 17 * 6144 * 4, false, 1); DIAG_SCAN(ws + WS_WIN, (size_t)83 * MiB, true, 2); DIAG_SCAN(ws + WS_TAB + TAB_D1, 640 * 1024, true, 3); DIAG_SCAN(ws + WS_TAB, 96 * 1024, false, 4);
#pragma unroll 1
    for (int l = 0; l < 4; ++l) {
        const bool even = (l & 1) == 0; const int e = l >> 1;
        const bool ctx_after = l < 2;
        const bool ctx_here = l < 3;
        const int Mfull = ctx_here ? MALL : TLAT;
        const int Mres = ctx_after ? MALL : TLAT;
        const float* modl = mod + (size_t)l * 17 * 6144;
        const float* xin_lat = (l == 0) ? A.x : A.out; const float* xin_ctx = (l == 0) ? A.ctx : xc;
        TBEG(4);
        { FRESH_LANE(lane_l); const int tid_l = wave * 64 + lane_l; (void)tid_l; norm_phase(xin_lat, xin_ctx, A.n1g + l * DM, modl, 0, Hb, Mfull, gw, NGW, lane_l); }
        GRID_SYNC();
        TEND(4);
        DIAG_SCAN(Hb, (size_t)Mfull * DM * 2, true, 10 + 10 * l);
        const bf16_t* mixA; const bf16_t* mixW;
        if (even) {
        TBEG(0);
            { int tg = LANE_ID(); asm volatile("" : "+v"(tg)); tg += wave * 64; pg8::Gemm g{Hb, (const bf16_t*)(ws + WS_WIN) + (size_t)e * INW * DM, Mfull, INW, DM}; pg8::StaticOrder S; S.init(Mfull, INW, G, (int)blockIdx.x);
              EpiInProj E{Pb, rope};
              pg8::gemm_phase<EpiInProj, pg8::StaticOrder, true, true>(lds, g, S, E, tg); }
            GRID_SYNC();
        TEND(0);
        DIAG_SCAN(Pb, (size_t)Mfull * INW * 2, true, 11 + 10 * l);

#ifndef SKIP_ATT
        TBEG(5);
            { FRESH_LANE(lane_l); const int tid_l = wave * 64 + lane_l; (void)tid_l; attn_phase(lds, Pb, CAT, A.sink + e * 8, ctx_after, G, tid_l, wave, lane_l); }
        TEND(5);
#endif


#ifndef SKIP_CONV
        TBEG(6);
            { FRESH_LANE(lane_l); const int tid_l = wave * 64 + lane_l; (void)tid_l; conv_phase(Pb, CAT, A.conv_w + e * 3 * 512, Mres, G, tid_l); }
#endif

            GRID_SYNC();
        TEND(6);
        DIAG_SCAN(CAT, (size_t)Mres * DM * 2, true, 12 + 10 * l);
            mixA = CAT; mixW = (const bf16_t*)(ws + WS_WMIX) + (size_t)e * DM * DM;
        } else {

#ifndef SKIP_FA
        TBEG(7);
            { FRESH_LANE(lane_l); const int tid_l = wave * 64 + lane_l; (void)tid_l; fourier_a(lds, Hb, DC, Z1, Zc, ctx_after, G, vcu, wave, lane_l); }
#endif

            GRID_SYNC();
        TEND(7);
        DIAG_SCAN(Z1, (size_t)128 * MiB, true, 11 + 10 * l); DIAG_SCAN(Z1 + 64 * MiB, (size_t)128 * MiB, true, 12 + 10 * l); DIAG_SCAN(Zc, (size_t)16 * MiB, true, 13 + 10 * l);
#ifdef DIAG2
        if (l == DIAG2_L) diag_max((unsigned*)ws, DIAG2_BUF, DIAG2_BYTES);
#endif

#ifndef SKIP_S1
        TBEG(8);
            { FRESH_LANE(lane_l); const int tid_l = wave * 64 + lane_l; (void)tid_l; fourier_s1<0>(Z1, D1, tw, A1p, G, vcu, wave, lane_l); }
#endif

            GRID_SYNC();
        TEND(8);
        DIAG_SCAN(A1p, (size_t)256 * MiB, true, 14 + 10 * l);

#ifndef SKIP_S2
        TBEG(9);
            { FRESH_LANE(lane_l); const int tid_l = wave * 64 + lane_l; (void)tid_l; fourier_s2(A1p, D2, Zc, DX, FM, ctx_after, G, vcu, gwv, NGW, wave, lane_l); }
#endif

            GRID_SYNC();
        TEND(9);
        DIAG_SCAN(FM, (size_t)Mres * DM * 2, true, 15 + 10 * l);
            mixA = FM; mixW = (const bf16_t*)(ws + WS_WF) + (size_t)e * DM * DM;
        }
        TBEG(1);
        { int tg = LANE_ID(); asm volatile("" : "+v"(tg)); tg += wave * 64; pg8::Gemm g{mixA, mixW, Mres, DM, DM}; pg8::StaticOrder S; S.init(Mres, DM, G, (int)blockIdx.x);
          EpiRes E{xin_lat, xin_ctx, A.out, xc, modl, 2};
          pg8::gemm_phase<EpiRes, pg8::StaticOrder, true, true>(lds, g, S, E, tg); }
        GRID_SYNC();
        TEND(1);
        DIAG_SCAN(A.out, (size_t)TLAT * DM * 4, false, 16 + 10 * l);
        TBEG(4);
        { FRESH_LANE(lane_l); const int tid_l = wave * 64 + lane_l; (void)tid_l; norm_phase(A.out, xc, A.n2g + l * DM, modl, 3, Hb, Mres, gw, NGW, lane_l); }
        GRID_SYNC();
        TEND(4);
        DIAG_SCAN(Hb, (size_t)Mres * DM * 2, true, 17 + 10 * l);
        TBEG(2);
        { int tg = LANE_ID(); asm volatile("" : "+v"(tg)); tg += wave * 64; pg8::Gemm g{Hb, (const bf16_t*)(ws + WS_WGU) + (size_t)l * 2 * DFF * DM, Mres, 2 * DFF, DM}; pg8::StaticOrder S; S.init(Mres, 2 * DFF, G, (int)blockIdx.x);
          EpiSwiGLU E{ACT};
          pg8::gemm_phase<EpiSwiGLU, pg8::StaticOrder, true, true>(lds, g, S, E, tg); }
        GRID_SYNC();
        TEND(2);
        DIAG_SCAN(ACT, (size_t)Mres * DFF * 2, true, 18 + 10 * l);
        TBEG(3);
        { int tg = LANE_ID(); asm volatile("" : "+v"(tg)); tg += wave * 64; pg8::Gemm g{ACT, (const bf16_t*)(ws + WS_WD) + (size_t)l * DM * DFF, Mres, DM, DFF}; pg8::StaticOrder S; S.init(Mres, DM, G, (int)blockIdx.x);
          EpiRes E{A.out, xc, A.out, xc, modl, 5};
          pg8::gemm_phase<EpiRes, pg8::StaticOrder, true, true>(lds, g, S, E, tg); }
        GRID_SYNC();
        TEND(3);
        DIAG_SCAN(A.out, (size_t)TLAT * DM * 4, false, 19 + 10 * l);
    }
    { int lane_f = LANE_ID(); asm volatile("" : "+v"(lane_f)); final_norm_phase(A.out, A.final_g, gw, NGW, lane_f); }
#ifdef TSEL
    if (blockIdx.x == 0) { const unsigned long long ts_ = __builtin_amdgcn_s_memrealtime(); while (__builtin_amdgcn_s_memrealtime() - ts_ < (unsigned long long)TMULT * tacc_) __builtin_amdgcn_s_sleep(8); }
#endif
#ifdef DIAG2
    GRID_SYNC();
    if (blockIdx.x == 0 && threadIdx.x == 0) { const unsigned mx = ((volatile unsigned*)ws)[1], nb = ((volatile unsigned*)ws)[2]; A.out[0] = 1000.f * __builtin_bit_cast(float, mx); A.out[1] = nb ? 1e9f + 1000.f * (float)nb : 0.f; }
#endif
#ifdef DIAG
    GRID_SYNC();
    if (blockIdx.x == 0 && threadIdx.x == 0) { const unsigned c = *(volatile unsigned*)ws; A.out[0] = (c == 0x7fffffffu) ? 999000.f : 1000.f * (float)c; }
#endif
}

extern "C" void kernel_launch(void* const* d_in, const int* in_sizes, int n_in, void* d_out, int out_size, void* d_ws, size_t ws_size, hipStream_t stream) {
    static int grid = 0;
    if (grid == 0) {
        if (n_in != 17 || out_size != TLAT * DM || ws_size < WS_END) { fprintf(stderr, "kernel_launch: unexpected shapes (n_in %d, out %d, ws %zu)\n", n_in, out_size, ws_size); grid = -1; return; }
        int dev = 0, cus = 0, per_cu = 0;
        hipGetDevice(&dev); hipDeviceGetAttribute(&cus, hipDeviceAttributeMultiprocessorCount, dev);
        if (hipFuncSetAttribute((const void*)fwd_megakernel, hipFuncAttributeMaxDynamicSharedMemorySize, LDS_BYTES) != hipSuccess) { fprintf(stderr, "kernel_launch: hipFuncSetAttribute failed\n"); grid = -1; return; }
        if (hipOccupancyMaxActiveBlocksPerMultiprocessor(&per_cu, (const void*)fwd_megakernel, NTHR, LDS_BYTES) != hipSuccess || per_cu < 1) { fprintf(stderr, "kernel_launch: occupancy query says %d\n", per_cu); per_cu = 1; }
        (void)hipGetLastError();
        grid = cus * 1;
    }
    if (grid < 0) return;
    Args a{};
    a.x = (const float*)d_in[0]; a.c = (const float*)d_in[1]; a.ctx = (const float*)d_in[2]; a.c_ctx = (const float*)d_in[3]; a.w_ada = (const float*)d_in[4]; a.b_ada = (const float*)d_in[5];
    a.n1g = (const float*)d_in[6]; a.n2g = (const float*)d_in[7]; a.w_in = (const float*)d_in[8]; a.conv_w = (const float*)d_in[9]; a.sink = (const float*)d_in[10]; a.w_mix = (const float*)d_in[11];
    a.w_four = (const float*)d_in[12]; a.w_gate = (const float*)d_in[13]; a.w_up = (const float*)d_in[14]; a.w_down = (const float*)d_in[15]; a.final_g = (const float*)d_in[16];
    a.out = (float*)d_out; a.ws = (unsigned char*)d_ws;
    for (int f = 0; f < 16; ++f) a.invf[f] = pow(10000.0, -(double)f / 16.0);
    void* args[] = {&a};
    hipError_t e = hipLaunchCooperativeKernel((const void*)fwd_megakernel, dim3(grid), dim3(NTHR), args, LDS_BYTES, stream);
    if (e != hipSuccess) fprintf(stderr, "kernel_launch: cooperative launch failed: %s (grid %d)\n", hipGetErrorString(e), grid);
}
```

```cpp
#include <hip/hip_runtime.h>
#include <hip/hip_cooperative_groups.h>
#include <cstdio>
#include <cstdint>
#include <cmath>
namespace cg = cooperative_groups;

namespace pg8 {
#define PG8_LAS __attribute__((address_space(3)))
typedef unsigned short bf16_t;
typedef short bf16x8 __attribute__((ext_vector_type(8)));
typedef float f32x4 __attribute__((ext_vector_type(4)));
typedef unsigned u32x4 __attribute__((ext_vector_type(4)));
constexpr int BM = 256, BK = 64, HALF = 128, HTB = HALF * BK * 2  , STAGE_BYTES = 8 * HTB, NXCD = 8, WGM = 8;

__host__ __device__ __forceinline__ int lds_byte(int r, int c) { const int st = (r >> 4) * 2 + (c >> 5), rr = r & 15, cc = c & 31, ob = rr * 64 + cc * 2; return st * 1024 + (ob ^ (((ob >> 9) & 1) << 5)); }
__host__ __device__ __forceinline__ void stage_rc(int b, int& R, int& C) { const int st = b / 1024, sb = b % 1024, swz = sb ^ (((sb >> 9) & 1) << 5); R = (st >> 1) * 16 + swz / 64; C = (st & 1) * 32 + (swz % 64) / 2; }
__host__ __device__ __forceinline__ int perm32(int rho) { const int n = rho >> 4, i = rho & 15; return 8 * (i >> 2) + 4 * n + (i & 3); }

struct Unit { int pm, pn; };
struct Gemm { const bf16_t* A; const bf16_t* Bt; int M, N, K; };

struct StaticOrder {
    int nM, nN, nwg, G, c;
    __host__ __device__ void init(int M, int N, int G_, int c_) { nM = M / BM; nN = N / BM; nwg = nM * nN; G = G_; c = c_; }
    __host__ __device__ bool next(int i, Unit& u) const {
        const long L = (long)i * G + c; if (L >= nwg) return false;
        int wgid = (int)L; { const int q = nwg / NXCD, r = nwg % NXCD, xcd = wgid % NXCD, off = wgid / NXCD; wgid = (xcd < r ? xcd * (q + 1) : r * (q + 1) + (xcd - r) * q) + off; }
        const int nig = WGM * nN, gid = wgid / nig, fm = gid * WGM, gsz = (nM - fm) < WGM ? (nM - fm) : WGM;
        u.pm = fm + ((wgid % nig) % gsz); u.pn = (wgid % nig) / gsz; return true;
    }
    __device__ __forceinline__ void a_ready(const Unit&) const {}
    __device__ __forceinline__ void done(const Unit&) const {}
};

template <class Epi, class Sched, bool ALIGN_EPI = false, bool SP2 = false>
__device__ __forceinline__ void gemm_phase(PG8_LAS unsigned char* lds, const Gemm g, const Sched& S, const Epi& E, int tid_in) {
    const int tid = tid_in, wid = __builtin_amdgcn_readfirstlane(tid >> 6), lane = tid & 63, wr = wid >> 2, wc = wid & 3, fr = lane & 15, fq = lane >> 4;
    const int K = g.K, nt = K / BK;
    unsigned voffA[2], voffB[2];
#pragma unroll
    for (int i = 0; i < 2; ++i) { int R, C; stage_rc(tid * 16 + i * 8192, R, C); const int Rb = Epi::PERM ? ((R & ~31) + perm32(R & 31)) : R;
        voffA[i] = (unsigned)(R * K + C) * 2u; voffB[i] = (unsigned)(Rb * K + C) * 2u; }
    const size_t kstep = (size_t)(BK * 2);
    const size_t hstep = (size_t)HALF * K * 2;
    const size_t tstep = 2 * hstep;
    const unsigned ldsw = (unsigned)wid * 1024u;
    const int aoff = lds_byte(wr * 64 + fr, fq * 8), boff = lds_byte(wc * 32 + fr, fq * 8);
#define PG8_SA(b, h) (((b) * 2 + (h)) * HTB)
#define PG8_SB(b, h) ((4 + (b) * 2 + (h)) * HTB)
#define PG8_STAGE(bufoff, gbase, voff) do { _Pragma("unroll") for (int _i = 0; _i < 2; ++_i) \
        __builtin_amdgcn_global_load_lds((const unsigned*)((const char*)(gbase) + (voff)[_i]), (PG8_LAS unsigned*)(lds + (bufoff) + ldsw + _i * 8192), 16, 0, 0); } while (0)
#define PG8_LDA(dst, b, h) do { _Pragma("unroll") for (int m = 0; m < 4; ++m) _Pragma("unroll") for (int k = 0; k < 2; ++k) dst[m][k] = *(const PG8_LAS bf16x8*)(lds + PG8_SA(b, h) + aoff + m * 2048 + k * 1024); } while (0)
#define PG8_LDB(dst, b, h) do { _Pragma("unroll") for (int n = 0; n < 2; ++n) _Pragma("unroll") for (int k = 0; k < 2; ++k) dst[n][k] = *(const PG8_LAS bf16x8*)(lds + PG8_SB(b, h) + boff + n * 2048 + k * 1024); } while (0)
#define PG8_MMA(ai, bj, At, Bt) do { __builtin_amdgcn_s_setprio(1); _Pragma("unroll") for (int m = 0; m < 4; ++m) _Pragma("unroll") for (int n = 0; n < 2; ++n) _Pragma("unroll") for (int k = 0; k < 2; ++k) \
        acc[ai][bj][m][n] = __builtin_amdgcn_mfma_f32_16x16x32_bf16(Bt[n][k], At[m][k], acc[ai][bj][m][n], 0, 0, 0); __builtin_amdgcn_s_setprio(0); } while (0)
#define PG8_WAIT_V(n) asm volatile("s_waitcnt vmcnt(" #n ")" ::: "memory")
#define PG8_WAIT_L(n) asm volatile("s_waitcnt lgkmcnt(" #n ")" ::: "memory")
#define PG8_BAR __builtin_amdgcn_s_barrier()
#define PG8_SCHED __builtin_amdgcn_sched_barrier(0)
    Unit cur, nxt; int ui = 0;
    if (!S.next(0, cur)) return;
    f32x4 acc[2][2][4][2];
#pragma unroll
    for (int a = 0; a < 2; ++a)
#pragma unroll
        for (int b = 0; b < 2; ++b)
#pragma unroll
            for (int m = 0; m < 4; ++m)
#pragma unroll
                for (int n = 0; n < 2; ++n) acc[a][b][m][n] = (f32x4){0.f, 0.f, 0.f, 0.f};
    bf16x8 At[4][2], B0[2][2], B1[2][2];
    const char* cA = (const char*)g.A + (size_t)cur.pm * tstep; const char* cB = (const char*)g.Bt + (size_t)cur.pn * tstep;
    S.a_ready(cur);
    if constexpr (SP2) {
        PG8_STAGE(PG8_SB(0, 0), cB, voffB); PG8_STAGE(PG8_SB(0, 1), cB + hstep, voffB); PG8_STAGE(PG8_SA(0, 0), cA, voffA); PG8_STAGE(PG8_SA(0, 1), cA + hstep, voffA);
        if (wr == 1) PG8_BAR;
        PG8_WAIT_V(2); PG8_BAR;
        PG8_STAGE(PG8_SB(1, 0), cB + kstep, voffB); PG8_STAGE(PG8_SA(1, 0), cA + kstep, voffA); PG8_STAGE(PG8_SB(1, 1), cB + hstep + kstep, voffB);
        PG8_WAIT_V(6); PG8_BAR;
    } else {
        PG8_STAGE(PG8_SB(0, 0), cB, voffB); PG8_STAGE(PG8_SA(0, 0), cA, voffA); PG8_STAGE(PG8_SB(0, 1), cB + hstep, voffB); PG8_STAGE(PG8_SA(0, 1), cA + hstep, voffA);
        if (wr == 1) PG8_BAR;
        PG8_WAIT_V(4); PG8_BAR;
        PG8_STAGE(PG8_SB(1, 0), cB + kstep, voffB); PG8_STAGE(PG8_SA(1, 0), cA + kstep, voffA); PG8_STAGE(PG8_SB(1, 1), cB + hstep + kstep, voffB);
        PG8_WAIT_V(6); PG8_BAR;
    }
    for (;;) {
        const bool has_next = S.next(ui + 1, nxt);
        const char* nA = has_next ? (const char*)g.A + (size_t)nxt.pm * tstep : cA; const char* nB = has_next ? (const char*)g.Bt + (size_t)nxt.pn * tstep : cB;
        for (int t = 0; t < nt; t += 2) {
            const bool last = (t == nt - 2);
            const char* a1 = cA + (size_t)(t + 1) * kstep;
            const char* a2 = last ? nA : cA + (size_t)(t + 2) * kstep; const char* b2 = last ? nB : cB + (size_t)(t + 2) * kstep;
            const char* a3 = a2 + kstep; const char* b3 = b2 + kstep;
            if (last && has_next) S.a_ready(nxt);
            if constexpr (SP2) {
            PG8_LDB(B0, 0, 0); PG8_LDB(B1, 0, 1); PG8_SCHED; PG8_LDA(At, 0, 0); PG8_STAGE(PG8_SA(1, 1), a1 + hstep, voffA);
            PG8_WAIT_V(8); PG8_WAIT_L(0); PG8_BAR; PG8_MMA(0, 0, At, B0); PG8_MMA(0, 1, At, B1); PG8_BAR; PG8_SCHED;
            PG8_LDA(At, 0, 1); PG8_STAGE(PG8_SB(0, 0), b2, voffB); PG8_STAGE(PG8_SB(0, 1), b2 + hstep, voffB); PG8_STAGE(PG8_SA(0, 0), a2, voffA);
            PG8_WAIT_V(8); PG8_WAIT_L(0); PG8_BAR; PG8_MMA(1, 0, At, B0); PG8_MMA(1, 1, At, B1); PG8_BAR; PG8_SCHED;
            PG8_LDB(B0, 1, 0); PG8_LDB(B1, 1, 1); PG8_SCHED; PG8_LDA(At, 1, 0); PG8_STAGE(PG8_SA(0, 1), a2 + hstep, voffA);
            PG8_WAIT_V(8); PG8_WAIT_L(0); PG8_BAR; PG8_MMA(0, 0, At, B0); PG8_MMA(0, 1, At, B1); PG8_BAR; PG8_SCHED;
            PG8_LDA(At, 1, 1); PG8_STAGE(PG8_SB(1, 0), b3, voffB); PG8_STAGE(PG8_SB(1, 1), b3 + hstep, voffB); PG8_STAGE(PG8_SA(1, 0), a3, voffA);
            PG8_WAIT_V(8); PG8_WAIT_L(0); PG8_BAR; PG8_MMA(1, 0, At, B0); PG8_MMA(1, 1, At, B1); PG8_BAR; PG8_SCHED;
            } else {
            PG8_LDB(B0, 0, 0); PG8_SCHED; PG8_LDA(At, 0, 0); PG8_STAGE(PG8_SA(1, 1), a1 + hstep, voffA);
            PG8_WAIT_L(8); PG8_BAR; PG8_WAIT_L(0); PG8_MMA(0, 0, At, B0); PG8_BAR; PG8_SCHED;
            PG8_LDB(B1, 0, 1); PG8_STAGE(PG8_SB(0, 0), b2, voffB);
            PG8_BAR; PG8_WAIT_L(0); PG8_MMA(0, 1, At, B1); PG8_BAR;
            PG8_LDA(At, 0, 1); PG8_STAGE(PG8_SA(0, 0), a2, voffA);
            PG8_BAR; PG8_WAIT_L(0); PG8_MMA(1, 0, At, B0); PG8_BAR; PG8_SCHED;
            PG8_STAGE(PG8_SB(0, 1), b2 + hstep, voffB);
            PG8_WAIT_V(6); PG8_BAR; PG8_MMA(1, 1, At, B1); PG8_BAR;
            PG8_LDB(B0, 1, 0); PG8_SCHED; PG8_LDA(At, 1, 0); PG8_STAGE(PG8_SA(0, 1), a2 + hstep, voffA);
            PG8_WAIT_L(8); PG8_BAR; PG8_WAIT_L(0); PG8_MMA(0, 0, At, B0); PG8_BAR; PG8_SCHED;
            PG8_LDB(B1, 1, 1); PG8_STAGE(PG8_SB(1, 0), b3, voffB);
            PG8_BAR; PG8_WAIT_L(0); PG8_MMA(0, 1, At, B1); PG8_BAR;
            PG8_LDA(At, 1, 1); PG8_STAGE(PG8_SA(1, 0), a3, voffA);
            PG8_BAR; PG8_WAIT_L(0); PG8_MMA(1, 0, At, B0); PG8_BAR; PG8_SCHED;
            PG8_STAGE(PG8_SB(1, 1), b3 + hstep, voffB);
            PG8_WAIT_V(6); PG8_BAR; PG8_MMA(1, 1, At, B1); PG8_BAR;
            }
        }
        if constexpr (ALIGN_EPI) { if (wr == 0) PG8_BAR; }
        if constexpr (!Epi::AFTER_DRAIN) { E(acc, cur, wr, wc, fr, fq); S.done(cur); }
        if (!has_next) break;
#pragma unroll
        for (int a = 0; a < 2; ++a)
#pragma unroll
            for (int b = 0; b < 2; ++b)
#pragma unroll
                for (int m = 0; m < 4; ++m)
#pragma unroll
                    for (int n = 0; n < 2; ++n) acc[a][b][m][n] = (f32x4){0.f, 0.f, 0.f, 0.f};
        cur = nxt; cA = nA; cB = nB; ++ui;
        if constexpr (ALIGN_EPI) { if (wr == 1) PG8_BAR; }
    }
    PG8_WAIT_V(0);
    if constexpr (!ALIGN_EPI) { if (wr == 0) PG8_BAR; }
    PG8_BAR;
    if constexpr (Epi::AFTER_DRAIN) { E.fused(acc, cur, wr, wc, fr, fq, lds, wid, lane); S.done(cur); }
#undef PG8_SA
#undef PG8_SB
#undef PG8_STAGE
#undef PG8_LDA
#undef PG8_LDB
#undef PG8_MMA
#undef PG8_WAIT_V
#undef PG8_WAIT_L
#undef PG8_BAR
#undef PG8_SCHED
}
}

#define LAS __attribute__((address_space(3)))
typedef unsigned short bf16_t;
typedef short bf16x8 __attribute__((ext_vector_type(8)));
typedef float f32x4 __attribute__((ext_vector_type(4)));
typedef float f32x16 __attribute__((ext_vector_type(16)));
typedef unsigned u32x4 __attribute__((ext_vector_type(4)));
typedef unsigned u32x2 __attribute__((ext_vector_type(2)));

constexpr int DM = 1024, NBATCH = 16, SEQ = 4096, TLAT = NBATCH * SEQ, LCTX = 256, TCTX = NBATCH * LCTX, MALL = TLAT + TCTX;
constexpr int DFF = 2816, INW = 2304, NWAVES = 8, NTHR = 512;
constexpr int QS = 1536, KS_ = 2048, VS_ = 2176;
constexpr float C2 = 0.125f * 1.4426950408889634f, LOG2E = 1.4426950408889634f;
constexpr size_t MiB = 1u << 20;
constexpr size_t WS_MOD = 1 * MiB, WS_TAB = 3 * MiB, WS_WIN = 4 * MiB, WS_WMIX = 13 * MiB, WS_WF = 17 * MiB, WS_WGU = 21 * MiB, WS_WD = 65 * MiB;
constexpr size_t WS_XB = 800 * MiB  ;
constexpr size_t WS_XC = 88 * MiB, WS_H = 104 * MiB, WS_R = 240 * MiB;
constexpr size_t WS_P = WS_R, WS_CAT = WS_R + 306 * MiB, WS_ACT = WS_R, WS_Z1 = WS_R, WS_ZC = WS_R + 256 * MiB, WS_A1 = WS_R + 272 * MiB, WS_FM = WS_R, WS_END = 1024 * MiB;
constexpr size_t TAB_ROPE = 0, TAB_TW = 64 * 1024, TAB_D1 = 128 * 1024, TAB_D2 = 192 * 1024, TAB_DC = 256 * 1024, TAB_DCTX = 512 * 1024;
constexpr int LDS_BYTES = 147456;

typedef float f32x2_t __attribute__((ext_vector_type(2))); typedef __bf16 bf16x2_t __attribute__((ext_vector_type(2)));
__device__ __forceinline__ unsigned cvt_pk(float lo, float hi) { f32x2_t v = {lo, hi}; bf16x2_t b = __builtin_convertvector(v, bf16x2_t); return __builtin_bit_cast(unsigned, b); }
__device__ __forceinline__ float bf_lo(unsigned w) { return __builtin_bit_cast(float, w << 16); }
__device__ __forceinline__ float bf_hi(unsigned w) { return __builtin_bit_cast(float, w & 0xffff0000u); }
__device__ __forceinline__ float fast_exp2(float x) { return __builtin_amdgcn_exp2f(x); }
__device__ __forceinline__ float fast_rcp(float x) { return __builtin_amdgcn_rcpf(x); }
__device__ __forceinline__ float silu_f(float x) { return x * fast_rcp(1.0f + fast_exp2(-x * LOG2E)); }
typedef _Float16 h16x2_t __attribute__((ext_vector_type(2)));
__device__ __forceinline__ float h2f(unsigned lowbits) { float f; asm("v_cvt_f32_f16 %0, %1" : "=v"(f) : "v"(lowbits)); return f; }
__device__ __forceinline__ f32x4 xs_unpack(u32x2 h) { return (f32x4){h2f(h.x), h2f(h.x >> 16), h2f(h.y), h2f(h.y >> 16)}; }
typedef __fp16 fp16x2_t __attribute__((ext_vector_type(2)));
__device__ __forceinline__ u32x2 xs_pack(f32x4 v) { const fp16x2_t a = __builtin_amdgcn_cvt_pkrtz(v.x, v.y), b = __builtin_amdgcn_cvt_pkrtz(v.z, v.w); u32x2 r; r.x = __builtin_bit_cast(unsigned, a); r.y = __builtin_bit_cast(unsigned, b); return r; }
#define LDS_WAIT() asm volatile("s_waitcnt lgkmcnt(0)" ::: "memory")

struct Args {
    const float* x; const float* c; const float* ctx; const float* c_ctx; const float* w_ada; const float* b_ada; const float* n1g; const float* n2g;
    const float* w_in; const float* conv_w; const float* sink; const float* w_mix; const float* w_four; const float* w_gate; const float* w_up; const float* w_down; const float* final_g;
    float* out; unsigned char* ws;
    double invf[16];
};

struct EpiInProj {
    static constexpr bool PERM = false, AFTER_DRAIN = false;
    bf16_t* P; const float* rope;
    __device__ __forceinline__ void operator()(const f32x4 (&acc)[2][2][4][2], const pg8::Unit& u, int wr, int wc, int fr, int fq) const {
        const bool lat = u.pm < 256, doq = (u.pn == 6 || u.pn == 7), ropeT = lat && u.pn >= 6;
#pragma unroll
        for (int ai = 0; ai < 2; ++ai)
#pragma unroll
            for (int m = 0; m < 4; ++m) {
                const int row = u.pm * 256 + ai * 128 + wr * 64 + m * 16 + fr;
                f32x4 cv = {1.f, 1.f, 1.f, 1.f}, sv = {0.f, 0.f, 0.f, 0.f};
                if (ropeT) { const int t = row & 4095; const int a = (wc & 1) ? (t & 63) : (t >> 6);
                    const f32x4* rp = (const f32x4*)(rope + (a * 16 + 4 * fq) * 2); const f32x4 c0 = rp[0], c1 = rp[1];
                    cv = (f32x4){c0.x, c0.z, c1.x, c1.z}; sv = (f32x4){c0.y, c0.w, c1.y, c1.w}; }
#pragma unroll
                for (int bj = 0; bj < 2; ++bj) {
                    f32x4 x1 = acc[ai][bj][m][0], x2 = acc[ai][bj][m][1];
                    if (ropeT && !(u.pn == 8 && bj == 1)) { const f32x4 o1 = x1 * cv - x2 * sv, o2 = x2 * cv + x1 * sv; x1 = o1; x2 = o2; }
                    if (doq) { x1 = x1 * C2; x2 = x2 * C2; }
                    bf16_t* p = P + (size_t)row * INW + u.pn * 256 + bj * 128 + wc * 32 + 4 * fq;
                    u32x2 w1, w2; w1.x = cvt_pk(x1[0], x1[1]); w1.y = cvt_pk(x1[2], x1[3]); w2.x = cvt_pk(x2[0], x2[1]); w2.y = cvt_pk(x2[2], x2[3]);
                    *(u32x2*)p = w1; *(u32x2*)(p + 16) = w2;
                }
            }
    }
};
template <bool IN_F32> struct EpiRes {
    static constexpr bool PERM = false, AFTER_DRAIN = false;
    const float* in_lat; const float* in_ctx; bf16_t* xb; const float* modl; int gate_idx;
    __device__ __forceinline__ void operator()(const f32x4 (&acc)[2][2][4][2], const pg8::Unit& u, int wr, int wc, int fr, int fq) const {
        const bool lat = u.pm < 256; const int rbase = lat ? u.pm * 256 : u.pm * 256 - TLAT; const int r = lat ? (u.pm >> 4) : 16;
        const float* ip = lat ? in_lat : in_ctx;
        const float* gate = modl + (r * 6 + gate_idx) * 1024;
        const int col0 = u.pn * 256 + wc * 32 + 4 * fq;
        f32x4 gv[2][2];
#pragma unroll
        for (int bj = 0; bj < 2; ++bj)
#pragma unroll
            for (int n = 0; n < 2; ++n) gv[bj][n] = *(const f32x4*)(gate + col0 + bj * 128 + 16 * n);
        const size_t offi = (size_t)(rbase + wr * 64 + fr) * DM + col0;
        const size_t offx = (size_t)(u.pm * 256 + wr * 64 + fr) * DM + col0;
        f32x4 xf[2][2][2]; u32x2 xh[2][2][2];
#pragma unroll
        for (int bj = 0; bj < 2; ++bj)
#pragma unroll
            for (int n = 0; n < 2; ++n) { if (IN_F32) xf[0][bj][n] = *(const f32x4*)(ip + offi + bj * 128 + 16 * n); else xh[0][bj][n] = *(const u32x2*)(xb + offx + bj * 128 + 16 * n); }
#pragma unroll
        for (int grp = 0; grp < 8; ++grp) {
            const int ai = grp >> 2, m = grp & 3, cb = grp & 1;
            const size_t roff = (size_t)(ai * 128 + m * 16) * DM;
            if (grp < 7) { const int ai2 = (grp + 1) >> 2, m2 = (grp + 1) & 3; const size_t rn = (size_t)(ai2 * 128 + m2 * 16) * DM;
#pragma unroll
                for (int bj = 0; bj < 2; ++bj)
#pragma unroll
                    for (int n = 0; n < 2; ++n) { if (IN_F32) xf[cb ^ 1][bj][n] = *(const f32x4*)(ip + offi + rn + bj * 128 + 16 * n); else xh[cb ^ 1][bj][n] = *(const u32x2*)(xb + offx + rn + bj * 128 + 16 * n); } }
            asm volatile("" ::: "memory");
#pragma unroll
            for (int bj = 0; bj < 2; ++bj)
#pragma unroll
                for (int n = 0; n < 2; ++n) {
                    f32x4 xi; if (IN_F32) xi = xf[cb][bj][n]; else xi = xs_unpack(xh[cb][bj][n]);
                    const f32x4 xo = xi + gv[bj][n] * acc[ai][bj][m][n];
                    *(u32x2*)(xb + offx + roff + bj * 128 + 16 * n) = xs_pack(xo); }
            asm volatile("" ::: "memory");
        }
    }
};
struct EpiSwiGLU {
    static constexpr bool PERM = false, AFTER_DRAIN = false;
    bf16_t* ACT;
    __device__ __forceinline__ void operator()(const f32x4 (&acc)[2][2][4][2], const pg8::Unit& u, int wr, int wc, int fr, int fq) const {
#pragma unroll
        for (int ai = 0; ai < 2; ++ai)
#pragma unroll
            for (int m = 0; m < 4; ++m) {
                const int row = u.pm * 256 + ai * 128 + wr * 64 + m * 16 + fr;
#pragma unroll
                for (int bj = 0; bj < 2; ++bj) {
                    const f32x4 g = acc[ai][bj][m][0], v = acc[ai][bj][m][1];
                    const int f = (u.pn * 8 + bj * 4 + wc) * 16 + 4 * fq;
                    u32x2 w; w.x = cvt_pk(silu_f(g[0]) * v[0], silu_f(g[1]) * v[1]); w.y = cvt_pk(silu_f(g[2]) * v[2], silu_f(g[3]) * v[3]);
                    *(u32x2*)(ACT + (size_t)row * DFF + f) = w;
                }
            }
    }
};
struct EpiPlain {
    static constexpr bool PERM = false, AFTER_DRAIN = false;
    bf16_t* O; int ldc;
    __device__ __forceinline__ void operator()(const f32x4 (&acc)[2][2][4][2], const pg8::Unit& u, int wr, int wc, int fr, int fq) const {
#pragma unroll
        for (int ai = 0; ai < 2; ++ai)
#pragma unroll
            for (int m = 0; m < 4; ++m) {
                const int row = u.pm * 256 + ai * 128 + wr * 64 + m * 16 + fr;
#pragma unroll
                for (int bj = 0; bj < 2; ++bj)
#pragma unroll
                    for (int n = 0; n < 2; ++n) {
                        const f32x4 x = acc[ai][bj][m][n]; u32x2 w; w.x = cvt_pk(x[0], x[1]); w.y = cvt_pk(x[2], x[3]);
                        *(u32x2*)(O + (size_t)row * ldc + u.pn * 256 + bj * 128 + wc * 32 + 16 * n + 4 * fq) = w;
                    }
            }
    }
};

__device__ __forceinline__ void sincos_turns(double x, double& s, double& c) {
    x = x - floor(x);
    const double q4 = floor(x * 4.0 + 0.5);
    const double r = x - q4 * 0.25;
    const int q = ((int)q4) & 3;
    const double th = r * 6.283185307179586476925, t2 = th * th;
    const double sp = th * (1.0 + t2 * (-1.0 / 6 + t2 * (1.0 / 120 + t2 * (-1.0 / 5040 + t2 * (1.0 / 362880 + t2 * (-1.0 / 39916800 + t2 * (1.0 / 6227020800.0)))))));
    const double cp = 1.0 + t2 * (-0.5 + t2 * (1.0 / 24 + t2 * (-1.0 / 720 + t2 * (1.0 / 40320 + t2 * (-1.0 / 3628800 + t2 * (1.0 / 479001600.0 + t2 * (-1.0 / 87178291200.0)))))));
    if (q == 0) { s = sp; c = cp; } else if (q == 1) { s = cp; c = -sp; } else if (q == 2) { s = -sp; c = -cp; } else { s = -cp; c = sp; }
}
__device__ __forceinline__ unsigned short f2bf(float f) { return __builtin_bit_cast(unsigned short, (__bf16)f); }

__device__ __forceinline__ void transpose_item(const float* W, int K, int N, bf16_t* WT, int mode, LAS float* scr, int item, int lane) {
    const int nblk = N / 32, kb = item / nblk, nb = item % nblk, k0 = 64 * kb, n0 = 32 * nb;
#pragma unroll 8
    for (int i = 0; i < 32; ++i) { const int kk = 2 * i + (lane >> 5); scr[kk * 33 + (lane & 31)] = W[(size_t)(k0 + kk) * N + n0 + (lane & 31)]; }
    LDS_WAIT(); asm volatile("" ::: "memory");
    const int c = lane & 7;
#pragma unroll
    for (int j = 0; j < 4; ++j) { const int n = (lane >> 3) + 8 * j; const LAS float* s = scr + (8 * c) * 33 + n;
        u32x4 o; o.x = cvt_pk(s[0 * 33], s[1 * 33]); o.y = cvt_pk(s[2 * 33], s[3 * 33]); o.z = cvt_pk(s[4 * 33], s[5 * 33]); o.w = cvt_pk(s[6 * 33], s[7 * 33]);
        const int f = n0 + n; const int orow = (mode == 0) ? f : (((f >> 4) << 5) + (f & 15) + (mode == 2 ? 16 : 0));
        *(u32x4*)(WT + (size_t)orow * K + k0 + 8 * c) = o; }
    LDS_WAIT(); asm volatile("" ::: "memory");
}

__device__ __forceinline__ void prologue(const Args& A, LAS unsigned char* lds, int tid, int wave, int lane, int G) {
    unsigned char* ws = A.ws;
    {
        LAS float* scr = (LAS float*)(lds + wave * 16384);
        const int gw = blockIdx.x * NWAVES + wave, NGW = G * NWAVES;
        constexpr int I_IN = 16 * 72, I_SQ = 16 * 32, I_FF = 16 * 88, I_DN = 44 * 32;
        constexpr int NIT = 2 * I_IN + 4 * I_SQ + 8 * I_FF + 4 * I_DN;
        for (int it = gw; it < NIT; it += NGW) {
            int r = it;
            if (r < 2 * I_IN) { const int e = r / I_IN; transpose_item(A.w_in + (size_t)e * DM * INW, DM, INW, (bf16_t*)(ws + WS_WIN) + (size_t)e * INW * DM, 0, scr, r % I_IN, lane); continue; } r -= 2 * I_IN;
            if (r < 2 * I_SQ) { const int e = r / I_SQ; transpose_item(A.w_mix + (size_t)e * DM * DM, DM, DM, (bf16_t*)(ws + WS_WMIX) + (size_t)e * DM * DM, 0, scr, r % I_SQ, lane); continue; } r -= 2 * I_SQ;
            if (r < 2 * I_SQ) { const int e = r / I_SQ; transpose_item(A.w_four + (size_t)e * DM * DM, DM, DM, (bf16_t*)(ws + WS_WF) + (size_t)e * DM * DM, 0, scr, r % I_SQ, lane); continue; } r -= 2 * I_SQ;
            if (r < 4 * I_FF) { const int l = r / I_FF; transpose_item(A.w_gate + (size_t)l * DM * DFF, DM, DFF, (bf16_t*)(ws + WS_WGU) + (size_t)l * 2 * DFF * DM, 1, scr, r % I_FF, lane); continue; } r -= 4 * I_FF;
            if (r < 4 * I_FF) { const int l = r / I_FF; transpose_item(A.w_up + (size_t)l * DM * DFF, DM, DFF, (bf16_t*)(ws + WS_WGU) + (size_t)l * 2 * DFF * DM, 2, scr, r % I_FF, lane); continue; } r -= 4 * I_FF;
            { const int l = r / I_DN; transpose_item(A.w_down + (size_t)l * DFF * DM, DFF, DM, (bf16_t*)(ws + WS_WD) + (size_t)l * DM * DFF, 0, scr, r % I_DN, lane); }
        }
    }
    {
        const int gt = blockIdx.x * NTHR + tid, NGT = G * NTHR;
        float* rope = (float*)(ws + WS_TAB + TAB_ROPE); float* tw = (float*)(ws + WS_TAB + TAB_TW);
        bf16_t* D1 = (bf16_t*)(ws + WS_TAB + TAB_D1); bf16_t* D2 = (bf16_t*)(ws + WS_TAB + TAB_D2); bf16_t* DC = (bf16_t*)(ws + WS_TAB + TAB_DC); bf16_t* DX = (bf16_t*)(ws + WS_TAB + TAB_DCTX);
        constexpr int N_ROPE = 1024, N_TW = 4096, N_D1 = 16384, N_D2 = 8192, N_DC = 131072, N_DX = 131072;
        for (int i = gt; i < N_ROPE + N_TW + N_D1 + N_D2 + N_DC + N_DX; i += NGT) {
            int r = i; double s, c;
            if (r < N_ROPE) { const int a = r >> 4, f = r & 15; sincos_turns((double)a * A.invf[f] * 0.15915494309189533577, s, c); rope[2 * r] = (float)c; rope[2 * r + 1] = (float)s; continue; } r -= N_ROPE;
            if (r < N_TW) { const int k1 = r >> 6, n2 = r & 63; sincos_turns((double)(k1 * n2) / 4096.0, s, c); tw[2 * r] = (float)c; tw[2 * r + 1] = (float)s; continue; } r -= N_TW;
            if (r < N_D1) { const int row = r >> 7, col = r & 127, k1 = row >> 1, rio = row & 1, rii = col >> 6, n1 = col & 63; sincos_turns((double)((k1 * n1) & 63) / 64.0, s, c);
                const double v = (rio == rii) ? c : (rio == 0 ? s : -s); D1[r] = f2bf((float)(v * 0.125)); continue; } r -= N_D1;
            if (r < N_D2) { const int k2 = r >> 7, col = r & 127, ri = col >> 6, n2 = col & 63; sincos_turns((double)((k2 * n2) & 63) / 64.0, s, c); D2[r] = f2bf((float)((ri ? s : c) * 0.125)); continue; } r -= N_D2;
            if (r < N_DC) { const int row = r >> 8, cc = r & 255, ri = row >> 8, m = row & 255; sincos_turns((double)((m * cc) & 255) / 256.0, s, c); DC[r] = f2bf((float)((ri ? -s : c) * 0.0625)); continue; } r -= N_DC;
            { const int k = r >> 9, col = r & 511, ri = col >> 8, n = col & 255; sincos_turns((double)((k * n) & 255) / 256.0, s, c); DX[r] = f2bf((float)((ri ? s : c) * 0.0625)); }
        }
    }
    __syncthreads();
    {
        LAS float* S = (LAS float*)lds; LAS float* Pp = (LAS float*)(lds + 69632);
        for (int i = tid; i < 17 * 1024; i += NTHR) { const int r = i >> 10, k = i & 1023; const float v = (r < 16) ? A.c[r * 1024 + k] : A.c_ctx[k]; S[i] = v / (1.0f + expf(-v)); }
        __syncthreads();
        float* mod = (float*)(ws + WS_MOD);
        for (int task = blockIdx.x; task < 4 * 96; task += G) {
            const int l = task / 96, j0 = (task % 96) * 64;
            const float* w = A.w_ada + (size_t)l * 1024 * 6144 + j0 + lane;
            float acc[17];
#pragma unroll
            for (int r = 0; r < 17; ++r) acc[r] = 0.f;
#pragma unroll 4
            for (int kk = 0; kk < 128; ++kk) { const int k = wave * 128 + kk; const float wv = w[(size_t)k * 6144];
#pragma unroll
                for (int r = 0; r < 17; ++r) acc[r] += S[r * 1024 + k] * wv; }
#pragma unroll
            for (int r = 0; r < 17; ++r) Pp[(wave * 17 + r) * 64 + lane] = acc[r];
            __syncthreads();
            for (int o = tid; o < 17 * 64; o += NTHR) { const int r = o >> 6, jj = o & 63; float sum = 0.f;
#pragma unroll
                for (int w8 = 0; w8 < 8; ++w8) sum += Pp[(w8 * 17 + r) * 64 + jj];
                mod[(size_t)(l * 17 + r) * 6144 + j0 + jj] = sum + A.b_ada[l * 6144 + j0 + jj]; }
            __syncthreads();
        }
    }
}

template <bool IN_F32> __device__ __forceinline__ void norm_ld(f32x4 (&v)[4], const float* lat, const float* ctxp, const bf16_t* xb, int row, int lane) {
    if (IN_F32) { const float* xr = (row < TLAT) ? lat + (size_t)row * DM : ctxp + (size_t)(row - TLAT) * DM;
#pragma unroll
        for (int j = 0; j < 4; ++j) v[j] = *(const f32x4*)(xr + 4 * lane + 256 * j); }
    else {
#pragma unroll
        for (int j = 0; j < 4; ++j) { v[j] = xs_unpack(*(const u32x2*)(xb + (size_t)row * DM + 4 * lane + 256 * j)); } }
}
template <bool IN_F32> __device__ __forceinline__ void norm_phase(const float* lat, const float* ctxp, const bf16_t* xb, const float* g, const float* modl, int shift_idx, bf16_t* hout, int M, int gw, int NGW, int lane) {
    constexpr int NR = 2;
    const int rpw = M / NGW, rbeg = gw * rpw, rend = rbeg + rpw;
    f32x4 gv[4];
#pragma unroll
    for (int j = 0; j < 4; ++j) gv[j] = *(const f32x4*)(g + 4 * lane + 256 * j);
    f32x4 vc[NR][4], vn[NR][4], scv[4], shv[4]; int rcur = -1;
#pragma unroll
    for (int q = 0; q < NR; ++q) norm_ld<IN_F32>(vc[q], lat, ctxp, xb, rbeg + q, lane);
    for (int row0 = rbeg; row0 < rend; row0 += NR) {
        const int r = (row0 < TLAT) ? (row0 >> 12) : 16;
        if (r != rcur) { rcur = r; const float* sh = modl + (r * 6 + shift_idx) * 1024; const float* sc = sh + 1024;
#pragma unroll
            for (int j = 0; j < 4; ++j) { scv[j] = (*(const f32x4*)(sc + 4 * lane + 256 * j) + 1.0f) * gv[j]; shv[j] = *(const f32x4*)(sh + 4 * lane + 256 * j); } }
        if (row0 + NR < rend) {
#pragma unroll
            for (int q = 0; q < NR; ++q) norm_ld<IN_F32>(vn[q], lat, ctxp, xb, row0 + NR + q, lane); }
        asm volatile("" ::: "memory");
#pragma unroll
        for (int q = 0; q < NR; ++q) { float ss = 0.f;
#pragma unroll
            for (int j = 0; j < 4; ++j) ss += (vc[q][j].x * vc[q][j].x + vc[q][j].y * vc[q][j].y) + (vc[q][j].z * vc[q][j].z + vc[q][j].w * vc[q][j].w);
#pragma unroll
            for (int o = 1; o < 64; o <<= 1) ss += __shfl_xor(ss, o);
            const float rstd = 1.0f / sqrtf(ss * (1.0f / DM) + 1e-6f);
#pragma unroll
            for (int j = 0; j < 4; ++j) { const f32x4 o = vc[q][j] * rstd * scv[j] + shv[j];
                u32x2 w; w.x = cvt_pk(o.x, o.y); w.y = cvt_pk(o.z, o.w);
                *(u32x2*)(hout + (size_t)(row0 + q) * DM + 4 * lane + 256 * j) = w; } }
        asm volatile("" ::: "memory");
#pragma unroll
        for (int q = 0; q < NR; ++q)
#pragma unroll
            for (int j = 0; j < 4; ++j) vc[q][j] = vn[q][j];
    }
}
__device__ __forceinline__ void final_norm_phase(const bf16_t* xb, float* xo, const float* g, int gw, int NGW, int lane) {
    constexpr int NR = 2;
    const int rpw = TLAT / NGW, rbeg = gw * rpw, rend = rbeg + rpw;
    f32x4 gv[4];
#pragma unroll
    for (int j = 0; j < 4; ++j) gv[j] = *(const f32x4*)(g + 4 * lane + 256 * j);
    f32x4 vc[NR][4], vn[NR][4];
#pragma unroll
    for (int q = 0; q < NR; ++q) norm_ld<false>(vc[q], nullptr, nullptr, xb, rbeg + q, lane);
    for (int row0 = rbeg; row0 < rend; row0 += NR) {
        if (row0 + NR < rend) {
#pragma unroll
            for (int q = 0; q < NR; ++q) norm_ld<false>(vn[q], nullptr, nullptr, xb, row0 + NR + q, lane); }
        asm volatile("" ::: "memory");
#pragma unroll
        for (int q = 0; q < NR; ++q) { float ss = 0.f;
#pragma unroll
            for (int j = 0; j < 4; ++j) ss += (vc[q][j].x * vc[q][j].x + vc[q][j].y * vc[q][j].y) + (vc[q][j].z * vc[q][j].z + vc[q][j].w * vc[q][j].w);
#pragma unroll
            for (int o = 1; o < 64; o <<= 1) ss += __shfl_xor(ss, o);
            const float rstd = 1.0f / sqrtf(ss * (1.0f / DM) + 1e-6f);
#pragma unroll
            for (int j = 0; j < 4; ++j) *(f32x4*)(xo + (size_t)(row0 + q) * DM + 4 * lane + 256 * j) = vc[q][j] * rstd * gv[j]; }
        asm volatile("" ::: "memory");
#pragma unroll
        for (int q = 0; q < NR; ++q)
#pragma unroll
            for (int j = 0; j < 4; ++j) vc[q][j] = vn[q][j];
    }
}

__device__ __forceinline__ int crow(int r, int hi) { return (r & 3) + 8 * (r >> 2) + 4 * hi; }

__device__ __forceinline__ void attn_phase(LAS unsigned char* lds, const bf16_t* P, bf16_t* cat, const float* sink, bool ctxq, int G, int tid, int wave, int lane) {
    constexpr int KROW = 144, VROW = 264;
    LAS unsigned char* Kl = lds; LAS unsigned char* Vl = lds + 128 * KROW;
    const int r32 = lane & 31, hi = lane >> 5, g = wave & 3, qh = wave >> 2;
    const int nitems = 1024 + (ctxq ? 64 : 0);
    for (int it = blockIdx.x; it < nitems; it += G) {
        int b, hk, qb, qr0; const bool isl = it < 1024;
        if (isl) { b = it >> 6; hk = (it >> 5) & 1; qb = it & 31; qr0 = b * SEQ + qb * 128; }
        else { const int j = it - 1024; b = j >> 2; hk = (j >> 1) & 1; qb = j & 1; qr0 = TLAT + b * LCTX + qb * 128; }
        const int crow0 = TLAT + b * LCTX, head = hk * 4 + g;
        bf16x8 qf[2][4];
#pragma unroll
        for (int s = 0; s < 2; ++s)
#pragma unroll
            for (int ks = 0; ks < 4; ++ks) qf[s][ks] = *(const bf16x8*)(P + (size_t)(qr0 + 64 * qh + 32 * s + r32) * INW + QS + head * 64 + 16 * ks + 8 * hi);
        float mrun[2], lrun[2]; f32x16 O[2][2];
        const float sk2 = sink[head] * LOG2E;
#pragma unroll
        for (int s = 0; s < 2; ++s) { mrun[s] = sk2; lrun[s] = 1.0f;
#pragma unroll
            for (int dt = 0; dt < 2; ++dt)
#pragma unroll
                for (int r = 0; r < 16; ++r) O[s][dt][r] = 0.f; }
#pragma unroll 1
        for (int ti = 0; ti < 5; ++ti) {
            int krow0, mtype = 0; bool valid = true;
            if (ti == 0) { krow0 = qr0 - 128; mtype = 1; valid = isl && qb > 0; }
            else if (ti == 1) { krow0 = qr0; valid = isl; }
            else if (ti == 2) { krow0 = qr0 + 128; mtype = 2; valid = isl && qb < 31; }
            else { krow0 = crow0 + (ti - 3) * 128; }
            if (!valid) continue;
            __syncthreads();
#pragma unroll
            for (int i = 0; i < 2; ++i) { const int id = tid + NTHR * i, key = id >> 3, c = id & 7;
                const u32x4 v = *(const u32x4*)(P + (size_t)(krow0 + key) * INW + KS_ + hk * 64 + 8 * c);
                *(LAS u32x4*)(Kl + key * KROW + c * 16) = v; }
#pragma unroll
            for (int i = 0; i < 2; ++i) { const int id = tid + NTHR * i, key = id & 127, c = id >> 7;
                const u32x4 v = *(const u32x4*)(P + (size_t)(krow0 + key) * INW + VS_ + hk * 64 + 8 * c);
                LAS unsigned char* vp = Vl + (8 * c) * VROW + key * 2;
                *(LAS unsigned short*)(vp + 0 * VROW) = (unsigned short)(v.x & 0xffffu); *(LAS unsigned short*)(vp + 1 * VROW) = (unsigned short)(v.x >> 16);
                *(LAS unsigned short*)(vp + 2 * VROW) = (unsigned short)(v.y & 0xffffu); *(LAS unsigned short*)(vp + 3 * VROW) = (unsigned short)(v.y >> 16);
                *(LAS unsigned short*)(vp + 4 * VROW) = (unsigned short)(v.z & 0xffffu); *(LAS unsigned short*)(vp + 5 * VROW) = (unsigned short)(v.z >> 16);
                *(LAS unsigned short*)(vp + 6 * VROW) = (unsigned short)(v.w & 0xffffu); *(LAS unsigned short*)(vp + 7 * VROW) = (unsigned short)(v.w >> 16); }
            __syncthreads();
#pragma unroll
            for (int half = 0; half < 2; ++half)
#pragma unroll
                for (int s = 0; s < 2; ++s) {
                    f32x16 S[2];
#pragma unroll
                    for (int rt = 0; rt < 2; ++rt) {
#pragma unroll
                        for (int r = 0; r < 16; ++r) S[rt][r] = 0.f;
#ifndef DIAG
                        asm volatile("" : "+v"(S[rt]));
#endif
#pragma unroll
                        for (int ks = 0; ks < 4; ++ks) { const bf16x8 kf = *(const LAS bf16x8*)(Kl + (64 * half + 32 * rt + r32) * KROW + (16 * ks + 8 * hi) * 2);
                            S[rt] = __builtin_amdgcn_mfma_f32_32x32x16_bf16(kf, qf[s][ks], S[rt], 0, 0, 0); }
                    }
                    if (mtype != 0) { int il = 64 * qh + 32 * s + r32; asm volatile("" : "+v"(il));
#pragma unroll
                        for (int rt = 0; rt < 2; ++rt)
#pragma unroll
                            for (int r = 0; r < 16; ++r) { const int jl = 64 * half + 32 * rt + crow(r, hi); const bool ok = (mtype == 1) ? (jl >= il) : (jl <= il); if (!ok) S[rt][r] = -INFINITY; } }
                    float tmax = S[0][0];
#pragma unroll
                    for (int rt = 0; rt < 2; ++rt)
#pragma unroll
                        for (int r = 0; r < 16; ++r) tmax = fmaxf(tmax, S[rt][r]);
                    tmax = fmaxf(tmax, __shfl_xor(tmax, 32));
                    const float mnew = fmaxf(mrun[s], tmax), alpha = fast_exp2(mrun[s] - mnew);
                    mrun[s] = mnew;
                    float psum = 0.f;
#pragma unroll
                    for (int rt = 0; rt < 2; ++rt)
#pragma unroll
                        for (int r = 0; r < 16; ++r) { const float p = fast_exp2(S[rt][r] - mnew); S[rt][r] = p; psum += p; }
                    psum += __shfl_xor(psum, 32);
                    lrun[s] = lrun[s] * alpha + psum;
#pragma unroll
                    for (int dt = 0; dt < 2; ++dt)
#pragma unroll
                        for (int r = 0; r < 16; ++r) O[s][dt][r] *= alpha;
#pragma unroll
                    for (int rt = 0; rt < 2; ++rt)
#pragma unroll
                        for (int s2 = 0; s2 < 2; ++s2) {
                            u32x4 pw; pw.x = cvt_pk(S[rt][8 * s2 + 0], S[rt][8 * s2 + 1]); pw.y = cvt_pk(S[rt][8 * s2 + 2], S[rt][8 * s2 + 3]);
                            pw.z = cvt_pk(S[rt][8 * s2 + 4], S[rt][8 * s2 + 5]); pw.w = cvt_pk(S[rt][8 * s2 + 6], S[rt][8 * s2 + 7]);
                            const bf16x8 pf = __builtin_bit_cast(bf16x8, pw);
#pragma unroll
                            for (int dt = 0; dt < 2; ++dt) {
                                const LAS unsigned char* vb = Vl + (32 * dt + r32) * VROW + (64 * half + 32 * rt + 16 * s2 + 4 * hi) * 2;
                                const u32x2 v0 = *(const LAS u32x2*)vb, v1 = *(const LAS u32x2*)(vb + 16);
                                const u32x4 vv = {v0.x, v0.y, v1.x, v1.y};
                                O[s][dt] = __builtin_amdgcn_mfma_f32_32x32x16_bf16(__builtin_bit_cast(bf16x8, vv), pf, O[s][dt], 0, 0, 0);
                            }
                        }
                }
        }
#pragma unroll
        for (int s = 0; s < 2; ++s) { const float inv = 1.0f / lrun[s];
            bf16_t* orow = cat + (size_t)(qr0 + 64 * qh + 32 * s + r32) * DM + 512 + head * 64;
#pragma unroll
            for (int dt = 0; dt < 2; ++dt)
#pragma unroll
                for (int q4 = 0; q4 < 4; ++q4) { u32x2 w; w.x = cvt_pk(O[s][dt][4 * q4 + 0] * inv, O[s][dt][4 * q4 + 1] * inv); w.y = cvt_pk(O[s][dt][4 * q4 + 2] * inv, O[s][dt][4 * q4 + 3] * inv);
                    *(u32x2*)(orow + 32 * dt + 8 * q4 + 4 * hi) = w; } }
    }
    __syncthreads();
}

__device__ __forceinline__ void load_u(const bf16_t* P, int t, int s0, int s1, int c8, float (&u)[8]) {
    if (t < s0 || t >= s1) {
#pragma unroll
        for (int j = 0; j < 8; ++j) u[j] = 0.f;
    } else {
        const u32x4 cv = *(const u32x4*)(P + (size_t)t * INW + 512 + 8 * c8), hv = *(const u32x4*)(P + (size_t)t * INW + 1024 + 8 * c8);
        u[0] = bf_lo(cv.x) * bf_lo(hv.x); u[1] = bf_hi(cv.x) * bf_hi(hv.x); u[2] = bf_lo(cv.y) * bf_lo(hv.y); u[3] = bf_hi(cv.y) * bf_hi(hv.y);
        u[4] = bf_lo(cv.z) * bf_lo(hv.z); u[5] = bf_hi(cv.z) * bf_hi(hv.z); u[6] = bf_lo(cv.w) * bf_lo(hv.w); u[7] = bf_hi(cv.w) * bf_hi(hv.w);
    }
}
__device__ __forceinline__ void conv_phase(const bf16_t* P, bf16_t* cat, const float* cw, int M, int G, int tid) {
    const int c8 = tid & 63, tg = tid >> 6;
    float w0[8], w1[8], w2[8];
#pragma unroll
    for (int j = 0; j < 8; ++j) { w0[j] = cw[8 * c8 + j]; w1[j] = cw[512 + 8 * c8 + j]; w2[j] = cw[1024 + 8 * c8 + j]; }
    for (int it = blockIdx.x; it < M / 128; it += G) {
        const int t0 = it * 128, ts = t0 + 16 * tg;
        int s0, s1; if (t0 < TLAT) { s0 = t0 & ~4095; s1 = s0 + 4096; } else { s0 = TLAT + ((t0 - TLAT) & ~255); s1 = s0 + 256; }
        float up[8], uc[8], un[8];
        load_u(P, ts - 1, s0, s1, c8, up); load_u(P, ts, s0, s1, c8, uc);
#pragma unroll 2
        for (int i = 0; i < 16; ++i) { const int t = ts + i;
            load_u(P, t + 1, s0, s1, c8, un);
            const u32x4 bv = *(const u32x4*)(P + (size_t)t * INW + 8 * c8);
            float bb[8] = {bf_lo(bv.x), bf_hi(bv.x), bf_lo(bv.y), bf_hi(bv.y), bf_lo(bv.z), bf_hi(bv.z), bf_lo(bv.w), bf_hi(bv.w)};
            float o[8];
#pragma unroll
            for (int j = 0; j < 8; ++j) { o[j] = bb[j] * (w0[j] * up[j] + w1[j] * uc[j] + w2[j] * un[j]); up[j] = uc[j]; uc[j] = un[j]; }
            u32x4 w; w.x = cvt_pk(o[0], o[1]); w.y = cvt_pk(o[2], o[3]); w.z = cvt_pk(o[4], o[5]); w.w = cvt_pk(o[6], o[7]);
            *(u32x4*)(cat + (size_t)t * DM + 8 * c8) = w; }
    }
}

template <int MT, int KS> __device__ __forceinline__ void dft_load_a(bf16x8 (&a)[MT][KS], const bf16_t* Mat, int row0, int r32, int hi) {
#pragma unroll
    for (int rt = 0; rt < MT; ++rt)
#pragma unroll
        for (int ks = 0; ks < KS; ++ks) a[rt][ks] = *(const bf16x8*)(Mat + (size_t)(row0 + 32 * rt + r32) * (KS * 16) + 16 * ks + 8 * hi);
}
template <int MT, int KS> __device__ __forceinline__ void dft_mm(f32x16 (&acc)[MT], const bf16x8 (&a)[MT][KS], const bf16_t* vec) {
#pragma unroll
    for (int rt = 0; rt < MT; ++rt)
#pragma unroll
        for (int r = 0; r < 16; ++r) acc[rt][r] = 0.f;
#pragma unroll
    for (int rt = 0; rt < MT; ++rt) asm volatile("" : "+v"(acc[rt]));
    constexpr int KC = 8;
#pragma unroll
    for (int kc = 0; kc < KS / KC; ++kc) {
        bf16x8 b[KC];
#pragma unroll
        for (int i = 0; i < KC; ++i) b[i] = *(const bf16x8*)(vec + 16 * (kc * KC + i));
#pragma unroll
        for (int i = 0; i < KC; ++i)
#pragma unroll
            for (int rt = 0; rt < MT; ++rt) acc[rt] = __builtin_amdgcn_mfma_f32_32x32x16_bf16(a[rt][kc * KC + i], b[i], acc[rt], 0, 0, 0);
    }
}
__device__ __forceinline__ void store_pair(bf16_t* base, size_t zoo, unsigned cA, unsigned cB, float va, float vb, bool odd) {
    const float keep = odd ? vb : va, send = odd ? va : vb;
    const float got = __builtin_bit_cast(float, __builtin_amdgcn_mov_dpp(__builtin_bit_cast(int, send), 0xB1, 0xf, 0xf, true));
    const unsigned w = odd ? cvt_pk(got, keep) : cvt_pk(keep, got);
    *(unsigned*)(base + zoo + (odd ? cB : cA)) = w;
}
__device__ __forceinline__ void dft_ld8(bf16x8 (&b)[8], const bf16_t* vec) {
#pragma unroll
    for (int i = 0; i < 8; ++i) b[i] = *(const bf16x8*)(vec + 16 * i);
}
template <int MT> __device__ __forceinline__ void dft_zero(f32x16 (&acc)[MT]) {
#pragma unroll
    for (int rt = 0; rt < MT; ++rt) {
#pragma unroll
        for (int r = 0; r < 16; ++r) acc[rt][r] = 0.f;
        asm volatile("" : "+v"(acc[rt]));
    }
}
template <int MT, int KS, int K0> __device__ __forceinline__ void dft_mma8(f32x16 (&acc)[MT], const bf16x8 (&a)[MT][KS], const bf16x8 (&b)[8]) {
#pragma unroll
    for (int i = 0; i < 8; ++i)
#pragma unroll
        for (int rt = 0; rt < MT; ++rt) acc[rt] = __builtin_amdgcn_mfma_f32_32x32x16_bf16(a[rt][K0 + i], b[i], acc[rt], 0, 0, 0);
}
__device__ __forceinline__ const bf16_t* fa_vec(const bf16_t* H, int tile, int r32, int hi) {
    int token, g;
    if (tile < 8192) { const int n1h = tile & 1, n2 = (tile >> 1) & 63, b = tile >> 9; g = (tile >> 7) & 3; token = b * SEQ + 64 * (32 * n1h + r32) + n2; }
    else { const int tc = tile - 8192, nq = tc & 7, b = tc >> 5; g = (tc >> 3) & 3; token = TLAT + b * LCTX + 32 * nq + r32; }
    return H + (size_t)token * DM + g * 256 + 8 * hi;
}
__device__ __forceinline__ int fa_token(int tile, int row) {
    if (tile < 8192) { const int n1h = tile & 1, n2 = (tile >> 1) & 63, b = tile >> 9; return b * SEQ + 64 * (32 * n1h + row) + n2; }
    const int tc = tile - 8192, nq = tc & 7, b = tc >> 5; return TLAT + b * LCTX + 32 * nq + row;
}
__device__ __forceinline__ void fourier_a(LAS unsigned char* lds, const bf16_t* H, const bf16_t* DC, bf16_t* Z1, bf16_t* Zc, bool with_ctx, int G, int vcu, int wave, int lane) {
    constexpr int ROWB = 528, BUFB = 32 * ROWB;
    const int r32 = lane & 31, hi = lane >> 5, sl = wave, tid = wave * 64 + lane; const bool odd = lane & 1;
    bf16x8 a[2][16]; dft_load_a<2, 16>(a, DC, 64 * sl, r32, hi);
    const int ntile = 8192 + (with_ctx ? 512 : 0);
    const int srow0 = tid >> 5, sch = tid & 31;
    u32x4 s0, s1;
    int tile = vcu, cur = 0;
    if (tile < ntile) { const int g = (tile < 8192) ? (tile >> 7) & 3 : ((tile - 8192) >> 3) & 3;
        s0 = *(const u32x4*)(H + (size_t)fa_token(tile, srow0) * DM + g * 256 + sch * 8); s1 = *(const u32x4*)(H + (size_t)fa_token(tile, srow0 + 16) * DM + g * 256 + sch * 8); }
    for (; tile < ntile; tile += G) {
        LAS unsigned char* buf = lds + cur * BUFB;
        *(LAS u32x4*)(buf + srow0 * ROWB + sch * 16) = s0; *(LAS u32x4*)(buf + (srow0 + 16) * ROWB + sch * 16) = s1;
        __syncthreads();
        if (tile + G < ntile) { const int tn = tile + G; const int g = (tn < 8192) ? (tn >> 7) & 3 : ((tn - 8192) >> 3) & 3;
            s0 = *(const u32x4*)(H + (size_t)fa_token(tn, srow0) * DM + g * 256 + sch * 8); s1 = *(const u32x4*)(H + (size_t)fa_token(tn, srow0 + 16) * DM + g * 256 + sch * 8); }
        asm volatile("" ::: "memory");
        f32x16 acc[2]; dft_zero<2>(acc);
        const LAS unsigned char* bp = buf + r32 * ROWB + hi * 16;
#pragma unroll
        for (int ks = 0; ks < 16; ++ks) { const bf16x8 bf = *(const LAS bf16x8*)(bp + ks * 32);
#pragma unroll
            for (int rt = 0; rt < 2; ++rt) acc[rt] = __builtin_amdgcn_mfma_f32_32x32x16_bf16(a[rt][ks], bf, acc[rt], 0, 0, 0); }
        if (tile < 8192) {
            const int n1h = tile & 1, n2 = (tile >> 1) & 63, g = (tile >> 7) & 3, b = tile >> 9;
            size_t zo = ((((size_t)((b * 4 + g) * 256 + 64 * (sl & 3) + 4 * hi)) * 64 + n2) * 2 + (sl >> 2)) * 64 + 32 * n1h + (r32 & ~1);
            asm volatile("" : "+v"(zo));
#pragma unroll
            for (int rt = 0; rt < 2; ++rt)
#pragma unroll
                for (int r = 0; r < 16; r += 2) store_pair(Z1, zo, (unsigned)(32 * rt + (r & 3) + 8 * (r >> 2)) * 8192u, (unsigned)(32 * rt + ((r + 1) & 3) + 8 * (r >> 2)) * 8192u, acc[rt][r], acc[rt][r + 1], odd);
        } else {
            const int tc = tile - 8192, nq = tc & 7, g = (tc >> 3) & 3, b = tc >> 5;
            size_t zo = (((size_t)((b * 4 + g) * 256 + 64 * (sl & 3) + 4 * hi)) * 2 + (sl >> 2)) * 256 + 32 * nq + (r32 & ~1);
            asm volatile("" : "+v"(zo));
#pragma unroll
            for (int rt = 0; rt < 2; ++rt)
#pragma unroll
                for (int r = 0; r < 16; r += 2) store_pair(Zc, zo, (unsigned)(32 * rt + (r & 3) + 8 * (r >> 2)) * 512u, (unsigned)(32 * rt + ((r + 1) & 3) + 8 * (r >> 2)) * 512u, acc[rt][r], acc[rt][r + 1], odd);
        }
        asm volatile("" ::: "memory");
        cur ^= 1;
    }
    __syncthreads();
}
template <int VAR> __device__ __forceinline__ void fourier_s1(const bf16_t* Z1, const bf16_t* D1, const float* tw, bf16_t* A1p, int G, int vcu, int wave, int lane) {
    const int r32 = lane & 31, hi = lane >> 5, sl = wave & 1; const bool odd = lane & 1;
    bf16x8 a[2][8]; dft_load_a<2, 8>(a, D1, 64 * sl, r32, hi);
    int tile = vcu * 4 + (wave >> 1); const int step = G * 4;
    const int n2 = 32 * (tile & 1) + r32;
    float2 twr[16];
#pragma unroll
    for (int rt = 0; rt < 2; ++rt)
#pragma unroll
        for (int q4 = 0; q4 < 4; ++q4)
#pragma unroll
            for (int e = 0; e < 2; ++e) twr[rt * 8 + q4 * 2 + e] = *(const float2*)(tw + 2 * ((32 * sl + 2 * hi + 16 * rt + 4 * q4 + e) * 64 + n2));
    bf16x8 bc[8], bn[8];
    if (tile < 32768) dft_ld8(bc, Z1 + ((size_t)tile * 32 + r32) * 128 + 8 * hi);
    for (; tile < 32768; tile += step) {
        asm volatile("" ::: "memory");
        if (tile + step < 32768) dft_ld8(bn, Z1 + ((size_t)(tile + step) * 32 + r32) * 128 + 8 * hi);
        asm volatile("" ::: "memory");
        f32x16 acc[2]; dft_zero<2>(acc);
        dft_mma8<2, 8, 0>(acc, a, bc);
        const int bgm = tile >> 1, bg = bgm >> 8, m = bgm & 255;
        size_t ao = ((((size_t)(bg * 64 + 32 * sl + 2 * hi)) * 256 + m) * 2) * 64 + (n2 & ~1);
        asm volatile("" : "+v"(ao));
#pragma unroll
        for (int rt = 0; rt < 2; ++rt)
#pragma unroll
            for (int q4 = 0; q4 < 4; ++q4)
#pragma unroll
                for (int e = 0; e < 2; ++e) { const int dk = 16 * rt + 4 * q4 + e;
                    const float re = acc[rt][4 * q4 + 2 * e], im = acc[rt][4 * q4 + 2 * e + 1];
                    const float2 cs = twr[rt * 8 + q4 * 2 + e];
                    const float re2 = re * cs.x + im * cs.y, im2 = im * cs.x - re * cs.y;
                    store_pair(A1p, ao, (unsigned)dk * 32768u, (unsigned)dk * 32768u + 64u, re2, im2, odd); }
        asm volatile("" ::: "memory");
#pragma unroll
        for (int i = 0; i < 8; ++i) bc[i] = bn[i];
    }
}
__device__ __forceinline__ void fourier_s2(const bf16_t* A1p, const bf16_t* D2, const bf16_t* Zc, const bf16_t* DX, bf16_t* FM, bool with_ctx, int G, int vcu, int gw, int NGW, int wave, int lane) {
    const int r32 = lane & 31, hi = lane >> 5; const bool odd = lane & 1;
    {
        bf16x8 a[2][8]; dft_load_a<2, 8>(a, D2, 0, r32, hi);
        bf16x8 bc[8], bn[8];
        int tile = gw;
        if (tile < 32768) dft_ld8(bc, A1p + ((size_t)tile * 32 + r32) * 128 + 8 * hi);
        for (; tile < 32768; tile += NGW) {
            asm volatile("" ::: "memory");
            if (tile + NGW < 32768) dft_ld8(bn, A1p + ((size_t)(tile + NGW) * 32 + r32) * 128 + 8 * hi);
            asm volatile("" ::: "memory");
            f32x16 acc[2]; dft_zero<2>(acc);
            dft_mma8<2, 8, 0>(acc, a, bc);
            const int m = 32 * (tile & 7) + r32, k1 = (tile >> 3) & 63, bg = tile >> 9, b = bg >> 2, g = bg & 3;
            size_t fo = (size_t)(b * SEQ + k1 + 256 * hi) * DM + g * 256 + (m & ~1);
            asm volatile("" : "+v"(fo));
#pragma unroll
            for (int rt = 0; rt < 2; ++rt)
#pragma unroll
                for (int r = 0; r < 16; r += 2) store_pair(FM, fo, (unsigned)(32 * rt + (r & 3) + 8 * (r >> 2)) * 65536u, (unsigned)(32 * rt + ((r + 1) & 3) + 8 * (r >> 2)) * 65536u, acc[rt][r], acc[rt][r + 1], odd);
            asm volatile("" ::: "memory");
#pragma unroll
            for (int i = 0; i < 8; ++i) bc[i] = bn[i];
        }
    }
    if (with_ctx) {
        for (int tile = vcu; tile < 512; tile += G) {
            f32x16 acc;
#pragma unroll
            for (int r = 0; r < 16; ++r) acc[r] = 0.f;
            asm volatile("" : "+v"(acc));
            const bf16_t* ap = DX + (size_t)(32 * wave + r32) * 512 + 8 * hi;
            const bf16_t* bp = Zc + ((size_t)tile * 32 + r32) * 512 + 8 * hi;
#pragma unroll 1
            for (int kc = 0; kc < 4; ++kc) {
                bf16x8 av[8], bv[8];
#pragma unroll
                for (int i = 0; i < 8; ++i) { av[i] = *(const bf16x8*)(ap + 16 * (kc * 8 + i)); bv[i] = *(const bf16x8*)(bp + 16 * (kc * 8 + i)); }
#pragma unroll
                for (int i = 0; i < 8; ++i) acc = __builtin_amdgcn_mfma_f32_32x32x16_bf16(av[i], bv[i], acc, 0, 0, 0);
            }
            const int m = 32 * (tile & 7) + r32, bg = tile >> 3, b = bg >> 2, g = bg & 3;
            size_t fo = (size_t)(TLAT + b * LCTX + 32 * wave + 4 * hi) * DM + g * 256 + (m & ~1);
            asm volatile("" : "+v"(fo));
#pragma unroll
            for (int r = 0; r < 16; r += 2) store_pair(FM, fo, (unsigned)((r & 3) + 8 * (r >> 2)) * 1024u, (unsigned)(((r + 1) & 3) + 8 * (r >> 2)) * 1024u, acc[r], acc[r + 1], odd);
        }
    }
}


#ifdef DIAG
__device__ __forceinline__ void diag_scan(unsigned* ctl, const void* buf, size_t bytes, bool is_bf16, int stage) {
    const size_t n16 = bytes / 16; const u32x4* p = (const u32x4*)buf; bool bad = false;
    int ln = (int)__builtin_amdgcn_mbcnt_hi(~0u, __builtin_amdgcn_mbcnt_lo(~0u, 0u)); asm volatile("" : "+v"(ln)); ln += 64 * __builtin_amdgcn_readfirstlane((int)threadIdx.x >> 6);
    for (size_t i = (size_t)blockIdx.x * NTHR + ln; i < n16; i += (size_t)gridDim.x * NTHR) {
        const u32x4 v = p[i];
        if (is_bf16) { for (int q = 0; q < 4; ++q) { const unsigned w = v[q]; if (((w >> 7) & 0xff) == 0xff || ((w >> 23) & 0xff) == 0xff) bad = true; } }
        else { for (int q = 0; q < 4; ++q) { if (((v[q] >> 23) & 0xff) >= 0xf0) bad = true; } }
    }
    if (bad) atomicMin(ctl, (unsigned)stage);
}
#define DIAG_SCAN(buf, bytes, isbf, stage) diag_scan((unsigned*)ws, buf, bytes, isbf, stage)
#else
#define DIAG_SCAN(buf, bytes, isbf, stage) do {} while (0)
#endif

#ifdef DIAG2
__device__ __forceinline__ void diag_max(unsigned* ctl, const void* buf, size_t bytes) {
    const size_t n16 = bytes / 16; const u32x4* p = (const u32x4*)buf; unsigned mx = 0, nb = 0;
    int ln = (int)__builtin_amdgcn_mbcnt_hi(~0u, __builtin_amdgcn_mbcnt_lo(~0u, 0u)); asm volatile("" : "+v"(ln)); ln += 64 * __builtin_amdgcn_readfirstlane((int)threadIdx.x >> 6);
    for (size_t i = (size_t)blockIdx.x * NTHR + ln; i < n16; i += (size_t)gridDim.x * NTHR) {
        const u32x4 v = p[i];
        for (int q = 0; q < 4; ++q) { const unsigned lo = (v[q] << 16) & 0x7fffffffu, hi = v[q] & 0x7fff0000u;
            if ((lo >> 23) == 0xff) ++nb; else mx = mx > lo ? mx : lo;
            if ((hi >> 23) == 0xff) ++nb; else mx = mx > hi ? mx : hi; }
    }
    atomicMax(ctl + 1, mx); if (nb) atomicAdd(ctl + 2, nb);
}
#endif

#ifdef TSEL
#define TBEG(c) do { if ((TSEL >> (c)) & 1) t0_ = __builtin_amdgcn_s_memrealtime(); } while (0)
#define TEND(c) do { if ((TSEL >> (c)) & 1) tacc_ += __builtin_amdgcn_s_memrealtime() - t0_; } while (0)
#else
#define TBEG(c) do {} while (0)
#define TEND(c) do {} while (0)
#endif
__global__ void __launch_bounds__(NTHR, 2) fwd_megakernel(Args A) {
    extern __shared__ __attribute__((aligned(16))) unsigned char lds_raw[];
    cg::grid_group grid = cg::this_grid();
#define GRID_SYNC() do { asm volatile("s_waitcnt vmcnt(0) lgkmcnt(0)" ::: "memory"); grid.sync(); } while (0)
    LAS unsigned char* lds = (LAS unsigned char*)lds_raw;
    const int wave = __builtin_amdgcn_readfirstlane((int)threadIdx.x >> 6);
#define FRESH_LANE(v) int v = LANE_ID(); asm volatile("" : "+v"(v))
#define LANE_ID() ((int)__builtin_amdgcn_mbcnt_hi(~0u, __builtin_amdgcn_mbcnt_lo(~0u, 0u)))
    const int lane = LANE_ID(), tid = wave * 64 + lane;
    const int G = gridDim.x, gw = blockIdx.x * NWAVES + wave, NGW = G * NWAVES;
    const int vcu = (G % 8 == 0) ? ((int)blockIdx.x % 8) * (G / 8) + (int)blockIdx.x / 8 : (int)blockIdx.x;
    const int gwv = vcu * NWAVES + wave;
    unsigned char* ws = A.ws;
#ifdef TSEL
    unsigned long long t0_ = 0, tacc_ = 0;
#endif
#ifdef DIAG
    if (blockIdx.x == 0 && threadIdx.x == 0) *(unsigned*)ws = 0x7fffffffu;
#endif
#ifdef DIAG2
    if (blockIdx.x == 0 && threadIdx.x == 0) { ((unsigned*)ws)[1] = 0u; ((unsigned*)ws)[2] = 0u; }
#endif
    float* mod = (float*)(ws + WS_MOD);
    const float* rope = (const float*)(ws + WS_TAB + TAB_ROPE); const float* tw = (const float*)(ws + WS_TAB + TAB_TW);
    const bf16_t* D1 = (const bf16_t*)(ws + WS_TAB + TAB_D1); const bf16_t* D2 = (const bf16_t*)(ws + WS_TAB + TAB_D2);
    const bf16_t* DC = (const bf16_t*)(ws + WS_TAB + TAB_DC); const bf16_t* DX = (const bf16_t*)(ws + WS_TAB + TAB_DCTX);
    bf16_t* XB = (bf16_t*)(ws + WS_XB);
    bf16_t* Hb = (bf16_t*)(ws + WS_H); bf16_t* Pb = (bf16_t*)(ws + WS_P); bf16_t* CAT = (bf16_t*)(ws + WS_CAT); bf16_t* ACT = (bf16_t*)(ws + WS_ACT);
    bf16_t* Z1 = (bf16_t*)(ws + WS_Z1); bf16_t* Zc = (bf16_t*)(ws + WS_ZC); bf16_t* A1p = (bf16_t*)(ws + WS_A1); bf16_t* FM = (bf16_t*)(ws + WS_FM);


#ifndef SKIP_PRO
        TBEG(10);
    prologue(A, lds, tid, wave, lane, G);
#endif

    GRID_SYNC();
        TEND(10);

    DIAG_SCAN(mod, 4 * 17 * 6144 * 4, false, 1); DIAG_SCAN(ws + WS_WIN, (size_t)83 * MiB, true, 2); DIAG_SCAN(ws + WS_TAB + TAB_D1, 640 * 1024, true, 3); DIAG_SCAN(ws + WS_TAB, 96 * 1024, false, 4);
#pragma unroll 1
    for (int l = 0; l < 4; ++l) {
        const bool even = (l & 1) == 0; const int e = l >> 1;
        const bool ctx_after = l < 2;
        const bool ctx_here = l < 3;
        const int Mfull = ctx_here ? MALL : TLAT;
        const int Mres = ctx_after ? MALL : TLAT;
        const float* modl = mod + (size_t)l * 17 * 6144;
        TBEG(4);
        { FRESH_LANE(lane_l); const int tid_l = wave * 64 + lane_l; (void)tid_l; if (l == 0) norm_phase<true>(A.x, A.ctx, XB, A.n1g + l * DM, modl, 0, Hb, Mfull, gw, NGW, lane_l); else norm_phase<false>(A.x, A.ctx, XB, A.n1g + l * DM, modl, 0, Hb, Mfull, gw, NGW, lane_l); }
        GRID_SYNC();
        TEND(4);
        DIAG_SCAN(Hb, (size_t)Mfull * DM * 2, true, 10 + 10 * l);
        const bf16_t* mixA; const bf16_t* mixW;
        if (even) {
        TBEG(0);
            { int tg = LANE_ID(); asm volatile("" : "+v"(tg)); tg += wave * 64; pg8::Gemm g{Hb, (const bf16_t*)(ws + WS_WIN) + (size_t)e * INW * DM, Mfull, INW, DM}; pg8::StaticOrder S; S.init(Mfull, INW, G, (int)blockIdx.x);
              EpiInProj E{Pb, rope};
              pg8::gemm_phase<EpiInProj, pg8::StaticOrder, true, true>(lds, g, S, E, tg); }
            GRID_SYNC();
        TEND(0);
        DIAG_SCAN(Pb, (size_t)Mfull * INW * 2, true, 11 + 10 * l);

#ifndef SKIP_ATT
        TBEG(5);
            { FRESH_LANE(lane_l); const int tid_l = wave * 64 + lane_l; (void)tid_l; attn_phase(lds, Pb, CAT, A.sink + e * 8, ctx_after, G, tid_l, wave, lane_l); }
        TEND(5);
#endif


#ifndef SKIP_CONV
        TBEG(6);
            { FRESH_LANE(lane_l); const int tid_l = wave * 64 + lane_l; (void)tid_l; conv_phase(Pb, CAT, A.conv_w + e * 3 * 512, Mres, G, tid_l); }
#endif

            GRID_SYNC();
        TEND(6);
        DIAG_SCAN(CAT, (size_t)Mres * DM * 2, true, 12 + 10 * l);
            mixA = CAT; mixW = (const bf16_t*)(ws + WS_WMIX) + (size_t)e * DM * DM;
        } else {

#ifndef SKIP_FA
        TBEG(7);
            { FRESH_LANE(lane_l); const int tid_l = wave * 64 + lane_l; (void)tid_l; fourier_a(lds, Hb, DC, Z1, Zc, ctx_after, G, vcu, wave, lane_l); }
#endif

            GRID_SYNC();
        TEND(7);
        DIAG_SCAN(Z1, (size_t)128 * MiB, true, 11 + 10 * l); DIAG_SCAN(Z1 + 64 * MiB, (size_t)128 * MiB, true, 12 + 10 * l); DIAG_SCAN(Zc, (size_t)16 * MiB, true, 13 + 10 * l);
#ifdef DIAG2
        if (l == DIAG2_L) diag_max((unsigned*)ws, DIAG2_BUF, DIAG2_BYTES);
#endif

#ifndef SKIP_S1
        TBEG(8);
            { FRESH_LANE(lane_l); const int tid_l = wave * 64 + lane_l; (void)tid_l; fourier_s1<0>(Z1, D1, tw, A1p, G, vcu, wave, lane_l); }
#endif

            GRID_SYNC();
        TEND(8);
        DIAG_SCAN(A1p, (size_t)256 * MiB, true, 14 + 10 * l);

#ifndef SKIP_S2
        TBEG(9);
            { FRESH_LANE(lane_l); const int tid_l = wave * 64 + lane_l; (void)tid_l; fourier_s2(A1p, D2, Zc, DX, FM, ctx_after, G, vcu, gwv, NGW, wave, lane_l); }
#endif

            GRID_SYNC();
        TEND(9);
        DIAG_SCAN(FM, (size_t)Mres * DM * 2, true, 15 + 10 * l);
            mixA = FM; mixW = (const bf16_t*)(ws + WS_WF) + (size_t)e * DM * DM;
        }
        TBEG(1);
        { int tg = LANE_ID(); asm volatile("" : "+v"(tg)); tg += wave * 64; pg8::Gemm g{mixA, mixW, Mres, DM, DM}; pg8::StaticOrder S; S.init(Mres, DM, G, (int)blockIdx.x);
          if (l == 0) { EpiRes<true> E{A.x, A.ctx, XB, modl, 2}; pg8::gemm_phase<EpiRes<true>, pg8::StaticOrder, true, true>(lds, g, S, E, tg); }
          else { EpiRes<false> E{A.x, A.ctx, XB, modl, 2}; pg8::gemm_phase<EpiRes<false>, pg8::StaticOrder, true, true>(lds, g, S, E, tg); } }
        GRID_SYNC();
        TEND(1);
        TBEG(4);
        { FRESH_LANE(lane_l); const int tid_l = wave * 64 + lane_l; (void)tid_l; norm_phase<false>(A.x, A.ctx, XB, A.n2g + l * DM, modl, 3, Hb, Mres, gw, NGW, lane_l); }
        GRID_SYNC();
        TEND(4);
        DIAG_SCAN(Hb, (size_t)Mres * DM * 2, true, 17 + 10 * l);
        TBEG(2);
        { int tg = LANE_ID(); asm volatile("" : "+v"(tg)); tg += wave * 64; pg8::Gemm g{Hb, (const bf16_t*)(ws + WS_WGU) + (size_t)l * 2 * DFF * DM, Mres, 2 * DFF, DM}; pg8::StaticOrder S; S.init(Mres, 2 * DFF, G, (int)blockIdx.x);
          EpiSwiGLU E{ACT};
          pg8::gemm_phase<EpiSwiGLU, pg8::StaticOrder, true, true>(lds, g, S, E, tg); }
        GRID_SYNC();
        TEND(2);
        DIAG_SCAN(ACT, (size_t)Mres * DFF * 2, true, 18 + 10 * l);
        TBEG(3);
        { int tg = LANE_ID(); asm volatile("" : "+v"(tg)); tg += wave * 64; pg8::Gemm g{ACT, (const bf16_t*)(ws + WS_WD) + (size_t)l * DM * DFF, Mres, DM, DFF}; pg8::StaticOrder S; S.init(Mres, DM, G, (int)blockIdx.x);
          EpiRes<false> E{A.x, A.ctx, XB, modl, 5}; pg8::gemm_phase<EpiRes<false>, pg8::StaticOrder, true, true>(lds, g, S, E, tg); }
        GRID_SYNC();
        TEND(3);
    }
    { int lane_f = LANE_ID(); asm volatile("" : "+v"(lane_f)); final_norm_phase(XB, A.out, A.final_g, gw, NGW, lane_f); }
#ifdef TSEL
    if (blockIdx.x == 0) { const unsigned long long ts_ = __builtin_amdgcn_s_memrealtime(); while (__builtin_amdgcn_s_memrealtime() - ts_ < (unsigned long long)TMULT * tacc_) __builtin_amdgcn_s_sleep(8); }
#endif
#ifdef DIAG2
    GRID_SYNC();
    if (blockIdx.x == 0 && threadIdx.x == 0) { const unsigned mx = ((volatile unsigned*)ws)[1], nb = ((volatile unsigned*)ws)[2]; A.out[0] = 1000.f * __builtin_bit_cast(float, mx); A.out[1] = nb ? 1e9f + 1000.f * (float)nb : 0.f; }
#endif
#ifdef DIAG
    GRID_SYNC();
    if (blockIdx.x == 0 && threadIdx.x == 0) { const unsigned c = *(volatile unsigned*)ws; A.out[0] = (c == 0x7fffffffu) ? 999000.f : 1000.f * (float)c; }
#endif
}

extern "C" void kernel_launch(void* const* d_in, const int* in_sizes, int n_in, void* d_out, int out_size, void* d_ws, size_t ws_size, hipStream_t stream) {
    static int grid = 0;
    if (grid == 0) {
        if (n_in != 17 || out_size != TLAT * DM || ws_size < WS_END) { fprintf(stderr, "kernel_launch: unexpected shapes (n_in %d, out %d, ws %zu)\n", n_in, out_size, ws_size); grid = -1; return; }
        int dev = 0, cus = 0, per_cu = 0;
        hipGetDevice(&dev); hipDeviceGetAttribute(&cus, hipDeviceAttributeMultiprocessorCount, dev);
        if (hipFuncSetAttribute((const void*)fwd_megakernel, hipFuncAttributeMaxDynamicSharedMemorySize, LDS_BYTES) != hipSuccess) { fprintf(stderr, "kernel_launch: hipFuncSetAttribute failed\n"); grid = -1; return; }
        if (hipOccupancyMaxActiveBlocksPerMultiprocessor(&per_cu, (const void*)fwd_megakernel, NTHR, LDS_BYTES) != hipSuccess || per_cu < 1) { fprintf(stderr, "kernel_launch: occupancy query says %d\n", per_cu); per_cu = 1; }
        (void)hipGetLastError();
        grid = cus * 1;
    }
    if (grid < 0) return;
    Args a{};
    a.x = (const float*)d_in[0]; a.c = (const float*)d_in[1]; a.ctx = (const float*)d_in[2]; a.c_ctx = (const float*)d_in[3]; a.w_ada = (const float*)d_in[4]; a.b_ada = (const float*)d_in[5];
    a.n1g = (const float*)d_in[6]; a.n2g = (const float*)d_in[7]; a.w_in = (const float*)d_in[8]; a.conv_w = (const float*)d_in[9]; a.sink = (const float*)d_in[10]; a.w_mix = (const float*)d_in[11];
    a.w_four = (const float*)d_in[12]; a.w_gate = (const float*)d_in[13]; a.w_up = (const float*)d_in[14]; a.w_down = (const float*)d_in[15]; a.final_g = (const float*)d_in[16];
    a.out = (float*)d_out; a.ws = (unsigned char*)d_ws;
    for (int f = 0; f < 16; ++f) a.invf[f] = pow(10000.0, -(double)f / 16.0);
    void* args[] = {&a};
    hipError_t e = hipLaunchCooperativeKernel((const void*)fwd_megakernel, dim3(grid), dim3(NTHR), args, LDS_BYTES, stream);
    if (e != hipSuccess) fprintf(stderr, "kernel_launch: cooperative launch failed: %s (grid %d)\n", hipGetErrorString(e), grid);
}
```

```cpp
#include <hip/hip_runtime.h>
#include <hip/hip_cooperative_groups.h>
#include <cstdio>
#include <cstdint>
#include <cmath>
namespace cg = cooperative_groups;

namespace pg8 {
#define PG8_LAS __attribute__((address_space(3)))
typedef unsigned short bf16_t;
typedef short bf16x8 __attribute__((ext_vector_type(8)));
typedef float f32x4 __attribute__((ext_vector_type(4)));
typedef unsigned u32x4 __attribute__((ext_vector_type(4)));
constexpr int BM = 256, BK = 64, HALF = 128, HTB = HALF * BK * 2  , STAGE_BYTES = 8 * HTB, NXCD = 8, WGM = 8;

__host__ __device__ __forceinline__ int lds_byte(int r, int c) { const int st = (r >> 4) * 2 + (c >> 5), rr = r & 15, cc = c & 31, ob = rr * 64 + cc * 2; return st * 1024 + (ob ^ (((ob >> 9) & 1) << 5)); }
__host__ __device__ __forceinline__ void stage_rc(int b, int& R, int& C) { const int st = b / 1024, sb = b % 1024, swz = sb ^ (((sb >> 9) & 1) << 5); R = (st >> 1) * 16 + swz / 64; C = (st & 1) * 32 + (swz % 64) / 2; }
__host__ __device__ __forceinline__ int perm32(int rho) { const int n = rho >> 4, i = rho & 15; return 8 * (i >> 2) + 4 * n + (i & 3); }

struct Unit { int pm, pn; };
struct Gemm { const bf16_t* A; const bf16_t* Bt; int M, N, K; };

struct StaticOrder {
    int nM, nN, nwg, G, c;
    __host__ __device__ void init(int M, int N, int G_, int c_) { nM = M / BM; nN = N / BM; nwg = nM * nN; G = G_; c = c_; }
    __host__ __device__ bool next(int i, Unit& u) const {
        const long L = (long)i * G + c; if (L >= nwg) return false;
        int wgid = (int)L; { const int q = nwg / NXCD, r = nwg % NXCD, xcd = wgid % NXCD, off = wgid / NXCD; wgid = (xcd < r ? xcd * (q + 1) : r * (q + 1) + (xcd - r) * q) + off; }
        const int nig = WGM * nN, gid = wgid / nig, fm = gid * WGM, gsz = (nM - fm) < WGM ? (nM - fm) : WGM;
        u.pm = fm + ((wgid % nig) % gsz); u.pn = (wgid % nig) / gsz; return true;
    }
    __device__ __forceinline__ void a_ready(const Unit&) const {}
    __device__ __forceinline__ void done(const Unit&) const {}
};

template <class Epi, class Sched, bool ALIGN_EPI = false, bool SP2 = false>
__device__ __forceinline__ void gemm_phase(PG8_LAS unsigned char* lds, const Gemm g, const Sched& S, const Epi& E, int tid_in) {
    const int tid = tid_in, wid = __builtin_amdgcn_readfirstlane(tid >> 6), lane = tid & 63, wr = wid >> 2, wc = wid & 3, fr = lane & 15, fq = lane >> 4;
    const int K = g.K, nt = K / BK;
    unsigned voffA[2], voffB[2];
#pragma unroll
    for (int i = 0; i < 2; ++i) { int R, C; stage_rc(tid * 16 + i * 8192, R, C); const int Rb = Epi::PERM ? ((R & ~31) + perm32(R & 31)) : R;
        voffA[i] = (unsigned)(R * K + C) * 2u; voffB[i] = (unsigned)(Rb * K + C) * 2u; }
    const size_t kstep = (size_t)(BK * 2);
    const size_t hstep = (size_t)HALF * K * 2;
    const size_t tstep = 2 * hstep;
    const unsigned ldsw = (unsigned)wid * 1024u;
    const int aoff = lds_byte(wr * 64 + fr, fq * 8), boff = lds_byte(wc * 32 + fr, fq * 8);
#define PG8_SA(b, h) (((b) * 2 + (h)) * HTB)
#define PG8_SB(b, h) ((4 + (b) * 2 + (h)) * HTB)
#define PG8_STAGE(bufoff, gbase, voff) do { _Pragma("unroll") for (int _i = 0; _i < 2; ++_i) \
        __builtin_amdgcn_global_load_lds((const unsigned*)((const char*)(gbase) + (voff)[_i]), (PG8_LAS unsigned*)(lds + (bufoff) + ldsw + _i * 8192), 16, 0, 0); } while (0)
#define PG8_LDA(dst, b, h) do { _Pragma("unroll") for (int m = 0; m < 4; ++m) _Pragma("unroll") for (int k = 0; k < 2; ++k) dst[m][k] = *(const PG8_LAS bf16x8*)(lds + PG8_SA(b, h) + aoff + m * 2048 + k * 1024); } while (0)
#define PG8_LDB(dst, b, h) do { _Pragma("unroll") for (int n = 0; n < 2; ++n) _Pragma("unroll") for (int k = 0; k < 2; ++k) dst[n][k] = *(const PG8_LAS bf16x8*)(lds + PG8_SB(b, h) + boff + n * 2048 + k * 1024); } while (0)
#define PG8_MMA(ai, bj, At, Bt) do { __builtin_amdgcn_s_setprio(1); _Pragma("unroll") for (int m = 0; m < 4; ++m) _Pragma("unroll") for (int n = 0; n < 2; ++n) _Pragma("unroll") for (int k = 0; k < 2; ++k) \
        acc[ai][bj][m][n] = __builtin_amdgcn_mfma_f32_16x16x32_bf16(Bt[n][k], At[m][k], acc[ai][bj][m][n], 0, 0, 0); __builtin_amdgcn_s_setprio(0); } while (0)
#define PG8_WAIT_V(n) asm volatile("s_waitcnt vmcnt(" #n ")" ::: "memory")
#define PG8_WAIT_L(n) asm volatile("s_waitcnt lgkmcnt(" #n ")" ::: "memory")
#define PG8_BAR __builtin_amdgcn_s_barrier()
#define PG8_SCHED __builtin_amdgcn_sched_barrier(0)
    Unit cur, nxt; int ui = 0;
    if (!S.next(0, cur)) return;
    f32x4 acc[2][2][4][2];
#pragma unroll
    for (int a = 0; a < 2; ++a)
#pragma unroll
        for (int b = 0; b < 2; ++b)
#pragma unroll
            for (int m = 0; m < 4; ++m)
#pragma unroll
                for (int n = 0; n < 2; ++n) acc[a][b][m][n] = (f32x4){0.f, 0.f, 0.f, 0.f};
    bf16x8 At[4][2], B0[2][2], B1[2][2];
    const char* cA = (const char*)g.A + (size_t)cur.pm * tstep; const char* cB = (const char*)g.Bt + (size_t)cur.pn * tstep;
    S.a_ready(cur);
    if constexpr (SP2) {
        PG8_STAGE(PG8_SB(0, 0), cB, voffB); PG8_STAGE(PG8_SB(0, 1), cB + hstep, voffB); PG8_STAGE(PG8_SA(0, 0), cA, voffA); PG8_STAGE(PG8_SA(0, 1), cA + hstep, voffA);
        if (wr == 1) PG8_BAR;
        PG8_WAIT_V(2); PG8_BAR;
        PG8_STAGE(PG8_SB(1, 0), cB + kstep, voffB); PG8_STAGE(PG8_SA(1, 0), cA + kstep, voffA); PG8_STAGE(PG8_SB(1, 1), cB + hstep + kstep, voffB);
        PG8_WAIT_V(6); PG8_BAR;
    } else {
        PG8_STAGE(PG8_SB(0, 0), cB, voffB); PG8_STAGE(PG8_SA(0, 0), cA, voffA); PG8_STAGE(PG8_SB(0, 1), cB + hstep, voffB); PG8_STAGE(PG8_SA(0, 1), cA + hstep, voffA);
        if (wr == 1) PG8_BAR;
        PG8_WAIT_V(4); PG8_BAR;
        PG8_STAGE(PG8_SB(1, 0), cB + kstep, voffB); PG8_STAGE(PG8_SA(1, 0), cA + kstep, voffA); PG8_STAGE(PG8_SB(1, 1), cB + hstep + kstep, voffB);
        PG8_WAIT_V(6); PG8_BAR;
    }
    for (;;) {
        const bool has_next = S.next(ui + 1, nxt);
        const char* nA = has_next ? (const char*)g.A + (size_t)nxt.pm * tstep : cA; const char* nB = has_next ? (const char*)g.Bt + (size_t)nxt.pn * tstep : cB;
        for (int t = 0; t < nt; t += 2) {
            const bool last = (t == nt - 2);
            const char* a1 = cA + (size_t)(t + 1) * kstep;
            const char* a2 = last ? nA : cA + (size_t)(t + 2) * kstep; const char* b2 = last ? nB : cB + (size_t)(t + 2) * kstep;
            const char* a3 = a2 + kstep; const char* b3 = b2 + kstep;
            if (last && has_next) S.a_ready(nxt);
            if constexpr (SP2) {
            PG8_LDB(B0, 0, 0); PG8_LDB(B1, 0, 1); PG8_SCHED; PG8_LDA(At, 0, 0); PG8_STAGE(PG8_SA(1, 1), a1 + hstep, voffA);
            PG8_WAIT_V(8); PG8_WAIT_L(0); PG8_BAR; PG8_MMA(0, 0, At, B0); PG8_MMA(0, 1, At, B1); PG8_BAR; PG8_SCHED;
            PG8_LDA(At, 0, 1); PG8_STAGE(PG8_SB(0, 0), b2, voffB); PG8_STAGE(PG8_SB(0, 1), b2 + hstep, voffB); PG8_STAGE(PG8_SA(0, 0), a2, voffA);
            PG8_WAIT_V(8); PG8_WAIT_L(0); PG8_BAR; PG8_MMA(1, 0, At, B0); PG8_MMA(1, 1, At, B1); PG8_BAR; PG8_SCHED;
            PG8_LDB(B0, 1, 0); PG8_LDB(B1, 1, 1); PG8_SCHED; PG8_LDA(At, 1, 0); PG8_STAGE(PG8_SA(0, 1), a2 + hstep, voffA);
            PG8_WAIT_V(8); PG8_WAIT_L(0); PG8_BAR; PG8_MMA(0, 0, At, B0); PG8_MMA(0, 1, At, B1); PG8_BAR; PG8_SCHED;
            PG8_LDA(At, 1, 1); PG8_STAGE(PG8_SB(1, 0), b3, voffB); PG8_STAGE(PG8_SB(1, 1), b3 + hstep, voffB); PG8_STAGE(PG8_SA(1, 0), a3, voffA);
            PG8_WAIT_V(8); PG8_WAIT_L(0); PG8_BAR; PG8_MMA(1, 0, At, B0); PG8_MMA(1, 1, At, B1); PG8_BAR; PG8_SCHED;
            } else {
            PG8_LDB(B0, 0, 0); PG8_SCHED; PG8_LDA(At, 0, 0); PG8_STAGE(PG8_SA(1, 1), a1 + hstep, voffA);
            PG8_WAIT_L(8); PG8_BAR; PG8_WAIT_L(0); PG8_MMA(0, 0, At, B0); PG8_BAR; PG8_SCHED;
            PG8_LDB(B1, 0, 1); PG8_STAGE(PG8_SB(0, 0), b2, voffB);
            PG8_BAR; PG8_WAIT_L(0); PG8_MMA(0, 1, At, B1); PG8_BAR;
            PG8_LDA(At, 0, 1); PG8_STAGE(PG8_SA(0, 0), a2, voffA);
            PG8_BAR; PG8_WAIT_L(0); PG8_MMA(1, 0, At, B0); PG8_BAR; PG8_SCHED;
            PG8_STAGE(PG8_SB(0, 1), b2 + hstep, voffB);
            PG8_WAIT_V(6); PG8_BAR; PG8_MMA(1, 1, At, B1); PG8_BAR;
            PG8_LDB(B0, 1, 0); PG8_SCHED; PG8_LDA(At, 1, 0); PG8_STAGE(PG8_SA(0, 1), a2 + hstep, voffA);
            PG8_WAIT_L(8); PG8_BAR; PG8_WAIT_L(0); PG8_MMA(0, 0, At, B0); PG8_BAR; PG8_SCHED;
            PG8_LDB(B1, 1, 1); PG8_STAGE(PG8_SB(1, 0), b3, voffB);
            PG8_BAR; PG8_WAIT_L(0); PG8_MMA(0, 1, At, B1); PG8_BAR;
            PG8_LDA(At, 1, 1); PG8_STAGE(PG8_SA(1, 0), a3, voffA);
            PG8_BAR; PG8_WAIT_L(0); PG8_MMA(1, 0, At, B0); PG8_BAR; PG8_SCHED;
            PG8_STAGE(PG8_SB(1, 1), b3 + hstep, voffB);
            PG8_WAIT_V(6); PG8_BAR; PG8_MMA(1, 1, At, B1); PG8_BAR;
            }
        }
        if constexpr (ALIGN_EPI) { if (wr == 0) PG8_BAR; }
        if constexpr (!Epi::AFTER_DRAIN) { E(acc, cur, wr, wc, fr, fq); S.done(cur); }
        if (!has_next) break;
#pragma unroll
        for (int a = 0; a < 2; ++a)
#pragma unroll
            for (int b = 0; b < 2; ++b)
#pragma unroll
                for (int m = 0; m < 4; ++m)
#pragma unroll
                    for (int n = 0; n < 2; ++n) acc[a][b][m][n] = (f32x4){0.f, 0.f, 0.f, 0.f};
        cur = nxt; cA = nA; cB = nB; ++ui;
        if constexpr (ALIGN_EPI) { if (wr == 1) PG8_BAR; }
    }
    PG8_WAIT_V(0);
    if constexpr (!ALIGN_EPI) { if (wr == 0) PG8_BAR; }
    PG8_BAR;
    if constexpr (Epi::AFTER_DRAIN) { E.fused(acc, cur, wr, wc, fr, fq, lds, wid, lane); S.done(cur); }
#undef PG8_SA
#undef PG8_SB
#undef PG8_STAGE
#undef PG8_LDA
#undef PG8_LDB
#undef PG8_MMA
#undef PG8_WAIT_V
#undef PG8_WAIT_L
#undef PG8_BAR
#undef PG8_SCHED
}
}

#define LAS __attribute__((address_space(3)))
typedef unsigned short bf16_t;
typedef short bf16x8 __attribute__((ext_vector_type(8)));
typedef float f32x4 __attribute__((ext_vector_type(4)));
typedef float f32x16 __attribute__((ext_vector_type(16)));
typedef unsigned u32x4 __attribute__((ext_vector_type(4)));
typedef unsigned u32x2 __attribute__((ext_vector_type(2)));

constexpr int DM = 1024, NBATCH = 16, SEQ = 4096, TLAT = NBATCH * SEQ, LCTX = 256, TCTX = NBATCH * LCTX, MALL = TLAT + TCTX;
constexpr int DFF = 2816, INW = 2304, NWAVES = 8, NTHR = 512;
constexpr int QS = 1536, KS_ = 2048, VS_ = 2176;
constexpr float C2 = 0.125f * 1.4426950408889634f, LOG2E = 1.4426950408889634f;
constexpr size_t MiB = 1u << 20;
constexpr size_t WS_MOD = 1 * MiB, WS_TAB = 3 * MiB, WS_WIN = 4 * MiB, WS_WMIX = 13 * MiB, WS_WF = 17 * MiB, WS_WGU = 21 * MiB, WS_WD = 65 * MiB;
constexpr size_t WS_XB = 800 * MiB  ;
constexpr size_t WS_XC = 88 * MiB, WS_H = 104 * MiB, WS_R = 240 * MiB;
constexpr size_t WS_P = WS_R, WS_CAT = WS_R + 306 * MiB, WS_ACT = WS_R, WS_Z1 = WS_R, WS_ZC = WS_R + 256 * MiB, WS_A1 = WS_R + 272 * MiB, WS_FM = WS_R, WS_END = 1024 * MiB;
constexpr size_t TAB_ROPE = 0, TAB_TW = 64 * 1024, TAB_D1 = 128 * 1024, TAB_D2 = 192 * 1024, TAB_DC = 256 * 1024, TAB_DCTX = 512 * 1024;
constexpr int LDS_BYTES = 147456;

typedef float f32x2_t __attribute__((ext_vector_type(2))); typedef __bf16 bf16x2_t __attribute__((ext_vector_type(2)));
__device__ __forceinline__ unsigned cvt_pk(float lo, float hi) { f32x2_t v = {lo, hi}; bf16x2_t b = __builtin_convertvector(v, bf16x2_t); return __builtin_bit_cast(unsigned, b); }
__device__ __forceinline__ float bf_lo(unsigned w) { return __builtin_bit_cast(float, w << 16); }
__device__ __forceinline__ float bf_hi(unsigned w) { return __builtin_bit_cast(float, w & 0xffff0000u); }
__device__ __forceinline__ float fast_exp2(float x) { return __builtin_amdgcn_exp2f(x); }
__device__ __forceinline__ float fast_rcp(float x) { return __builtin_amdgcn_rcpf(x); }
__device__ __forceinline__ float silu_f(float x) { return x * fast_rcp(1.0f + fast_exp2(-x * LOG2E)); }
typedef _Float16 h16x2_t __attribute__((ext_vector_type(2)));
__device__ __forceinline__ float h2f(unsigned lowbits) { float f; asm("v_cvt_f32_f16 %0, %1" : "=v"(f) : "v"(lowbits)); return f; }
__device__ __forceinline__ f32x4 xs_unpack(u32x2 h) { return (f32x4){h2f(h.x), h2f(h.x >> 16), h2f(h.y), h2f(h.y >> 16)}; }
typedef __fp16 fp16x2_t __attribute__((ext_vector_type(2)));
__device__ __forceinline__ u32x2 xs_pack(f32x4 v) { const fp16x2_t a = __builtin_amdgcn_cvt_pkrtz(v.x, v.y), b = __builtin_amdgcn_cvt_pkrtz(v.z, v.w); u32x2 r; r.x = __builtin_bit_cast(unsigned, a); r.y = __builtin_bit_cast(unsigned, b); return r; }
#define LDS_WAIT() asm volatile("s_waitcnt lgkmcnt(0)" ::: "memory")

struct Args {
    const float* x; const float* c; const float* ctx; const float* c_ctx; const float* w_ada; const float* b_ada; const float* n1g; const float* n2g;
    const float* w_in; const float* conv_w; const float* sink; const float* w_mix; const float* w_four; const float* w_gate; const float* w_up; const float* w_down; const float* final_g;
    float* out; unsigned char* ws;
    double invf[16];
};

struct EpiInProj {
    static constexpr bool PERM = false, AFTER_DRAIN = false;
    bf16_t* P; const float* rope;
    __device__ __forceinline__ void operator()(const f32x4 (&acc)[2][2][4][2], const pg8::Unit& u, int wr, int wc, int fr, int fq) const {
        const bool lat = u.pm < 256, doq = (u.pn == 6 || u.pn == 7), ropeT = lat && u.pn >= 6;
#pragma unroll
        for (int ai = 0; ai < 2; ++ai)
#pragma unroll
            for (int m = 0; m < 4; ++m) {
                const int row = u.pm * 256 + ai * 128 + wr * 64 + m * 16 + fr;
                f32x4 cv = {1.f, 1.f, 1.f, 1.f}, sv = {0.f, 0.f, 0.f, 0.f};
                if (ropeT) { const int t = row & 4095; const int a = (wc & 1) ? (t & 63) : (t >> 6);
                    const f32x4* rp = (const f32x4*)(rope + (a * 16 + 4 * fq) * 2); const f32x4 c0 = rp[0], c1 = rp[1];
                    cv = (f32x4){c0.x, c0.z, c1.x, c1.z}; sv = (f32x4){c0.y, c0.w, c1.y, c1.w}; }
#pragma unroll
                for (int bj = 0; bj < 2; ++bj) {
                    f32x4 x1 = acc[ai][bj][m][0], x2 = acc[ai][bj][m][1];
                    if (ropeT && !(u.pn == 8 && bj == 1)) { const f32x4 o1 = x1 * cv - x2 * sv, o2 = x2 * cv + x1 * sv; x1 = o1; x2 = o2; }
                    if (doq) { x1 = x1 * C2; x2 = x2 * C2; }
                    bf16_t* p = P + (size_t)row * INW + u.pn * 256 + bj * 128 + wc * 32 + 4 * fq;
                    u32x2 w1, w2; w1.x = cvt_pk(x1[0], x1[1]); w1.y = cvt_pk(x1[2], x1[3]); w2.x = cvt_pk(x2[0], x2[1]); w2.y = cvt_pk(x2[2], x2[3]);
                    *(u32x2*)p = w1; *(u32x2*)(p + 16) = w2;
                }
            }
    }
};
template <bool IN_F32> struct EpiRes {
    static constexpr bool PERM = false, AFTER_DRAIN = false;
    const float* in_lat; const float* in_ctx; bf16_t* xb; const float* modl; int gate_idx;
    __device__ __forceinline__ void operator()(const f32x4 (&acc)[2][2][4][2], const pg8::Unit& u, int wr, int wc, int fr, int fq) const {
        const bool lat = u.pm < 256; const int rbase = lat ? u.pm * 256 : u.pm * 256 - TLAT; const int r = lat ? (u.pm >> 4) : 16;
        const float* ip = lat ? in_lat : in_ctx;
        const float* gate = modl + (r * 6 + gate_idx) * 1024;
        const int col0 = u.pn * 256 + wc * 32 + 4 * fq;
        f32x4 gv[2][2];
#pragma unroll
        for (int bj = 0; bj < 2; ++bj)
#pragma unroll
            for (int n = 0; n < 2; ++n) gv[bj][n] = *(const f32x4*)(gate + col0 + bj * 128 + 16 * n);
        const size_t offi = (size_t)(rbase + wr * 64 + fr) * DM + col0;
        const size_t offx = (size_t)(u.pm * 256 + wr * 64 + fr) * DM + col0;
        f32x4 xf[2][2][2]; u32x2 xh[2][2][2];
#pragma unroll
        for (int bj = 0; bj < 2; ++bj)
#pragma unroll
            for (int n = 0; n < 2; ++n) { if (IN_F32) xf[0][bj][n] = *(const f32x4*)(ip + offi + bj * 128 + 16 * n); else xh[0][bj][n] = *(const u32x2*)(xb + offx + bj * 128 + 16 * n); }
#pragma unroll
        for (int grp = 0; grp < 8; ++grp) {
            const int ai = grp >> 2, m = grp & 3, cb = grp & 1;
            const size_t roff = (size_t)(ai * 128 + m * 16) * DM;
            if (grp < 7) { const int ai2 = (grp + 1) >> 2, m2 = (grp + 1) & 3; const size_t rn = (size_t)(ai2 * 128 + m2 * 16) * DM;
#pragma unroll
                for (int bj = 0; bj < 2; ++bj)
#pragma unroll
                    for (int n = 0; n < 2; ++n) { if (IN_F32) xf[cb ^ 1][bj][n] = *(const f32x4*)(ip + offi + rn + bj * 128 + 16 * n); else xh[cb ^ 1][bj][n] = *(const u32x2*)(xb + offx + rn + bj * 128 + 16 * n); } }
            asm volatile("" ::: "memory");
#pragma unroll
            for (int bj = 0; bj < 2; ++bj)
#pragma unroll
                for (int n = 0; n < 2; ++n) {
                    f32x4 xi; if (IN_F32) xi = xf[cb][bj][n]; else xi = xs_unpack(xh[cb][bj][n]);
                    const f32x4 xo = xi + gv[bj][n] * acc[ai][bj][m][n];
                    *(u32x2*)(xb + offx + roff + bj * 128 + 16 * n) = xs_pack(xo); }
            asm volatile("" ::: "memory");
        }
    }
};
struct EpiSwiGLU {
    static constexpr bool PERM = false, AFTER_DRAIN = false;
    bf16_t* ACT;
    __device__ __forceinline__ void operator()(const f32x4 (&acc)[2][2][4][2], const pg8::Unit& u, int wr, int wc, int fr, int fq) const {
#pragma unroll
        for (int ai = 0; ai < 2; ++ai)
#pragma unroll
            for (int m = 0; m < 4; ++m) {
                const int row = u.pm * 256 + ai * 128 + wr * 64 + m * 16 + fr;
#pragma unroll
                for (int bj = 0; bj < 2; ++bj) {
                    const f32x4 g = acc[ai][bj][m][0], v = acc[ai][bj][m][1];
                    const int f = (u.pn * 8 + bj * 4 + wc) * 16 + 4 * fq;
                    u32x2 w; w.x = cvt_pk(silu_f(g[0]) * v[0], silu_f(g[1]) * v[1]); w.y = cvt_pk(silu_f(g[2]) * v[2], silu_f(g[3]) * v[3]);
                    *(u32x2*)(ACT + (size_t)row * DFF + f) = w;
                }
            }
    }
};
struct EpiPlain {
    static constexpr bool PERM = false, AFTER_DRAIN = false;
    bf16_t* O; int ldc;
    __device__ __forceinline__ void operator()(const f32x4 (&acc)[2][2][4][2], const pg8::Unit& u, int wr, int wc, int fr, int fq) const {
#pragma unroll
        for (int ai = 0; ai < 2; ++ai)
#pragma unroll
            for (int m = 0; m < 4; ++m) {
                const int row = u.pm * 256 + ai * 128 + wr * 64 + m * 16 + fr;
#pragma unroll
                for (int bj = 0; bj < 2; ++bj)
#pragma unroll
                    for (int n = 0; n < 2; ++n) {
                        const f32x4 x = acc[ai][bj][m][n]; u32x2 w; w.x = cvt_pk(x[0], x[1]); w.y = cvt_pk(x[2], x[3]);
                        *(u32x2*)(O + (size_t)row * ldc + u.pn * 256 + bj * 128 + wc * 32 + 16 * n + 4 * fq) = w;
                    }
            }
    }
};

__device__ __forceinline__ void sincos_turns(double x, double& s, double& c) {
    x = x - floor(x);
    const double q4 = floor(x * 4.0 + 0.5);
    const double r = x - q4 * 0.25;
    const int q = ((int)q4) & 3;
    const double th = r * 6.283185307179586476925, t2 = th * th;
    const double sp = th * (1.0 + t2 * (-1.0 / 6 + t2 * (1.0 / 120 + t2 * (-1.0 / 5040 + t2 * (1.0 / 362880 + t2 * (-1.0 / 39916800 + t2 * (1.0 / 6227020800.0)))))));
    const double cp = 1.0 + t2 * (-0.5 + t2 * (1.0 / 24 + t2 * (-1.0 / 720 + t2 * (1.0 / 40320 + t2 * (-1.0 / 3628800 + t2 * (1.0 / 479001600.0 + t2 * (-1.0 / 87178291200.0)))))));
    if (q == 0) { s = sp; c = cp; } else if (q == 1) { s = cp; c = -sp; } else if (q == 2) { s = -sp; c = -cp; } else { s = -cp; c = sp; }
}
__device__ __forceinline__ unsigned short f2bf(float f) { return __builtin_bit_cast(unsigned short, (__bf16)f); }

__device__ __forceinline__ void transpose_item(const float* W, int K, int N, bf16_t* WT, int mode, LAS float* scr, int item, int lane) {
    const int nblk = N / 32, kb = item / nblk, nb = item % nblk, k0 = 64 * kb, n0 = 32 * nb;
#pragma unroll 8
    for (int i = 0; i < 32; ++i) { const int kk = 2 * i + (lane >> 5); scr[kk * 33 + (lane & 31)] = W[(size_t)(k0 + kk) * N + n0 + (lane & 31)]; }
    LDS_WAIT(); asm volatile("" ::: "memory");
    const int c = lane & 7;
#pragma unroll
    for (int j = 0; j < 4; ++j) { const int n = (lane >> 3) + 8 * j; const LAS float* s = scr + (8 * c) * 33 + n;
        u32x4 o; o.x = cvt_pk(s[0 * 33], s[1 * 33]); o.y = cvt_pk(s[2 * 33], s[3 * 33]); o.z = cvt_pk(s[4 * 33], s[5 * 33]); o.w = cvt_pk(s[6 * 33], s[7 * 33]);
        const int f = n0 + n; const int orow = (mode == 0) ? f : (((f >> 4) << 5) + (f & 15) + (mode == 2 ? 16 : 0));
        *(u32x4*)(WT + (size_t)orow * K + k0 + 8 * c) = o; }
    LDS_WAIT(); asm volatile("" ::: "memory");
}

__device__ __forceinline__ void prologue(const Args& A, LAS unsigned char* lds, int tid, int wave, int lane, int G) {
    unsigned char* ws = A.ws;
    {
        LAS float* scr = (LAS float*)(lds + wave * 16384);
        const int gw = blockIdx.x * NWAVES + wave, NGW = G * NWAVES;
        constexpr int I_IN = 16 * 72, I_SQ = 16 * 32, I_FF = 16 * 88, I_DN = 44 * 32;
        constexpr int NIT = 2 * I_IN + 4 * I_SQ + 8 * I_FF + 4 * I_DN;
        for (int it = gw; it < NIT; it += NGW) {
            int r = it;
            if (r < 2 * I_IN) { const int e = r / I_IN; transpose_item(A.w_in + (size_t)e * DM * INW, DM, INW, (bf16_t*)(ws + WS_WIN) + (size_t)e * INW * DM, 0, scr, r % I_IN, lane); continue; } r -= 2 * I_IN;
            if (r < 2 * I_SQ) { const int e = r / I_SQ; transpose_item(A.w_mix + (size_t)e * DM * DM, DM, DM, (bf16_t*)(ws + WS_WMIX) + (size_t)e * DM * DM, 0, scr, r % I_SQ, lane); continue; } r -= 2 * I_SQ;
            if (r < 2 * I_SQ) { const int e = r / I_SQ; transpose_item(A.w_four + (size_t)e * DM * DM, DM, DM, (bf16_t*)(ws + WS_WF) + (size_t)e * DM * DM, 0, scr, r % I_SQ, lane); continue; } r -= 2 * I_SQ;
            if (r < 4 * I_FF) { const int l = r / I_FF; transpose_item(A.w_gate + (size_t)l * DM * DFF, DM, DFF, (bf16_t*)(ws + WS_WGU) + (size_t)l * 2 * DFF * DM, 1, scr, r % I_FF, lane); continue; } r -= 4 * I_FF;
            if (r < 4 * I_FF) { const int l = r / I_FF; transpose_item(A.w_up + (size_t)l * DM * DFF, DM, DFF, (bf16_t*)(ws + WS_WGU) + (size_t)l * 2 * DFF * DM, 2, scr, r % I_FF, lane); continue; } r -= 4 * I_FF;
            { const int l = r / I_DN; transpose_item(A.w_down + (size_t)l * DFF * DM, DFF, DM, (bf16_t*)(ws + WS_WD) + (size_t)l * DM * DFF, 0, scr, r % I_DN, lane); }
        }
    }
    {
        const int gt = blockIdx.x * NTHR + tid, NGT = G * NTHR;
        float* rope = (float*)(ws + WS_TAB + TAB_ROPE); float* tw = (float*)(ws + WS_TAB + TAB_TW);
        bf16_t* D1 = (bf16_t*)(ws + WS_TAB + TAB_D1); bf16_t* D2 = (bf16_t*)(ws + WS_TAB + TAB_D2); bf16_t* DC = (bf16_t*)(ws + WS_TAB + TAB_DC); bf16_t* DX = (bf16_t*)(ws + WS_TAB + TAB_DCTX);
        constexpr int N_ROPE = 1024, N_TW = 4096, N_D1 = 16384, N_D2 = 8192, N_DC = 131072, N_DX = 131072;
        for (int i = gt; i < N_ROPE + N_TW + N_D1 + N_D2 + N_DC + N_DX; i += NGT) {
            int r = i; double s, c;
            if (r < N_ROPE) { const int a = r >> 4, f = r & 15; sincos_turns((double)a * A.invf[f] * 0.15915494309189533577, s, c); rope[2 * r] = (float)c; rope[2 * r + 1] = (float)s; continue; } r -= N_ROPE;
            if (r < N_TW) { const int k1 = r >> 6, n2 = r & 63; sincos_turns((double)(k1 * n2) / 4096.0, s, c); tw[2 * r] = (float)c; tw[2 * r + 1] = (float)s; continue; } r -= N_TW;
            if (r < N_D1) { const int row = r >> 7, col = r & 127, k1 = row >> 1, rio = row & 1, rii = col >> 6, n1 = col & 63; sincos_turns((double)((k1 * n1) & 63) / 64.0, s, c);
                const double v = (rio == rii) ? c : (rio == 0 ? s : -s); D1[r] = f2bf((float)(v * 0.125)); continue; } r -= N_D1;
            if (r < N_D2) { const int k2 = r >> 7, col = r & 127, ri = col >> 6, n2 = col & 63; sincos_turns((double)((k2 * n2) & 63) / 64.0, s, c); D2[r] = f2bf((float)((ri ? s : c) * 0.125)); continue; } r -= N_D2;
            if (r < N_DC) { const int row = r >> 8, cc = r & 255, ri = row >> 8, m = row & 255; sincos_turns((double)((m * cc) & 255) / 256.0, s, c); DC[r] = f2bf((float)((ri ? -s : c) * 0.0625)); continue; } r -= N_DC;
            { const int k = r >> 9, col = r & 511, ri = col >> 8, n = col & 255; sincos_turns((double)((k * n) & 255) / 256.0, s, c); DX[r] = f2bf((float)((ri ? s : c) * 0.0625)); }
        }
    }
    __syncthreads();
    {
        LAS float* S = (LAS float*)lds; LAS float* Pp = (LAS float*)(lds + 69632);
        for (int i = tid; i < 17 * 1024; i += NTHR) { const int r = i >> 10, k = i & 1023; const float v = (r < 16) ? A.c[r * 1024 + k] : A.c_ctx[k]; S[i] = v / (1.0f + expf(-v)); }
        __syncthreads();
        float* mod = (float*)(ws + WS_MOD);
        for (int task = blockIdx.x; task < 4 * 96; task += G) {
            const int l = task / 96, j0 = (task % 96) * 64;
            const float* w = A.w_ada + (size_t)l * 1024 * 6144 + j0 + lane;
            float acc[17];
#pragma unroll
            for (int r = 0; r < 17; ++r) acc[r] = 0.f;
#pragma unroll 4
            for (int kk = 0; kk < 128; ++kk) { const int k = wave * 128 + kk; const float wv = w[(size_t)k * 6144];
#pragma unroll
                for (int r = 0; r < 17; ++r) acc[r] += S[r * 1024 + k] * wv; }
#pragma unroll
            for (int r = 0; r < 17; ++r) Pp[(wave * 17 + r) * 64 + lane] = acc[r];
            __syncthreads();
            for (int o = tid; o < 17 * 64; o += NTHR) { const int r = o >> 6, jj = o & 63; float sum = 0.f;
#pragma unroll
                for (int w8 = 0; w8 < 8; ++w8) sum += Pp[(w8 * 17 + r) * 64 + jj];
                mod[(size_t)(l * 17 + r) * 6144 + j0 + jj] = sum + A.b_ada[l * 6144 + j0 + jj]; }
            __syncthreads();
        }
    }
}

template <bool IN_F32> __device__ __forceinline__ void norm_ld(f32x4 (&v)[4], const float* lat, const float* ctxp, const bf16_t* xb, int row, int lane) {
    if (IN_F32) { const float* xr = (row < TLAT) ? lat + (size_t)row * DM : ctxp + (size_t)(row - TLAT) * DM;
#pragma unroll
        for (int j = 0; j < 4; ++j) v[j] = *(const f32x4*)(xr + 4 * lane + 256 * j); }
    else {
#pragma unroll
        for (int j = 0; j < 4; ++j) { v[j] = xs_unpack(*(const u32x2*)(xb + (size_t)row * DM + 4 * lane + 256 * j)); } }
}
template <bool IN_F32> __device__ __forceinline__ void norm_phase(const float* lat, const float* ctxp, const bf16_t* xb, const float* g, const float* modl, int shift_idx, bf16_t* hout, int M, int gw, int NGW, int lane) {
    constexpr int NR = 2;
    const int rpw = M / NGW, rbeg = gw * rpw, rend = rbeg + rpw;
    f32x4 gv[4];
#pragma unroll
    for (int j = 0; j < 4; ++j) gv[j] = *(const f32x4*)(g + 4 * lane + 256 * j);
    f32x4 vc[NR][4], vn[NR][4], scv[4], shv[4]; int rcur = -1;
#pragma unroll
    for (int q = 0; q < NR; ++q) norm_ld<IN_F32>(vc[q], lat, ctxp, xb, rbeg + q, lane);
    for (int row0 = rbeg; row0 < rend; row0 += NR) {
        const int r = (row0 < TLAT) ? (row0 >> 12) : 16;
        if (r != rcur) { rcur = r; const float* sh = modl + (r * 6 + shift_idx) * 1024; const float* sc = sh + 1024;
#pragma unroll
            for (int j = 0; j < 4; ++j) { scv[j] = (*(const f32x4*)(sc + 4 * lane + 256 * j) + 1.0f) * gv[j]; shv[j] = *(const f32x4*)(sh + 4 * lane + 256 * j); } }
        if (row0 + NR < rend) {
#pragma unroll
            for (int q = 0; q < NR; ++q) norm_ld<IN_F32>(vn[q], lat, ctxp, xb, row0 + NR + q, lane); }
        asm volatile("" ::: "memory");
#pragma unroll
        for (int q = 0; q < NR; ++q) { float ss = 0.f;
#pragma unroll
            for (int j = 0; j < 4; ++j) ss += (vc[q][j].x * vc[q][j].x + vc[q][j].y * vc[q][j].y) + (vc[q][j].z * vc[q][j].z + vc[q][j].w * vc[q][j].w);
#pragma unroll
            for (int o = 1; o < 64; o <<= 1) ss += __shfl_xor(ss, o);
            const float rstd = 1.0f / sqrtf(ss * (1.0f / DM) + 1e-6f);
#pragma unroll
            for (int j = 0; j < 4; ++j) { const f32x4 o = vc[q][j] * rstd * scv[j] + shv[j];
                u32x2 w; w.x = cvt_pk(o.x, o.y); w.y = cvt_pk(o.z, o.w);
                *(u32x2*)(hout + (size_t)(row0 + q) * DM + 4 * lane + 256 * j) = w; } }
        asm volatile("" ::: "memory");
#pragma unroll
        for (int q = 0; q < NR; ++q)
#pragma unroll
            for (int j = 0; j < 4; ++j) vc[q][j] = vn[q][j];
    }
}
__device__ __forceinline__ void final_norm_phase(const bf16_t* xb, float* xo, const float* g, int gw, int NGW, int lane) {
    constexpr int NR = 2;
    const int rpw = TLAT / NGW, rbeg = gw * rpw, rend = rbeg + rpw;
    f32x4 gv[4];
#pragma unroll
    for (int j = 0; j < 4; ++j) gv[j] = *(const f32x4*)(g + 4 * lane + 256 * j);
    f32x4 vc[NR][4], vn[NR][4];
#pragma unroll
    for (int q = 0; q < NR; ++q) norm_ld<false>(vc[q], nullptr, nullptr, xb, rbeg + q, lane);
    for (int row0 = rbeg; row0 < rend; row0 += NR) {
        if (row0 + NR < rend) {
#pragma unroll
            for (int q = 0; q < NR; ++q) norm_ld<false>(vn[q], nullptr, nullptr, xb, row0 + NR + q, lane); }
        asm volatile("" ::: "memory");
#pragma unroll
        for (int q = 0; q < NR; ++q) { float ss = 0.f;
#pragma unroll
            for (int j = 0; j < 4; ++j) ss += (vc[q][j].x * vc[q][j].x + vc[q][j].y * vc[q][j].y) + (vc[q][j].z * vc[q][j].z + vc[q][j].w * vc[q][j].w);
#pragma unroll
            for (int o = 1; o < 64; o <<= 1) ss += __shfl_xor(ss, o);
            const float rstd = 1.0f / sqrtf(ss * (1.0f / DM) + 1e-6f);
#pragma unroll
            for (int j = 0; j < 4; ++j) *(f32x4*)(xo + (size_t)(row0 + q) * DM + 4 * lane + 256 * j) = vc[q][j] * rstd * gv[j]; }
        asm volatile("" ::: "memory");
#pragma unroll
        for (int q = 0; q < NR; ++q)
#pragma unroll
            for (int j = 0; j < 4; ++j) vc[q][j] = vn[q][j];
    }
}

__device__ __forceinline__ int crow(int r, int hi) { return (r & 3) + 8 * (r >> 2) + 4 * hi; }

__device__ __forceinline__ void attn_phase(LAS unsigned char* lds, const bf16_t* P, bf16_t* cat, const float* sink, bool ctxq, int G, int tid, int wave, int lane) {
    constexpr int KROW = 144, VROW = 264;
    LAS unsigned char* Kl = lds; LAS unsigned char* Vl = lds + 128 * KROW;
    const int r32 = lane & 31, hi = lane >> 5, g = wave & 3, qh = wave >> 2;
    const int nitems = 1024 + (ctxq ? 64 : 0);
    for (int it = blockIdx.x; it < nitems; it += G) {
        int b, hk, qb, qr0; const bool isl = it < 1024;
        if (isl) { b = it >> 6; hk = (it >> 5) & 1; qb = it & 31; qr0 = b * SEQ + qb * 128; }
        else { const int j = it - 1024; b = j >> 2; hk = (j >> 1) & 1; qb = j & 1; qr0 = TLAT + b * LCTX + qb * 128; }
        const int crow0 = TLAT + b * LCTX, head = hk * 4 + g;
        bf16x8 qf[2][4];
#pragma unroll
        for (int s = 0; s < 2; ++s)
#pragma unroll
            for (int ks = 0; ks < 4; ++ks) qf[s][ks] = *(const bf16x8*)(P + (size_t)(qr0 + 64 * qh + 32 * s + r32) * INW + QS + head * 64 + 16 * ks + 8 * hi);
        float mrun[2], lrun[2]; f32x16 O[2][2];
        const float sk2 = sink[head] * LOG2E;
#pragma unroll
        for (int s = 0; s < 2; ++s) { mrun[s] = sk2; lrun[s] = 1.0f;
#pragma unroll
            for (int dt = 0; dt < 2; ++dt)
#pragma unroll
                for (int r = 0; r < 16; ++r) O[s][dt][r] = 0.f; }
#pragma unroll 1
        for (int ti = 0; ti < 5; ++ti) {
            int krow0, mtype = 0; bool valid = true;
            if (ti == 0) { krow0 = qr0 - 128; mtype = 1; valid = isl && qb > 0; }
            else if (ti == 1) { krow0 = qr0; valid = isl; }
            else if (ti == 2) { krow0 = qr0 + 128; mtype = 2; valid = isl && qb < 31; }
            else { krow0 = crow0 + (ti - 3) * 128; }
            if (!valid) continue;
            __syncthreads();
#pragma unroll
            for (int i = 0; i < 2; ++i) { const int id = tid + NTHR * i, key = id >> 3, c = id & 7;
                const u32x4 v = *(const u32x4*)(P + (size_t)(krow0 + key) * INW + KS_ + hk * 64 + 8 * c);
                *(LAS u32x4*)(Kl + key * KROW + c * 16) = v; }
#pragma unroll
            for (int i = 0; i < 2; ++i) { const int id = tid + NTHR * i, key = id & 127, c = id >> 7;
                const u32x4 v = *(const u32x4*)(P + (size_t)(krow0 + key) * INW + VS_ + hk * 64 + 8 * c);
                LAS unsigned char* vp = Vl + (8 * c) * VROW + key * 2;
                *(LAS unsigned short*)(vp + 0 * VROW) = (unsigned short)(v.x & 0xffffu); *(LAS unsigned short*)(vp + 1 * VROW) = (unsigned short)(v.x >> 16);
                *(LAS unsigned short*)(vp + 2 * VROW) = (unsigned short)(v.y & 0xffffu); *(LAS unsigned short*)(vp + 3 * VROW) = (unsigned short)(v.y >> 16);
                *(LAS unsigned short*)(vp + 4 * VROW) = (unsigned short)(v.z & 0xffffu); *(LAS unsigned short*)(vp + 5 * VROW) = (unsigned short)(v.z >> 16);
                *(LAS unsigned short*)(vp + 6 * VROW) = (unsigned short)(v.w & 0xffffu); *(LAS unsigned short*)(vp + 7 * VROW) = (unsigned short)(v.w >> 16); }
            __syncthreads();
#pragma unroll
            for (int half = 0; half < 2; ++half)
#pragma unroll
                for (int s = 0; s < 2; ++s) {
                    f32x16 S[2];
#pragma unroll
                    for (int rt = 0; rt < 2; ++rt) {
#pragma unroll
                        for (int r = 0; r < 16; ++r) S[rt][r] = 0.f;
#ifndef DIAG
                        asm volatile("" : "+v"(S[rt]));
#endif
#pragma unroll
                        for (int ks = 0; ks < 4; ++ks) { const bf16x8 kf = *(const LAS bf16x8*)(Kl + (64 * half + 32 * rt + r32) * KROW + (16 * ks + 8 * hi) * 2);
                            S[rt] = __builtin_amdgcn_mfma_f32_32x32x16_bf16(kf, qf[s][ks], S[rt], 0, 0, 0); }
                    }
                    if (mtype != 0) { int il = 64 * qh + 32 * s + r32; asm volatile("" : "+v"(il));
#pragma unroll
                        for (int rt = 0; rt < 2; ++rt)
#pragma unroll
                            for (int r = 0; r < 16; ++r) { const int jl = 64 * half + 32 * rt + crow(r, hi); const bool ok = (mtype == 1) ? (jl >= il) : (jl <= il); if (!ok) S[rt][r] = -INFINITY; } }
                    float tmax = S[0][0];
#pragma unroll
                    for (int rt = 0; rt < 2; ++rt)
#pragma unroll
                        for (int r = 0; r < 16; ++r) tmax = fmaxf(tmax, S[rt][r]);
                    tmax = fmaxf(tmax, __shfl_xor(tmax, 32));
                    const float mnew = fmaxf(mrun[s], tmax), alpha = fast_exp2(mrun[s] - mnew);
                    mrun[s] = mnew;
                    float psum = 0.f;
#pragma unroll
                    for (int rt = 0; rt < 2; ++rt)
#pragma unroll
                        for (int r = 0; r < 16; ++r) { const float p = fast_exp2(S[rt][r] - mnew); S[rt][r] = p; psum += p; }
                    psum += __shfl_xor(psum, 32);
                    lrun[s] = lrun[s] * alpha + psum;
#pragma unroll
                    for (int dt = 0; dt < 2; ++dt)
#pragma unroll
                        for (int r = 0; r < 16; ++r) O[s][dt][r] *= alpha;
#pragma unroll
                    for (int rt = 0; rt < 2; ++rt)
#pragma unroll
                        for (int s2 = 0; s2 < 2; ++s2) {
                            u32x4 pw; pw.x = cvt_pk(S[rt][8 * s2 + 0], S[rt][8 * s2 + 1]); pw.y = cvt_pk(S[rt][8 * s2 + 2], S[rt][8 * s2 + 3]);
                            pw.z = cvt_pk(S[rt][8 * s2 + 4], S[rt][8 * s2 + 5]); pw.w = cvt_pk(S[rt][8 * s2 + 6], S[rt][8 * s2 + 7]);
                            const bf16x8 pf = __builtin_bit_cast(bf16x8, pw);
#pragma unroll
                            for (int dt = 0; dt < 2; ++dt) {
                                const LAS unsigned char* vb = Vl + (32 * dt + r32) * VROW + (64 * half + 32 * rt + 16 * s2 + 4 * hi) * 2;
                                const u32x2 v0 = *(const LAS u32x2*)vb, v1 = *(const LAS u32x2*)(vb + 16);
                                const u32x4 vv = {v0.x, v0.y, v1.x, v1.y};
                                O[s][dt] = __builtin_amdgcn_mfma_f32_32x32x16_bf16(__builtin_bit_cast(bf16x8, vv), pf, O[s][dt], 0, 0, 0);
                            }
                        }
                }
        }
#pragma unroll
        for (int s = 0; s < 2; ++s) { const float inv = 1.0f / lrun[s];
            bf16_t* orow = cat + (size_t)(qr0 + 64 * qh + 32 * s + r32) * DM + 512 + head * 64;
#pragma unroll
            for (int dt = 0; dt < 2; ++dt)
#pragma unroll
                for (int q4 = 0; q4 < 4; ++q4) { u32x2 w; w.x = cvt_pk(O[s][dt][4 * q4 + 0] * inv, O[s][dt][4 * q4 + 1] * inv); w.y = cvt_pk(O[s][dt][4 * q4 + 2] * inv, O[s][dt][4 * q4 + 3] * inv);
                    *(u32x2*)(orow + 32 * dt + 8 * q4 + 4 * hi) = w; } }
    }
    __syncthreads();
}

__device__ __forceinline__ void load_u(const bf16_t* P, int t, int s0, int s1, int c8, float (&u)[8]) {
    if (t < s0 || t >= s1) {
#pragma unroll
        for (int j = 0; j < 8; ++j) u[j] = 0.f;
    } else {
        const u32x4 cv = *(const u32x4*)(P + (size_t)t * INW + 512 + 8 * c8), hv = *(const u32x4*)(P + (size_t)t * INW + 1024 + 8 * c8);
        u[0] = bf_lo(cv.x) * bf_lo(hv.x); u[1] = bf_hi(cv.x) * bf_hi(hv.x); u[2] = bf_lo(cv.y) * bf_lo(hv.y); u[3] = bf_hi(cv.y) * bf_hi(hv.y);
        u[4] = bf_lo(cv.z) * bf_lo(hv.z); u[5] = bf_hi(cv.z) * bf_hi(hv.z); u[6] = bf_lo(cv.w) * bf_lo(hv.w); u[7] = bf_hi(cv.w) * bf_hi(hv.w);
    }
}
__device__ __forceinline__ void cvt8(const u32x4 v, float (&f)[8]) { f[0] = bf_lo(v.x); f[1] = bf_hi(v.x); f[2] = bf_lo(v.y); f[3] = bf_hi(v.y); f[4] = bf_lo(v.z); f[5] = bf_hi(v.z); f[6] = bf_lo(v.w); f[7] = bf_hi(v.w); }
__device__ __forceinline__ void conv_phase(const bf16_t* P, bf16_t* cat, const float* cw, int M, int G, int tid) {
    const int c8 = tid & 63, tg = tid >> 6;
    float w0[8], w1[8], w2[8];
#pragma unroll
    for (int j = 0; j < 8; ++j) { w0[j] = cw[8 * c8 + j]; w1[j] = cw[512 + 8 * c8 + j]; w2[j] = cw[1024 + 8 * c8 + j]; }
    for (int it = blockIdx.x; it < M / 128; it += G) {
        const int t0 = it * 128, ts = t0 + 16 * tg;
        int s0, s1; if (t0 < TLAT) { s0 = t0 & ~4095; s1 = s0 + 4096; } else { s0 = TLAT + ((t0 - TLAT) & ~255); s1 = s0 + 256; }
        float up[8], uc[8];
        load_u(P, ts - 1, s0, s1, c8, up); load_u(P, ts, s0, s1, c8, uc);
#pragma unroll 1
        for (int i = 0; i < 16; i += 4) {
            const int t = ts + i;
            u32x4 bv[4], cv[4], hv[4];
#pragma unroll
            for (int q = 0; q < 4; ++q) { bv[q] = *(const u32x4*)(P + (size_t)(t + q) * INW + 8 * c8);
                const int tq = (t + q + 1 < s1) ? t + q + 1 : t + q;
                cv[q] = *(const u32x4*)(P + (size_t)tq * INW + 512 + 8 * c8); hv[q] = *(const u32x4*)(P + (size_t)tq * INW + 1024 + 8 * c8); }
            asm volatile("" ::: "memory");
#pragma unroll
            for (int q = 0; q < 4; ++q) {
                float cf[8], hf[8], bb[8], un[8], o[8]; cvt8(cv[q], cf); cvt8(hv[q], hf); cvt8(bv[q], bb);
                const bool inb = (t + q + 1 < s1);
#pragma unroll
                for (int j = 0; j < 8; ++j) { un[j] = inb ? cf[j] * hf[j] : 0.f; o[j] = bb[j] * (w0[j] * up[j] + w1[j] * uc[j] + w2[j] * un[j]); up[j] = uc[j]; uc[j] = un[j]; }
                u32x4 w; w.x = cvt_pk(o[0], o[1]); w.y = cvt_pk(o[2], o[3]); w.z = cvt_pk(o[4], o[5]); w.w = cvt_pk(o[6], o[7]);
                *(u32x4*)(cat + (size_t)(t + q) * DM + 8 * c8) = w; }
            asm volatile("" ::: "memory");
        }
    }
}

template <int MT, int KS> __device__ __forceinline__ void dft_load_a(bf16x8 (&a)[MT][KS], const bf16_t* Mat, int row0, int r32, int hi) {
#pragma unroll
    for (int rt = 0; rt < MT; ++rt)
#pragma unroll
        for (int ks = 0; ks < KS; ++ks) a[rt][ks] = *(const bf16x8*)(Mat + (size_t)(row0 + 32 * rt + r32) * (KS * 16) + 16 * ks + 8 * hi);
}
template <int MT, int KS> __device__ __forceinline__ void dft_mm(f32x16 (&acc)[MT], const bf16x8 (&a)[MT][KS], const bf16_t* vec) {
#pragma unroll
    for (int rt = 0; rt < MT; ++rt)
#pragma unroll
        for (int r = 0; r < 16; ++r) acc[rt][r] = 0.f;
#pragma unroll
    for (int rt = 0; rt < MT; ++rt) asm volatile("" : "+v"(acc[rt]));
    constexpr int KC = 8;
#pragma unroll
    for (int kc = 0; kc < KS / KC; ++kc) {
        bf16x8 b[KC];
#pragma unroll
        for (int i = 0; i < KC; ++i) b[i] = *(const bf16x8*)(vec + 16 * (kc * KC + i));
#pragma unroll
        for (int i = 0; i < KC; ++i)
#pragma unroll
            for (int rt = 0; rt < MT; ++rt) acc[rt] = __builtin_amdgcn_mfma_f32_32x32x16_bf16(a[rt][kc * KC + i], b[i], acc[rt], 0, 0, 0);
    }
}
__device__ __forceinline__ void store_pair(bf16_t* base, size_t zoo, unsigned cA, unsigned cB, float va, float vb, bool odd) {
    const float keep = odd ? vb : va, send = odd ? va : vb;
    const float got = __builtin_bit_cast(float, __builtin_amdgcn_mov_dpp(__builtin_bit_cast(int, send), 0xB1, 0xf, 0xf, true));
    const unsigned w = odd ? cvt_pk(got, keep) : cvt_pk(keep, got);
    *(unsigned*)(base + zoo + (odd ? cB : cA)) = w;
}
__device__ __forceinline__ void dft_ld8(bf16x8 (&b)[8], const bf16_t* vec) {
#pragma unroll
    for (int i = 0; i < 8; ++i) b[i] = *(const bf16x8*)(vec + 16 * i);
}
template <int MT> __device__ __forceinline__ void dft_zero(f32x16 (&acc)[MT]) {
#pragma unroll
    for (int rt = 0; rt < MT; ++rt) {
#pragma unroll
        for (int r = 0; r < 16; ++r) acc[rt][r] = 0.f;
        asm volatile("" : "+v"(acc[rt]));
    }
}
template <int MT, int KS, int K0> __device__ __forceinline__ void dft_mma8(f32x16 (&acc)[MT], const bf16x8 (&a)[MT][KS], const bf16x8 (&b)[8]) {
#pragma unroll
    for (int i = 0; i < 8; ++i)
#pragma unroll
        for (int rt = 0; rt < MT; ++rt) acc[rt] = __builtin_amdgcn_mfma_f32_32x32x16_bf16(a[rt][K0 + i], b[i], acc[rt], 0, 0, 0);
}
__device__ __forceinline__ const bf16_t* fa_vec(const bf16_t* H, int tile, int r32, int hi) {
    int token, g;
    if (tile < 8192) { const int n1h = tile & 1, n2 = (tile >> 1) & 63, b = tile >> 9; g = (tile >> 7) & 3; token = b * SEQ + 64 * (32 * n1h + r32) + n2; }
    else { const int tc = tile - 8192, nq = tc & 7, b = tc >> 5; g = (tc >> 3) & 3; token = TLAT + b * LCTX + 32 * nq + r32; }
    return H + (size_t)token * DM + g * 256 + 8 * hi;
}
__device__ __forceinline__ int fa_token(int tile, int row) {
    if (tile < 8192) { const int n1h = tile & 1, n2 = (tile >> 1) & 63, b = tile >> 9; return b * SEQ + 64 * (32 * n1h + row) + n2; }
    const int tc = tile - 8192, nq = tc & 7, b = tc >> 5; return TLAT + b * LCTX + 32 * nq + row;
}
__device__ __forceinline__ void fourier_a(LAS unsigned char* lds, const bf16_t* H, const bf16_t* DC, bf16_t* Z1, bf16_t* Zc, bool with_ctx, int G, int vcu, int wave, int lane) {
    constexpr int ROWB = 528, BUFB = 32 * ROWB;
    const int r32 = lane & 31, hi = lane >> 5, sl = wave, tid = wave * 64 + lane; const bool odd = lane & 1;
    bf16x8 a[2][16]; dft_load_a<2, 16>(a, DC, 64 * sl, r32, hi);
    const int ntile = 8192 + (with_ctx ? 512 : 0);
    const int srow0 = tid >> 5, sch = tid & 31;
    u32x4 s0, s1;
    int tile = vcu, cur = 0;
    if (tile < ntile) { const int g = (tile < 8192) ? (tile >> 7) & 3 : ((tile - 8192) >> 3) & 3;
        s0 = *(const u32x4*)(H + (size_t)fa_token(tile, srow0) * DM + g * 256 + sch * 8); s1 = *(const u32x4*)(H + (size_t)fa_token(tile, srow0 + 16) * DM + g * 256 + sch * 8); }
    for (; tile < ntile; tile += G) {
        LAS unsigned char* buf = lds + cur * BUFB;
        *(LAS u32x4*)(buf + srow0 * ROWB + sch * 16) = s0; *(LAS u32x4*)(buf + (srow0 + 16) * ROWB + sch * 16) = s1;
        __syncthreads();
        if (tile + G < ntile) { const int tn = tile + G; const int g = (tn < 8192) ? (tn >> 7) & 3 : ((tn - 8192) >> 3) & 3;
            s0 = *(const u32x4*)(H + (size_t)fa_token(tn, srow0) * DM + g * 256 + sch * 8); s1 = *(const u32x4*)(H + (size_t)fa_token(tn, srow0 + 16) * DM + g * 256 + sch * 8); }
        asm volatile("" ::: "memory");
        f32x16 acc[2]; dft_zero<2>(acc);
        const LAS unsigned char* bp = buf + r32 * ROWB + hi * 16;
#pragma unroll
        for (int ks = 0; ks < 16; ++ks) { const bf16x8 bf = *(const LAS bf16x8*)(bp + ks * 32);
#pragma unroll
            for (int rt = 0; rt < 2; ++rt) acc[rt] = __builtin_amdgcn_mfma_f32_32x32x16_bf16(a[rt][ks], bf, acc[rt], 0, 0, 0); }
        if (tile < 8192) {
            const int n1h = tile & 1, n2 = (tile >> 1) & 63, g = (tile >> 7) & 3, b = tile >> 9;
            size_t zo = ((((size_t)((b * 4 + g) * 256 + 64 * (sl & 3) + 4 * hi)) * 64 + n2) * 2 + (sl >> 2)) * 64 + 32 * n1h + (r32 & ~1);
            asm volatile("" : "+v"(zo));
#pragma unroll
            for (int rt = 0; rt < 2; ++rt)
#pragma unroll
                for (int r = 0; r < 16; r += 2) store_pair(Z1, zo, (unsigned)(32 * rt + (r & 3) + 8 * (r >> 2)) * 8192u, (unsigned)(32 * rt + ((r + 1) & 3) + 8 * (r >> 2)) * 8192u, acc[rt][r], acc[rt][r + 1], odd);
        } else {
            const int tc = tile - 8192, nq = tc & 7, g = (tc >> 3) & 3, b = tc >> 5;
            size_t zo = (((size_t)((b * 4 + g) * 256 + 64 * (sl & 3) + 4 * hi)) * 2 + (sl >> 2)) * 256 + 32 * nq + (r32 & ~1);
            asm volatile("" : "+v"(zo));
#pragma unroll
            for (int rt = 0; rt < 2; ++rt)
#pragma unroll
                for (int r = 0; r < 16; r += 2) store_pair(Zc, zo, (unsigned)(32 * rt + (r & 3) + 8 * (r >> 2)) * 512u, (unsigned)(32 * rt + ((r + 1) & 3) + 8 * (r >> 2)) * 512u, acc[rt][r], acc[rt][r + 1], odd);
        }
        asm volatile("" ::: "memory");
        cur ^= 1;
    }
    __syncthreads();
}
template <int VAR> __device__ __forceinline__ void fourier_s1(const bf16_t* Z1, const bf16_t* D1, const float* tw, bf16_t* A1p, int G, int vcu, int wave, int lane) {
    const int r32 = lane & 31, hi = lane >> 5, sl = wave & 1; const bool odd = lane & 1;
    bf16x8 a[2][8]; dft_load_a<2, 8>(a, D1, 64 * sl, r32, hi);
    int tile = vcu * 4 + (wave >> 1); const int step = G * 4;
    const int n2 = 32 * (tile & 1) + r32;
    float2 twr[16];
#pragma unroll
    for (int rt = 0; rt < 2; ++rt)
#pragma unroll
        for (int q4 = 0; q4 < 4; ++q4)
#pragma unroll
            for (int e = 0; e < 2; ++e) twr[rt * 8 + q4 * 2 + e] = *(const float2*)(tw + 2 * ((32 * sl + 2 * hi + 16 * rt + 4 * q4 + e) * 64 + n2));
    bf16x8 bc[8], bn[8];
    if (tile < 32768) dft_ld8(bc, Z1 + ((size_t)tile * 32 + r32) * 128 + 8 * hi);
    for (; tile < 32768; tile += step) {
        asm volatile("" ::: "memory");
        if (tile + step < 32768) dft_ld8(bn, Z1 + ((size_t)(tile + step) * 32 + r32) * 128 + 8 * hi);
        asm volatile("" ::: "memory");
        f32x16 acc[2]; dft_zero<2>(acc);
        dft_mma8<2, 8, 0>(acc, a, bc);
        const int bgm = tile >> 1, bg = bgm >> 8, m = bgm & 255;
        size_t ao = ((((size_t)(bg * 64 + 32 * sl + 2 * hi)) * 256 + m) * 2) * 64 + (n2 & ~1);
        asm volatile("" : "+v"(ao));
#pragma unroll
        for (int rt = 0; rt < 2; ++rt)
#pragma unroll
            for (int q4 = 0; q4 < 4; ++q4)
#pragma unroll
                for (int e = 0; e < 2; ++e) { const int dk = 16 * rt + 4 * q4 + e;
                    const float re = acc[rt][4 * q4 + 2 * e], im = acc[rt][4 * q4 + 2 * e + 1];
                    const float2 cs = twr[rt * 8 + q4 * 2 + e];
                    const float re2 = re * cs.x + im * cs.y, im2 = im * cs.x - re * cs.y;
                    store_pair(A1p, ao, (unsigned)dk * 32768u, (unsigned)dk * 32768u + 64u, re2, im2, odd); }
        asm volatile("" ::: "memory");
#pragma unroll
        for (int i = 0; i < 8; ++i) bc[i] = bn[i];
    }
}
__device__ __forceinline__ void fourier_s2(const bf16_t* A1p, const bf16_t* D2, const bf16_t* Zc, const bf16_t* DX, bf16_t* FM, bool with_ctx, int G, int vcu, int gw, int NGW, int wave, int lane) {
    const int r32 = lane & 31, hi = lane >> 5; const bool odd = lane & 1;
    {
        bf16x8 a[2][8]; dft_load_a<2, 8>(a, D2, 0, r32, hi);
        bf16x8 bc[8], bn[8];
        int tile = gw;
        if (tile < 32768) dft_ld8(bc, A1p + ((size_t)tile * 32 + r32) * 128 + 8 * hi);
        for (; tile < 32768; tile += NGW) {
            asm volatile("" ::: "memory");
            if (tile + NGW < 32768) dft_ld8(bn, A1p + ((size_t)(tile + NGW) * 32 + r32) * 128 + 8 * hi);
            asm volatile("" ::: "memory");
            f32x16 acc[2]; dft_zero<2>(acc);
            dft_mma8<2, 8, 0>(acc, a, bc);
            const int m = 32 * (tile & 7) + r32, k1 = (tile >> 3) & 63, bg = tile >> 9, b = bg >> 2, g = bg & 3;
            size_t fo = (size_t)(b * SEQ + k1 + 256 * hi) * DM + g * 256 + (m & ~1);
            asm volatile("" : "+v"(fo));
#pragma unroll
            for (int rt = 0; rt < 2; ++rt)
#pragma unroll
                for (int r = 0; r < 16; r += 2) store_pair(FM, fo, (unsigned)(32 * rt + (r & 3) + 8 * (r >> 2)) * 65536u, (unsigned)(32 * rt + ((r + 1) & 3) + 8 * (r >> 2)) * 65536u, acc[rt][r], acc[rt][r + 1], odd);
            asm volatile("" ::: "memory");
#pragma unroll
            for (int i = 0; i < 8; ++i) bc[i] = bn[i];
        }
    }
    if (with_ctx) {
        for (int tile = vcu; tile < 512; tile += G) {
            f32x16 acc;
#pragma unroll
            for (int r = 0; r < 16; ++r) acc[r] = 0.f;
            asm volatile("" : "+v"(acc));
            const bf16_t* ap = DX + (size_t)(32 * wave + r32) * 512 + 8 * hi;
            const bf16_t* bp = Zc + ((size_t)tile * 32 + r32) * 512 + 8 * hi;
#pragma unroll 1
            for (int kc = 0; kc < 4; ++kc) {
                bf16x8 av[8], bv[8];
#pragma unroll
                for (int i = 0; i < 8; ++i) { av[i] = *(const bf16x8*)(ap + 16 * (kc * 8 + i)); bv[i] = *(const bf16x8*)(bp + 16 * (kc * 8 + i)); }
#pragma unroll
                for (int i = 0; i < 8; ++i) acc = __builtin_amdgcn_mfma_f32_32x32x16_bf16(av[i], bv[i], acc, 0, 0, 0);
            }
            const int m = 32 * (tile & 7) + r32, bg = tile >> 3, b = bg >> 2, g = bg & 3;
            size_t fo = (size_t)(TLAT + b * LCTX + 32 * wave + 4 * hi) * DM + g * 256 + (m & ~1);
            asm volatile("" : "+v"(fo));
#pragma unroll
            for (int r = 0; r < 16; r += 2) store_pair(FM, fo, (unsigned)((r & 3) + 8 * (r >> 2)) * 1024u, (unsigned)(((r + 1) & 3) + 8 * (r >> 2)) * 1024u, acc[r], acc[r + 1], odd);
        }
    }
}


#define RLX_AGENT __ATOMIC_RELAXED, __HIP_MEMORY_SCOPE_AGENT
#define XB_TMO      128
#define XB_XCNT(j)  (256  + 64 * (j))
#define XB_XSUB(j)  (1280 + 64 * (j))
#define XB_XGEN(j)  (2304 + 64 * (j))
#define XB_TOP      3328
#define XB_TOPGEN   3392
#define XCD_BAR_WORDS 3456
#define XB_SPIN_CAP (1u << 18)

__device__ __forceinline__ unsigned xb_ld(unsigned* p)              { return __hip_atomic_load(p, __ATOMIC_RELAXED, __HIP_MEMORY_SCOPE_AGENT); }
__device__ __forceinline__ unsigned xb_add(unsigned* p, unsigned v) { return __hip_atomic_fetch_add(p, v, __ATOMIC_RELAXED, __HIP_MEMORY_SCOPE_AGENT); }
__device__ __forceinline__ unsigned xb_xcc_id() { return (unsigned)__builtin_amdgcn_s_getreg((3 << 11) | 20) & 0xFu; }
#define XB_SPIN(cond, bar) do { unsigned _sp = 0; while (cond) { __builtin_amdgcn_s_sleep(1); \
    if ((++_sp & 255u) == 0u) { if (xb_ld(&(bar)[XB_TMO])) break; if (_sp > XB_SPIN_CAP) { atomicAdd(&(bar)[XB_TMO], 1u); break; } } } } while (0)

struct XcdBarrier {
    unsigned* bar; unsigned x;
    volatile LAS unsigned* st;
};

__device__ __forceinline__ XcdBarrier xcd_barrier_post(unsigned* bar, volatile LAS unsigned* st) {
    XcdBarrier b; b.bar = bar; b.x = xb_xcc_id(); b.st = st;
    if (threadIdx.x == 0) (void)xb_add(&bar[XB_XCNT(b.x)], 1u);
    return b;
}
__device__ __forceinline__ void xcd_barrier_complete(unsigned* bar, unsigned x, unsigned& nloc, unsigned& nx) {
    const unsigned G = gridDim.x * gridDim.y * gridDim.z;
    unsigned sum, cnt, mine, sp = 0u;
    for (;;) {
        sum = 0u; cnt = 0u; mine = 0u;
#pragma unroll
        for (unsigned j = 0; j < 16; ++j) { const unsigned c = xb_ld(&bar[XB_XCNT(j)]); sum += c; cnt += (c > 0u) ? 1u : 0u; mine = (j == x) ? c : mine; }
        if (sum == G) break;
        __builtin_amdgcn_s_sleep(1);
        if ((++sp & 255u) == 0u) { if (xb_ld(&bar[XB_TMO])) break; if (sp > XB_SPIN_CAP) { atomicAdd(&bar[XB_TMO], 1u); break; } }
    }
    nloc = mine > 0u ? mine : 1u; nx = cnt > 0u ? cnt : 1u;
}

__device__ __forceinline__ void xcd_barrier(const XcdBarrier& b) {
    asm volatile("s_waitcnt vmcnt(0)" ::: "memory");
    __syncthreads();
    if (threadIdx.x == 0) {
        unsigned* bar = b.bar;
        __builtin_amdgcn_s_waitcnt(0);
        unsigned nloc = b.st[0], nx = b.st[1];
        if (nloc == 0u) { xcd_barrier_complete(bar, b.x, nloc, nx); b.st[0] = nloc; b.st[1] = nx; }
        const unsigned old = xb_add(&bar[XB_XSUB(b.x)], 1u);
        const unsigned gen = old / nloc;
        if (old + 1u == (gen + 1u) * nloc) {
            __builtin_amdgcn_fence(__ATOMIC_RELEASE, "agent");
            asm volatile("s_waitcnt vmcnt(0)" ::: "memory");
            const unsigned og = xb_add(&bar[XB_TOP], 1u);
            const unsigned tg = og / nx;
            if (og + 1u == (tg + 1u) * nx) xb_add(&bar[XB_TOPGEN], 1u);
            else XB_SPIN(xb_ld(&bar[XB_TOPGEN]) == tg, bar);
            __builtin_amdgcn_fence(__ATOMIC_ACQUIRE, "agent");
            xb_add(&bar[XB_XGEN(b.x)], 1u);
            asm volatile("s_waitcnt vmcnt(0)" ::: "memory");
        } else {
            XB_SPIN(xb_ld(&bar[XB_XGEN(b.x)]) == gen, bar);
            __builtin_amdgcn_fence(__ATOMIC_ACQUIRE, "agent");
            asm volatile("s_waitcnt vmcnt(0)" ::: "memory");
        }
    }
    __syncthreads();
}

#ifdef DIAG
__device__ __forceinline__ void diag_scan(unsigned* ctl, const void* buf, size_t bytes, bool is_bf16, int stage) {
    const size_t n16 = bytes / 16; const u32x4* p = (const u32x4*)buf; bool bad = false;
    int ln = (int)__builtin_amdgcn_mbcnt_hi(~0u, __builtin_amdgcn_mbcnt_lo(~0u, 0u)); asm volatile("" : "+v"(ln)); ln += 64 * __builtin_amdgcn_readfirstlane((int)threadIdx.x >> 6);
    for (size_t i = (size_t)blockIdx.x * NTHR + ln; i < n16; i += (size_t)gridDim.x * NTHR) {
        const u32x4 v = p[i];
        if (is_bf16) { for (int q = 0; q < 4; ++q) { const unsigned w = v[q]; if (((w >> 7) & 0xff) == 0xff || ((w >> 23) & 0xff) == 0xff) bad = true; } }
        else { for (int q = 0; q < 4; ++q) { if (((v[q] >> 23) & 0xff) >= 0xf0) bad = true; } }
    }
    if (bad) atomicMin(ctl, (unsigned)stage);
}
#define DIAG_SCAN(buf, bytes, isbf, stage) diag_scan((unsigned*)ws, buf, bytes, isbf, stage)
#else
#define DIAG_SCAN(buf, bytes, isbf, stage) do {} while (0)
#endif

#ifdef DIAG2
__device__ __forceinline__ void diag_max(unsigned* ctl, const void* buf, size_t bytes) {
    const size_t n16 = bytes / 16; const u32x4* p = (const u32x4*)buf; unsigned mx = 0, nb = 0;
    int ln = (int)__builtin_amdgcn_mbcnt_hi(~0u, __builtin_amdgcn_mbcnt_lo(~0u, 0u)); asm volatile("" : "+v"(ln)); ln += 64 * __builtin_amdgcn_readfirstlane((int)threadIdx.x >> 6);
    for (size_t i = (size_t)blockIdx.x * NTHR + ln; i < n16; i += (size_t)gridDim.x * NTHR) {
        const u32x4 v = p[i];
        for (int q = 0; q < 4; ++q) { const unsigned lo = (v[q] << 16) & 0x7fffffffu, hi = v[q] & 0x7fff0000u;
            if ((lo >> 23) == 0xff) ++nb; else mx = mx > lo ? mx : lo;
            if ((hi >> 23) == 0xff) ++nb; else mx = mx > hi ? mx : hi; }
    }
    atomicMax(ctl + 1, mx); if (nb) atomicAdd(ctl + 2, nb);
}
#endif

#ifdef TSEL
#define TBEG(c) do { if ((TSEL >> (c)) & 1) t0_ = __builtin_amdgcn_s_memrealtime(); } while (0)
#define TEND(c) do { if ((TSEL >> (c)) & 1) tacc_ += __builtin_amdgcn_s_memrealtime() - t0_; } while (0)
#else
#define TBEG(c) do {} while (0)
#define TEND(c) do {} while (0)
#endif
__global__ void __launch_bounds__(NTHR, 2) fwd_megakernel(Args A) {
    extern __shared__ __attribute__((aligned(16))) unsigned char lds_raw[];
    cg::grid_group grid = cg::this_grid();
#define GRID_SYNC() xcd_barrier(xbar)
#define CG_SYNC() do { asm volatile("s_waitcnt vmcnt(0) lgkmcnt(0)" ::: "memory"); grid.sync(); } while (0)
    LAS unsigned char* lds = (LAS unsigned char*)lds_raw;
    const int wave = __builtin_amdgcn_readfirstlane((int)threadIdx.x >> 6);
#define FRESH_LANE(v) int v = LANE_ID(); asm volatile("" : "+v"(v))
#define LANE_ID() ((int)__builtin_amdgcn_mbcnt_hi(~0u, __builtin_amdgcn_mbcnt_lo(~0u, 0u)))
    const int lane = LANE_ID(), tid = wave * 64 + lane;
    const int G = gridDim.x, gw = blockIdx.x * NWAVES + wave, NGW = G * NWAVES;
    const int vcu = (G % 8 == 0) ? ((int)blockIdx.x % 8) * (G / 8) + (int)blockIdx.x / 8 : (int)blockIdx.x;
    const int gwv = vcu * NWAVES + wave;
    unsigned char* ws = A.ws;
    volatile LAS unsigned* xb_st = (volatile LAS unsigned*)(lds + 131072 + 64);
    if (threadIdx.x == 0) { xb_st[0] = 0u; xb_st[1] = 0u; }
    __syncthreads();
    const XcdBarrier xbar = xcd_barrier_post((unsigned*)ws + 4096, xb_st);
#ifdef TSEL
    unsigned long long t0_ = 0, tacc_ = 0;
#endif
#ifdef DIAG
    if (blockIdx.x == 0 && threadIdx.x == 0) *(unsigned*)ws = 0x7fffffffu;
#endif
#ifdef DIAG2
    if (blockIdx.x == 0 && threadIdx.x == 0) { ((unsigned*)ws)[1] = 0u; ((unsigned*)ws)[2] = 0u; }
#endif
    float* mod = (float*)(ws + WS_MOD);
    const float* rope = (const float*)(ws + WS_TAB + TAB_ROPE); const float* tw = (const float*)(ws + WS_TAB + TAB_TW);
    const bf16_t* D1 = (const bf16_t*)(ws + WS_TAB + TAB_D1); const bf16_t* D2 = (const bf16_t*)(ws + WS_TAB + TAB_D2);
    const bf16_t* DC = (const bf16_t*)(ws + WS_TAB + TAB_DC); const bf16_t* DX = (const bf16_t*)(ws + WS_TAB + TAB_DCTX);
    bf16_t* XB = (bf16_t*)(ws + WS_XB);
    bf16_t* Hb = (bf16_t*)(ws + WS_H); bf16_t* Pb = (bf16_t*)(ws + WS_P); bf16_t* CAT = (bf16_t*)(ws + WS_CAT); bf16_t* ACT = (bf16_t*)(ws + WS_ACT);
    bf16_t* Z1 = (bf16_t*)(ws + WS_Z1); bf16_t* Zc = (bf16_t*)(ws + WS_ZC); bf16_t* A1p = (bf16_t*)(ws + WS_A1); bf16_t* FM = (bf16_t*)(ws + WS_FM);


#ifndef SKIP_PRO
        TBEG(10);
    prologue(A, lds, tid, wave, lane, G);
#endif

    CG_SYNC();
        TEND(10);

    DIAG_SCAN(mod, 4 * 17 * 6144 * 4, false, 1); DIAG_SCAN(ws + WS_WIN, (size_t)83 * MiB, true, 2); DIAG_SCAN(ws + WS_TAB + TAB_D1, 640 * 1024, true, 3); DIAG_SCAN(ws + WS_TAB, 96 * 1024, false, 4);
#pragma unroll 1
    for (int l = 0; l < 4; ++l) {
        const bool even = (l & 1) == 0; const int e = l >> 1;
        const bool ctx_after = l < 2;
        const bool ctx_here = l < 3;
        const int Mfull = ctx_here ? MALL : TLAT;
        const int Mres = ctx_after ? MALL : TLAT;
        const float* modl = mod + (size_t)l * 17 * 6144;
        TBEG(4);
        { FRESH_LANE(lane_l); const int tid_l = wave * 64 + lane_l; (void)tid_l; if (l == 0) norm_phase<true>(A.x, A.ctx, XB, A.n1g + l * DM, modl, 0, Hb, Mfull, gw, NGW, lane_l); else norm_phase<false>(A.x, A.ctx, XB, A.n1g + l * DM, modl, 0, Hb, Mfull, gw, NGW, lane_l); }
        GRID_SYNC();
        TEND(4);
        DIAG_SCAN(Hb, (size_t)Mfull * DM * 2, true, 10 + 10 * l);
        const bf16_t* mixA; const bf16_t* mixW;
        if (even) {
        TBEG(0);
            { int tg = LANE_ID(); asm volatile("" : "+v"(tg)); tg += wave * 64; pg8::Gemm g{Hb, (const bf16_t*)(ws + WS_WIN) + (size_t)e * INW * DM, Mfull, INW, DM}; pg8::StaticOrder S; S.init(Mfull, INW, G, (int)blockIdx.x);
              EpiInProj E{Pb, rope};
              pg8::gemm_phase<EpiInProj, pg8::StaticOrder, true, true>(lds, g, S, E, tg); }
            GRID_SYNC();
        TEND(0);
        DIAG_SCAN(Pb, (size_t)Mfull * INW * 2, true, 11 + 10 * l);

#ifndef SKIP_ATT
        TBEG(5);
            { FRESH_LANE(lane_l); const int tid_l = wave * 64 + lane_l; (void)tid_l; attn_phase(lds, Pb, CAT, A.sink + e * 8, ctx_after, G, tid_l, wave, lane_l); }
        TEND(5);
#endif


#ifndef SKIP_CONV
        TBEG(6);
            { FRESH_LANE(lane_l); const int tid_l = wave * 64 + lane_l; (void)tid_l; conv_phase(Pb, CAT, A.conv_w + e * 3 * 512, Mres, G, tid_l); }
#endif

            GRID_SYNC();
        TEND(6);
        DIAG_SCAN(CAT, (size_t)Mres * DM * 2, true, 12 + 10 * l);
            mixA = CAT; mixW = (const bf16_t*)(ws + WS_WMIX) + (size_t)e * DM * DM;
        } else {

#ifndef SKIP_FA
        TBEG(7);
            { FRESH_LANE(lane_l); const int tid_l = wave * 64 + lane_l; (void)tid_l; fourier_a(lds, Hb, DC, Z1, Zc, ctx_after, G, vcu, wave, lane_l); }
#endif

            GRID_SYNC();
        TEND(7);
        DIAG_SCAN(Z1, (size_t)128 * MiB, true, 11 + 10 * l); DIAG_SCAN(Z1 + 64 * MiB, (size_t)128 * MiB, true, 12 + 10 * l); DIAG_SCAN(Zc, (size_t)16 * MiB, true, 13 + 10 * l);
#ifdef DIAG2
        if (l == DIAG2_L) diag_max((unsigned*)ws, DIAG2_BUF, DIAG2_BYTES);
#endif

#ifndef SKIP_S1
        TBEG(8);
            { FRESH_LANE(lane_l); const int tid_l = wave * 64 + lane_l; (void)tid_l; fourier_s1<0>(Z1, D1, tw, A1p, G, vcu, wave, lane_l); }
#endif

            GRID_SYNC();
        TEND(8);
        DIAG_SCAN(A1p, (size_t)256 * MiB, true, 14 + 10 * l);

#ifndef SKIP_S2
        TBEG(9);
            { FRESH_LANE(lane_l); const int tid_l = wave * 64 + lane_l; (void)tid_l; fourier_s2(A1p, D2, Zc, DX, FM, ctx_after, G, vcu, gwv, NGW, wave, lane_l); }
#endif

            GRID_SYNC();
        TEND(9);
        DIAG_SCAN(FM, (size_t)Mres * DM * 2, true, 15 + 10 * l);
            mixA = FM; mixW = (const bf16_t*)(ws + WS_WF) + (size_t)e * DM * DM;
        }
        TBEG(1);
        { int tg = LANE_ID(); asm volatile("" : "+v"(tg)); tg += wave * 64; pg8::Gemm g{mixA, mixW, Mres, DM, DM}; pg8::StaticOrder S; S.init(Mres, DM, G, (int)blockIdx.x);
          if (l == 0) { EpiRes<true> E{A.x, A.ctx, XB, modl, 2}; pg8::gemm_phase<EpiRes<true>, pg8::StaticOrder, true, true>(lds, g, S, E, tg); }
          else { EpiRes<false> E{A.x, A.ctx, XB, modl, 2}; pg8::gemm_phase<EpiRes<false>, pg8::StaticOrder, true, true>(lds, g, S, E, tg); } }
        GRID_SYNC();
        TEND(1);
        TBEG(4);
        { FRESH_LANE(lane_l); const int tid_l = wave * 64 + lane_l; (void)tid_l; norm_phase<false>(A.x, A.ctx, XB, A.n2g + l * DM, modl, 3, Hb, Mres, gw, NGW, lane_l); }
        GRID_SYNC();
        TEND(4);
        DIAG_SCAN(Hb, (size_t)Mres * DM * 2, true, 17 + 10 * l);
        TBEG(2);
        { int tg = LANE_ID(); asm volatile("" : "+v"(tg)); tg += wave * 64; pg8::Gemm g{Hb, (const bf16_t*)(ws + WS_WGU) + (size_t)l * 2 * DFF * DM, Mres, 2 * DFF, DM}; pg8::StaticOrder S; S.init(Mres, 2 * DFF, G, (int)blockIdx.x);
          EpiSwiGLU E{ACT};
          pg8::gemm_phase<EpiSwiGLU, pg8::StaticOrder, true, true>(lds, g, S, E, tg); }
        GRID_SYNC();
        TEND(2);
        DIAG_SCAN(ACT, (size_t)Mres * DFF * 2, true, 18 + 10 * l);
        TBEG(3);
        { int tg = LANE_ID(); asm volatile("" : "+v"(tg)); tg += wave * 64; pg8::Gemm g{ACT, (const bf16_t*)(ws + WS_WD) + (size_t)l * DM * DFF, Mres, DM, DFF}; pg8::StaticOrder S; S.init(Mres, DM, G, (int)blockIdx.x);
          EpiRes<false> E{A.x, A.ctx, XB, modl, 5}; pg8::gemm_phase<EpiRes<false>, pg8::StaticOrder, true, true>(lds, g, S, E, tg); }
        GRID_SYNC();
        TEND(3);
    }
    { int lane_f = LANE_ID(); asm volatile("" : "+v"(lane_f)); final_norm_phase(XB, A.out, A.final_g, gw, NGW, lane_f); }
#ifdef TSEL
    if (blockIdx.x == 0) { const unsigned long long ts_ = __builtin_amdgcn_s_memrealtime(); while (__builtin_amdgcn_s_memrealtime() - ts_ < (unsigned long long)TMULT * tacc_) __builtin_amdgcn_s_sleep(8); }
#endif
#ifdef DIAG2
    GRID_SYNC();
    if (blockIdx.x == 0 && threadIdx.x == 0) { const unsigned mx = ((volatile unsigned*)ws)[1], nb = ((volatile unsigned*)ws)[2]; A.out[0] = 1000.f * __builtin_bit_cast(float, mx); A.out[1] = nb ? 1e9f + 1000.f * (float)nb : 0.f; }
#endif
#ifdef DIAG
    GRID_SYNC();
    if (blockIdx.x == 0 && threadIdx.x == 0) { const unsigned c = *(volatile unsigned*)ws; A.out[0] = (c == 0x7fffffffu) ? 999000.f : 1000.f * (float)c; }
#endif
}

extern "C" void kernel_launch(void* const* d_in, const int* in_sizes, int n_in, void* d_out, int out_size, void* d_ws, size_t ws_size, hipStream_t stream) {
    static int grid = 0;
    if (grid == 0) {
        if (n_in != 17 || out_size != TLAT * DM || ws_size < WS_END) { fprintf(stderr, "kernel_launch: unexpected shapes (n_in %d, out %d, ws %zu)\n", n_in, out_size, ws_size); grid = -1; return; }
        int dev = 0, cus = 0, per_cu = 0;
        hipGetDevice(&dev); hipDeviceGetAttribute(&cus, hipDeviceAttributeMultiprocessorCount, dev);
        if (hipFuncSetAttribute((const void*)fwd_megakernel, hipFuncAttributeMaxDynamicSharedMemorySize, LDS_BYTES) != hipSuccess) { fprintf(stderr, "kernel_launch: hipFuncSetAttribute failed\n"); grid = -1; return; }
        if (hipOccupancyMaxActiveBlocksPerMultiprocessor(&per_cu, (const void*)fwd_megakernel, NTHR, LDS_BYTES) != hipSuccess || per_cu < 1) { fprintf(stderr, "kernel_launch: occupancy query says %d\n", per_cu); per_cu = 1; }
        (void)hipGetLastError();
        grid = cus * 1;
    }
    if (grid < 0) return;
    if (hipMemsetAsync(d_ws, 0, 65536, stream) != hipSuccess) { fprintf(stderr, "kernel_launch: hipMemsetAsync of the barrier words failed\n"); return; }
    Args a{};
    a.x = (const float*)d_in[0]; a.c = (const float*)d_in[1]; a.ctx = (const float*)d_in[2]; a.c_ctx = (const float*)d_in[3]; a.w_ada = (const float*)d_in[4]; a.b_ada = (const float*)d_in[5];
    a.n1g = (const float*)d_in[6]; a.n2g = (const float*)d_in[7]; a.w_in = (const float*)d_in[8]; a.conv_w = (const float*)d_in[9]; a.sink = (const float*)d_in[10]; a.w_mix = (const float*)d_in[11];
    a.w_four = (const float*)d_in[12]; a.w_gate = (const float*)d_in[13]; a.w_up = (const float*)d_in[14]; a.w_down = (const float*)d_in[15]; a.final_g = (const float*)d_in[16];
    a.out = (float*)d_out; a.ws = (unsigned char*)d_ws;
    for (int f = 0; f < 16; ++f) a.invf[f] = pow(10000.0, -(double)f / 16.0);
    void* args[] = {&a};
    hipError_t e = hipLaunchCooperativeKernel((const void*)fwd_megakernel, dim3(grid), dim3(NTHR), args, LDS_BYTES, stream);
    if (e != hipSuccess) fprintf(stderr, "kernel_launch: cooperative launch failed: %s (grid %d)\n", hipGetErrorString(e), grid);
}
```

```cpp
#include <hip/hip_runtime.h>
#include <hip/hip_cooperative_groups.h>
#include <cstdio>
#include <cstdint>
#include <cmath>
namespace cg = cooperative_groups;

namespace pg8 {
#define PG8_LAS __attribute__((address_space(3)))
typedef unsigned short bf16_t;
typedef short bf16x8 __attribute__((ext_vector_type(8)));
typedef float f32x4 __attribute__((ext_vector_type(4)));
typedef unsigned u32x4 __attribute__((ext_vector_type(4)));
constexpr int BM = 256, BK = 64, HALF = 128, HTB = HALF * BK * 2  , STAGE_BYTES = 8 * HTB, NXCD = 8, WGM = 8;

__host__ __device__ __forceinline__ int lds_byte(int r, int c) { const int st = (r >> 4) * 2 + (c >> 5), rr = r & 15, cc = c & 31, ob = rr * 64 + cc * 2; return st * 1024 + (ob ^ (((ob >> 9) & 1) << 5)); }
__host__ __device__ __forceinline__ void stage_rc(int b, int& R, int& C) { const int st = b / 1024, sb = b % 1024, swz = sb ^ (((sb >> 9) & 1) << 5); R = (st >> 1) * 16 + swz / 64; C = (st & 1) * 32 + (swz % 64) / 2; }
__host__ __device__ __forceinline__ int perm32(int rho) { const int n = rho >> 4, i = rho & 15; return 8 * (i >> 2) + 4 * n + (i & 3); }

struct Unit { int pm, pn; };
struct Gemm { const bf16_t* A; const bf16_t* Bt; int M, N, K; };

struct StaticOrder {
    int nM, nN, nwg, G, c;
    __host__ __device__ void init(int M, int N, int G_, int c_) { nM = M / BM; nN = N / BM; nwg = nM * nN; G = G_; c = c_; }
    __host__ __device__ bool next(int i, Unit& u) const {
        const long L = (long)i * G + c; if (L >= nwg) return false;
        int wgid = (int)L; { const int q = nwg / NXCD, r = nwg % NXCD, xcd = wgid % NXCD, off = wgid / NXCD; wgid = (xcd < r ? xcd * (q + 1) : r * (q + 1) + (xcd - r) * q) + off; }
        const int nig = WGM * nN, gid = wgid / nig, fm = gid * WGM, gsz = (nM - fm) < WGM ? (nM - fm) : WGM;
        u.pm = fm + ((wgid % nig) % gsz); u.pn = (wgid % nig) / gsz; return true;
    }
    __device__ __forceinline__ void a_ready(const Unit&) const {}
    __device__ __forceinline__ void done(const Unit&) const {}
};

template <class Epi, class Sched, bool ALIGN_EPI = false, bool SP2 = false>
__device__ __forceinline__ void gemm_phase(PG8_LAS unsigned char* lds, const Gemm g, const Sched& S, const Epi& E, int tid_in) {
    const int tid = tid_in, wid = __builtin_amdgcn_readfirstlane(tid >> 6), lane = tid & 63, wr = wid >> 2, wc = wid & 3, fr = lane & 15, fq = lane >> 4;
    const int K = g.K, nt = K / BK;
    unsigned voffA[2], voffB[2];
#pragma unroll
    for (int i = 0; i < 2; ++i) { int R, C; stage_rc(tid * 16 + i * 8192, R, C); const int Rb = Epi::PERM ? ((R & ~31) + perm32(R & 31)) : R;
        voffA[i] = (unsigned)(R * K + C) * 2u; voffB[i] = (unsigned)(Rb * K + C) * 2u; }
    const size_t kstep = (size_t)(BK * 2);
    const size_t hstep = (size_t)HALF * K * 2;
    const size_t tstep = 2 * hstep;
    const unsigned ldsw = (unsigned)wid * 1024u;
    const int aoff = lds_byte(wr * 64 + fr, fq * 8), boff = lds_byte(wc * 32 + fr, fq * 8);
#define PG8_SA(b, h) (((b) * 2 + (h)) * HTB)
#define PG8_SB(b, h) ((4 + (b) * 2 + (h)) * HTB)
#define PG8_STAGE(bufoff, gbase, voff) do { _Pragma("unroll") for (int _i = 0; _i < 2; ++_i) \
        __builtin_amdgcn_global_load_lds((const unsigned*)((const char*)(gbase) + (voff)[_i]), (PG8_LAS unsigned*)(lds + (bufoff) + ldsw + _i * 8192), 16, 0, 0); } while (0)
#define PG8_LDA(dst, b, h) do { _Pragma("unroll") for (int m = 0; m < 4; ++m) _Pragma("unroll") for (int k = 0; k < 2; ++k) dst[m][k] = *(const PG8_LAS bf16x8*)(lds + PG8_SA(b, h) + aoff + m * 2048 + k * 1024); } while (0)
#define PG8_LDB(dst, b, h) do { _Pragma("unroll") for (int n = 0; n < 2; ++n) _Pragma("unroll") for (int k = 0; k < 2; ++k) dst[n][k] = *(const PG8_LAS bf16x8*)(lds + PG8_SB(b, h) + boff + n * 2048 + k * 1024); } while (0)
#define PG8_MMA(ai, bj, At, Bt) do { __builtin_amdgcn_s_setprio(1); _Pragma("unroll") for (int m = 0; m < 4; ++m) _Pragma("unroll") for (int n = 0; n < 2; ++n) _Pragma("unroll") for (int k = 0; k < 2; ++k) \
        acc[ai][bj][m][n] = __builtin_amdgcn_mfma_f32_16x16x32_bf16(Bt[n][k], At[m][k], acc[ai][bj][m][n], 0, 0, 0); __builtin_amdgcn_s_setprio(0); } while (0)
#define PG8_WAIT_V(n) asm volatile("s_waitcnt vmcnt(" #n ")" ::: "memory")
#define PG8_WAIT_L(n) asm volatile("s_waitcnt lgkmcnt(" #n ")" ::: "memory")
#define PG8_BAR __builtin_amdgcn_s_barrier()
#define PG8_SCHED __builtin_amdgcn_sched_barrier(0)
    Unit cur, nxt; int ui = 0;
    if (!S.next(0, cur)) return;
    f32x4 acc[2][2][4][2];
#pragma unroll
    for (int a = 0; a < 2; ++a)
#pragma unroll
        for (int b = 0; b < 2; ++b)
#pragma unroll
            for (int m = 0; m < 4; ++m)
#pragma unroll
                for (int n = 0; n < 2; ++n) acc[a][b][m][n] = (f32x4){0.f, 0.f, 0.f, 0.f};
    bf16x8 At[4][2], B0[2][2], B1[2][2];
    const char* cA = (const char*)g.A + (size_t)cur.pm * tstep; const char* cB = (const char*)g.Bt + (size_t)cur.pn * tstep;
    S.a_ready(cur);
    if constexpr (SP2) {
        PG8_STAGE(PG8_SB(0, 0), cB, voffB); PG8_STAGE(PG8_SB(0, 1), cB + hstep, voffB); PG8_STAGE(PG8_SA(0, 0), cA, voffA); PG8_STAGE(PG8_SA(0, 1), cA + hstep, voffA);
        if (wr == 1) PG8_BAR;
        PG8_WAIT_V(2); PG8_BAR;
        PG8_STAGE(PG8_SB(1, 0), cB + kstep, voffB); PG8_STAGE(PG8_SA(1, 0), cA + kstep, voffA); PG8_STAGE(PG8_SB(1, 1), cB + hstep + kstep, voffB);
        PG8_WAIT_V(6); PG8_BAR;
    } else {
        PG8_STAGE(PG8_SB(0, 0), cB, voffB); PG8_STAGE(PG8_SA(0, 0), cA, voffA); PG8_STAGE(PG8_SB(0, 1), cB + hstep, voffB); PG8_STAGE(PG8_SA(0, 1), cA + hstep, voffA);
        if (wr == 1) PG8_BAR;
        PG8_WAIT_V(4); PG8_BAR;
        PG8_STAGE(PG8_SB(1, 0), cB + kstep, voffB); PG8_STAGE(PG8_SA(1, 0), cA + kstep, voffA); PG8_STAGE(PG8_SB(1, 1), cB + hstep + kstep, voffB);
        PG8_WAIT_V(6); PG8_BAR;
    }
    for (;;) {
        const bool has_next = S.next(ui + 1, nxt);
        const char* nA = has_next ? (const char*)g.A + (size_t)nxt.pm * tstep : cA; const char* nB = has_next ? (const char*)g.Bt + (size_t)nxt.pn * tstep : cB;
        for (int t = 0; t < nt; t += 2) {
            const bool last = (t == nt - 2);
            const char* a1 = cA + (size_t)(t + 1) * kstep;
            const char* a2 = last ? nA : cA + (size_t)(t + 2) * kstep; const char* b2 = last ? nB : cB + (size_t)(t + 2) * kstep;
            const char* a3 = a2 + kstep; const char* b3 = b2 + kstep;
            if (last && has_next) S.a_ready(nxt);
            if constexpr (SP2) {
            PG8_LDB(B0, 0, 0); PG8_LDB(B1, 0, 1); PG8_SCHED; PG8_LDA(At, 0, 0); PG8_STAGE(PG8_SA(1, 1), a1 + hstep, voffA);
            PG8_WAIT_V(8); PG8_WAIT_L(0); PG8_BAR; PG8_MMA(0, 0, At, B0); PG8_MMA(0, 1, At, B1); PG8_BAR; PG8_SCHED;
            PG8_LDA(At, 0, 1); PG8_STAGE(PG8_SB(0, 0), b2, voffB); PG8_STAGE(PG8_SB(0, 1), b2 + hstep, voffB); PG8_STAGE(PG8_SA(0, 0), a2, voffA);
            PG8_WAIT_V(8); PG8_WAIT_L(0); PG8_BAR; PG8_MMA(1, 0, At, B0); PG8_MMA(1, 1, At, B1); PG8_BAR; PG8_SCHED;
            PG8_LDB(B0, 1, 0); PG8_LDB(B1, 1, 1); PG8_SCHED; PG8_LDA(At, 1, 0); PG8_STAGE(PG8_SA(0, 1), a2 + hstep, voffA);
            PG8_WAIT_V(8); PG8_WAIT_L(0); PG8_BAR; PG8_MMA(0, 0, At, B0); PG8_MMA(0, 1, At, B1); PG8_BAR; PG8_SCHED;
            PG8_LDA(At, 1, 1); PG8_STAGE(PG8_SB(1, 0), b3, voffB); PG8_STAGE(PG8_SB(1, 1), b3 + hstep, voffB); PG8_STAGE(PG8_SA(1, 0), a3, voffA);
            PG8_WAIT_V(8); PG8_WAIT_L(0); PG8_BAR; PG8_MMA(1, 0, At, B0); PG8_MMA(1, 1, At, B1); PG8_BAR; PG8_SCHED;
            } else {
            PG8_LDB(B0, 0, 0); PG8_SCHED; PG8_LDA(At, 0, 0); PG8_STAGE(PG8_SA(1, 1), a1 + hstep, voffA);
            PG8_WAIT_L(8); PG8_BAR; PG8_WAIT_L(0); PG8_MMA(0, 0, At, B0); PG8_BAR; PG8_SCHED;
            PG8_LDB(B1, 0, 1); PG8_STAGE(PG8_SB(0, 0), b2, voffB);
            PG8_BAR; PG8_WAIT_L(0); PG8_MMA(0, 1, At, B1); PG8_BAR;
            PG8_LDA(At, 0, 1); PG8_STAGE(PG8_SA(0, 0), a2, voffA);
            PG8_BAR; PG8_WAIT_L(0); PG8_MMA(1, 0, At, B0); PG8_BAR; PG8_SCHED;
            PG8_STAGE(PG8_SB(0, 1), b2 + hstep, voffB);
            PG8_WAIT_V(6); PG8_BAR; PG8_MMA(1, 1, At, B1); PG8_BAR;
            PG8_LDB(B0, 1, 0); PG8_SCHED; PG8_LDA(At, 1, 0); PG8_STAGE(PG8_SA(0, 1), a2 + hstep, voffA);
            PG8_WAIT_L(8); PG8_BAR; PG8_WAIT_L(0); PG8_MMA(0, 0, At, B0); PG8_BAR; PG8_SCHED;
            PG8_LDB(B1, 1, 1); PG8_STAGE(PG8_SB(1, 0), b3, voffB);
            PG8_BAR; PG8_WAIT_L(0); PG8_MMA(0, 1, At, B1); PG8_BAR;
            PG8_LDA(At, 1, 1); PG8_STAGE(PG8_SA(1, 0), a3, voffA);
            PG8_BAR; PG8_WAIT_L(0); PG8_MMA(1, 0, At, B0); PG8_BAR; PG8_SCHED;
            PG8_STAGE(PG8_SB(1, 1), b3 + hstep, voffB);
            PG8_WAIT_V(6); PG8_BAR; PG8_MMA(1, 1, At, B1); PG8_BAR;
            }
        }
        if constexpr (ALIGN_EPI) { if (wr == 0) PG8_BAR; }
        if constexpr (!Epi::AFTER_DRAIN) { E(acc, cur, wr, wc, fr, fq); S.done(cur); }
        if (!has_next) break;
#pragma unroll
        for (int a = 0; a < 2; ++a)
#pragma unroll
            for (int b = 0; b < 2; ++b)
#pragma unroll
                for (int m = 0; m < 4; ++m)
#pragma unroll
                    for (int n = 0; n < 2; ++n) acc[a][b][m][n] = (f32x4){0.f, 0.f, 0.f, 0.f};
        cur = nxt; cA = nA; cB = nB; ++ui;
        if constexpr (ALIGN_EPI) { if (wr == 1) PG8_BAR; }
    }
    PG8_WAIT_V(0);
    if constexpr (!ALIGN_EPI) { if (wr == 0) PG8_BAR; }
    PG8_BAR;
    if constexpr (Epi::AFTER_DRAIN) { E.fused(acc, cur, wr, wc, fr, fq, lds, wid, lane); S.done(cur); }
#undef PG8_SA
#undef PG8_SB
#undef PG8_STAGE
#undef PG8_LDA
#undef PG8_LDB
#undef PG8_MMA
#undef PG8_WAIT_V
#undef PG8_WAIT_L
#undef PG8_BAR
#undef PG8_SCHED
}
}

#define LAS __attribute__((address_space(3)))
typedef unsigned short bf16_t;
typedef short bf16x8 __attribute__((ext_vector_type(8)));
typedef float f32x4 __attribute__((ext_vector_type(4)));
typedef float f32x16 __attribute__((ext_vector_type(16)));
typedef unsigned u32x4 __attribute__((ext_vector_type(4)));
typedef unsigned u32x2 __attribute__((ext_vector_type(2)));

constexpr int DM = 1024, NBATCH = 16, SEQ = 4096, TLAT = NBATCH * SEQ, LCTX = 256, TCTX = NBATCH * LCTX, MALL = TLAT + TCTX;
constexpr int DFF = 2816, INW = 2304, NWAVES = 8, NTHR = 512;
constexpr int QS = 1536, KS_ = 2048, VS_ = 2176;
constexpr float C2 = 0.125f * 1.4426950408889634f, LOG2E = 1.4426950408889634f;
constexpr size_t MiB = 1u << 20;
constexpr size_t WS_MOD = 1 * MiB, WS_TAB = 3 * MiB, WS_WIN = 4 * MiB, WS_WMIX = 13 * MiB, WS_WF = 17 * MiB, WS_WGU = 21 * MiB, WS_WD = 65 * MiB;
constexpr size_t WS_XB = 800 * MiB  ;
constexpr size_t WS_XC = 88 * MiB, WS_H = 104 * MiB, WS_R = 240 * MiB;
constexpr size_t WS_P = WS_R, WS_CAT = WS_R + 306 * MiB, WS_ACT = WS_R, WS_Z1 = WS_R, WS_ZC = WS_R + 256 * MiB, WS_A1 = WS_R + 272 * MiB, WS_FM = WS_R, WS_END = 1024 * MiB;
constexpr size_t TAB_ROPE = 0, TAB_TW = 64 * 1024, TAB_D1 = 128 * 1024, TAB_D2 = 192 * 1024, TAB_DC = 256 * 1024, TAB_DCTX = 512 * 1024;
constexpr int LDS_BYTES = 147456;

typedef float f32x2_t __attribute__((ext_vector_type(2))); typedef __bf16 bf16x2_t __attribute__((ext_vector_type(2)));
__device__ __forceinline__ unsigned cvt_pk(float lo, float hi) { f32x2_t v = {lo, hi}; bf16x2_t b = __builtin_convertvector(v, bf16x2_t); return __builtin_bit_cast(unsigned, b); }
__device__ __forceinline__ float bf_lo(unsigned w) { return __builtin_bit_cast(float, w << 16); }
__device__ __forceinline__ float bf_hi(unsigned w) { return __builtin_bit_cast(float, w & 0xffff0000u); }
__device__ __forceinline__ float fast_exp2(float x) { return __builtin_amdgcn_exp2f(x); }
__device__ __forceinline__ float fast_rcp(float x) { return __builtin_amdgcn_rcpf(x); }
__device__ __forceinline__ float silu_f(float x) { return x * fast_rcp(1.0f + fast_exp2(-x * LOG2E)); }
typedef _Float16 h16x2_t __attribute__((ext_vector_type(2)));
__device__ __forceinline__ float h2f(unsigned lowbits) { float f; asm("v_cvt_f32_f16 %0, %1" : "=v"(f) : "v"(lowbits)); return f; }
__device__ __forceinline__ f32x4 xs_unpack(u32x2 h) { return (f32x4){h2f(h.x), h2f(h.x >> 16), h2f(h.y), h2f(h.y >> 16)}; }
typedef __fp16 fp16x2_t __attribute__((ext_vector_type(2)));
__device__ __forceinline__ u32x2 xs_pack(f32x4 v) { const fp16x2_t a = __builtin_amdgcn_cvt_pkrtz(v.x, v.y), b = __builtin_amdgcn_cvt_pkrtz(v.z, v.w); u32x2 r; r.x = __builtin_bit_cast(unsigned, a); r.y = __builtin_bit_cast(unsigned, b); return r; }
#define LDS_WAIT() asm volatile("s_waitcnt lgkmcnt(0)" ::: "memory")

struct Args {
    const float* x; const float* c; const float* ctx; const float* c_ctx; const float* w_ada; const float* b_ada; const float* n1g; const float* n2g;
    const float* w_in; const float* conv_w; const float* sink; const float* w_mix; const float* w_four; const float* w_gate; const float* w_up; const float* w_down; const float* final_g;
    float* out; unsigned char* ws;
    double invf[16];
};

struct EpiInProj {
    static constexpr bool PERM = false, AFTER_DRAIN = false;
    bf16_t* P; const float* rope;
    __device__ __forceinline__ void operator()(const f32x4 (&acc)[2][2][4][2], const pg8::Unit& u, int wr, int wc, int fr, int fq) const {
        const bool lat = u.pm < 256, doq = (u.pn == 6 || u.pn == 7), ropeT = lat && u.pn >= 6;
#pragma unroll
        for (int ai = 0; ai < 2; ++ai)
#pragma unroll
            for (int m = 0; m < 4; ++m) {
                const int row = u.pm * 256 + ai * 128 + wr * 64 + m * 16 + fr;
                f32x4 cv = {1.f, 1.f, 1.f, 1.f}, sv = {0.f, 0.f, 0.f, 0.f};
                if (ropeT) { const int t = row & 4095; const int a = (wc & 1) ? (t & 63) : (t >> 6);
                    const f32x4* rp = (const f32x4*)(rope + (a * 16 + 4 * fq) * 2); const f32x4 c0 = rp[0], c1 = rp[1];
                    cv = (f32x4){c0.x, c0.z, c1.x, c1.z}; sv = (f32x4){c0.y, c0.w, c1.y, c1.w}; }
#pragma unroll
                for (int bj = 0; bj < 2; ++bj) {
                    f32x4 x1 = acc[ai][bj][m][0], x2 = acc[ai][bj][m][1];
                    if (ropeT && !(u.pn == 8 && bj == 1)) { const f32x4 o1 = x1 * cv - x2 * sv, o2 = x2 * cv + x1 * sv; x1 = o1; x2 = o2; }
                    if (doq) { x1 = x1 * C2; x2 = x2 * C2; }
                    bf16_t* p = P + (size_t)row * INW + u.pn * 256 + bj * 128 + wc * 32 + 4 * fq;
                    u32x2 w1, w2; w1.x = cvt_pk(x1[0], x1[1]); w1.y = cvt_pk(x1[2], x1[3]); w2.x = cvt_pk(x2[0], x2[1]); w2.y = cvt_pk(x2[2], x2[3]);
                    *(u32x2*)p = w1; *(u32x2*)(p + 16) = w2;
                }
            }
    }
};
template <bool IN_F32> struct EpiRes {
    static constexpr bool PERM = false, AFTER_DRAIN = false;
    const float* in_lat; const float* in_ctx; bf16_t* xb; const float* modl; int gate_idx;
    __device__ __forceinline__ void operator()(const f32x4 (&acc)[2][2][4][2], const pg8::Unit& u, int wr, int wc, int fr, int fq) const {
        const bool lat = u.pm < 256; const int rbase = lat ? u.pm * 256 : u.pm * 256 - TLAT; const int r = lat ? (u.pm >> 4) : 16;
        const float* ip = lat ? in_lat : in_ctx;
        const float* gate = modl + (r * 6 + gate_idx) * 1024;
        const int col0 = u.pn * 256 + wc * 32 + 4 * fq;
        f32x4 gv[2][2];
#pragma unroll
        for (int bj = 0; bj < 2; ++bj)
#pragma unroll
            for (int n = 0; n < 2; ++n) gv[bj][n] = *(const f32x4*)(gate + col0 + bj * 128 + 16 * n);
        const size_t offi = (size_t)(rbase + wr * 64 + fr) * DM + col0;
        const size_t offx = (size_t)(u.pm * 256 + wr * 64 + fr) * DM + col0;
        f32x4 xf[2][2][2]; u32x2 xh[2][2][2];
#pragma unroll
        for (int bj = 0; bj < 2; ++bj)
#pragma unroll
            for (int n = 0; n < 2; ++n) { if (IN_F32) xf[0][bj][n] = *(const f32x4*)(ip + offi + bj * 128 + 16 * n); else xh[0][bj][n] = *(const u32x2*)(xb + offx + bj * 128 + 16 * n); }
#pragma unroll
        for (int grp = 0; grp < 8; ++grp) {
            const int ai = grp >> 2, m = grp & 3, cb = grp & 1;
            const size_t roff = (size_t)(ai * 128 + m * 16) * DM;
            if (grp < 7) { const int ai2 = (grp + 1) >> 2, m2 = (grp + 1) & 3; const size_t rn = (size_t)(ai2 * 128 + m2 * 16) * DM;
#pragma unroll
                for (int bj = 0; bj < 2; ++bj)
#pragma unroll
                    for (int n = 0; n < 2; ++n) { if (IN_F32) xf[cb ^ 1][bj][n] = *(const f32x4*)(ip + offi + rn + bj * 128 + 16 * n); else xh[cb ^ 1][bj][n] = *(const u32x2*)(xb + offx + rn + bj * 128 + 16 * n); } }
            asm volatile("" ::: "memory");
#pragma unroll
            for (int bj = 0; bj < 2; ++bj)
#pragma unroll
                for (int n = 0; n < 2; ++n) {
                    f32x4 xi; if (IN_F32) xi = xf[cb][bj][n]; else xi = xs_unpack(xh[cb][bj][n]);
                    const f32x4 xo = xi + gv[bj][n] * acc[ai][bj][m][n];
                    *(u32x2*)(xb + offx + roff + bj * 128 + 16 * n) = xs_pack(xo); }
            asm volatile("" ::: "memory");
        }
    }
};
struct EpiSwiGLU {
    static constexpr bool PERM = false, AFTER_DRAIN = false;
    bf16_t* ACT;
    __device__ __forceinline__ void operator()(const f32x4 (&acc)[2][2][4][2], const pg8::Unit& u, int wr, int wc, int fr, int fq) const {
#pragma unroll
        for (int ai = 0; ai < 2; ++ai)
#pragma unroll
            for (int m = 0; m < 4; ++m) {
                const int row = u.pm * 256 + ai * 128 + wr * 64 + m * 16 + fr;
#pragma unroll
                for (int bj = 0; bj < 2; ++bj) {
                    const f32x4 g = acc[ai][bj][m][0], v = acc[ai][bj][m][1];
                    const int f = (u.pn * 8 + bj * 4 + wc) * 16 + 4 * fq;
                    u32x2 w; w.x = cvt_pk(silu_f(g[0]) * v[0], silu_f(g[1]) * v[1]); w.y = cvt_pk(silu_f(g[2]) * v[2], silu_f(g[3]) * v[3]);
                    *(u32x2*)(ACT + (size_t)row * DFF + f) = w;
                }
            }
    }
};
struct EpiPlain {
    static constexpr bool PERM = false, AFTER_DRAIN = false;
    bf16_t* O; int ldc;
    __device__ __forceinline__ void operator()(const f32x4 (&acc)[2][2][4][2], const pg8::Unit& u, int wr, int wc, int fr, int fq) const {
#pragma unroll
        for (int ai = 0; ai < 2; ++ai)
#pragma unroll
            for (int m = 0; m < 4; ++m) {
                const int row = u.pm * 256 + ai * 128 + wr * 64 + m * 16 + fr;
#pragma unroll
                for (int bj = 0; bj < 2; ++bj)
#pragma unroll
                    for (int n = 0; n < 2; ++n) {
                        const f32x4 x = acc[ai][bj][m][n]; u32x2 w; w.x = cvt_pk(x[0], x[1]); w.y = cvt_pk(x[2], x[3]);
                        *(u32x2*)(O + (size_t)row * ldc + u.pn * 256 + bj * 128 + wc * 32 + 16 * n + 4 * fq) = w;
                    }
            }
    }
};

__device__ __forceinline__ void sincos_turns(double x, double& s, double& c) {
    x = x - floor(x);
    const double q4 = floor(x * 4.0 + 0.5);
    const double r = x - q4 * 0.25;
    const int q = ((int)q4) & 3;
    const double th = r * 6.283185307179586476925, t2 = th * th;
    const double sp = th * (1.0 + t2 * (-1.0 / 6 + t2 * (1.0 / 120 + t2 * (-1.0 / 5040 + t2 * (1.0 / 362880 + t2 * (-1.0 / 39916800 + t2 * (1.0 / 6227020800.0)))))));
    const double cp = 1.0 + t2 * (-0.5 + t2 * (1.0 / 24 + t2 * (-1.0 / 720 + t2 * (1.0 / 40320 + t2 * (-1.0 / 3628800 + t2 * (1.0 / 479001600.0 + t2 * (-1.0 / 87178291200.0)))))));
    if (q == 0) { s = sp; c = cp; } else if (q == 1) { s = cp; c = -sp; } else if (q == 2) { s = -sp; c = -cp; } else { s = -cp; c = sp; }
}
__device__ __forceinline__ unsigned short f2bf(float f) { return __builtin_bit_cast(unsigned short, (__bf16)f); }

__device__ __forceinline__ void transpose_item(const float* W, int K, int N, bf16_t* WT, int mode, LAS float* scr, int item, int lane) {
    const int nblk = N / 32, kb = item / nblk, nb = item % nblk, k0 = 64 * kb, n0 = 32 * nb;
#pragma unroll 8
    for (int i = 0; i < 32; ++i) { const int kk = 2 * i + (lane >> 5); scr[kk * 33 + (lane & 31)] = W[(size_t)(k0 + kk) * N + n0 + (lane & 31)]; }
    LDS_WAIT(); asm volatile("" ::: "memory");
    const int c = lane & 7;
#pragma unroll
    for (int j = 0; j < 4; ++j) { const int n = (lane >> 3) + 8 * j; const LAS float* s = scr + (8 * c) * 33 + n;
        u32x4 o; o.x = cvt_pk(s[0 * 33], s[1 * 33]); o.y = cvt_pk(s[2 * 33], s[3 * 33]); o.z = cvt_pk(s[4 * 33], s[5 * 33]); o.w = cvt_pk(s[6 * 33], s[7 * 33]);
        const int f = n0 + n; const int orow = (mode == 0) ? f : (((f >> 4) << 5) + (f & 15) + (mode == 2 ? 16 : 0));
        *(u32x4*)(WT + (size_t)orow * K + k0 + 8 * c) = o; }
    LDS_WAIT(); asm volatile("" ::: "memory");
}

__device__ __forceinline__ void prologue(const Args& A, LAS unsigned char* lds, int tid, int wave, int lane, int G) {
    unsigned char* ws = A.ws;
    {
        LAS float* scr = (LAS float*)(lds + wave * 16384);
        const int gw = blockIdx.x * NWAVES + wave, NGW = G * NWAVES;
        constexpr int I_IN = 16 * 72, I_SQ = 16 * 32, I_FF = 16 * 88, I_DN = 44 * 32;
        constexpr int NIT = 2 * I_IN + 4 * I_SQ + 8 * I_FF + 4 * I_DN;
        for (int it = gw; it < NIT; it += NGW) {
            int r = it;
            if (r < 2 * I_IN) { const int e = r / I_IN; transpose_item(A.w_in + (size_t)e * DM * INW, DM, INW, (bf16_t*)(ws + WS_WIN) + (size_t)e * INW * DM, 0, scr, r % I_IN, lane); continue; } r -= 2 * I_IN;
            if (r < 2 * I_SQ) { const int e = r / I_SQ; transpose_item(A.w_mix + (size_t)e * DM * DM, DM, DM, (bf16_t*)(ws + WS_WMIX) + (size_t)e * DM * DM, 0, scr, r % I_SQ, lane); continue; } r -= 2 * I_SQ;
            if (r < 2 * I_SQ) { const int e = r / I_SQ; transpose_item(A.w_four + (size_t)e * DM * DM, DM, DM, (bf16_t*)(ws + WS_WF) + (size_t)e * DM * DM, 0, scr, r % I_SQ, lane); continue; } r -= 2 * I_SQ;
            if (r < 4 * I_FF) { const int l = r / I_FF; transpose_item(A.w_gate + (size_t)l * DM * DFF, DM, DFF, (bf16_t*)(ws + WS_WGU) + (size_t)l * 2 * DFF * DM, 1, scr, r % I_FF, lane); continue; } r -= 4 * I_FF;
            if (r < 4 * I_FF) { const int l = r / I_FF; transpose_item(A.w_up + (size_t)l * DM * DFF, DM, DFF, (bf16_t*)(ws + WS_WGU) + (size_t)l * 2 * DFF * DM, 2, scr, r % I_FF, lane); continue; } r -= 4 * I_FF;
            { const int l = r / I_DN; transpose_item(A.w_down + (size_t)l * DFF * DM, DFF, DM, (bf16_t*)(ws + WS_WD) + (size_t)l * DM * DFF, 0, scr, r % I_DN, lane); }
        }
    }
    {
        const int gt = blockIdx.x * NTHR + tid, NGT = G * NTHR;
        float* rope = (float*)(ws + WS_TAB + TAB_ROPE); float* tw = (float*)(ws + WS_TAB + TAB_TW);
        bf16_t* D1 = (bf16_t*)(ws + WS_TAB + TAB_D1); bf16_t* D2 = (bf16_t*)(ws + WS_TAB + TAB_D2); bf16_t* DC = (bf16_t*)(ws + WS_TAB + TAB_DC); bf16_t* DX = (bf16_t*)(ws + WS_TAB + TAB_DCTX);
        constexpr int N_ROPE = 1024, N_TW = 4096, N_D1 = 16384, N_D2 = 8192, N_DC = 131072, N_DX = 131072;
        for (int i = gt; i < N_ROPE + N_TW + N_D1 + N_D2 + N_DC + N_DX; i += NGT) {
            int r = i; double s, c;
            if (r < N_ROPE) { const int a = r >> 4, f = r & 15; sincos_turns((double)a * A.invf[f] * 0.15915494309189533577, s, c); rope[2 * r] = (float)c; rope[2 * r + 1] = (float)s; continue; } r -= N_ROPE;
            if (r < N_TW) { const int k1 = r >> 6, n2 = r & 63; sincos_turns((double)(k1 * n2) / 4096.0, s, c); tw[2 * r] = (float)c; tw[2 * r + 1] = (float)s; continue; } r -= N_TW;
            if (r < N_D1) { const int row = r >> 7, col = r & 127, k1 = row >> 1, rio = row & 1, rii = col >> 6, n1 = col & 63; sincos_turns((double)((k1 * n1) & 63) / 64.0, s, c);
                const double v = (rio == rii) ? c : (rio == 0 ? s : -s); D1[r] = f2bf((float)(v * 0.125)); continue; } r -= N_D1;
            if (r < N_D2) { const int k2 = r >> 7, col = r & 127, ri = col >> 6, n2 = col & 63; sincos_turns((double)((k2 * n2) & 63) / 64.0, s, c); D2[r] = f2bf((float)((ri ? s : c) * 0.125)); continue; } r -= N_D2;
            if (r < N_DC) { const int row = r >> 8, cc = r & 255, ri = row >> 8, m = row & 255; sincos_turns((double)((m * cc) & 255) / 256.0, s, c); DC[r] = f2bf((float)((ri ? -s : c) * 0.0625)); continue; } r -= N_DC;
            { const int k = r >> 9, col = r & 511, ri = col >> 8, n = col & 255; sincos_turns((double)((k * n) & 255) / 256.0, s, c); DX[r] = f2bf((float)((ri ? s : c) * 0.0625)); }
        }
    }
    __syncthreads();
    {
        LAS float* S = (LAS float*)lds; LAS float* Pp = (LAS float*)(lds + 69632);
        for (int i = tid; i < 17 * 1024; i += NTHR) { const int r = i >> 10, k = i & 1023; const float v = (r < 16) ? A.c[r * 1024 + k] : A.c_ctx[k]; S[i] = v / (1.0f + expf(-v)); }
        __syncthreads();
        float* mod = (float*)(ws + WS_MOD);
        for (int task = blockIdx.x; task < 4 * 96; task += G) {
            const int l = task / 96, j0 = (task % 96) * 64;
            const float* w = A.w_ada + (size_t)l * 1024 * 6144 + j0 + lane;
            float acc[17];
#pragma unroll
            for (int r = 0; r < 17; ++r) acc[r] = 0.f;
#pragma unroll 4
            for (int kk = 0; kk < 128; ++kk) { const int k = wave * 128 + kk; const float wv = w[(size_t)k * 6144];
#pragma unroll
                for (int r = 0; r < 17; ++r) acc[r] += S[r * 1024 + k] * wv; }
#pragma unroll
            for (int r = 0; r < 17; ++r) Pp[(wave * 17 + r) * 64 + lane] = acc[r];
            __syncthreads();
            for (int o = tid; o < 17 * 64; o += NTHR) { const int r = o >> 6, jj = o & 63; float sum = 0.f;
#pragma unroll
                for (int w8 = 0; w8 < 8; ++w8) sum += Pp[(w8 * 17 + r) * 64 + jj];
                mod[(size_t)(l * 17 + r) * 6144 + j0 + jj] = sum + A.b_ada[l * 6144 + j0 + jj]; }
            __syncthreads();
        }
    }
}

template <bool IN_F32> __device__ __forceinline__ void norm_ld(f32x4 (&v)[4], const float* lat, const float* ctxp, const bf16_t* xb, int row, int lane) {
    if (IN_F32) { const float* xr = (row < TLAT) ? lat + (size_t)row * DM : ctxp + (size_t)(row - TLAT) * DM;
#pragma unroll
        for (int j = 0; j < 4; ++j) v[j] = *(const f32x4*)(xr + 4 * lane + 256 * j); }
    else {
#pragma unroll
        for (int j = 0; j < 4; ++j) { v[j] = xs_unpack(*(const u32x2*)(xb + (size_t)row * DM + 4 * lane + 256 * j)); } }
}
template <bool IN_F32> __device__ __forceinline__ void norm_phase(const float* lat, const float* ctxp, const bf16_t* xb, const float* g, const float* modl, int shift_idx, bf16_t* hout, int M, int gw, int NGW, int lane) {
    constexpr int NR = 2;
    const int rpw = M / NGW, rbeg = gw * rpw, rend = rbeg + rpw;
    f32x4 gv[4];
#pragma unroll
    for (int j = 0; j < 4; ++j) gv[j] = *(const f32x4*)(g + 4 * lane + 256 * j);
    f32x4 vc[NR][4], vn[NR][4], scv[4], shv[4]; int rcur = -1;
#pragma unroll
    for (int q = 0; q < NR; ++q) norm_ld<IN_F32>(vc[q], lat, ctxp, xb, rbeg + q, lane);
    for (int row0 = rbeg; row0 < rend; row0 += NR) {
        const int r = (row0 < TLAT) ? (row0 >> 12) : 16;
        if (r != rcur) { rcur = r; const float* sh = modl + (r * 6 + shift_idx) * 1024; const float* sc = sh + 1024;
#pragma unroll
            for (int j = 0; j < 4; ++j) { scv[j] = (*(const f32x4*)(sc + 4 * lane + 256 * j) + 1.0f) * gv[j]; shv[j] = *(const f32x4*)(sh + 4 * lane + 256 * j); } }
        if (row0 + NR < rend) {
#pragma unroll
            for (int q = 0; q < NR; ++q) norm_ld<IN_F32>(vn[q], lat, ctxp, xb, row0 + NR + q, lane); }
        asm volatile("" ::: "memory");
#pragma unroll
        for (int q = 0; q < NR; ++q) { float ss = 0.f;
#pragma unroll
            for (int j = 0; j < 4; ++j) ss += (vc[q][j].x * vc[q][j].x + vc[q][j].y * vc[q][j].y) + (vc[q][j].z * vc[q][j].z + vc[q][j].w * vc[q][j].w);
#pragma unroll
            for (int o = 1; o < 64; o <<= 1) ss += __shfl_xor(ss, o);
            const float rstd = 1.0f / sqrtf(ss * (1.0f / DM) + 1e-6f);
#pragma unroll
            for (int j = 0; j < 4; ++j) { const f32x4 o = vc[q][j] * rstd * scv[j] + shv[j];
                u32x2 w; w.x = cvt_pk(o.x, o.y); w.y = cvt_pk(o.z, o.w);
                *(u32x2*)(hout + (size_t)(row0 + q) * DM + 4 * lane + 256 * j) = w; } }
        asm volatile("" ::: "memory");
#pragma unroll
        for (int q = 0; q < NR; ++q)
#pragma unroll
            for (int j = 0; j < 4; ++j) vc[q][j] = vn[q][j];
    }
}
__device__ __forceinline__ void final_norm_phase(const bf16_t* xb, float* xo, const float* g, int gw, int NGW, int lane) {
    constexpr int NR = 2;
    const int rpw = TLAT / NGW, rbeg = gw * rpw, rend = rbeg + rpw;
    f32x4 gv[4];
#pragma unroll
    for (int j = 0; j < 4; ++j) gv[j] = *(const f32x4*)(g + 4 * lane + 256 * j);
    f32x4 vc[NR][4], vn[NR][4];
#pragma unroll
    for (int q = 0; q < NR; ++q) norm_ld<false>(vc[q], nullptr, nullptr, xb, rbeg + q, lane);
    for (int row0 = rbeg; row0 < rend; row0 += NR) {
        if (row0 + NR < rend) {
#pragma unroll
            for (int q = 0; q < NR; ++q) norm_ld<false>(vn[q], nullptr, nullptr, xb, row0 + NR + q, lane); }
        asm volatile("" ::: "memory");
#pragma unroll
        for (int q = 0; q < NR; ++q) { float ss = 0.f;
#pragma unroll
            for (int j = 0; j < 4; ++j) ss += (vc[q][j].x * vc[q][j].x + vc[q][j].y * vc[q][j].y) + (vc[q][j].z * vc[q][j].z + vc[q][j].w * vc[q][j].w);
#pragma unroll
            for (int o = 1; o < 64; o <<= 1) ss += __shfl_xor(ss, o);
            const float rstd = 1.0f / sqrtf(ss * (1.0f / DM) + 1e-6f);
#pragma unroll
            for (int j = 0; j < 4; ++j) *(f32x4*)(xo + (size_t)(row0 + q) * DM + 4 * lane + 256 * j) = vc[q][j] * rstd * gv[j]; }
        asm volatile("" ::: "memory");
#pragma unroll
        for (int q = 0; q < NR; ++q)
#pragma unroll
            for (int j = 0; j < 4; ++j) vc[q][j] = vn[q][j];
    }
}

__device__ __forceinline__ int crow(int r, int hi) { return (r & 3) + 8 * (r >> 2) + 4 * hi; }

__device__ __forceinline__ void attn_phase(LAS unsigned char* lds, const bf16_t* P, bf16_t* cat, const float* sink, bool ctxq, int G, int tid, int wave, int lane) {
    constexpr int KROW = 144, VROW = 264;
    LAS unsigned char* Kl = lds; LAS unsigned char* Vl = lds + 128 * KROW;
    const int r32 = lane & 31, hi = lane >> 5, g = wave & 3, qh = wave >> 2;
    const int nitems = 1024 + (ctxq ? 64 : 0);
    for (int it = blockIdx.x; it < nitems; it += G) {
        int b, hk, qb, qr0; const bool isl = it < 1024;
        if (isl) { b = it >> 6; hk = (it >> 5) & 1; qb = it & 31; qr0 = b * SEQ + qb * 128; }
        else { const int j = it - 1024; b = j >> 2; hk = (j >> 1) & 1; qb = j & 1; qr0 = TLAT + b * LCTX + qb * 128; }
        const int crow0 = TLAT + b * LCTX, head = hk * 4 + g;
        bf16x8 qf[2][4];
#pragma unroll
        for (int s = 0; s < 2; ++s)
#pragma unroll
            for (int ks = 0; ks < 4; ++ks) qf[s][ks] = *(const bf16x8*)(P + (size_t)(qr0 + 64 * qh + 32 * s + r32) * INW + QS + head * 64 + 16 * ks + 8 * hi);
        float mrun[2], lrun[2]; f32x16 O[2][2];
        const float sk2 = sink[head] * LOG2E;
#pragma unroll
        for (int s = 0; s < 2; ++s) { mrun[s] = sk2; lrun[s] = 1.0f;
#pragma unroll
            for (int dt = 0; dt < 2; ++dt)
#pragma unroll
                for (int r = 0; r < 16; ++r) O[s][dt][r] = 0.f; }
#pragma unroll 1
        for (int ti = 0; ti < 5; ++ti) {
            int krow0, mtype = 0; bool valid = true;
            if (ti == 0) { krow0 = qr0 - 128; mtype = 1; valid = isl && qb > 0; }
            else if (ti == 1) { krow0 = qr0; valid = isl; }
            else if (ti == 2) { krow0 = qr0 + 128; mtype = 2; valid = isl && qb < 31; }
            else { krow0 = crow0 + (ti - 3) * 128; }
            if (!valid) continue;
            __syncthreads();
#pragma unroll
            for (int i = 0; i < 2; ++i) { const int id = tid + NTHR * i, key = id >> 3, c = id & 7;
                const u32x4 v = *(const u32x4*)(P + (size_t)(krow0 + key) * INW + KS_ + hk * 64 + 8 * c);
                *(LAS u32x4*)(Kl + key * KROW + c * 16) = v; }
#pragma unroll
            for (int i = 0; i < 2; ++i) { const int id = tid + NTHR * i, key = id & 127, c = id >> 7;
                const u32x4 v = *(const u32x4*)(P + (size_t)(krow0 + key) * INW + VS_ + hk * 64 + 8 * c);
                LAS unsigned char* vp = Vl + (8 * c) * VROW + key * 2;
                *(LAS unsigned short*)(vp + 0 * VROW) = (unsigned short)(v.x & 0xffffu); *(LAS unsigned short*)(vp + 1 * VROW) = (unsigned short)(v.x >> 16);
                *(LAS unsigned short*)(vp + 2 * VROW) = (unsigned short)(v.y & 0xffffu); *(LAS unsigned short*)(vp + 3 * VROW) = (unsigned short)(v.y >> 16);
                *(LAS unsigned short*)(vp + 4 * VROW) = (unsigned short)(v.z & 0xffffu); *(LAS unsigned short*)(vp + 5 * VROW) = (unsigned short)(v.z >> 16);
                *(LAS unsigned short*)(vp + 6 * VROW) = (unsigned short)(v.w & 0xffffu); *(LAS unsigned short*)(vp + 7 * VROW) = (unsigned short)(v.w >> 16); }
            __syncthreads();
#pragma unroll
            for (int half = 0; half < 2; ++half)
#pragma unroll
                for (int s = 0; s < 2; ++s) {
                    f32x16 S[2];
#pragma unroll
                    for (int rt = 0; rt < 2; ++rt) {
#pragma unroll
                        for (int r = 0; r < 16; ++r) S[rt][r] = 0.f;
#ifndef DIAG
                        asm volatile("" : "+v"(S[rt]));
#endif
#pragma unroll
                        for (int ks = 0; ks < 4; ++ks) { const bf16x8 kf = *(const LAS bf16x8*)(Kl + (64 * half + 32 * rt + r32) * KROW + (16 * ks + 8 * hi) * 2);
                            S[rt] = __builtin_amdgcn_mfma_f32_32x32x16_bf16(kf, qf[s][ks], S[rt], 0, 0, 0); }
                    }
                    if (mtype != 0) { int il = 64 * qh + 32 * s + r32; asm volatile("" : "+v"(il));
#pragma unroll
                        for (int rt = 0; rt < 2; ++rt)
#pragma unroll
                            for (int r = 0; r < 16; ++r) { const int jl = 64 * half + 32 * rt + crow(r, hi); const bool ok = (mtype == 1) ? (jl >= il) : (jl <= il); if (!ok) S[rt][r] = -INFINITY; } }
                    float tmax = S[0][0];
#pragma unroll
                    for (int rt = 0; rt < 2; ++rt)
#pragma unroll
                        for (int r = 0; r < 16; ++r) tmax = fmaxf(tmax, S[rt][r]);
                    tmax = fmaxf(tmax, __shfl_xor(tmax, 32));
                    const float mnew = fmaxf(mrun[s], tmax), alpha = fast_exp2(mrun[s] - mnew);
                    mrun[s] = mnew;
                    float psum = 0.f;
#pragma unroll
                    for (int rt = 0; rt < 2; ++rt)
#pragma unroll
                        for (int r = 0; r < 16; ++r) { const float p = fast_exp2(S[rt][r] - mnew); S[rt][r] = p; psum += p; }
                    psum += __shfl_xor(psum, 32);
                    lrun[s] = lrun[s] * alpha + psum;
#pragma unroll
                    for (int dt = 0; dt < 2; ++dt)
#pragma unroll
                        for (int r = 0; r < 16; ++r) O[s][dt][r] *= alpha;
#pragma unroll
                    for (int rt = 0; rt < 2; ++rt)
#pragma unroll
                        for (int s2 = 0; s2 < 2; ++s2) {
                            u32x4 pw; pw.x = cvt_pk(S[rt][8 * s2 + 0], S[rt][8 * s2 + 1]); pw.y = cvt_pk(S[rt][8 * s2 + 2], S[rt][8 * s2 + 3]);
                            pw.z = cvt_pk(S[rt][8 * s2 + 4], S[rt][8 * s2 + 5]); pw.w = cvt_pk(S[rt][8 * s2 + 6], S[rt][8 * s2 + 7]);
                            const bf16x8 pf = __builtin_bit_cast(bf16x8, pw);
#pragma unroll
                            for (int dt = 0; dt < 2; ++dt) {
                                const LAS unsigned char* vb = Vl + (32 * dt + r32) * VROW + (64 * half + 32 * rt + 16 * s2 + 4 * hi) * 2;
                                const u32x2 v0 = *(const LAS u32x2*)vb, v1 = *(const LAS u32x2*)(vb + 16);
                                const u32x4 vv = {v0.x, v0.y, v1.x, v1.y};
                                O[s][dt] = __builtin_amdgcn_mfma_f32_32x32x16_bf16(__builtin_bit_cast(bf16x8, vv), pf, O[s][dt], 0, 0, 0);
                            }
                        }
                }
        }
#pragma unroll
        for (int s = 0; s < 2; ++s) { const float inv = 1.0f / lrun[s];
            bf16_t* orow = cat + (size_t)(qr0 + 64 * qh + 32 * s + r32) * DM + 512 + head * 64;
#pragma unroll
            for (int dt = 0; dt < 2; ++dt)
#pragma unroll
                for (int q4 = 0; q4 < 4; ++q4) { u32x2 w; w.x = cvt_pk(O[s][dt][4 * q4 + 0] * inv, O[s][dt][4 * q4 + 1] * inv); w.y = cvt_pk(O[s][dt][4 * q4 + 2] * inv, O[s][dt][4 * q4 + 3] * inv);
                    *(u32x2*)(orow + 32 * dt + 8 * q4 + 4 * hi) = w; } }
    }
    __syncthreads();
}

__device__ __forceinline__ void load_u(const bf16_t* P, int t, int s0, int s1, int c8, float (&u)[8]) {
    if (t < s0 || t >= s1) {
#pragma unroll
        for (int j = 0; j < 8; ++j) u[j] = 0.f;
    } else {
        const u32x4 cv = *(const u32x4*)(P + (size_t)t * INW + 512 + 8 * c8), hv = *(const u32x4*)(P + (size_t)t * INW + 1024 + 8 * c8);
        u[0] = bf_lo(cv.x) * bf_lo(hv.x); u[1] = bf_hi(cv.x) * bf_hi(hv.x); u[2] = bf_lo(cv.y) * bf_lo(hv.y); u[3] = bf_hi(cv.y) * bf_hi(hv.y);
        u[4] = bf_lo(cv.z) * bf_lo(hv.z); u[5] = bf_hi(cv.z) * bf_hi(hv.z); u[6] = bf_lo(cv.w) * bf_lo(hv.w); u[7] = bf_hi(cv.w) * bf_hi(hv.w);
    }
}
__device__ __forceinline__ void cvt8(const u32x4 v, float (&f)[8]) { f[0] = bf_lo(v.x); f[1] = bf_hi(v.x); f[2] = bf_lo(v.y); f[3] = bf_hi(v.y); f[4] = bf_lo(v.z); f[5] = bf_hi(v.z); f[6] = bf_lo(v.w); f[7] = bf_hi(v.w); }
__device__ __forceinline__ void conv_phase(const bf16_t* P, bf16_t* cat, const float* cw, int M, int G, int tid) {
    const int c8 = tid & 63, tg = tid >> 6;
    float w0[8], w1[8], w2[8];
#pragma unroll
    for (int j = 0; j < 8; ++j) { w0[j] = cw[8 * c8 + j]; w1[j] = cw[512 + 8 * c8 + j]; w2[j] = cw[1024 + 8 * c8 + j]; }
    for (int it = blockIdx.x; it < M / 128; it += G) {
        const int t0 = it * 128, ts = t0 + 16 * tg;
        int s0, s1; if (t0 < TLAT) { s0 = t0 & ~4095; s1 = s0 + 4096; } else { s0 = TLAT + ((t0 - TLAT) & ~255); s1 = s0 + 256; }
        float up[8], uc[8];
        load_u(P, ts - 1, s0, s1, c8, up); load_u(P, ts, s0, s1, c8, uc);
#pragma unroll 1
        for (int i = 0; i < 16; i += 4) {
            const int t = ts + i;
            u32x4 bv[4], cv[4], hv[4];
#pragma unroll
            for (int q = 0; q < 4; ++q) { bv[q] = *(const u32x4*)(P + (size_t)(t + q) * INW + 8 * c8);
                const int tq = (t + q + 1 < s1) ? t + q + 1 : t + q;
                cv[q] = *(const u32x4*)(P + (size_t)tq * INW + 512 + 8 * c8); hv[q] = *(const u32x4*)(P + (size_t)tq * INW + 1024 + 8 * c8); }
            asm volatile("" ::: "memory");
#pragma unroll
            for (int q = 0; q < 4; ++q) {
                float cf[8], hf[8], bb[8], un[8], o[8]; cvt8(cv[q], cf); cvt8(hv[q], hf); cvt8(bv[q], bb);
                const bool inb = (t + q + 1 < s1);
#pragma unroll
                for (int j = 0; j < 8; ++j) { un[j] = inb ? cf[j] * hf[j] : 0.f; o[j] = bb[j] * (w0[j] * up[j] + w1[j] * uc[j] + w2[j] * un[j]); up[j] = uc[j]; uc[j] = un[j]; }
                u32x4 w; w.x = cvt_pk(o[0], o[1]); w.y = cvt_pk(o[2], o[3]); w.z = cvt_pk(o[4], o[5]); w.w = cvt_pk(o[6], o[7]);
                *(u32x4*)(cat + (size_t)(t + q) * DM + 8 * c8) = w; }
            asm volatile("" ::: "memory");
        }
    }
}

template <int MT, int KS> __device__ __forceinline__ void dft_load_a(bf16x8 (&a)[MT][KS], const bf16_t* Mat, int row0, int r32, int hi) {
#pragma unroll
    for (int rt = 0; rt < MT; ++rt)
#pragma unroll
        for (int ks = 0; ks < KS; ++ks) a[rt][ks] = *(const bf16x8*)(Mat + (size_t)(row0 + 32 * rt + r32) * (KS * 16) + 16 * ks + 8 * hi);
}
template <int MT, int KS> __device__ __forceinline__ void dft_mm(f32x16 (&acc)[MT], const bf16x8 (&a)[MT][KS], const bf16_t* vec) {
#pragma unroll
    for (int rt = 0; rt < MT; ++rt)
#pragma unroll
        for (int r = 0; r < 16; ++r) acc[rt][r] = 0.f;
#pragma unroll
    for (int rt = 0; rt < MT; ++rt) asm volatile("" : "+v"(acc[rt]));
    constexpr int KC = 8;
#pragma unroll
    for (int kc = 0; kc < KS / KC; ++kc) {
        bf16x8 b[KC];
#pragma unroll
        for (int i = 0; i < KC; ++i) b[i] = *(const bf16x8*)(vec + 16 * (kc * KC + i));
#pragma unroll
        for (int i = 0; i < KC; ++i)
#pragma unroll
            for (int rt = 0; rt < MT; ++rt) acc[rt] = __builtin_amdgcn_mfma_f32_32x32x16_bf16(a[rt][kc * KC + i], b[i], acc[rt], 0, 0, 0);
    }
}
__device__ __forceinline__ void store_pair(bf16_t* base, size_t zoo, unsigned cA, unsigned cB, float va, float vb, bool odd) {
    const float keep = odd ? vb : va, send = odd ? va : vb;
    const float got = __builtin_bit_cast(float, __builtin_amdgcn_mov_dpp(__builtin_bit_cast(int, send), 0xB1, 0xf, 0xf, true));
    const unsigned w = odd ? cvt_pk(got, keep) : cvt_pk(keep, got);
    *(unsigned*)(base + zoo + (odd ? cB : cA)) = w;
}
__device__ __forceinline__ void dft_ld8(bf16x8 (&b)[8], const bf16_t* vec) {
#pragma unroll
    for (int i = 0; i < 8; ++i) b[i] = *(const bf16x8*)(vec + 16 * i);
}
template <int MT> __device__ __forceinline__ void dft_zero(f32x16 (&acc)[MT]) {
#pragma unroll
    for (int rt = 0; rt < MT; ++rt) {
#pragma unroll
        for (int r = 0; r < 16; ++r) acc[rt][r] = 0.f;
        asm volatile("" : "+v"(acc[rt]));
    }
}
template <int MT, int KS, int K0> __device__ __forceinline__ void dft_mma8(f32x16 (&acc)[MT], const bf16x8 (&a)[MT][KS], const bf16x8 (&b)[8]) {
#pragma unroll
    for (int i = 0; i < 8; ++i)
#pragma unroll
        for (int rt = 0; rt < MT; ++rt) acc[rt] = __builtin_amdgcn_mfma_f32_32x32x16_bf16(a[rt][K0 + i], b[i], acc[rt], 0, 0, 0);
}
__device__ __forceinline__ const bf16_t* fa_vec(const bf16_t* H, int tile, int r32, int hi) {
    int token, g;
    if (tile < 8192) { const int n1h = tile & 1, n2 = (tile >> 1) & 63, b = tile >> 9; g = (tile >> 7) & 3; token = b * SEQ + 64 * (32 * n1h + r32) + n2; }
    else { const int tc = tile - 8192, nq = tc & 7, b = tc >> 5; g = (tc >> 3) & 3; token = TLAT + b * LCTX + 32 * nq + r32; }
    return H + (size_t)token * DM + g * 256 + 8 * hi;
}
__device__ __forceinline__ int fa_token(int tile, int row) {
    if (tile < 8192) { const int n1h = tile & 1, n2 = (tile >> 1) & 63, b = tile >> 9; return b * SEQ + 64 * (32 * n1h + row) + n2; }
    const int tc = tile - 8192, nq = tc & 7, b = tc >> 5; return TLAT + b * LCTX + 32 * nq + row;
}
__device__ __forceinline__ void fourier_a(LAS unsigned char* lds, const bf16_t* H, const bf16_t* DC, bf16_t* Z1, bf16_t* Zc, bool with_ctx, int G, int vcu, int wave, int lane) {
    constexpr int ROWB = 528, BUFB = 32 * ROWB;
    const int r32 = lane & 31, hi = lane >> 5, sl = wave, tid = wave * 64 + lane; const bool odd = lane & 1;
    bf16x8 a[2][16]; dft_load_a<2, 16>(a, DC, 64 * sl, r32, hi);
    const int ntile = 8192 + (with_ctx ? 512 : 0);
    const int srow0 = tid >> 5, sch = tid & 31;
    u32x4 s0, s1;
    int it = vcu, cur = 0;
    if (it < ntile) { const int tile = ntile - 1 - it; const int g = (tile < 8192) ? (tile >> 7) & 3 : ((tile - 8192) >> 3) & 3;
        s0 = *(const u32x4*)(H + (size_t)fa_token(tile, srow0) * DM + g * 256 + sch * 8); s1 = *(const u32x4*)(H + (size_t)fa_token(tile, srow0 + 16) * DM + g * 256 + sch * 8); }
    for (; it < ntile; it += G) {
        const int tile = ntile - 1 - it;
        LAS unsigned char* buf = lds + cur * BUFB;
        *(LAS u32x4*)(buf + srow0 * ROWB + sch * 16) = s0; *(LAS u32x4*)(buf + (srow0 + 16) * ROWB + sch * 16) = s1;
        __syncthreads();
        if (it + G < ntile) { const int tn = ntile - 1 - (it + G); const int g = (tn < 8192) ? (tn >> 7) & 3 : ((tn - 8192) >> 3) & 3;
            s0 = *(const u32x4*)(H + (size_t)fa_token(tn, srow0) * DM + g * 256 + sch * 8); s1 = *(const u32x4*)(H + (size_t)fa_token(tn, srow0 + 16) * DM + g * 256 + sch * 8); }
        asm volatile("" ::: "memory");
        f32x16 acc[2]; dft_zero<2>(acc);
        const LAS unsigned char* bp = buf + r32 * ROWB + hi * 16;
#pragma unroll
        for (int ks = 0; ks < 16; ++ks) { const bf16x8 bf = *(const LAS bf16x8*)(bp + ks * 32);
#pragma unroll
            for (int rt = 0; rt < 2; ++rt) acc[rt] = __builtin_amdgcn_mfma_f32_32x32x16_bf16(a[rt][ks], bf, acc[rt], 0, 0, 0); }
        if (tile < 8192) {
            const int n1h = tile & 1, n2 = (tile >> 1) & 63, g = (tile >> 7) & 3, b = tile >> 9;
            size_t zo = ((((size_t)((b * 4 + g) * 256 + 64 * (sl & 3) + 4 * hi)) * 64 + n2) * 2 + (sl >> 2)) * 64 + 32 * n1h + (r32 & ~1);
            asm volatile("" : "+v"(zo));
#pragma unroll
            for (int rt = 0; rt < 2; ++rt)
#pragma unroll
                for (int r = 0; r < 16; r += 2) store_pair(Z1, zo, (unsigned)(32 * rt + (r & 3) + 8 * (r >> 2)) * 8192u, (unsigned)(32 * rt + ((r + 1) & 3) + 8 * (r >> 2)) * 8192u, acc[rt][r], acc[rt][r + 1], odd);
        } else {
            const int tc = tile - 8192, nq = tc & 7, g = (tc >> 3) & 3, b = tc >> 5;
            size_t zo = (((size_t)((b * 4 + g) * 256 + 64 * (sl & 3) + 4 * hi)) * 2 + (sl >> 2)) * 256 + 32 * nq + (r32 & ~1);
            asm volatile("" : "+v"(zo));
#pragma unroll
            for (int rt = 0; rt < 2; ++rt)
#pragma unroll
                for (int r = 0; r < 16; r += 2) store_pair(Zc, zo, (unsigned)(32 * rt + (r & 3) + 8 * (r >> 2)) * 512u, (unsigned)(32 * rt + ((r + 1) & 3) + 8 * (r >> 2)) * 512u, acc[rt][r], acc[rt][r + 1], odd);
        }
        asm volatile("" ::: "memory");
        cur ^= 1;
    }
    __syncthreads();
}
template <int VAR> __device__ __forceinline__ void fourier_s1(const bf16_t* Z1, const bf16_t* D1, const float* tw, bf16_t* A1p, int G, int vcu, int wave, int lane) {
    const int r32 = lane & 31, hi = lane >> 5, sl = wave & 1; const bool odd = lane & 1;
    bf16x8 a[2][8]; dft_load_a<2, 8>(a, D1, 64 * sl, r32, hi);
    int tile = vcu * 4 + (wave >> 1); const int step = G * 4;
    const int n2 = 32 * (tile & 1) + r32;
    float2 twr[16];
#pragma unroll
    for (int rt = 0; rt < 2; ++rt)
#pragma unroll
        for (int q4 = 0; q4 < 4; ++q4)
#pragma unroll
            for (int e = 0; e < 2; ++e) twr[rt * 8 + q4 * 2 + e] = *(const float2*)(tw + 2 * ((32 * sl + 2 * hi + 16 * rt + 4 * q4 + e) * 64 + n2));
    bf16x8 bc[8], bn[8];
    if (tile < 32768) dft_ld8(bc, Z1 + ((size_t)tile * 32 + r32) * 128 + 8 * hi);
    for (; tile < 32768; tile += step) {
        asm volatile("" ::: "memory");
        if (tile + step < 32768) dft_ld8(bn, Z1 + ((size_t)(tile + step) * 32 + r32) * 128 + 8 * hi);
        asm volatile("" ::: "memory");
        f32x16 acc[2]; dft_zero<2>(acc);
        dft_mma8<2, 8, 0>(acc, a, bc);
        const int bgm = tile >> 1, bg = bgm >> 8, m = bgm & 255;
        size_t ao = ((((size_t)(bg * 64 + 32 * sl + 2 * hi)) * 256 + m) * 2) * 64 + (n2 & ~1);
        asm volatile("" : "+v"(ao));
#pragma unroll
        for (int rt = 0; rt < 2; ++rt)
#pragma unroll
            for (int q4 = 0; q4 < 4; ++q4)
#pragma unroll
                for (int e = 0; e < 2; ++e) { const int dk = 16 * rt + 4 * q4 + e;
                    const float re = acc[rt][4 * q4 + 2 * e], im = acc[rt][4 * q4 + 2 * e + 1];
                    const float2 cs = twr[rt * 8 + q4 * 2 + e];
                    const float re2 = re * cs.x + im * cs.y, im2 = im * cs.x - re * cs.y;
                    store_pair(A1p, ao, (unsigned)dk * 32768u, (unsigned)dk * 32768u + 64u, re2, im2, odd); }
        asm volatile("" ::: "memory");
#pragma unroll
        for (int i = 0; i < 8; ++i) bc[i] = bn[i];
    }
}
__device__ __forceinline__ void fourier_s2(const bf16_t* A1p, const bf16_t* D2, const bf16_t* Zc, const bf16_t* DX, bf16_t* FM, bool with_ctx, int G, int vcu, int gw, int NGW, int wave, int lane) {
    const int r32 = lane & 31, hi = lane >> 5; const bool odd = lane & 1;
    {
        bf16x8 a[2][8]; dft_load_a<2, 8>(a, D2, 0, r32, hi);
        bf16x8 bc[8], bn[8];
        int it = gw;
        if (it < 32768) dft_ld8(bc, A1p + ((size_t)(32767 - it) * 32 + r32) * 128 + 8 * hi);
        for (; it < 32768; it += NGW) {
            const int tile = 32767 - it;
            asm volatile("" ::: "memory");
            if (it + NGW < 32768) dft_ld8(bn, A1p + ((size_t)(32767 - it - NGW) * 32 + r32) * 128 + 8 * hi);
            asm volatile("" ::: "memory");
            f32x16 acc[2]; dft_zero<2>(acc);
            dft_mma8<2, 8, 0>(acc, a, bc);
            const int m = 32 * (tile & 7) + r32, k1 = (tile >> 3) & 63, bg = tile >> 9, b = bg >> 2, g = bg & 3;
            size_t fo = (size_t)(b * SEQ + k1 + 256 * hi) * DM + g * 256 + (m & ~1);
            asm volatile("" : "+v"(fo));
#pragma unroll
            for (int rt = 0; rt < 2; ++rt)
#pragma unroll
                for (int r = 0; r < 16; r += 2) store_pair(FM, fo, (unsigned)(32 * rt + (r & 3) + 8 * (r >> 2)) * 65536u, (unsigned)(32 * rt + ((r + 1) & 3) + 8 * (r >> 2)) * 65536u, acc[rt][r], acc[rt][r + 1], odd);
            asm volatile("" ::: "memory");
#pragma unroll
            for (int i = 0; i < 8; ++i) bc[i] = bn[i];
        }
    }
    if (with_ctx) {
        for (int tile = vcu; tile < 512; tile += G) {
            f32x16 acc;
#pragma unroll
            for (int r = 0; r < 16; ++r) acc[r] = 0.f;
            asm volatile("" : "+v"(acc));
            const bf16_t* ap = DX + (size_t)(32 * wave + r32) * 512 + 8 * hi;
            const bf16_t* bp = Zc + ((size_t)tile * 32 + r32) * 512 + 8 * hi;
#pragma unroll 1
            for (int kc = 0; kc < 4; ++kc) {
                bf16x8 av[8], bv[8];
#pragma unroll
                for (int i = 0; i < 8; ++i) { av[i] = *(const bf16x8*)(ap + 16 * (kc * 8 + i)); bv[i] = *(const bf16x8*)(bp + 16 * (kc * 8 + i)); }
#pragma unroll
                for (int i = 0; i < 8; ++i) acc = __builtin_amdgcn_mfma_f32_32x32x16_bf16(av[i], bv[i], acc, 0, 0, 0);
            }
            const int m = 32 * (tile & 7) + r32, bg = tile >> 3, b = bg >> 2, g = bg & 3;
            size_t fo = (size_t)(TLAT + b * LCTX + 32 * wave + 4 * hi) * DM + g * 256 + (m & ~1);
            asm volatile("" : "+v"(fo));
#pragma unroll
            for (int r = 0; r < 16; r += 2) store_pair(FM, fo, (unsigned)((r & 3) + 8 * (r >> 2)) * 1024u, (unsigned)(((r + 1) & 3) + 8 * (r >> 2)) * 1024u, acc[r], acc[r + 1], odd);
        }
    }
}


#define RLX_AGENT __ATOMIC_RELAXED, __HIP_MEMORY_SCOPE_AGENT
#define XB_TMO      128
#define XB_XCNT(j)  (256  + 64 * (j))
#define XB_XSUB(j)  (1280 + 64 * (j))
#define XB_XGEN(j)  (2304 + 64 * (j))
#define XB_TOP      3328
#define XB_TOPGEN   3392
#define XCD_BAR_WORDS 3456
#define XB_SPIN_CAP (1u << 18)

__device__ __forceinline__ unsigned xb_ld(unsigned* p)              { return __hip_atomic_load(p, __ATOMIC_RELAXED, __HIP_MEMORY_SCOPE_AGENT); }
__device__ __forceinline__ unsigned xb_add(unsigned* p, unsigned v) { return __hip_atomic_fetch_add(p, v, __ATOMIC_RELAXED, __HIP_MEMORY_SCOPE_AGENT); }
__device__ __forceinline__ unsigned xb_xcc_id() { return (unsigned)__builtin_amdgcn_s_getreg((3 << 11) | 20) & 0xFu; }
#define XB_SPIN(cond, bar) do { unsigned _sp = 0; while (cond) { __builtin_amdgcn_s_sleep(1); \
    if ((++_sp & 255u) == 0u) { if (xb_ld(&(bar)[XB_TMO])) break; if (_sp > XB_SPIN_CAP) { atomicAdd(&(bar)[XB_TMO], 1u); break; } } } } while (0)

struct XcdBarrier {
    unsigned* bar; unsigned x;
    volatile LAS unsigned* st;
};

__device__ __forceinline__ XcdBarrier xcd_barrier_post(unsigned* bar, volatile LAS unsigned* st) {
    XcdBarrier b; b.bar = bar; b.x = xb_xcc_id(); b.st = st;
    if (threadIdx.x == 0) (void)xb_add(&bar[XB_XCNT(b.x)], 1u);
    return b;
}
__device__ __forceinline__ void xcd_barrier_complete(unsigned* bar, unsigned x, unsigned& nloc, unsigned& nx) {
    const unsigned G = gridDim.x * gridDim.y * gridDim.z;
    unsigned sum, cnt, mine, sp = 0u;
    for (;;) {
        sum = 0u; cnt = 0u; mine = 0u;
#pragma unroll
        for (unsigned j = 0; j < 16; ++j) { const unsigned c = xb_ld(&bar[XB_XCNT(j)]); sum += c; cnt += (c > 0u) ? 1u : 0u; mine = (j == x) ? c : mine; }
        if (sum == G) break;
        __builtin_amdgcn_s_sleep(1);
        if ((++sp & 255u) == 0u) { if (xb_ld(&bar[XB_TMO])) break; if (sp > XB_SPIN_CAP) { atomicAdd(&bar[XB_TMO], 1u); break; } }
    }
    nloc = mine > 0u ? mine : 1u; nx = cnt > 0u ? cnt : 1u;
}

__device__ __forceinline__ void xcd_barrier(const XcdBarrier& b) {
    asm volatile("s_waitcnt vmcnt(0)" ::: "memory");
    __syncthreads();
    if (threadIdx.x == 0) {
        unsigned* bar = b.bar;
        __builtin_amdgcn_s_waitcnt(0);
        unsigned nloc = b.st[0], nx = b.st[1];
        if (nloc == 0u) { xcd_barrier_complete(bar, b.x, nloc, nx); b.st[0] = nloc; b.st[1] = nx; }
        const unsigned old = xb_add(&bar[XB_XSUB(b.x)], 1u);
        const unsigned gen = old / nloc;
        if (old + 1u == (gen + 1u) * nloc) {
            __builtin_amdgcn_fence(__ATOMIC_RELEASE, "agent");
            asm volatile("s_waitcnt vmcnt(0)" ::: "memory");
            const unsigned og = xb_add(&bar[XB_TOP], 1u);
            const unsigned tg = og / nx;
            if (og + 1u == (tg + 1u) * nx) xb_add(&bar[XB_TOPGEN], 1u);
            else XB_SPIN(xb_ld(&bar[XB_TOPGEN]) == tg, bar);
            __builtin_amdgcn_fence(__ATOMIC_ACQUIRE, "agent");
            xb_add(&bar[XB_XGEN(b.x)], 1u);
            asm volatile("s_waitcnt vmcnt(0)" ::: "memory");
        } else {
            XB_SPIN(xb_ld(&bar[XB_XGEN(b.x)]) == gen, bar);
            __builtin_amdgcn_fence(__ATOMIC_ACQUIRE, "agent");
            asm volatile("s_waitcnt vmcnt(0)" ::: "memory");
        }
    }
    __syncthreads();
}

#ifdef DIAG
__device__ __forceinline__ void diag_scan(unsigned* ctl, const void* buf, size_t bytes, bool is_bf16, int stage) {
    const size_t n16 = bytes / 16; const u32x4* p = (const u32x4*)buf; bool bad = false;
    int ln = (int)__builtin_amdgcn_mbcnt_hi(~0u, __builtin_amdgcn_mbcnt_lo(~0u, 0u)); asm volatile("" : "+v"(ln)); ln += 64 * __builtin_amdgcn_readfirstlane((int)threadIdx.x >> 6);
    for (size_t i = (size_t)blockIdx.x * NTHR + ln; i < n16; i += (size_t)gridDim.x * NTHR) {
        const u32x4 v = p[i];
        if (is_bf16) { for (int q = 0; q < 4; ++q) { const unsigned w = v[q]; if (((w >> 7) & 0xff) == 0xff || ((w >> 23) & 0xff) == 0xff) bad = true; } }
        else { for (int q = 0; q < 4; ++q) { if (((v[q] >> 23) & 0xff) >= 0xf0) bad = true; } }
    }
    if (bad) atomicMin(ctl, (unsigned)stage);
}
#define DIAG_SCAN(buf, bytes, isbf, stage) diag_scan((unsigned*)ws, buf, bytes, isbf, stage)
#else
#define DIAG_SCAN(buf, bytes, isbf, stage) do {} while (0)
#endif

#ifdef DIAG2
__device__ __forceinline__ void diag_max(unsigned* ctl, const void* buf, size_t bytes) {
    const size_t n16 = bytes / 16; const u32x4* p = (const u32x4*)buf; unsigned mx = 0, nb = 0;
    int ln = (int)__builtin_amdgcn_mbcnt_hi(~0u, __builtin_amdgcn_mbcnt_lo(~0u, 0u)); asm volatile("" : "+v"(ln)); ln += 64 * __builtin_amdgcn_readfirstlane((int)threadIdx.x >> 6);
    for (size_t i = (size_t)blockIdx.x * NTHR + ln; i < n16; i += (size_t)gridDim.x * NTHR) {
        const u32x4 v = p[i];
        for (int q = 0; q < 4; ++q) { const unsigned lo = (v[q] << 16) & 0x7fffffffu, hi = v[q] & 0x7fff0000u;
            if ((lo >> 23) == 0xff) ++nb; else mx = mx > lo ? mx : lo;
            if ((hi >> 23) == 0xff) ++nb; else mx = mx > hi ? mx : hi; }
    }
    atomicMax(ctl + 1, mx); if (nb) atomicAdd(ctl + 2, nb);
}
#endif

#ifdef TSEL
#define TBEG(c) do { if ((TSEL >> (c)) & 1) t0_ = __builtin_amdgcn_s_memrealtime(); } while (0)
#define TEND(c) do { if ((TSEL >> (c)) & 1) tacc_ += __builtin_amdgcn_s_memrealtime() - t0_; } while (0)
#else
#define TBEG(c) do {} while (0)
#define TEND(c) do {} while (0)
#endif
__global__ void __launch_bounds__(NTHR, 2) fwd_megakernel(Args A) {
    extern __shared__ __attribute__((aligned(16))) unsigned char lds_raw[];
    cg::grid_group grid = cg::this_grid();
#define GRID_SYNC() xcd_barrier(xbar)
#define CG_SYNC() do { asm volatile("s_waitcnt vmcnt(0) lgkmcnt(0)" ::: "memory"); grid.sync(); } while (0)
    LAS unsigned char* lds = (LAS unsigned char*)lds_raw;
    const int wave = __builtin_amdgcn_readfirstlane((int)threadIdx.x >> 6);
#define FRESH_LANE(v) int v = LANE_ID(); asm volatile("" : "+v"(v))
#define LANE_ID() ((int)__builtin_amdgcn_mbcnt_hi(~0u, __builtin_amdgcn_mbcnt_lo(~0u, 0u)))
    const int lane = LANE_ID(), tid = wave * 64 + lane;
    const int G = gridDim.x, gw = blockIdx.x * NWAVES + wave, NGW = G * NWAVES;
    const int vcu = (G % 8 == 0) ? ((int)blockIdx.x % 8) * (G / 8) + (int)blockIdx.x / 8 : (int)blockIdx.x;
    const int gwv = vcu * NWAVES + wave;
    unsigned char* ws = A.ws;
    volatile LAS unsigned* xb_st = (volatile LAS unsigned*)(lds + 131072 + 64);
    if (threadIdx.x == 0) { xb_st[0] = 0u; xb_st[1] = 0u; }
    __syncthreads();
    const XcdBarrier xbar = xcd_barrier_post((unsigned*)ws + 4096, xb_st);
#ifdef TSEL
    unsigned long long t0_ = 0, tacc_ = 0;
#endif
#ifdef DIAG
    if (blockIdx.x == 0 && threadIdx.x == 0) *(unsigned*)ws = 0x7fffffffu;
#endif
#ifdef DIAG2
    if (blockIdx.x == 0 && threadIdx.x == 0) { ((unsigned*)ws)[1] = 0u; ((unsigned*)ws)[2] = 0u; }
#endif
    float* mod = (float*)(ws + WS_MOD);
    const float* rope = (const float*)(ws + WS_TAB + TAB_ROPE); const float* tw = (const float*)(ws + WS_TAB + TAB_TW);
    const bf16_t* D1 = (const bf16_t*)(ws + WS_TAB + TAB_D1); const bf16_t* D2 = (const bf16_t*)(ws + WS_TAB + TAB_D2);
    const bf16_t* DC = (const bf16_t*)(ws + WS_TAB + TAB_DC); const bf16_t* DX = (const bf16_t*)(ws + WS_TAB + TAB_DCTX);
    bf16_t* XB = (bf16_t*)(ws + WS_XB);
    bf16_t* Hb = (bf16_t*)(ws + WS_H); bf16_t* Pb = (bf16_t*)(ws + WS_P); bf16_t* CAT = (bf16_t*)(ws + WS_CAT); bf16_t* ACT = (bf16_t*)(ws + WS_ACT);
    bf16_t* Z1 = (bf16_t*)(ws + WS_Z1); bf16_t* Zc = (bf16_t*)(ws + WS_ZC); bf16_t* A1p = (bf16_t*)(ws + WS_A1); bf16_t* FM = (bf16_t*)(ws + WS_FM);


#ifndef SKIP_PRO
        TBEG(10);
    prologue(A, lds, tid, wave, lane, G);
#endif

    CG_SYNC();
        TEND(10);

    DIAG_SCAN(mod, 4 * 17 * 6144 * 4, false, 1); DIAG_SCAN(ws + WS_WIN, (size_t)83 * MiB, true, 2); DIAG_SCAN(ws + WS_TAB + TAB_D1, 640 * 1024, true, 3); DIAG_SCAN(ws + WS_TAB, 96 * 1024, false, 4);
#pragma unroll 1
    for (int l = 0; l < 4; ++l) {
        const bool even = (l & 1) == 0; const int e = l >> 1;
        const bool ctx_after = l < 2;
        const bool ctx_here = l < 3;
        const int Mfull = ctx_here ? MALL : TLAT;
        const int Mres = ctx_after ? MALL : TLAT;
        const float* modl = mod + (size_t)l * 17 * 6144;
        TBEG(4);
        { FRESH_LANE(lane_l); const int tid_l = wave * 64 + lane_l; (void)tid_l; if (l == 0) norm_phase<true>(A.x, A.ctx, XB, A.n1g + l * DM, modl, 0, Hb, Mfull, gw, NGW, lane_l); else norm_phase<false>(A.x, A.ctx, XB, A.n1g + l * DM, modl, 0, Hb, Mfull, gw, NGW, lane_l); }
        GRID_SYNC();
        TEND(4);
        DIAG_SCAN(Hb, (size_t)Mfull * DM * 2, true, 10 + 10 * l);
        const bf16_t* mixA; const bf16_t* mixW;
        if (even) {
        TBEG(0);
            { int tg = LANE_ID(); asm volatile("" : "+v"(tg)); tg += wave * 64; pg8::Gemm g{Hb, (const bf16_t*)(ws + WS_WIN) + (size_t)e * INW * DM, Mfull, INW, DM}; pg8::StaticOrder S; S.init(Mfull, INW, G, (int)blockIdx.x);
              EpiInProj E{Pb, rope};
              pg8::gemm_phase<EpiInProj, pg8::StaticOrder, true, true>(lds, g, S, E, tg); }
            GRID_SYNC();
        TEND(0);
        DIAG_SCAN(Pb, (size_t)Mfull * INW * 2, true, 11 + 10 * l);

#ifndef SKIP_ATT
        TBEG(5);
            { FRESH_LANE(lane_l); const int tid_l = wave * 64 + lane_l; (void)tid_l; attn_phase(lds, Pb, CAT, A.sink + e * 8, ctx_after, G, tid_l, wave, lane_l); }
        TEND(5);
#endif


#ifndef SKIP_CONV
        TBEG(6);
            { FRESH_LANE(lane_l); const int tid_l = wave * 64 + lane_l; (void)tid_l; conv_phase(Pb, CAT, A.conv_w + e * 3 * 512, Mres, G, tid_l); }
#endif

            GRID_SYNC();
        TEND(6);
        DIAG_SCAN(CAT, (size_t)Mres * DM * 2, true, 12 + 10 * l);
            mixA = CAT; mixW = (const bf16_t*)(ws + WS_WMIX) + (size_t)e * DM * DM;
        } else {

#ifndef SKIP_FA
        TBEG(7);
            { FRESH_LANE(lane_l); const int tid_l = wave * 64 + lane_l; (void)tid_l; fourier_a(lds, Hb, DC, Z1, Zc, ctx_after, G, vcu, wave, lane_l); }
#endif

            GRID_SYNC();
        TEND(7);
        DIAG_SCAN(Z1, (size_t)128 * MiB, true, 11 + 10 * l); DIAG_SCAN(Z1 + 64 * MiB, (size_t)128 * MiB, true, 12 + 10 * l); DIAG_SCAN(Zc, (size_t)16 * MiB, true, 13 + 10 * l);
#ifdef DIAG2
        if (l == DIAG2_L) diag_max((unsigned*)ws, DIAG2_BUF, DIAG2_BYTES);
#endif

#ifndef SKIP_S1
        TBEG(8);
            { FRESH_LANE(lane_l); const int tid_l = wave * 64 + lane_l; (void)tid_l; fourier_s1<0>(Z1, D1, tw, A1p, G, vcu, wave, lane_l); }
#endif

            GRID_SYNC();
        TEND(8);
        DIAG_SCAN(A1p, (size_t)256 * MiB, true, 14 + 10 * l);

#ifndef SKIP_S2
        TBEG(9);
            { FRESH_LANE(lane_l); const int tid_l = wave * 64 + lane_l; (void)tid_l; fourier_s2(A1p, D2, Zc, DX, FM, ctx_after, G, vcu, gwv, NGW, wave, lane_l); }
#endif

            GRID_SYNC();
        TEND(9);
        DIAG_SCAN(FM, (size_t)Mres * DM * 2, true, 15 + 10 * l);
            mixA = FM; mixW = (const bf16_t*)(ws + WS_WF) + (size_t)e * DM * DM;
        }
        TBEG(1);
        { int tg = LANE_ID(); asm volatile("" : "+v"(tg)); tg += wave * 64; pg8::Gemm g{mixA, mixW, Mres, DM, DM}; pg8::StaticOrder S; S.init(Mres, DM, G, (int)blockIdx.x);
          if (l == 0) { EpiRes<true> E{A.x, A.ctx, XB, modl, 2}; pg8::gemm_phase<EpiRes<true>, pg8::StaticOrder, true, true>(lds, g, S, E, tg); }
          else { EpiRes<false> E{A.x, A.ctx, XB, modl, 2}; pg8::gemm_phase<EpiRes<false>, pg8::StaticOrder, true, true>(lds, g, S, E, tg); } }
        GRID_SYNC();
        TEND(1);
        TBEG(4);
        { FRESH_LANE(lane_l); const int tid_l = wave * 64 + lane_l; (void)tid_l; norm_phase<false>(A.x, A.ctx, XB, A.n2g + l * DM, modl, 3, Hb, Mres, gw, NGW, lane_l); }
        GRID_SYNC();
        TEND(4);
        DIAG_SCAN(Hb, (size_t)Mres * DM * 2, true, 17 + 10 * l);
        TBEG(2);
        { int tg = LANE_ID(); asm volatile("" : "+v"(tg)); tg += wave * 64; pg8::Gemm g{Hb, (const bf16_t*)(ws + WS_WGU) + (size_t)l * 2 * DFF * DM, Mres, 2 * DFF, DM}; pg8::StaticOrder S; S.init(Mres, 2 * DFF, G, (int)blockIdx.x);
          EpiSwiGLU E{ACT};
          pg8::gemm_phase<EpiSwiGLU, pg8::StaticOrder, true, true>(lds, g, S, E, tg); }
        GRID_SYNC();
        TEND(2);
        DIAG_SCAN(ACT, (size_t)Mres * DFF * 2, true, 18 + 10 * l);
        TBEG(3);
        { int tg = LANE_ID(); asm volatile("" : "+v"(tg)); tg += wave * 64; pg8::Gemm g{ACT, (const bf16_t*)(ws + WS_WD) + (size_t)l * DM * DFF, Mres, DM, DFF}; pg8::StaticOrder S; S.init(Mres, DM, G, (int)blockIdx.x);
          EpiRes<false> E{A.x, A.ctx, XB, modl, 5}; pg8::gemm_phase<EpiRes<false>, pg8::StaticOrder, true, true>(lds, g, S, E, tg); }
        GRID_SYNC();
        TEND(3);
    }
    { int lane_f = LANE_ID(); asm volatile("" : "+v"(lane_f)); final_norm_phase(XB, A.out, A.final_g, gw, NGW, lane_f); }
#ifdef TSEL
    if (blockIdx.x == 0) { const unsigned long long ts_ = __builtin_amdgcn_s_memrealtime(); while (__builtin_amdgcn_s_memrealtime() - ts_ < (unsigned long long)TMULT * tacc_) __builtin_amdgcn_s_sleep(8); }
#endif
#ifdef DIAG2
    GRID_SYNC();
    if (blockIdx.x == 0 && threadIdx.x == 0) { const unsigned mx = ((volatile unsigned*)ws)[1], nb = ((volatile unsigned*)ws)[2]; A.out[0] = 1000.f * __builtin_bit_cast(float, mx); A.out[1] = nb ? 1e9f + 1000.f * (float)nb : 0.f; }
#endif
#ifdef DIAG
    GRID_SYNC();
    if (blockIdx.x == 0 && threadIdx.x == 0) { const unsigned c = *(volatile unsigned*)ws; A.out[0] = (c == 0x7fffffffu) ? 999000.f : 1000.f * (float)c; }
#endif
}

extern "C" void kernel_launch(void* const* d_in, const int* in_sizes, int n_in, void* d_out, int out_size, void* d_ws, size_t ws_size, hipStream_t stream) {
    static int grid = 0;
    if (grid == 0) {
        if (n_in != 17 || out_size != TLAT * DM || ws_size < WS_END) { fprintf(stderr, "kernel_launch: unexpected shapes (n_in %d, out %d, ws %zu)\n", n_in, out_size, ws_size); grid = -1; return; }
        int dev = 0, cus = 0, per_cu = 0;
        hipGetDevice(&dev); hipDeviceGetAttribute(&cus, hipDeviceAttributeMultiprocessorCount, dev);
        if (hipFuncSetAttribute((const void*)fwd_megakernel, hipFuncAttributeMaxDynamicSharedMemorySize, LDS_BYTES) != hipSuccess) { fprintf(stderr, "kernel_launch: hipFuncSetAttribute failed\n"); grid = -1; return; }
        if (hipOccupancyMaxActiveBlocksPerMultiprocessor(&per_cu, (const void*)fwd_megakernel, NTHR, LDS_BYTES) != hipSuccess || per_cu < 1) { fprintf(stderr, "kernel_launch: occupancy query says %d\n", per_cu); per_cu = 1; }
        (void)hipGetLastError();
        grid = cus * 1;
    }
    if (grid < 0) return;
    if (hipMemsetAsync(d_ws, 0, 65536, stream) != hipSuccess) { fprintf(stderr, "kernel_launch: hipMemsetAsync of the barrier words failed\n"); return; }
    Args a{};
    a.x = (const float*)d_in[0]; a.c = (const float*)d_in[1]; a.ctx = (const float*)d_in[2]; a.c_ctx = (const float*)d_in[3]; a.w_ada = (const float*)d_in[4]; a.b_ada = (const float*)d_in[5];
    a.n1g = (const float*)d_in[6]; a.n2g = (const float*)d_in[7]; a.w_in = (const float*)d_in[8]; a.conv_w = (const float*)d_in[9]; a.sink = (const float*)d_in[10]; a.w_mix = (const float*)d_in[11];
    a.w_four = (const float*)d_in[12]; a.w_gate = (const float*)d_in[13]; a.w_up = (const float*)d_in[14]; a.w_down = (const float*)d_in[15]; a.final_g = (const float*)d_in[16];
    a.out = (float*)d_out; a.ws = (unsigned char*)d_ws;
    for (int f = 0; f < 16; ++f) a.invf[f] = pow(10000.0, -(double)f / 16.0);
    void* args[] = {&a};
    hipError_t e = hipLaunchCooperativeKernel((const void*)fwd_megakernel, dim3(grid), dim3(NTHR), args, LDS_BYTES, stream);
    if (e != hipSuccess) fprintf(stderr, "kernel_launch: cooperative launch failed: %s (grid %d)\n", hipGetErrorString(e), grid);
}
```

```cpp
#include <hip/hip_runtime.h>
#include <hip/hip_cooperative_groups.h>
#include <cstdio>
#include <cstdint>
#include <cmath>
namespace cg = cooperative_groups;

namespace pg8 {
#define PG8_LAS __attribute__((address_space(3)))
typedef unsigned short bf16_t;
typedef short bf16x8 __attribute__((ext_vector_type(8)));
typedef float f32x4 __attribute__((ext_vector_type(4)));
typedef unsigned u32x4 __attribute__((ext_vector_type(4)));
constexpr int BM = 256, BK = 64, HALF = 128, HTB = HALF * BK * 2  , STAGE_BYTES = 8 * HTB, NXCD = 8, WGM = 8;

__host__ __device__ __forceinline__ int lds_byte(int r, int c) { const int st = (r >> 4) * 2 + (c >> 5), rr = r & 15, cc = c & 31, ob = rr * 64 + cc * 2; return st * 1024 + (ob ^ (((ob >> 9) & 1) << 5)); }
__host__ __device__ __forceinline__ void stage_rc(int b, int& R, int& C) { const int st = b / 1024, sb = b % 1024, swz = sb ^ (((sb >> 9) & 1) << 5); R = (st >> 1) * 16 + swz / 64; C = (st & 1) * 32 + (swz % 64) / 2; }
__host__ __device__ __forceinline__ int perm32(int rho) { const int n = rho >> 4, i = rho & 15; return 8 * (i >> 2) + 4 * n + (i & 3); }

struct Unit { int pm, pn; };
struct Gemm { const bf16_t* A; const bf16_t* Bt; int M, N, K; };

struct StaticOrder {
    int nM, nN, nwg, G, c, pm_off;
    __host__ __device__ void init(int M, int N, int G_, int c_) { nM = M / BM; nN = N / BM; nwg = nM * nN; G = G_; c = c_; pm_off = 0; }
    __host__ __device__ bool next(int i, Unit& u) const {
        const long L = (long)i * G + c; if (L >= nwg) return false;
        int wgid = (int)L; { const int q = nwg / NXCD, r = nwg % NXCD, xcd = wgid % NXCD, off = wgid / NXCD; wgid = (xcd < r ? xcd * (q + 1) : r * (q + 1) + (xcd - r) * q) + off; }
        const int nig = WGM * nN, gid = wgid / nig, fm = gid * WGM, gsz = (nM - fm) < WGM ? (nM - fm) : WGM;
        u.pm = pm_off + fm + ((wgid % nig) % gsz); u.pn = (wgid % nig) / gsz; return true;
    }
    __device__ __forceinline__ void a_ready(const Unit&) const {}
    __device__ __forceinline__ void done(const Unit&) const {}
};

template <class Epi, class Sched, bool ALIGN_EPI = false, bool SP2 = false>
__device__ __forceinline__ void gemm_phase(PG8_LAS unsigned char* lds, const Gemm g, const Sched& S, const Epi& E, int tid_in) {
    const int tid = tid_in, wid = __builtin_amdgcn_readfirstlane(tid >> 6), lane = tid & 63, wr = wid >> 2, wc = wid & 3, fr = lane & 15, fq = lane >> 4;
    const int K = g.K, nt = K / BK;
    unsigned voffA[2], voffB[2];
#pragma unroll
    for (int i = 0; i < 2; ++i) { int R, C; stage_rc(tid * 16 + i * 8192, R, C); const int Rb = Epi::PERM ? ((R & ~31) + perm32(R & 31)) : R;
        voffA[i] = (unsigned)(R * K + C) * 2u; voffB[i] = (unsigned)(Rb * K + C) * 2u; }
    const size_t kstep = (size_t)(BK * 2);
    const size_t hstep = (size_t)HALF * K * 2;
    const size_t tstep = 2 * hstep;
    const unsigned ldsw = (unsigned)wid * 1024u;
    const int aoff = lds_byte(wr * 64 + fr, fq * 8), boff = lds_byte(wc * 32 + fr, fq * 8);
#define PG8_SA(b, h) (((b) * 2 + (h)) * HTB)
#define PG8_SB(b, h) ((4 + (b) * 2 + (h)) * HTB)
#define PG8_STAGE(bufoff, gbase, voff) do { _Pragma("unroll") for (int _i = 0; _i < 2; ++_i) \
        __builtin_amdgcn_global_load_lds((const unsigned*)((const char*)(gbase) + (voff)[_i]), (PG8_LAS unsigned*)(lds + (bufoff) + ldsw + _i * 8192), 16, 0, 0); } while (0)
#define PG8_LDA(dst, b, h) do { _Pragma("unroll") for (int m = 0; m < 4; ++m) _Pragma("unroll") for (int k = 0; k < 2; ++k) dst[m][k] = *(const PG8_LAS bf16x8*)(lds + PG8_SA(b, h) + aoff + m * 2048 + k * 1024); } while (0)
#define PG8_LDB(dst, b, h) do { _Pragma("unroll") for (int n = 0; n < 2; ++n) _Pragma("unroll") for (int k = 0; k < 2; ++k) dst[n][k] = *(const PG8_LAS bf16x8*)(lds + PG8_SB(b, h) + boff + n * 2048 + k * 1024); } while (0)
#define PG8_MMA(ai, bj, At, Bt) do { __builtin_amdgcn_s_setprio(1); _Pragma("unroll") for (int m = 0; m < 4; ++m) _Pragma("unroll") for (int n = 0; n < 2; ++n) _Pragma("unroll") for (int k = 0; k < 2; ++k) \
        acc[ai][bj][m][n] = __builtin_amdgcn_mfma_f32_16x16x32_bf16(Bt[n][k], At[m][k], acc[ai][bj][m][n], 0, 0, 0); __builtin_amdgcn_s_setprio(0); } while (0)
#define PG8_WAIT_V(n) asm volatile("s_waitcnt vmcnt(" #n ")" ::: "memory")
#define PG8_WAIT_L(n) asm volatile("s_waitcnt lgkmcnt(" #n ")" ::: "memory")
#define PG8_BAR __builtin_amdgcn_s_barrier()
#define PG8_SCHED __builtin_amdgcn_sched_barrier(0)
    Unit cur, nxt; int ui = 0;
    if (!S.next(0, cur)) return;
    f32x4 acc[2][2][4][2];
#pragma unroll
    for (int a = 0; a < 2; ++a)
#pragma unroll
        for (int b = 0; b < 2; ++b)
#pragma unroll
            for (int m = 0; m < 4; ++m)
#pragma unroll
                for (int n = 0; n < 2; ++n) acc[a][b][m][n] = (f32x4){0.f, 0.f, 0.f, 0.f};
    bf16x8 At[4][2], B0[2][2], B1[2][2];
    const char* cA = (const char*)g.A + (size_t)cur.pm * tstep; const char* cB = (const char*)g.Bt + (size_t)cur.pn * tstep;
    S.a_ready(cur);
    if constexpr (SP2) {
        PG8_STAGE(PG8_SB(0, 0), cB, voffB); PG8_STAGE(PG8_SB(0, 1), cB + hstep, voffB); PG8_STAGE(PG8_SA(0, 0), cA, voffA); PG8_STAGE(PG8_SA(0, 1), cA + hstep, voffA);
        if (wr == 1) PG8_BAR;
        PG8_WAIT_V(2); PG8_BAR;
        PG8_STAGE(PG8_SB(1, 0), cB + kstep, voffB); PG8_STAGE(PG8_SA(1, 0), cA + kstep, voffA); PG8_STAGE(PG8_SB(1, 1), cB + hstep + kstep, voffB);
        PG8_WAIT_V(6); PG8_BAR;
    } else {
        PG8_STAGE(PG8_SB(0, 0), cB, voffB); PG8_STAGE(PG8_SA(0, 0), cA, voffA); PG8_STAGE(PG8_SB(0, 1), cB + hstep, voffB); PG8_STAGE(PG8_SA(0, 1), cA + hstep, voffA);
        if (wr == 1) PG8_BAR;
        PG8_WAIT_V(4); PG8_BAR;
        PG8_STAGE(PG8_SB(1, 0), cB + kstep, voffB); PG8_STAGE(PG8_SA(1, 0), cA + kstep, voffA); PG8_STAGE(PG8_SB(1, 1), cB + hstep + kstep, voffB);
        PG8_WAIT_V(6); PG8_BAR;
    }
    for (;;) {
        const bool has_next = S.next(ui + 1, nxt);
        const char* nA = has_next ? (const char*)g.A + (size_t)nxt.pm * tstep : cA; const char* nB = has_next ? (const char*)g.Bt + (size_t)nxt.pn * tstep : cB;
        for (int t = 0; t < nt; t += 2) {
            const bool last = (t == nt - 2);
            const char* a1 = cA + (size_t)(t + 1) * kstep;
            const char* a2 = last ? nA : cA + (size_t)(t + 2) * kstep; const char* b2 = last ? nB : cB + (size_t)(t + 2) * kstep;
            const char* a3 = a2 + kstep; const char* b3 = b2 + kstep;
            if (last && has_next) S.a_ready(nxt);
            if constexpr (SP2) {
            PG8_LDB(B0, 0, 0); PG8_LDB(B1, 0, 1); PG8_SCHED; PG8_LDA(At, 0, 0); PG8_STAGE(PG8_SA(1, 1), a1 + hstep, voffA);
            PG8_WAIT_V(8); PG8_WAIT_L(0); PG8_BAR; PG8_MMA(0, 0, At, B0); PG8_MMA(0, 1, At, B1); PG8_BAR; PG8_SCHED;
            PG8_LDA(At, 0, 1); PG8_STAGE(PG8_SB(0, 0), b2, voffB); PG8_STAGE(PG8_SB(0, 1), b2 + hstep, voffB); PG8_STAGE(PG8_SA(0, 0), a2, voffA);
            PG8_WAIT_V(8); PG8_WAIT_L(0); PG8_BAR; PG8_MMA(1, 0, At, B0); PG8_MMA(1, 1, At, B1); PG8_BAR; PG8_SCHED;
            PG8_LDB(B0, 1, 0); PG8_LDB(B1, 1, 1); PG8_SCHED; PG8_LDA(At, 1, 0); PG8_STAGE(PG8_SA(0, 1), a2 + hstep, voffA);
            PG8_WAIT_V(8); PG8_WAIT_L(0); PG8_BAR; PG8_MMA(0, 0, At, B0); PG8_MMA(0, 1, At, B1); PG8_BAR; PG8_SCHED;
            PG8_LDA(At, 1, 1); PG8_STAGE(PG8_SB(1, 0), b3, voffB); PG8_STAGE(PG8_SB(1, 1), b3 + hstep, voffB); PG8_STAGE(PG8_SA(1, 0), a3, voffA);
            PG8_WAIT_V(8); PG8_WAIT_L(0); PG8_BAR; PG8_MMA(1, 0, At, B0); PG8_MMA(1, 1, At, B1); PG8_BAR; PG8_SCHED;
            } else {
            PG8_LDB(B0, 0, 0); PG8_SCHED; PG8_LDA(At, 0, 0); PG8_STAGE(PG8_SA(1, 1), a1 + hstep, voffA);
            PG8_WAIT_L(8); PG8_BAR; PG8_WAIT_L(0); PG8_MMA(0, 0, At, B0); PG8_BAR; PG8_SCHED;
            PG8_LDB(B1, 0, 1); PG8_STAGE(PG8_SB(0, 0), b2, voffB);
            PG8_BAR; PG8_WAIT_L(0); PG8_MMA(0, 1, At, B1); PG8_BAR;
            PG8_LDA(At, 0, 1); PG8_STAGE(PG8_SA(0, 0), a2, voffA);
            PG8_BAR; PG8_WAIT_L(0); PG8_MMA(1, 0, At, B0); PG8_BAR; PG8_SCHED;
            PG8_STAGE(PG8_SB(0, 1), b2 + hstep, voffB);
            PG8_WAIT_V(6); PG8_BAR; PG8_MMA(1, 1, At, B1); PG8_BAR;
            PG8_LDB(B0, 1, 0); PG8_SCHED; PG8_LDA(At, 1, 0); PG8_STAGE(PG8_SA(0, 1), a2 + hstep, voffA);
            PG8_WAIT_L(8); PG8_BAR; PG8_WAIT_L(0); PG8_MMA(0, 0, At, B0); PG8_BAR; PG8_SCHED;
            PG8_LDB(B1, 1, 1); PG8_STAGE(PG8_SB(1, 0), b3, voffB);
            PG8_BAR; PG8_WAIT_L(0); PG8_MMA(0, 1, At, B1); PG8_BAR;
            PG8_LDA(At, 1, 1); PG8_STAGE(PG8_SA(1, 0), a3, voffA);
            PG8_BAR; PG8_WAIT_L(0); PG8_MMA(1, 0, At, B0); PG8_BAR; PG8_SCHED;
            PG8_STAGE(PG8_SB(1, 1), b3 + hstep, voffB);
            PG8_WAIT_V(6); PG8_BAR; PG8_MMA(1, 1, At, B1); PG8_BAR;
            }
        }
        if constexpr (ALIGN_EPI) { if (wr == 0) PG8_BAR; }
        if constexpr (!Epi::AFTER_DRAIN) { E(acc, cur, wr, wc, fr, fq); S.done(cur); }
        if (!has_next) break;
#pragma unroll
        for (int a = 0; a < 2; ++a)
#pragma unroll
            for (int b = 0; b < 2; ++b)
#pragma unroll
                for (int m = 0; m < 4; ++m)
#pragma unroll
                    for (int n = 0; n < 2; ++n) acc[a][b][m][n] = (f32x4){0.f, 0.f, 0.f, 0.f};
        cur = nxt; cA = nA; cB = nB; ++ui;
        if constexpr (ALIGN_EPI) { if (wr == 1) PG8_BAR; }
    }
    PG8_WAIT_V(0);
    if constexpr (!ALIGN_EPI) { if (wr == 0) PG8_BAR; }
    PG8_BAR;
    if constexpr (Epi::AFTER_DRAIN) { E.fused(acc, cur, wr, wc, fr, fq, lds, wid, lane); S.done(cur); }
#undef PG8_SA
#undef PG8_SB
#undef PG8_STAGE
#undef PG8_LDA
#undef PG8_LDB
#undef PG8_MMA
#undef PG8_WAIT_V
#undef PG8_WAIT_L
#undef PG8_BAR
#undef PG8_SCHED
}
}

#define LAS __attribute__((address_space(3)))
typedef unsigned short bf16_t;
typedef short bf16x8 __attribute__((ext_vector_type(8)));
typedef float f32x4 __attribute__((ext_vector_type(4)));
typedef float f32x16 __attribute__((ext_vector_type(16)));
typedef unsigned u32x4 __attribute__((ext_vector_type(4)));
typedef unsigned u32x2 __attribute__((ext_vector_type(2)));

constexpr int DM = 1024, NBATCH = 16, SEQ = 4096, TLAT = NBATCH * SEQ, LCTX = 256, TCTX = NBATCH * LCTX, MALL = TLAT + TCTX;
constexpr int DFF = 2816, INW = 2304, NWAVES = 8, NTHR = 512;
constexpr int QS = 1536, KS_ = 2048, VS_ = 2176;
constexpr float C2 = 0.125f * 1.4426950408889634f, LOG2E = 1.4426950408889634f;
constexpr size_t MiB = 1u << 20;
constexpr size_t WS_MOD = 1 * MiB, WS_TAB = 3 * MiB, WS_WIN = 4 * MiB, WS_WMIX = 13 * MiB, WS_WF = 17 * MiB, WS_WGU = 21 * MiB, WS_WD = 65 * MiB;
constexpr size_t WS_XB = 800 * MiB  ;
constexpr size_t WS_XC = 88 * MiB, WS_H = 104 * MiB, WS_R = 240 * MiB;
constexpr size_t WS_P = WS_R, WS_CAT = WS_R + 306 * MiB, WS_ACT = WS_R, WS_Z1 = WS_R, WS_ZC = WS_R + 256 * MiB, WS_A1 = WS_R + 272 * MiB, WS_FM = WS_R, WS_END = 1024 * MiB;
constexpr size_t TAB_ROPE = 0, TAB_TW = 64 * 1024, TAB_D1 = 128 * 1024, TAB_D2 = 192 * 1024, TAB_DC = 256 * 1024, TAB_DCTX = 512 * 1024;
constexpr int LDS_BYTES = 147456;

typedef float f32x2_t __attribute__((ext_vector_type(2))); typedef __bf16 bf16x2_t __attribute__((ext_vector_type(2)));
__device__ __forceinline__ unsigned cvt_pk(float lo, float hi) { f32x2_t v = {lo, hi}; bf16x2_t b = __builtin_convertvector(v, bf16x2_t); return __builtin_bit_cast(unsigned, b); }
__device__ __forceinline__ float bf_lo(unsigned w) { return __builtin_bit_cast(float, w << 16); }
__device__ __forceinline__ float bf_hi(unsigned w) { return __builtin_bit_cast(float, w & 0xffff0000u); }
__device__ __forceinline__ float fast_exp2(float x) { return __builtin_amdgcn_exp2f(x); }
__device__ __forceinline__ float fast_rcp(float x) { return __builtin_amdgcn_rcpf(x); }
__device__ __forceinline__ float silu_f(float x) { return x * fast_rcp(1.0f + fast_exp2(-x * LOG2E)); }
typedef _Float16 h16x2_t __attribute__((ext_vector_type(2)));
__device__ __forceinline__ float h2f(unsigned lowbits) { float f; asm("v_cvt_f32_f16 %0, %1" : "=v"(f) : "v"(lowbits)); return f; }
__device__ __forceinline__ f32x4 xs_unpack(u32x2 h) { return (f32x4){h2f(h.x), h2f(h.x >> 16), h2f(h.y), h2f(h.y >> 16)}; }
typedef __fp16 fp16x2_t __attribute__((ext_vector_type(2)));
__device__ __forceinline__ u32x2 xs_pack(f32x4 v) { const fp16x2_t a = __builtin_amdgcn_cvt_pkrtz(v.x, v.y), b = __builtin_amdgcn_cvt_pkrtz(v.z, v.w); u32x2 r; r.x = __builtin_bit_cast(unsigned, a); r.y = __builtin_bit_cast(unsigned, b); return r; }
#define LDS_WAIT() asm volatile("s_waitcnt lgkmcnt(0)" ::: "memory")

struct Args {
    const float* x; const float* c; const float* ctx; const float* c_ctx; const float* w_ada; const float* b_ada; const float* n1g; const float* n2g;
    const float* w_in; const float* conv_w; const float* sink; const float* w_mix; const float* w_four; const float* w_gate; const float* w_up; const float* w_down; const float* final_g;
    float* out; unsigned char* ws;
    double invf[16];
};

struct EpiInProj {
    static constexpr bool PERM = false, AFTER_DRAIN = false;
    bf16_t* P; const float* rope;
    __device__ __forceinline__ void operator()(const f32x4 (&acc)[2][2][4][2], const pg8::Unit& u, int wr, int wc, int fr, int fq) const {
        const bool lat = u.pm < 256, doq = (u.pn == 6 || u.pn == 7), ropeT = lat && u.pn >= 6;
#pragma unroll
        for (int ai = 0; ai < 2; ++ai)
#pragma unroll
            for (int m = 0; m < 4; ++m) {
                const int row = u.pm * 256 + ai * 128 + wr * 64 + m * 16 + fr;
                f32x4 cv = {1.f, 1.f, 1.f, 1.f}, sv = {0.f, 0.f, 0.f, 0.f};
                if (ropeT) { const int t = row & 4095; const int a = (wc & 1) ? (t & 63) : (t >> 6);
                    const f32x4* rp = (const f32x4*)(rope + (a * 16 + 4 * fq) * 2); const f32x4 c0 = rp[0], c1 = rp[1];
                    cv = (f32x4){c0.x, c0.z, c1.x, c1.z}; sv = (f32x4){c0.y, c0.w, c1.y, c1.w}; }
#pragma unroll
                for (int bj = 0; bj < 2; ++bj) {
                    f32x4 x1 = acc[ai][bj][m][0], x2 = acc[ai][bj][m][1];
                    if (ropeT && !(u.pn == 8 && bj == 1)) { const f32x4 o1 = x1 * cv - x2 * sv, o2 = x2 * cv + x1 * sv; x1 = o1; x2 = o2; }
                    if (doq) { x1 = x1 * C2; x2 = x2 * C2; }
                    bf16_t* p = P + (size_t)row * INW + u.pn * 256 + bj * 128 + wc * 32 + 4 * fq;
                    u32x2 w1, w2; w1.x = cvt_pk(x1[0], x1[1]); w1.y = cvt_pk(x1[2], x1[3]); w2.x = cvt_pk(x2[0], x2[1]); w2.y = cvt_pk(x2[2], x2[3]);
                    *(u32x2*)p = w1; *(u32x2*)(p + 16) = w2;
                }
            }
    }
};
template <bool IN_F32> struct EpiRes {
    static constexpr bool PERM = false, AFTER_DRAIN = false;
    const float* in_lat; const float* in_ctx; bf16_t* xb; const float* modl; int gate_idx;
    __device__ __forceinline__ void operator()(const f32x4 (&acc)[2][2][4][2], const pg8::Unit& u, int wr, int wc, int fr, int fq) const {
        const bool lat = u.pm < 256; const int rbase = lat ? u.pm * 256 : u.pm * 256 - TLAT; const int r = lat ? (u.pm >> 4) : 16;
        const float* ip = lat ? in_lat : in_ctx;
        const float* gate = modl + (r * 6 + gate_idx) * 1024;
        const int col0 = u.pn * 256 + wc * 32 + 4 * fq;
        f32x4 gv[2][2];
#pragma unroll
        for (int bj = 0; bj < 2; ++bj)
#pragma unroll
            for (int n = 0; n < 2; ++n) gv[bj][n] = *(const f32x4*)(gate + col0 + bj * 128 + 16 * n);
        const size_t offi = (size_t)(rbase + wr * 64 + fr) * DM + col0;
        const size_t offx = (size_t)(u.pm * 256 + wr * 64 + fr) * DM + col0;
        f32x4 xf[2][2][2]; u32x2 xh[2][2][2];
#pragma unroll
        for (int bj = 0; bj < 2; ++bj)
#pragma unroll
            for (int n = 0; n < 2; ++n) { if (IN_F32) xf[0][bj][n] = *(const f32x4*)(ip + offi + bj * 128 + 16 * n); else xh[0][bj][n] = *(const u32x2*)(xb + offx + bj * 128 + 16 * n); }
#pragma unroll
        for (int grp = 0; grp < 8; ++grp) {
            const int ai = grp >> 2, m = grp & 3, cb = grp & 1;
            const size_t roff = (size_t)(ai * 128 + m * 16) * DM;
            if (grp < 7) { const int ai2 = (grp + 1) >> 2, m2 = (grp + 1) & 3; const size_t rn = (size_t)(ai2 * 128 + m2 * 16) * DM;
#pragma unroll
                for (int bj = 0; bj < 2; ++bj)
#pragma unroll
                    for (int n = 0; n < 2; ++n) { if (IN_F32) xf[cb ^ 1][bj][n] = *(const f32x4*)(ip + offi + rn + bj * 128 + 16 * n); else xh[cb ^ 1][bj][n] = *(const u32x2*)(xb + offx + rn + bj * 128 + 16 * n); } }
            asm volatile("" ::: "memory");
#pragma unroll
            for (int bj = 0; bj < 2; ++bj)
#pragma unroll
                for (int n = 0; n < 2; ++n) {
                    f32x4 xi; if (IN_F32) xi = xf[cb][bj][n]; else xi = xs_unpack(xh[cb][bj][n]);
                    const f32x4 xo = xi + gv[bj][n] * acc[ai][bj][m][n];
                    *(u32x2*)(xb + offx + roff + bj * 128 + 16 * n) = xs_pack(xo); }
            asm volatile("" ::: "memory");
        }
    }
};
struct EpiSwiGLU {
    static constexpr bool PERM = false, AFTER_DRAIN = false;
    bf16_t* ACT;
    __device__ __forceinline__ void operator()(const f32x4 (&acc)[2][2][4][2], const pg8::Unit& u, int wr, int wc, int fr, int fq) const {
#pragma unroll
        for (int ai = 0; ai < 2; ++ai)
#pragma unroll
            for (int m = 0; m < 4; ++m) {
                const int row = u.pm * 256 + ai * 128 + wr * 64 + m * 16 + fr;
#pragma unroll
                for (int bj = 0; bj < 2; ++bj) {
                    const f32x4 g = acc[ai][bj][m][0], v = acc[ai][bj][m][1];
                    const int f = (u.pn * 8 + bj * 4 + wc) * 16 + 4 * fq;
                    u32x2 w; w.x = cvt_pk(silu_f(g[0]) * v[0], silu_f(g[1]) * v[1]); w.y = cvt_pk(silu_f(g[2]) * v[2], silu_f(g[3]) * v[3]);
                    *(u32x2*)(ACT + (size_t)row * DFF + f) = w;
                }
            }
    }
};
struct EpiPlain {
    static constexpr bool PERM = false, AFTER_DRAIN = false;
    bf16_t* O; int ldc;
    __device__ __forceinline__ void operator()(const f32x4 (&acc)[2][2][4][2], const pg8::Unit& u, int wr, int wc, int fr, int fq) const {
#pragma unroll
        for (int ai = 0; ai < 2; ++ai)
#pragma unroll
            for (int m = 0; m < 4; ++m) {
                const int row = u.pm * 256 + ai * 128 + wr * 64 + m * 16 + fr;
#pragma unroll
                for (int bj = 0; bj < 2; ++bj)
#pragma unroll
                    for (int n = 0; n < 2; ++n) {
                        const f32x4 x = acc[ai][bj][m][n]; u32x2 w; w.x = cvt_pk(x[0], x[1]); w.y = cvt_pk(x[2], x[3]);
                        *(u32x2*)(O + (size_t)row * ldc + u.pn * 256 + bj * 128 + wc * 32 + 16 * n + 4 * fq) = w;
                    }
            }
    }
};

__device__ __forceinline__ void sincos_turns(double x, double& s, double& c) {
    x = x - floor(x);
    const double q4 = floor(x * 4.0 + 0.5);
    const double r = x - q4 * 0.25;
    const int q = ((int)q4) & 3;
    const double th = r * 6.283185307179586476925, t2 = th * th;
    const double sp = th * (1.0 + t2 * (-1.0 / 6 + t2 * (1.0 / 120 + t2 * (-1.0 / 5040 + t2 * (1.0 / 362880 + t2 * (-1.0 / 39916800 + t2 * (1.0 / 6227020800.0)))))));
    const double cp = 1.0 + t2 * (-0.5 + t2 * (1.0 / 24 + t2 * (-1.0 / 720 + t2 * (1.0 / 40320 + t2 * (-1.0 / 3628800 + t2 * (1.0 / 479001600.0 + t2 * (-1.0 / 87178291200.0)))))));
    if (q == 0) { s = sp; c = cp; } else if (q == 1) { s = cp; c = -sp; } else if (q == 2) { s = -sp; c = -cp; } else { s = -cp; c = sp; }
}
__device__ __forceinline__ unsigned short f2bf(float f) { return __builtin_bit_cast(unsigned short, (__bf16)f); }

__device__ __forceinline__ void transpose_item(const float* W, int K, int N, bf16_t* WT, int mode, LAS float* scr, int item, int lane) {
    const int nblk = N / 32, kb = item / nblk, nb = item % nblk, k0 = 64 * kb, n0 = 32 * nb;
#pragma unroll 8
    for (int i = 0; i < 32; ++i) { const int kk = 2 * i + (lane >> 5); scr[kk * 33 + (lane & 31)] = W[(size_t)(k0 + kk) * N + n0 + (lane & 31)]; }
    LDS_WAIT(); asm volatile("" ::: "memory");
    const int c = lane & 7;
#pragma unroll
    for (int j = 0; j < 4; ++j) { const int n = (lane >> 3) + 8 * j; const LAS float* s = scr + (8 * c) * 33 + n;
        u32x4 o; o.x = cvt_pk(s[0 * 33], s[1 * 33]); o.y = cvt_pk(s[2 * 33], s[3 * 33]); o.z = cvt_pk(s[4 * 33], s[5 * 33]); o.w = cvt_pk(s[6 * 33], s[7 * 33]);
        const int f = n0 + n; const int orow = (mode == 0) ? f : (((f >> 4) << 5) + (f & 15) + (mode == 2 ? 16 : 0));
        *(u32x4*)(WT + (size_t)orow * K + k0 + 8 * c) = o; }
    LDS_WAIT(); asm volatile("" ::: "memory");
}

__device__ __forceinline__ void prologue(const Args& A, LAS unsigned char* lds, int tid, int wave, int lane, int G) {
    unsigned char* ws = A.ws;
    {
        LAS float* scr = (LAS float*)(lds + wave * 16384);
        const int gw = blockIdx.x * NWAVES + wave, NGW = G * NWAVES;
        constexpr int I_IN = 16 * 72, I_SQ = 16 * 32, I_FF = 16 * 88, I_DN = 44 * 32;
        constexpr int NIT = 2 * I_IN + 4 * I_SQ + 8 * I_FF + 4 * I_DN;
        for (int it = gw; it < NIT; it += NGW) {
            int r = it;
            if (r < 2 * I_IN) { const int e = r / I_IN; transpose_item(A.w_in + (size_t)e * DM * INW, DM, INW, (bf16_t*)(ws + WS_WIN) + (size_t)e * INW * DM, 0, scr, r % I_IN, lane); continue; } r -= 2 * I_IN;
            if (r < 2 * I_SQ) { const int e = r / I_SQ; transpose_item(A.w_mix + (size_t)e * DM * DM, DM, DM, (bf16_t*)(ws + WS_WMIX) + (size_t)e * DM * DM, 0, scr, r % I_SQ, lane); continue; } r -= 2 * I_SQ;
            if (r < 2 * I_SQ) { const int e = r / I_SQ; transpose_item(A.w_four + (size_t)e * DM * DM, DM, DM, (bf16_t*)(ws + WS_WF) + (size_t)e * DM * DM, 0, scr, r % I_SQ, lane); continue; } r -= 2 * I_SQ;
            if (r < 4 * I_FF) { const int l = r / I_FF; transpose_item(A.w_gate + (size_t)l * DM * DFF, DM, DFF, (bf16_t*)(ws + WS_WGU) + (size_t)l * 2 * DFF * DM, 1, scr, r % I_FF, lane); continue; } r -= 4 * I_FF;
            if (r < 4 * I_FF) { const int l = r / I_FF; transpose_item(A.w_up + (size_t)l * DM * DFF, DM, DFF, (bf16_t*)(ws + WS_WGU) + (size_t)l * 2 * DFF * DM, 2, scr, r % I_FF, lane); continue; } r -= 4 * I_FF;
            { const int l = r / I_DN; transpose_item(A.w_down + (size_t)l * DFF * DM, DFF, DM, (bf16_t*)(ws + WS_WD) + (size_t)l * DM * DFF, 0, scr, r % I_DN, lane); }
        }
    }
    {
        const int gt = blockIdx.x * NTHR + tid, NGT = G * NTHR;
        float* rope = (float*)(ws + WS_TAB + TAB_ROPE); float* tw = (float*)(ws + WS_TAB + TAB_TW);
        bf16_t* D1 = (bf16_t*)(ws + WS_TAB + TAB_D1); bf16_t* D2 = (bf16_t*)(ws + WS_TAB + TAB_D2); bf16_t* DC = (bf16_t*)(ws + WS_TAB + TAB_DC); bf16_t* DX = (bf16_t*)(ws + WS_TAB + TAB_DCTX);
        constexpr int N_ROPE = 1024, N_TW = 4096, N_D1 = 16384, N_D2 = 8192, N_DC = 131072, N_DX = 131072;
        for (int i = gt; i < N_ROPE + N_TW + N_D1 + N_D2 + N_DC + N_DX; i += NGT) {
            int r = i; double s, c;
            if (r < N_ROPE) { const int a = r >> 4, f = r & 15; sincos_turns((double)a * A.invf[f] * 0.15915494309189533577, s, c); rope[2 * r] = (float)c; rope[2 * r + 1] = (float)s; continue; } r -= N_ROPE;
            if (r < N_TW) { const int k1 = r >> 6, n2 = r & 63; sincos_turns((double)(k1 * n2) / 4096.0, s, c); tw[2 * r] = (float)c; tw[2 * r + 1] = (float)s; continue; } r -= N_TW;
            if (r < N_D1) { const int row = r >> 7, col = r & 127, k1 = row >> 1, rio = row & 1, rii = col >> 6, n1 = col & 63; sincos_turns((double)((k1 * n1) & 63) / 64.0, s, c);
                const double v = (rio == rii) ? c : (rio == 0 ? s : -s); D1[r] = f2bf((float)(v * 0.125)); continue; } r -= N_D1;
            if (r < N_D2) { const int k2 = r >> 7, col = r & 127, ri = col >> 6, n2 = col & 63; sincos_turns((double)((k2 * n2) & 63) / 64.0, s, c); D2[r] = f2bf((float)((ri ? s : c) * 0.125)); continue; } r -= N_D2;
            if (r < N_DC) { const int row = r >> 8, cc = r & 255, ri = row >> 8, m = row & 255; sincos_turns((double)((m * cc) & 255) / 256.0, s, c); DC[r] = f2bf((float)((ri ? -s : c) * 0.0625)); continue; } r -= N_DC;
            { const int k = r >> 9, col = r & 511, ri = col >> 8, n = col & 255; sincos_turns((double)((k * n) & 255) / 256.0, s, c); DX[r] = f2bf((float)((ri ? s : c) * 0.0625)); }
        }
    }
    __syncthreads();
    {
        LAS float* S = (LAS float*)lds; LAS float* Pp = (LAS float*)(lds + 69632);
        for (int i = tid; i < 17 * 1024; i += NTHR) { const int r = i >> 10, k = i & 1023; const float v = (r < 16) ? A.c[r * 1024 + k] : A.c_ctx[k]; S[i] = v / (1.0f + expf(-v)); }
        __syncthreads();
        float* mod = (float*)(ws + WS_MOD);
        for (int task = blockIdx.x; task < 4 * 96; task += G) {
            const int l = task / 96, j0 = (task % 96) * 64;
            const float* w = A.w_ada + (size_t)l * 1024 * 6144 + j0 + lane;
            float acc[17];
#pragma unroll
            for (int r = 0; r < 17; ++r) acc[r] = 0.f;
#pragma unroll 4
            for (int kk = 0; kk < 128; ++kk) { const int k = wave * 128 + kk; const float wv = w[(size_t)k * 6144];
#pragma unroll
                for (int r = 0; r < 17; ++r) acc[r] += S[r * 1024 + k] * wv; }
#pragma unroll
            for (int r = 0; r < 17; ++r) Pp[(wave * 17 + r) * 64 + lane] = acc[r];
            __syncthreads();
            for (int o = tid; o < 17 * 64; o += NTHR) { const int r = o >> 6, jj = o & 63; float sum = 0.f;
#pragma unroll
                for (int w8 = 0; w8 < 8; ++w8) sum += Pp[(w8 * 17 + r) * 64 + jj];
                mod[(size_t)(l * 17 + r) * 6144 + j0 + jj] = sum + A.b_ada[l * 6144 + j0 + jj]; }
            __syncthreads();
        }
    }
}

template <bool IN_F32> __device__ __forceinline__ void norm_ld(f32x4 (&v)[4], const float* lat, const float* ctxp, const bf16_t* xb, int row, int lane) {
    if (IN_F32) { const float* xr = (row < TLAT) ? lat + (size_t)row * DM : ctxp + (size_t)(row - TLAT) * DM;
#pragma unroll
        for (int j = 0; j < 4; ++j) v[j] = *(const f32x4*)(xr + 4 * lane + 256 * j); }
    else {
#pragma unroll
        for (int j = 0; j < 4; ++j) { v[j] = xs_unpack(*(const u32x2*)(xb + (size_t)row * DM + 4 * lane + 256 * j)); } }
}
template <bool IN_F32> __device__ __forceinline__ void norm_phase(const float* lat, const float* ctxp, const bf16_t* xb, const float* g, const float* modl, int shift_idx, bf16_t* hout, int rbeg, int rend, int lane) {
    constexpr int NR = 2;
    if (rbeg >= rend) return;
    f32x4 gv[4];
#pragma unroll
    for (int j = 0; j < 4; ++j) gv[j] = *(const f32x4*)(g + 4 * lane + 256 * j);
    f32x4 vc[NR][4], vn[NR][4], scv[4], shv[4]; int rcur = -1;
#pragma unroll
    for (int q = 0; q < NR; ++q) norm_ld<IN_F32>(vc[q], lat, ctxp, xb, rbeg + q, lane);
    for (int row0 = rbeg; row0 < rend; row0 += NR) {
        const int r = (row0 < TLAT) ? (row0 >> 12) : 16;
        if (r != rcur) { rcur = r; const float* sh = modl + (r * 6 + shift_idx) * 1024; const float* sc = sh + 1024;
#pragma unroll
            for (int j = 0; j < 4; ++j) { scv[j] = (*(const f32x4*)(sc + 4 * lane + 256 * j) + 1.0f) * gv[j]; shv[j] = *(const f32x4*)(sh + 4 * lane + 256 * j); } }
        if (row0 + NR < rend) {
#pragma unroll
            for (int q = 0; q < NR; ++q) norm_ld<IN_F32>(vn[q], lat, ctxp, xb, row0 + NR + q, lane); }
        asm volatile("" ::: "memory");
#pragma unroll
        for (int q = 0; q < NR; ++q) { float ss = 0.f;
#pragma unroll
            for (int j = 0; j < 4; ++j) ss += (vc[q][j].x * vc[q][j].x + vc[q][j].y * vc[q][j].y) + (vc[q][j].z * vc[q][j].z + vc[q][j].w * vc[q][j].w);
#pragma unroll
            for (int o = 1; o < 64; o <<= 1) ss += __shfl_xor(ss, o);
            const float rstd = 1.0f / sqrtf(ss * (1.0f / DM) + 1e-6f);
#pragma unroll
            for (int j = 0; j < 4; ++j) { const f32x4 o = vc[q][j] * rstd * scv[j] + shv[j];
                u32x2 w; w.x = cvt_pk(o.x, o.y); w.y = cvt_pk(o.z, o.w);
                *(u32x2*)(hout + (size_t)(row0 + q) * DM + 4 * lane + 256 * j) = w; } }
        asm volatile("" ::: "memory");
#pragma unroll
        for (int q = 0; q < NR; ++q)
#pragma unroll
            for (int j = 0; j < 4; ++j) vc[q][j] = vn[q][j];
    }
}
__device__ __forceinline__ void final_norm_phase(const bf16_t* xb, float* xo, const float* g, int gw, int NGW, int lane) {
    constexpr int NR = 2;
    const int rpw = TLAT / NGW, rbeg = gw * rpw, rend = rbeg + rpw;
    f32x4 gv[4];
#pragma unroll
    for (int j = 0; j < 4; ++j) gv[j] = *(const f32x4*)(g + 4 * lane + 256 * j);
    f32x4 vc[NR][4], vn[NR][4];
#pragma unroll
    for (int q = 0; q < NR; ++q) norm_ld<false>(vc[q], nullptr, nullptr, xb, rbeg + q, lane);
    for (int row0 = rbeg; row0 < rend; row0 += NR) {
        if (row0 + NR < rend) {
#pragma unroll
            for (int q = 0; q < NR; ++q) norm_ld<false>(vn[q], nullptr, nullptr, xb, row0 + NR + q, lane); }
        asm volatile("" ::: "memory");
#pragma unroll
        for (int q = 0; q < NR; ++q) { float ss = 0.f;
#pragma unroll
            for (int j = 0; j < 4; ++j) ss += (vc[q][j].x * vc[q][j].x + vc[q][j].y * vc[q][j].y) + (vc[q][j].z * vc[q][j].z + vc[q][j].w * vc[q][j].w);
#pragma unroll
            for (int o = 1; o < 64; o <<= 1) ss += __shfl_xor(ss, o);
            const float rstd = 1.0f / sqrtf(ss * (1.0f / DM) + 1e-6f);
#pragma unroll
            for (int j = 0; j < 4; ++j) *(f32x4*)(xo + (size_t)(row0 + q) * DM + 4 * lane + 256 * j) = vc[q][j] * rstd * gv[j]; }
        asm volatile("" ::: "memory");
#pragma unroll
        for (int q = 0; q < NR; ++q)
#pragma unroll
            for (int j = 0; j < 4; ++j) vc[q][j] = vn[q][j];
    }
}

__device__ __forceinline__ int crow(int r, int hi) { return (r & 3) + 8 * (r >> 2) + 4 * hi; }

__device__ __forceinline__ void attn_phase(LAS unsigned char* lds, const bf16_t* P, bf16_t* cat, const float* sink, bool ctxq, int G, int tid, int wave, int lane) {
    constexpr int KROW = 144, VROW = 264;
    LAS unsigned char* Kl = lds; LAS unsigned char* Vl = lds + 128 * KROW;
    const int r32 = lane & 31, hi = lane >> 5, g = wave & 3, qh = wave >> 2;
    const int nitems = 1024 + (ctxq ? 64 : 0);
    for (int it = blockIdx.x; it < nitems; it += G) {
        int b, hk, qb, qr0; const bool isl = it < 1024;
        if (isl) { b = it >> 6; hk = (it >> 5) & 1; qb = it & 31; qr0 = b * SEQ + qb * 128; }
        else { const int j = it - 1024; b = j >> 2; hk = (j >> 1) & 1; qb = j & 1; qr0 = TLAT + b * LCTX + qb * 128; }
        const int crow0 = TLAT + b * LCTX, head = hk * 4 + g;
        bf16x8 qf[2][4];
#pragma unroll
        for (int s = 0; s < 2; ++s)
#pragma unroll
            for (int ks = 0; ks < 4; ++ks) qf[s][ks] = *(const bf16x8*)(P + (size_t)(qr0 + 64 * qh + 32 * s + r32) * INW + QS + head * 64 + 16 * ks + 8 * hi);
        float mrun[2], lrun[2]; f32x16 O[2][2];
        const float sk2 = sink[head] * LOG2E;
#pragma unroll
        for (int s = 0; s < 2; ++s) { mrun[s] = sk2; lrun[s] = 1.0f;
#pragma unroll
            for (int dt = 0; dt < 2; ++dt)
#pragma unroll
                for (int r = 0; r < 16; ++r) O[s][dt][r] = 0.f; }
#pragma unroll 1
        for (int ti = 0; ti < 5; ++ti) {
            int krow0, mtype = 0; bool valid = true;
            if (ti == 0) { krow0 = qr0 - 128; mtype = 1; valid = isl && qb > 0; }
            else if (ti == 1) { krow0 = qr0; valid = isl; }
            else if (ti == 2) { krow0 = qr0 + 128; mtype = 2; valid = isl && qb < 31; }
            else { krow0 = crow0 + (ti - 3) * 128; }
            if (!valid) continue;
            __syncthreads();
#pragma unroll
            for (int i = 0; i < 2; ++i) { const int id = tid + NTHR * i, key = id >> 3, c = id & 7;
                const u32x4 v = *(const u32x4*)(P + (size_t)(krow0 + key) * INW + KS_ + hk * 64 + 8 * c);
                *(LAS u32x4*)(Kl + key * KROW + c * 16) = v; }
#pragma unroll
            for (int i = 0; i < 2; ++i) { const int id = tid + NTHR * i, key = id & 127, c = id >> 7;
                const u32x4 v = *(const u32x4*)(P + (size_t)(krow0 + key) * INW + VS_ + hk * 64 + 8 * c);
                LAS unsigned char* vp = Vl + (8 * c) * VROW + key * 2;
                *(LAS unsigned short*)(vp + 0 * VROW) = (unsigned short)(v.x & 0xffffu); *(LAS unsigned short*)(vp + 1 * VROW) = (unsigned short)(v.x >> 16);
                *(LAS unsigned short*)(vp + 2 * VROW) = (unsigned short)(v.y & 0xffffu); *(LAS unsigned short*)(vp + 3 * VROW) = (unsigned short)(v.y >> 16);
                *(LAS unsigned short*)(vp + 4 * VROW) = (unsigned short)(v.z & 0xffffu); *(LAS unsigned short*)(vp + 5 * VROW) = (unsigned short)(v.z >> 16);
                *(LAS unsigned short*)(vp + 6 * VROW) = (unsigned short)(v.w & 0xffffu); *(LAS unsigned short*)(vp + 7 * VROW) = (unsigned short)(v.w >> 16); }
            __syncthreads();
#pragma unroll
            for (int half = 0; half < 2; ++half)
#pragma unroll
                for (int s = 0; s < 2; ++s) {
                    f32x16 S[2];
#pragma unroll
                    for (int rt = 0; rt < 2; ++rt) {
#pragma unroll
                        for (int r = 0; r < 16; ++r) S[rt][r] = 0.f;
#ifndef DIAG
                        asm volatile("" : "+v"(S[rt]));
#endif
#pragma unroll
                        for (int ks = 0; ks < 4; ++ks) { const bf16x8 kf = *(const LAS bf16x8*)(Kl + (64 * half + 32 * rt + r32) * KROW + (16 * ks + 8 * hi) * 2);
                            S[rt] = __builtin_amdgcn_mfma_f32_32x32x16_bf16(kf, qf[s][ks], S[rt], 0, 0, 0); }
                    }
                    if (mtype != 0) { int il = 64 * qh + 32 * s + r32; asm volatile("" : "+v"(il));
#pragma unroll
                        for (int rt = 0; rt < 2; ++rt)
#pragma unroll
                            for (int r = 0; r < 16; ++r) { const int jl = 64 * half + 32 * rt + crow(r, hi); const bool ok = (mtype == 1) ? (jl >= il) : (jl <= il); if (!ok) S[rt][r] = -INFINITY; } }
                    float tmax = S[0][0];
#pragma unroll
                    for (int rt = 0; rt < 2; ++rt)
#pragma unroll
                        for (int r = 0; r < 16; ++r) tmax = fmaxf(tmax, S[rt][r]);
                    tmax = fmaxf(tmax, __shfl_xor(tmax, 32));
                    const float mnew = fmaxf(mrun[s], tmax), alpha = fast_exp2(mrun[s] - mnew);
                    mrun[s] = mnew;
                    float psum = 0.f;
#pragma unroll
                    for (int rt = 0; rt < 2; ++rt)
#pragma unroll
                        for (int r = 0; r < 16; ++r) { const float p = fast_exp2(S[rt][r] - mnew); S[rt][r] = p; psum += p; }
                    psum += __shfl_xor(psum, 32);
                    lrun[s] = lrun[s] * alpha + psum;
#pragma unroll
                    for (int dt = 0; dt < 2; ++dt)
#pragma unroll
                        for (int r = 0; r < 16; ++r) O[s][dt][r] *= alpha;
#pragma unroll
                    for (int rt = 0; rt < 2; ++rt)
#pragma unroll
                        for (int s2 = 0; s2 < 2; ++s2) {
                            u32x4 pw; pw.x = cvt_pk(S[rt][8 * s2 + 0], S[rt][8 * s2 + 1]); pw.y = cvt_pk(S[rt][8 * s2 + 2], S[rt][8 * s2 + 3]);
                            pw.z = cvt_pk(S[rt][8 * s2 + 4], S[rt][8 * s2 + 5]); pw.w = cvt_pk(S[rt][8 * s2 + 6], S[rt][8 * s2 + 7]);
                            const bf16x8 pf = __builtin_bit_cast(bf16x8, pw);
#pragma unroll
                            for (int dt = 0; dt < 2; ++dt) {
                                const LAS unsigned char* vb = Vl + (32 * dt + r32) * VROW + (64 * half + 32 * rt + 16 * s2 + 4 * hi) * 2;
                                const u32x2 v0 = *(const LAS u32x2*)vb, v1 = *(const LAS u32x2*)(vb + 16);
                                const u32x4 vv = {v0.x, v0.y, v1.x, v1.y};
                                O[s][dt] = __builtin_amdgcn_mfma_f32_32x32x16_bf16(__builtin_bit_cast(bf16x8, vv), pf, O[s][dt], 0, 0, 0);
                            }
                        }
                }
        }
#pragma unroll
        for (int s = 0; s < 2; ++s) { const float inv = 1.0f / lrun[s];
            bf16_t* orow = cat + (size_t)(qr0 + 64 * qh + 32 * s + r32) * DM + 512 + head * 64;
#pragma unroll
            for (int dt = 0; dt < 2; ++dt)
#pragma unroll
                for (int q4 = 0; q4 < 4; ++q4) { u32x2 w; w.x = cvt_pk(O[s][dt][4 * q4 + 0] * inv, O[s][dt][4 * q4 + 1] * inv); w.y = cvt_pk(O[s][dt][4 * q4 + 2] * inv, O[s][dt][4 * q4 + 3] * inv);
                    *(u32x2*)(orow + 32 * dt + 8 * q4 + 4 * hi) = w; } }
    }
    __syncthreads();
}

__device__ __forceinline__ void load_u(const bf16_t* P, int t, int s0, int s1, int c8, float (&u)[8]) {
    if (t < s0 || t >= s1) {
#pragma unroll
        for (int j = 0; j < 8; ++j) u[j] = 0.f;
    } else {
        const u32x4 cv = *(const u32x4*)(P + (size_t)t * INW + 512 + 8 * c8), hv = *(const u32x4*)(P + (size_t)t * INW + 1024 + 8 * c8);
        u[0] = bf_lo(cv.x) * bf_lo(hv.x); u[1] = bf_hi(cv.x) * bf_hi(hv.x); u[2] = bf_lo(cv.y) * bf_lo(hv.y); u[3] = bf_hi(cv.y) * bf_hi(hv.y);
        u[4] = bf_lo(cv.z) * bf_lo(hv.z); u[5] = bf_hi(cv.z) * bf_hi(hv.z); u[6] = bf_lo(cv.w) * bf_lo(hv.w); u[7] = bf_hi(cv.w) * bf_hi(hv.w);
    }
}
__device__ __forceinline__ void cvt8(const u32x4 v, float (&f)[8]) { f[0] = bf_lo(v.x); f[1] = bf_hi(v.x); f[2] = bf_lo(v.y); f[3] = bf_hi(v.y); f[4] = bf_lo(v.z); f[5] = bf_hi(v.z); f[6] = bf_lo(v.w); f[7] = bf_hi(v.w); }
__device__ __forceinline__ void conv_phase(const bf16_t* P, bf16_t* cat, const float* cw, int M, int G, int tid) {
    const int c8 = tid & 63, tg = tid >> 6;
    float w0[8], w1[8], w2[8];
#pragma unroll
    for (int j = 0; j < 8; ++j) { w0[j] = cw[8 * c8 + j]; w1[j] = cw[512 + 8 * c8 + j]; w2[j] = cw[1024 + 8 * c8 + j]; }
    for (int it = blockIdx.x; it < M / 128; it += G) {
        const int t0 = it * 128, ts = t0 + 16 * tg;
        int s0, s1; if (t0 < TLAT) { s0 = t0 & ~4095; s1 = s0 + 4096; } else { s0 = TLAT + ((t0 - TLAT) & ~255); s1 = s0 + 256; }
        float up[8], uc[8];
        load_u(P, ts - 1, s0, s1, c8, up); load_u(P, ts, s0, s1, c8, uc);
#pragma unroll 1
        for (int i = 0; i < 16; i += 4) {
            const int t = ts + i;
            u32x4 bv[4], cv[4], hv[4];
#pragma unroll
            for (int q = 0; q < 4; ++q) { bv[q] = *(const u32x4*)(P + (size_t)(t + q) * INW + 8 * c8);
                const int tq = (t + q + 1 < s1) ? t + q + 1 : t + q;
                cv[q] = *(const u32x4*)(P + (size_t)tq * INW + 512 + 8 * c8); hv[q] = *(const u32x4*)(P + (size_t)tq * INW + 1024 + 8 * c8); }
            asm volatile("" ::: "memory");
#pragma unroll
            for (int q = 0; q < 4; ++q) {
                float cf[8], hf[8], bb[8], un[8], o[8]; cvt8(cv[q], cf); cvt8(hv[q], hf); cvt8(bv[q], bb);
                const bool inb = (t + q + 1 < s1);
#pragma unroll
                for (int j = 0; j < 8; ++j) { un[j] = inb ? cf[j] * hf[j] : 0.f; o[j] = bb[j] * (w0[j] * up[j] + w1[j] * uc[j] + w2[j] * un[j]); up[j] = uc[j]; uc[j] = un[j]; }
                u32x4 w; w.x = cvt_pk(o[0], o[1]); w.y = cvt_pk(o[2], o[3]); w.z = cvt_pk(o[4], o[5]); w.w = cvt_pk(o[6], o[7]);
                *(u32x4*)(cat + (size_t)(t + q) * DM + 8 * c8) = w; }
            asm volatile("" ::: "memory");
        }
    }
}

template <int MT, int KS> __device__ __forceinline__ void dft_load_a(bf16x8 (&a)[MT][KS], const bf16_t* Mat, int row0, int r32, int hi) {
#pragma unroll
    for (int rt = 0; rt < MT; ++rt)
#pragma unroll
        for (int ks = 0; ks < KS; ++ks) a[rt][ks] = *(const bf16x8*)(Mat + (size_t)(row0 + 32 * rt + r32) * (KS * 16) + 16 * ks + 8 * hi);
}
template <int MT, int KS> __device__ __forceinline__ void dft_mm(f32x16 (&acc)[MT], const bf16x8 (&a)[MT][KS], const bf16_t* vec) {
#pragma unroll
    for (int rt = 0; rt < MT; ++rt)
#pragma unroll
        for (int r = 0; r < 16; ++r) acc[rt][r] = 0.f;
#pragma unroll
    for (int rt = 0; rt < MT; ++rt) asm volatile("" : "+v"(acc[rt]));
    constexpr int KC = 8;
#pragma unroll
    for (int kc = 0; kc < KS / KC; ++kc) {
        bf16x8 b[KC];
#pragma unroll
        for (int i = 0; i < KC; ++i) b[i] = *(const bf16x8*)(vec + 16 * (kc * KC + i));
#pragma unroll
        for (int i = 0; i < KC; ++i)
#pragma unroll
            for (int rt = 0; rt < MT; ++rt) acc[rt] = __builtin_amdgcn_mfma_f32_32x32x16_bf16(a[rt][kc * KC + i], b[i], acc[rt], 0, 0, 0);
    }
}
__device__ __forceinline__ void store_pair(bf16_t* base, size_t zoo, unsigned cA, unsigned cB, float va, float vb, bool odd) {
    const float keep = odd ? vb : va, send = odd ? va : vb;
    const float got = __builtin_bit_cast(float, __builtin_amdgcn_mov_dpp(__builtin_bit_cast(int, send), 0xB1, 0xf, 0xf, true));
    const unsigned w = odd ? cvt_pk(got, keep) : cvt_pk(keep, got);
    *(unsigned*)(base + zoo + (odd ? cB : cA)) = w;
}
__device__ __forceinline__ void dft_ld8(bf16x8 (&b)[8], const bf16_t* vec) {
#pragma unroll
    for (int i = 0; i < 8; ++i) b[i] = *(const bf16x8*)(vec + 16 * i);
}
template <int MT> __device__ __forceinline__ void dft_zero(f32x16 (&acc)[MT]) {
#pragma unroll
    for (int rt = 0; rt < MT; ++rt) {
#pragma unroll
        for (int r = 0; r < 16; ++r) acc[rt][r] = 0.f;
        asm volatile("" : "+v"(acc[rt]));
    }
}
template <int MT, int KS, int K0> __device__ __forceinline__ void dft_mma8(f32x16 (&acc)[MT], const bf16x8 (&a)[MT][KS], const bf16x8 (&b)[8]) {
#pragma unroll
    for (int i = 0; i < 8; ++i)
#pragma unroll
        for (int rt = 0; rt < MT; ++rt) acc[rt] = __builtin_amdgcn_mfma_f32_32x32x16_bf16(a[rt][K0 + i], b[i], acc[rt], 0, 0, 0);
}
__device__ __forceinline__ const bf16_t* fa_vec(const bf16_t* H, int tile, int r32, int hi) {
    int token, g;
    if (tile < 8192) { const int n1h = tile & 1, n2 = (tile >> 1) & 63, b = tile >> 9; g = (tile >> 7) & 3; token = b * SEQ + 64 * (32 * n1h + r32) + n2; }
    else { const int tc = tile - 8192, nq = tc & 7, b = tc >> 5; g = (tc >> 3) & 3; token = TLAT + b * LCTX + 32 * nq + r32; }
    return H + (size_t)token * DM + g * 256 + 8 * hi;
}
__device__ __forceinline__ int fa_token(int tile, int row) {
    if (tile < 8192) { const int n1h = tile & 1, n2 = (tile >> 1) & 63, b = tile >> 9; return b * SEQ + 64 * (32 * n1h + row) + n2; }
    const int tc = tile - 8192, nq = tc & 7, b = tc >> 5; return TLAT + b * LCTX + 32 * nq + row;
}
__device__ __forceinline__ void fourier_a(LAS unsigned char* lds, const bf16_t* H, const bf16_t* DC, bf16_t* Z1, bf16_t* Zc, bool with_ctx, int G, int vcu, int wave, int lane) {
    constexpr int ROWB = 528, BUFB = 32 * ROWB;
    const int r32 = lane & 31, hi = lane >> 5, sl = wave, tid = wave * 64 + lane; const bool odd = lane & 1;
    bf16x8 a[2][16]; dft_load_a<2, 16>(a, DC, 64 * sl, r32, hi);
    const int ntile = 8192 + (with_ctx ? 512 : 0);
    const int srow0 = tid >> 5, sch = tid & 31;
    u32x4 s0, s1;
    int it = vcu, cur = 0;
    if (it < ntile) { const int tile = ntile - 1 - it; const int g = (tile < 8192) ? (tile >> 7) & 3 : ((tile - 8192) >> 3) & 3;
        s0 = *(const u32x4*)(H + (size_t)fa_token(tile, srow0) * DM + g * 256 + sch * 8); s1 = *(const u32x4*)(H + (size_t)fa_token(tile, srow0 + 16) * DM + g * 256 + sch * 8); }
    for (; it < ntile; it += G) {
        const int tile = ntile - 1 - it;
        LAS unsigned char* buf = lds + cur * BUFB;
        *(LAS u32x4*)(buf + srow0 * ROWB + sch * 16) = s0; *(LAS u32x4*)(buf + (srow0 + 16) * ROWB + sch * 16) = s1;
        __syncthreads();
        if (it + G < ntile) { const int tn = ntile - 1 - (it + G); const int g = (tn < 8192) ? (tn >> 7) & 3 : ((tn - 8192) >> 3) & 3;
            s0 = *(const u32x4*)(H + (size_t)fa_token(tn, srow0) * DM + g * 256 + sch * 8); s1 = *(const u32x4*)(H + (size_t)fa_token(tn, srow0 + 16) * DM + g * 256 + sch * 8); }
        asm volatile("" ::: "memory");
        f32x16 acc[2]; dft_zero<2>(acc);
        const LAS unsigned char* bp = buf + r32 * ROWB + hi * 16;
#pragma unroll
        for (int ks = 0; ks < 16; ++ks) { const bf16x8 bf = *(const LAS bf16x8*)(bp + ks * 32);
#pragma unroll
            for (int rt = 0; rt < 2; ++rt) acc[rt] = __builtin_amdgcn_mfma_f32_32x32x16_bf16(a[rt][ks], bf, acc[rt], 0, 0, 0); }
        if (tile < 8192) {
            const int n1h = tile & 1, n2 = (tile >> 1) & 63, g = (tile >> 7) & 3, b = tile >> 9;
            size_t zo = ((((size_t)((b * 4 + g) * 256 + 64 * (sl & 3) + 4 * hi)) * 64 + n2) * 2 + (sl >> 2)) * 64 + 32 * n1h + (r32 & ~1);
            asm volatile("" : "+v"(zo));
#pragma unroll
            for (int rt = 0; rt < 2; ++rt)
#pragma unroll
                for (int r = 0; r < 16; r += 2) store_pair(Z1, zo, (unsigned)(32 * rt + (r & 3) + 8 * (r >> 2)) * 8192u, (unsigned)(32 * rt + ((r + 1) & 3) + 8 * (r >> 2)) * 8192u, acc[rt][r], acc[rt][r + 1], odd);
        } else {
            const int tc = tile - 8192, nq = tc & 7, g = (tc >> 3) & 3, b = tc >> 5;
            size_t zo = (((size_t)((b * 4 + g) * 256 + 64 * (sl & 3) + 4 * hi)) * 2 + (sl >> 2)) * 256 + 32 * nq + (r32 & ~1);
            asm volatile("" : "+v"(zo));
#pragma unroll
            for (int rt = 0; rt < 2; ++rt)
#pragma unroll
                for (int r = 0; r < 16; r += 2) store_pair(Zc, zo, (unsigned)(32 * rt + (r & 3) + 8 * (r >> 2)) * 512u, (unsigned)(32 * rt + ((r + 1) & 3) + 8 * (r >> 2)) * 512u, acc[rt][r], acc[rt][r + 1], odd);
        }
        asm volatile("" ::: "memory");
        cur ^= 1;
    }
    __syncthreads();
}
template <int VAR> __device__ __forceinline__ void fourier_s1(const bf16_t* Z1, const bf16_t* D1, const float* tw, bf16_t* A1p, int G, int vcu, int wave, int lane) {
    const int r32 = lane & 31, hi = lane >> 5, sl = wave & 1; const bool odd = lane & 1;
    bf16x8 a[2][8]; dft_load_a<2, 8>(a, D1, 64 * sl, r32, hi);
    int tile = vcu * 4 + (wave >> 1); const int step = G * 4;
    const int n2 = 32 * (tile & 1) + r32;
    float2 twr[16];
#pragma unroll
    for (int rt = 0; rt < 2; ++rt)
#pragma unroll
        for (int q4 = 0; q4 < 4; ++q4)
#pragma unroll
            for (int e = 0; e < 2; ++e) twr[rt * 8 + q4 * 2 + e] = *(const float2*)(tw + 2 * ((32 * sl + 2 * hi + 16 * rt + 4 * q4 + e) * 64 + n2));
    bf16x8 bc[8], bn[8];
    if (tile < 32768) dft_ld8(bc, Z1 + ((size_t)tile * 32 + r32) * 128 + 8 * hi);
    for (; tile < 32768; tile += step) {
        asm volatile("" ::: "memory");
        if (tile + step < 32768) dft_ld8(bn, Z1 + ((size_t)(tile + step) * 32 + r32) * 128 + 8 * hi);
        asm volatile("" ::: "memory");
        f32x16 acc[2]; dft_zero<2>(acc);
        dft_mma8<2, 8, 0>(acc, a, bc);
        const int bgm = tile >> 1, bg = bgm >> 8, m = bgm & 255;
        size_t ao = ((((size_t)(bg * 64 + 32 * sl + 2 * hi)) * 256 + m) * 2) * 64 + (n2 & ~1);
        asm volatile("" : "+v"(ao));
#pragma unroll
        for (int rt = 0; rt < 2; ++rt)
#pragma unroll
            for (int q4 = 0; q4 < 4; ++q4)
#pragma unroll
                for (int e = 0; e < 2; ++e) { const int dk = 16 * rt + 4 * q4 + e;
                    const float re = acc[rt][4 * q4 + 2 * e], im = acc[rt][4 * q4 + 2 * e + 1];
                    const float2 cs = twr[rt * 8 + q4 * 2 + e];
                    const float re2 = re * cs.x + im * cs.y, im2 = im * cs.x - re * cs.y;
                    store_pair(A1p, ao, (unsigned)dk * 32768u, (unsigned)dk * 32768u + 64u, re2, im2, odd); }
        asm volatile("" ::: "memory");
#pragma unroll
        for (int i = 0; i < 8; ++i) bc[i] = bn[i];
    }
}
__device__ __forceinline__ void fourier_s2(const bf16_t* A1p, const bf16_t* D2, const bf16_t* Zc, const bf16_t* DX, bf16_t* FM, bool with_ctx, int G, int vcu, int gw, int NGW, int wave, int lane) {
    const int r32 = lane & 31, hi = lane >> 5; const bool odd = lane & 1;
    {
        bf16x8 a[2][8]; dft_load_a<2, 8>(a, D2, 0, r32, hi);
        bf16x8 bc[8], bn[8];
        int it = gw;
        if (it < 32768) dft_ld8(bc, A1p + ((size_t)(32767 - it) * 32 + r32) * 128 + 8 * hi);
        for (; it < 32768; it += NGW) {
            const int tile = 32767 - it;
            asm volatile("" ::: "memory");
            if (it + NGW < 32768) dft_ld8(bn, A1p + ((size_t)(32767 - it - NGW) * 32 + r32) * 128 + 8 * hi);
            asm volatile("" ::: "memory");
            f32x16 acc[2]; dft_zero<2>(acc);
            dft_mma8<2, 8, 0>(acc, a, bc);
            const int m = 32 * (tile & 7) + r32, k1 = (tile >> 3) & 63, bg = tile >> 9, b = bg >> 2, g = bg & 3;
            size_t fo = (size_t)(b * SEQ + k1 + 256 * hi) * DM + g * 256 + (m & ~1);
            asm volatile("" : "+v"(fo));
#pragma unroll
            for (int rt = 0; rt < 2; ++rt)
#pragma unroll
                for (int r = 0; r < 16; r += 2) store_pair(FM, fo, (unsigned)(32 * rt + (r & 3) + 8 * (r >> 2)) * 65536u, (unsigned)(32 * rt + ((r + 1) & 3) + 8 * (r >> 2)) * 65536u, acc[rt][r], acc[rt][r + 1], odd);
            asm volatile("" ::: "memory");
#pragma unroll
            for (int i = 0; i < 8; ++i) bc[i] = bn[i];
        }
    }
    if (with_ctx) {
        for (int tile = vcu; tile < 512; tile += G) {
            f32x16 acc;
#pragma unroll
            for (int r = 0; r < 16; ++r) acc[r] = 0.f;
            asm volatile("" : "+v"(acc));
            const bf16_t* ap = DX + (size_t)(32 * wave + r32) * 512 + 8 * hi;
            const bf16_t* bp = Zc + ((size_t)tile * 32 + r32) * 512 + 8 * hi;
#pragma unroll 1
            for (int kc = 0; kc < 4; ++kc) {
                bf16x8 av[8], bv[8];
#pragma unroll
                for (int i = 0; i < 8; ++i) { av[i] = *(const bf16x8*)(ap + 16 * (kc * 8 + i)); bv[i] = *(const bf16x8*)(bp + 16 * (kc * 8 + i)); }
#pragma unroll
                for (int i = 0; i < 8; ++i) acc = __builtin_amdgcn_mfma_f32_32x32x16_bf16(av[i], bv[i], acc, 0, 0, 0);
            }
            const int m = 32 * (tile & 7) + r32, bg = tile >> 3, b = bg >> 2, g = bg & 3;
            size_t fo = (size_t)(TLAT + b * LCTX + 32 * wave + 4 * hi) * DM + g * 256 + (m & ~1);
            asm volatile("" : "+v"(fo));
#pragma unroll
            for (int r = 0; r < 16; r += 2) store_pair(FM, fo, (unsigned)((r & 3) + 8 * (r >> 2)) * 1024u, (unsigned)(((r + 1) & 3) + 8 * (r >> 2)) * 1024u, acc[r], acc[r + 1], odd);
        }
    }
}


#define RLX_AGENT __ATOMIC_RELAXED, __HIP_MEMORY_SCOPE_AGENT
#define XB_TMO      128
#define XB_XCNT(j)  (256  + 64 * (j))
#define XB_XSUB(j)  (1280 + 64 * (j))
#define XB_XGEN(j)  (2304 + 64 * (j))
#define XB_TOP      3328
#define XB_TOPGEN   3392
#define XCD_BAR_WORDS 3456
#define XB_SPIN_CAP (1u << 18)

__device__ __forceinline__ unsigned xb_ld(unsigned* p)              { return __hip_atomic_load(p, __ATOMIC_RELAXED, __HIP_MEMORY_SCOPE_AGENT); }
__device__ __forceinline__ unsigned xb_add(unsigned* p, unsigned v) { return __hip_atomic_fetch_add(p, v, __ATOMIC_RELAXED, __HIP_MEMORY_SCOPE_AGENT); }
__device__ __forceinline__ unsigned xb_xcc_id() { return (unsigned)__builtin_amdgcn_s_getreg((3 << 11) | 20) & 0xFu; }
#define XB_SPIN(cond, bar) do { unsigned _sp = 0; while (cond) { __builtin_amdgcn_s_sleep(1); \
    if ((++_sp & 255u) == 0u) { if (xb_ld(&(bar)[XB_TMO])) break; if (_sp > XB_SPIN_CAP) { atomicAdd(&(bar)[XB_TMO], 1u); break; } } } } while (0)

struct XcdBarrier {
    unsigned* bar; unsigned x;
    volatile LAS unsigned* st;
};

__device__ __forceinline__ XcdBarrier xcd_barrier_post(unsigned* bar, volatile LAS unsigned* st) {
    XcdBarrier b; b.bar = bar; b.x = xb_xcc_id(); b.st = st;
    if (threadIdx.x == 0) (void)xb_add(&bar[XB_XCNT(b.x)], 1u);
    return b;
}
__device__ __forceinline__ void xcd_barrier_complete(unsigned* bar, unsigned x, unsigned& nloc, unsigned& nx) {
    const unsigned G = gridDim.x * gridDim.y * gridDim.z;
    unsigned sum, cnt, mine, sp = 0u;
    for (;;) {
        sum = 0u; cnt = 0u; mine = 0u;
#pragma unroll
        for (unsigned j = 0; j < 16; ++j) { const unsigned c = xb_ld(&bar[XB_XCNT(j)]); sum += c; cnt += (c > 0u) ? 1u : 0u; mine = (j == x) ? c : mine; }
        if (sum == G) break;
        __builtin_amdgcn_s_sleep(1);
        if ((++sp & 255u) == 0u) { if (xb_ld(&bar[XB_TMO])) break; if (sp > XB_SPIN_CAP) { atomicAdd(&bar[XB_TMO], 1u); break; } }
    }
    nloc = mine > 0u ? mine : 1u; nx = cnt > 0u ? cnt : 1u;
}

__device__ __forceinline__ void xcd_barrier(const XcdBarrier& b) {
    asm volatile("s_waitcnt vmcnt(0)" ::: "memory");
    __syncthreads();
    if (threadIdx.x == 0) {
        unsigned* bar = b.bar;
        __builtin_amdgcn_s_waitcnt(0);
        unsigned nloc = b.st[0], nx = b.st[1];
        if (nloc == 0u) { xcd_barrier_complete(bar, b.x, nloc, nx); b.st[0] = nloc; b.st[1] = nx; }
        const unsigned old = xb_add(&bar[XB_XSUB(b.x)], 1u);
        const unsigned gen = old / nloc;
        if (old + 1u == (gen + 1u) * nloc) {
            __builtin_amdgcn_fence(__ATOMIC_RELEASE, "agent");
            asm volatile("s_waitcnt vmcnt(0)" ::: "memory");
            const unsigned og = xb_add(&bar[XB_TOP], 1u);
            const unsigned tg = og / nx;
            if (og + 1u == (tg + 1u) * nx) xb_add(&bar[XB_TOPGEN], 1u);
            else XB_SPIN(xb_ld(&bar[XB_TOPGEN]) == tg, bar);
            __builtin_amdgcn_fence(__ATOMIC_ACQUIRE, "agent");
            xb_add(&bar[XB_XGEN(b.x)], 1u);
            asm volatile("s_waitcnt vmcnt(0)" ::: "memory");
        } else {
            XB_SPIN(xb_ld(&bar[XB_XGEN(b.x)]) == gen, bar);
            __builtin_amdgcn_fence(__ATOMIC_ACQUIRE, "agent");
            asm volatile("s_waitcnt vmcnt(0)" ::: "memory");
        }
    }
    __syncthreads();
}

#ifdef DIAG
__device__ __forceinline__ void diag_scan(unsigned* ctl, const void* buf, size_t bytes, bool is_bf16, int stage) {
    const size_t n16 = bytes / 16; const u32x4* p = (const u32x4*)buf; bool bad = false;
    int ln = (int)__builtin_amdgcn_mbcnt_hi(~0u, __builtin_amdgcn_mbcnt_lo(~0u, 0u)); asm volatile("" : "+v"(ln)); ln += 64 * __builtin_amdgcn_readfirstlane((int)threadIdx.x >> 6);
    for (size_t i = (size_t)blockIdx.x * NTHR + ln; i < n16; i += (size_t)gridDim.x * NTHR) {
        const u32x4 v = p[i];
        if (is_bf16) { for (int q = 0; q < 4; ++q) { const unsigned w = v[q]; if (((w >> 7) & 0xff) == 0xff || ((w >> 23) & 0xff) == 0xff) bad = true; } }
        else { for (int q = 0; q < 4; ++q) { if (((v[q] >> 23) & 0xff) >= 0xf0) bad = true; } }
    }
    if (bad) atomicMin(ctl, (unsigned)stage);
}
#define DIAG_SCAN(buf, bytes, isbf, stage) diag_scan((unsigned*)ws, buf, bytes, isbf, stage)
#else
#define DIAG_SCAN(buf, bytes, isbf, stage) do {} while (0)
#endif

#ifdef DIAG2
__device__ __forceinline__ void diag_max(unsigned* ctl, const void* buf, size_t bytes) {
    const size_t n16 = bytes / 16; const u32x4* p = (const u32x4*)buf; unsigned mx = 0, nb = 0;
    int ln = (int)__builtin_amdgcn_mbcnt_hi(~0u, __builtin_amdgcn_mbcnt_lo(~0u, 0u)); asm volatile("" : "+v"(ln)); ln += 64 * __builtin_amdgcn_readfirstlane((int)threadIdx.x >> 6);
    for (size_t i = (size_t)blockIdx.x * NTHR + ln; i < n16; i += (size_t)gridDim.x * NTHR) {
        const u32x4 v = p[i];
        for (int q = 0; q < 4; ++q) { const unsigned lo = (v[q] << 16) & 0x7fffffffu, hi = v[q] & 0x7fff0000u;
            if ((lo >> 23) == 0xff) ++nb; else mx = mx > lo ? mx : lo;
            if ((hi >> 23) == 0xff) ++nb; else mx = mx > hi ? mx : hi; }
    }
    atomicMax(ctl + 1, mx); if (nb) atomicAdd(ctl + 2, nb);
}
#endif

#ifdef TSEL
#define TBEG(c) do { if ((TSEL >> (c)) & 1) t0_ = __builtin_amdgcn_s_memrealtime(); } while (0)
#define TEND(c) do { if ((TSEL >> (c)) & 1) tacc_ += __builtin_amdgcn_s_memrealtime() - t0_; } while (0)
#else
#define TBEG(c) do {} while (0)
#define TEND(c) do {} while (0)
#endif
__global__ void __launch_bounds__(NTHR, 2) fwd_megakernel(Args A) {
    extern __shared__ __attribute__((aligned(16))) unsigned char lds_raw[];
    cg::grid_group grid = cg::this_grid();
#define GRID_SYNC() xcd_barrier(xbar)
#define CG_SYNC() do { asm volatile("s_waitcnt vmcnt(0) lgkmcnt(0)" ::: "memory"); grid.sync(); } while (0)
    LAS unsigned char* lds = (LAS unsigned char*)lds_raw;
    const int wave = __builtin_amdgcn_readfirstlane((int)threadIdx.x >> 6);
#define FRESH_LANE(v) int v = LANE_ID(); asm volatile("" : "+v"(v))
#define LANE_ID() ((int)__builtin_amdgcn_mbcnt_hi(~0u, __builtin_amdgcn_mbcnt_lo(~0u, 0u)))
    const int lane = LANE_ID(), tid = wave * 64 + lane;
    const int G = gridDim.x, gw = blockIdx.x * NWAVES + wave, NGW = G * NWAVES;
    const int vcu = (G % 8 == 0) ? ((int)blockIdx.x % 8) * (G / 8) + (int)blockIdx.x / 8 : (int)blockIdx.x;
    const int gwv = vcu * NWAVES + wave;
    unsigned char* ws = A.ws;
    volatile LAS unsigned* xb_st = (volatile LAS unsigned*)(lds + 131072 + 64);
    if (threadIdx.x == 0) { xb_st[0] = 0u; xb_st[1] = 0u; }
    __syncthreads();
    const XcdBarrier xbar = xcd_barrier_post((unsigned*)ws + 4096, xb_st);
#ifdef TSEL
    unsigned long long t0_ = 0, tacc_ = 0;
#endif
#ifdef DIAG
    if (blockIdx.x == 0 && threadIdx.x == 0) *(unsigned*)ws = 0x7fffffffu;
#endif
#ifdef DIAG2
    if (blockIdx.x == 0 && threadIdx.x == 0) { ((unsigned*)ws)[1] = 0u; ((unsigned*)ws)[2] = 0u; }
#endif
    float* mod = (float*)(ws + WS_MOD);
    const float* rope = (const float*)(ws + WS_TAB + TAB_ROPE); const float* tw = (const float*)(ws + WS_TAB + TAB_TW);
    const bf16_t* D1 = (const bf16_t*)(ws + WS_TAB + TAB_D1); const bf16_t* D2 = (const bf16_t*)(ws + WS_TAB + TAB_D2);
    const bf16_t* DC = (const bf16_t*)(ws + WS_TAB + TAB_DC); const bf16_t* DX = (const bf16_t*)(ws + WS_TAB + TAB_DCTX);
    bf16_t* XB = (bf16_t*)(ws + WS_XB);
    bf16_t* Hb = (bf16_t*)(ws + WS_H); bf16_t* Pb = (bf16_t*)(ws + WS_P); bf16_t* CAT = (bf16_t*)(ws + WS_CAT); bf16_t* ACT = (bf16_t*)(ws + WS_ACT);
    bf16_t* Z1 = (bf16_t*)(ws + WS_Z1); bf16_t* Zc = (bf16_t*)(ws + WS_ZC); bf16_t* A1p = (bf16_t*)(ws + WS_A1); bf16_t* FM = (bf16_t*)(ws + WS_FM);


#ifndef SKIP_PRO
        TBEG(10);
    prologue(A, lds, tid, wave, lane, G);
#endif

    CG_SYNC();
        TEND(10);

    DIAG_SCAN(mod, 4 * 17 * 6144 * 4, false, 1); DIAG_SCAN(ws + WS_WIN, (size_t)83 * MiB, true, 2); DIAG_SCAN(ws + WS_TAB + TAB_D1, 640 * 1024, true, 3); DIAG_SCAN(ws + WS_TAB, 96 * 1024, false, 4);
#pragma unroll 1
    for (int l = 0; l < 4; ++l) {
        const bool even = (l & 1) == 0; const int e = l >> 1;
        const bool ctx_after = l < 2;
        const bool ctx_here = l < 3;
        const int Mfull = ctx_here ? MALL : TLAT;
        const int Mres = ctx_after ? MALL : TLAT;
        const float* modl = mod + (size_t)l * 17 * 6144;
        TBEG(4);
        if (l == 0 || l == 3) {
        { FRESH_LANE(lane_l); const int rpw_ = Mfull / NGW; if (l == 0) norm_phase<true>(A.x, A.ctx, XB, A.n1g + l * DM, modl, 0, Hb, gw * rpw_, gw * rpw_ + rpw_, lane_l); else norm_phase<false>(A.x, A.ctx, XB, A.n1g + l * DM, modl, 0, Hb, gw * rpw_, gw * rpw_ + rpw_, lane_l); }
        GRID_SYNC();
        }
        TEND(4);
        DIAG_SCAN(Hb, (size_t)Mfull * DM * 2, true, 10 + 10 * l);
        const bf16_t* mixA; const bf16_t* mixW;
        if (even) {
        TBEG(0);
            { int tg = LANE_ID(); asm volatile("" : "+v"(tg)); tg += wave * 64; pg8::Gemm g{Hb, (const bf16_t*)(ws + WS_WIN) + (size_t)e * INW * DM, Mfull, INW, DM}; pg8::StaticOrder S; S.init(Mfull, INW, G, (int)blockIdx.x);
              EpiInProj E{Pb, rope};
              pg8::gemm_phase<EpiInProj, pg8::StaticOrder, true, true>(lds, g, S, E, tg); }
            GRID_SYNC();
        TEND(0);
        DIAG_SCAN(Pb, (size_t)Mfull * INW * 2, true, 11 + 10 * l);

#ifndef SKIP_ATT
        TBEG(5);
            { FRESH_LANE(lane_l); const int tid_l = wave * 64 + lane_l; (void)tid_l; attn_phase(lds, Pb, CAT, A.sink + e * 8, ctx_after, G, tid_l, wave, lane_l); }
        TEND(5);
#endif


#ifndef SKIP_CONV
        TBEG(6);
            { FRESH_LANE(lane_l); const int tid_l = wave * 64 + lane_l; (void)tid_l; conv_phase(Pb, CAT, A.conv_w + e * 3 * 512, Mres, G, tid_l); }
#endif

            GRID_SYNC();
        TEND(6);
        DIAG_SCAN(CAT, (size_t)Mres * DM * 2, true, 12 + 10 * l);
            mixA = CAT; mixW = (const bf16_t*)(ws + WS_WMIX) + (size_t)e * DM * DM;
        } else {

#ifndef SKIP_FA
        TBEG(7);
            { FRESH_LANE(lane_l); const int tid_l = wave * 64 + lane_l; (void)tid_l; fourier_a(lds, Hb, DC, Z1, Zc, ctx_after, G, vcu, wave, lane_l); }
#endif

            GRID_SYNC();
        TEND(7);
        DIAG_SCAN(Z1, (size_t)128 * MiB, true, 11 + 10 * l); DIAG_SCAN(Z1 + 64 * MiB, (size_t)128 * MiB, true, 12 + 10 * l); DIAG_SCAN(Zc, (size_t)16 * MiB, true, 13 + 10 * l);
#ifdef DIAG2
        if (l == DIAG2_L) diag_max((unsigned*)ws, DIAG2_BUF, DIAG2_BYTES);
#endif

#ifndef SKIP_S1
        TBEG(8);
            { FRESH_LANE(lane_l); const int tid_l = wave * 64 + lane_l; (void)tid_l; fourier_s1<0>(Z1, D1, tw, A1p, G, vcu, wave, lane_l); }
#endif

            GRID_SYNC();
        TEND(8);
        DIAG_SCAN(A1p, (size_t)256 * MiB, true, 14 + 10 * l);

#ifndef SKIP_S2
        TBEG(9);
            { FRESH_LANE(lane_l); const int tid_l = wave * 64 + lane_l; (void)tid_l; fourier_s2(A1p, D2, Zc, DX, FM, ctx_after, G, vcu, gwv, NGW, wave, lane_l); }
#endif

            GRID_SYNC();
        TEND(9);
        DIAG_SCAN(FM, (size_t)Mres * DM * 2, true, 15 + 10 * l);
            mixA = FM; mixW = (const bf16_t*)(ws + WS_WF) + (size_t)e * DM * DM;
        }
        TBEG(1);
        { int tg = LANE_ID(); asm volatile("" : "+v"(tg)); tg += wave * 64; pg8::Gemm g{mixA, mixW, Mres, DM, DM}; pg8::StaticOrder S; S.init(Mres, DM, G, (int)blockIdx.x);
          if (l == 0) { EpiRes<true> E{A.x, A.ctx, XB, modl, 2}; pg8::gemm_phase<EpiRes<true>, pg8::StaticOrder, true, true>(lds, g, S, E, tg); }
          else { EpiRes<false> E{A.x, A.ctx, XB, modl, 2}; pg8::gemm_phase<EpiRes<false>, pg8::StaticOrder, true, true>(lds, g, S, E, tg); } }
        GRID_SYNC();
        TEND(1);
        TBEG(4);
        { FRESH_LANE(lane_l); const int tid_l = wave * 64 + lane_l; (void)tid_l; const int rpw_ = Mres / NGW; norm_phase<false>(A.x, A.ctx, XB, A.n2g + l * DM, modl, 3, Hb, gw * rpw_, gw * rpw_ + rpw_, lane_l); }
        GRID_SYNC();
        TEND(4);
        DIAG_SCAN(Hb, (size_t)Mres * DM * 2, true, 17 + 10 * l);
        TBEG(2);
        { int tg = LANE_ID(); asm volatile("" : "+v"(tg)); tg += wave * 64; pg8::Gemm g{Hb, (const bf16_t*)(ws + WS_WGU) + (size_t)l * 2 * DFF * DM, Mres, 2 * DFF, DM}; pg8::StaticOrder S; S.init(Mres, 2 * DFF, G, (int)blockIdx.x);
          EpiSwiGLU E{ACT};
          pg8::gemm_phase<EpiSwiGLU, pg8::StaticOrder, true, true>(lds, g, S, E, tg); }
        GRID_SYNC();
        TEND(2);
        DIAG_SCAN(ACT, (size_t)Mres * DFF * 2, true, 18 + 10 * l);
        TBEG(3);
        { int tg = LANE_ID(); asm volatile("" : "+v"(tg)); tg += wave * 64; pg8::Gemm g{ACT, (const bf16_t*)(ws + WS_WD) + (size_t)l * DM * DFF, TLAT, DM, DFF}; pg8::StaticOrder S; S.init(TLAT, DM, G, (int)blockIdx.x);
          EpiRes<false> E{A.x, A.ctx, XB, modl, 5}; pg8::gemm_phase<EpiRes<false>, pg8::StaticOrder, true, true>(lds, g, S, E, tg); }
        GRID_SYNC();
        if (l < 2) {
            const float* modn = mod + (size_t)(l + 1) * 17 * 6144;
            if (blockIdx.x < 64) {
                int tg = LANE_ID(); asm volatile("" : "+v"(tg)); tg += wave * 64; pg8::Gemm g{ACT, (const bf16_t*)(ws + WS_WD) + (size_t)l * DM * DFF, MALL, DM, DFF}; pg8::StaticOrder S; S.init(TCTX, DM, 64, (int)blockIdx.x); S.pm_off = 256;
                EpiRes<false> E{A.x, A.ctx, XB, modl, 5}; pg8::gemm_phase<EpiRes<false>, pg8::StaticOrder, true, true>(lds, g, S, E, tg);
            } else {
                FRESH_LANE(lane_l); const int gw2 = ((int)blockIdx.x - 64) * NWAVES + wave, rb = gw2 * 44;
                norm_phase<false>(A.x, A.ctx, XB, A.n1g + (l + 1) * DM, modn, 0, Hb, rb, (rb + 44 < TLAT) ? rb + 44 : TLAT, lane_l);
            }
            GRID_SYNC();
            { FRESH_LANE(lane_l); norm_phase<false>(A.x, A.ctx, XB, A.n1g + (l + 1) * DM, modn, 0, Hb, TLAT + 2 * gw, TLAT + 2 * gw + 2, lane_l); }
            GRID_SYNC();
        }
        TEND(3);
    }
    { int lane_f = LANE_ID(); asm volatile("" : "+v"(lane_f)); final_norm_phase(XB, A.out, A.final_g, gw, NGW, lane_f); }
#ifdef TSEL
    if (blockIdx.x == 0) { const unsigned long long ts_ = __builtin_amdgcn_s_memrealtime(); while (__builtin_amdgcn_s_memrealtime() - ts_ < (unsigned long long)TMULT * tacc_) __builtin_amdgcn_s_sleep(8); }
#endif
#ifdef DIAG2
    GRID_SYNC();
    if (blockIdx.x == 0 && threadIdx.x == 0) { const unsigned mx = ((volatile unsigned*)ws)[1], nb = ((volatile unsigned*)ws)[2]; A.out[0] = 1000.f * __builtin_bit_cast(float, mx); A.out[1] = nb ? 1e9f + 1000.f * (float)nb : 0.f; }
#endif
#ifdef DIAG
    GRID_SYNC();
    if (blockIdx.x == 0 && threadIdx.x == 0) { const unsigned c = *(volatile unsigned*)ws; A.out[0] = (c == 0x7fffffffu) ? 999000.f : 1000.f * (float)c; }
#endif
}

extern "C" void kernel_launch(void* const* d_in, const int* in_sizes, int n_in, void* d_out, int out_size, void* d_ws, size_t ws_size, hipStream_t stream) {
    static int grid = 0;
    if (grid == 0) {
        if (n_in != 17 || out_size != TLAT * DM || ws_size < WS_END) { fprintf(stderr, "kernel_launch: unexpected shapes (n_in %d, out %d, ws %zu)\n", n_in, out_size, ws_size); grid = -1; return; }
        int dev = 0, cus = 0, per_cu = 0;
        hipGetDevice(&dev); hipDeviceGetAttribute(&cus, hipDeviceAttributeMultiprocessorCount, dev);
        if (hipFuncSetAttribute((const void*)fwd_megakernel, hipFuncAttributeMaxDynamicSharedMemorySize, LDS_BYTES) != hipSuccess) { fprintf(stderr, "kernel_launch: hipFuncSetAttribute failed\n"); grid = -1; return; }
        if (hipOccupancyMaxActiveBlocksPerMultiprocessor(&per_cu, (const void*)fwd_megakernel, NTHR, LDS_BYTES) != hipSuccess || per_cu < 1) { fprintf(stderr, "kernel_launch: occupancy query says %d\n", per_cu); per_cu = 1; }
        (void)hipGetLastError();
        grid = cus * 1;
    }
    if (grid < 0) return;
    if (hipMemsetAsync(d_ws, 0, 65536, stream) != hipSuccess) { fprintf(stderr, "kernel_launch: hipMemsetAsync of the barrier words failed\n"); return; }
    Args a{};
    a.x = (const float*)d_in[0]; a.c = (const float*)d_in[1]; a.ctx = (const float*)d_in[2]; a.c_ctx = (const float*)d_in[3]; a.w_ada = (const float*)d_in[4]; a.b_ada = (const float*)d_in[5];
    a.n1g = (const float*)d_in[6]; a.n2g = (const float*)d_in[7]; a.w_in = (const float*)d_in[8]; a.conv_w = (const float*)d_in[9]; a.sink = (const float*)d_in[10]; a.w_mix = (const float*)d_in[11];
    a.w_four = (const float*)d_in[12]; a.w_gate = (const float*)d_in[13]; a.w_up = (const float*)d_in[14]; a.w_down = (const float*)d_in[15]; a.final_g = (const float*)d_in[16];
    a.out = (float*)d_out; a.ws = (unsigned char*)d_ws;
    for (int f = 0; f < 16; ++f) a.invf[f] = pow(10000.0, -(double)f / 16.0);
    void* args[] = {&a};
    hipError_t e = hipLaunchCooperativeKernel((const void*)fwd_megakernel, dim3(grid), dim3(NTHR), args, LDS_BYTES, stream);
    if (e != hipSuccess) fprintf(stderr, "kernel_launch: cooperative launch failed: %s (grid %d)\n", hipGetErrorString(e), grid);
}
```

```cpp
#include <hip/hip_runtime.h>
#include <hip/hip_cooperative_groups.h>
#include <cstdio>
#include <cstdint>
#include <cmath>
namespace cg = cooperative_groups;

namespace pg8 {
#define PG8_LAS __attribute__((address_space(3)))
typedef unsigned short bf16_t;
typedef short bf16x8 __attribute__((ext_vector_type(8)));
typedef float f32x4 __attribute__((ext_vector_type(4)));
typedef unsigned u32x4 __attribute__((ext_vector_type(4)));
constexpr int BM = 256, BK = 64, HALF = 128, HTB = HALF * BK * 2  , STAGE_BYTES = 8 * HTB, NXCD = 8, WGM = 8;

__host__ __device__ __forceinline__ int lds_byte(int r, int c) { const int st = (r >> 4) * 2 + (c >> 5), rr = r & 15, cc = c & 31, ob = rr * 64 + cc * 2; return st * 1024 + (ob ^ (((ob >> 9) & 1) << 5)); }
__host__ __device__ __forceinline__ void stage_rc(int b, int& R, int& C) { const int st = b / 1024, sb = b % 1024, swz = sb ^ (((sb >> 9) & 1) << 5); R = (st >> 1) * 16 + swz / 64; C = (st & 1) * 32 + (swz % 64) / 2; }
__host__ __device__ __forceinline__ int perm32(int rho) { const int n = rho >> 4, i = rho & 15; return 8 * (i >> 2) + 4 * n + (i & 3); }

struct Unit { int pm, pn; };
struct Gemm { const bf16_t* A; const bf16_t* Bt; int M, N, K; };

struct StaticOrder {
    int nM, nN, nwg, G, c, pm_off;
    __host__ __device__ void init(int M, int N, int G_, int c_) { nM = M / BM; nN = N / BM; nwg = nM * nN; G = G_; c = c_; pm_off = 0; }
    __host__ __device__ bool next(int i, Unit& u) const {
        const long L = (long)i * G + c; if (L >= nwg) return false;
        int wgid = (int)L; { const int q = nwg / NXCD, r = nwg % NXCD, xcd = wgid % NXCD, off = wgid / NXCD; wgid = (xcd < r ? xcd * (q + 1) : r * (q + 1) + (xcd - r) * q) + off; }
        const int nig = WGM * nN, gid = wgid / nig, fm = gid * WGM, gsz = (nM - fm) < WGM ? (nM - fm) : WGM;
        u.pm = pm_off + fm + ((wgid % nig) % gsz); u.pn = (wgid % nig) / gsz; return true;
    }
    __device__ __forceinline__ void a_ready(const Unit&) const {}
    __device__ __forceinline__ void done(const Unit&) const {}
};

template <class Epi, class Sched, bool ALIGN_EPI = false, bool SP2 = false>
__device__ __forceinline__ void gemm_phase(PG8_LAS unsigned char* lds, const Gemm g, const Sched& S, const Epi& E, int tid_in) {
    const int tid = tid_in, wid = __builtin_amdgcn_readfirstlane(tid >> 6), lane = tid & 63, wr = wid >> 2, wc = wid & 3, fr = lane & 15, fq = lane >> 4;
    const int K = g.K, nt = K / BK;
    unsigned voffA[2], voffB[2];
#pragma unroll
    for (int i = 0; i < 2; ++i) { int R, C; stage_rc(tid * 16 + i * 8192, R, C); const int Rb = Epi::PERM ? ((R & ~31) + perm32(R & 31)) : R;
        voffA[i] = (unsigned)(R * K + C) * 2u; voffB[i] = (unsigned)(Rb * K + C) * 2u; }
    const size_t kstep = (size_t)(BK * 2);
    const size_t hstep = (size_t)HALF * K * 2;
    const size_t tstep = 2 * hstep;
    const unsigned ldsw = (unsigned)wid * 1024u;
    const int aoff = lds_byte(wr * 64 + fr, fq * 8), boff = lds_byte(wc * 32 + fr, fq * 8);
#define PG8_SA(b, h) (((b) * 2 + (h)) * HTB)
#define PG8_SB(b, h) ((4 + (b) * 2 + (h)) * HTB)
#define PG8_STAGE(bufoff, gbase, voff) do { _Pragma("unroll") for (int _i = 0; _i < 2; ++_i) \
        __builtin_amdgcn_global_load_lds((const unsigned*)((const char*)(gbase) + (voff)[_i]), (PG8_LAS unsigned*)(lds + (bufoff) + ldsw + _i * 8192), 16, 0, 0); } while (0)
#define PG8_LDA(dst, b, h) do { _Pragma("unroll") for (int m = 0; m < 4; ++m) _Pragma("unroll") for (int k = 0; k < 2; ++k) dst[m][k] = *(const PG8_LAS bf16x8*)(lds + PG8_SA(b, h) + aoff + m * 2048 + k * 1024); } while (0)
#define PG8_LDB(dst, b, h) do { _Pragma("unroll") for (int n = 0; n < 2; ++n) _Pragma("unroll") for (int k = 0; k < 2; ++k) dst[n][k] = *(const PG8_LAS bf16x8*)(lds + PG8_SB(b, h) + boff + n * 2048 + k * 1024); } while (0)
#define PG8_MMA(ai, bj, At, Bt) do { __builtin_amdgcn_s_setprio(1); _Pragma("unroll") for (int m = 0; m < 4; ++m) _Pragma("unroll") for (int n = 0; n < 2; ++n) _Pragma("unroll") for (int k = 0; k < 2; ++k) \
        acc[ai][bj][m][n] = __builtin_amdgcn_mfma_f32_16x16x32_bf16(Bt[n][k], At[m][k], acc[ai][bj][m][n], 0, 0, 0); __builtin_amdgcn_s_setprio(0); } while (0)
#define PG8_WAIT_V(n) asm volatile("s_waitcnt vmcnt(" #n ")" ::: "memory")
#define PG8_WAIT_L(n) asm volatile("s_waitcnt lgkmcnt(" #n ")" ::: "memory")
#define PG8_BAR __builtin_amdgcn_s_barrier()
#define PG8_SCHED __builtin_amdgcn_sched_barrier(0)
    Unit cur, nxt; int ui = 0;
    if (!S.next(0, cur)) return;
    f32x4 acc[2][2][4][2];
#pragma unroll
    for (int a = 0; a < 2; ++a)
#pragma unroll
        for (int b = 0; b < 2; ++b)
#pragma unroll
            for (int m = 0; m < 4; ++m)
#pragma unroll
                for (int n = 0; n < 2; ++n) acc[a][b][m][n] = (f32x4){0.f, 0.f, 0.f, 0.f};
    bf16x8 At[4][2], B0[2][2], B1[2][2];
    const char* cA = (const char*)g.A + (size_t)cur.pm * tstep; const char* cB = (const char*)g.Bt + (size_t)cur.pn * tstep;
    S.a_ready(cur);
    if constexpr (SP2) {
        PG8_STAGE(PG8_SB(0, 0), cB, voffB); PG8_STAGE(PG8_SB(0, 1), cB + hstep, voffB); PG8_STAGE(PG8_SA(0, 0), cA, voffA); PG8_STAGE(PG8_SA(0, 1), cA + hstep, voffA);
        if (wr == 1) PG8_BAR;
        PG8_WAIT_V(2); PG8_BAR;
        PG8_STAGE(PG8_SB(1, 0), cB + kstep, voffB); PG8_STAGE(PG8_SA(1, 0), cA + kstep, voffA); PG8_STAGE(PG8_SB(1, 1), cB + hstep + kstep, voffB);
        PG8_WAIT_V(6); PG8_BAR;
    } else {
        PG8_STAGE(PG8_SB(0, 0), cB, voffB); PG8_STAGE(PG8_SA(0, 0), cA, voffA); PG8_STAGE(PG8_SB(0, 1), cB + hstep, voffB); PG8_STAGE(PG8_SA(0, 1), cA + hstep, voffA);
        if (wr == 1) PG8_BAR;
        PG8_WAIT_V(4); PG8_BAR;
        PG8_STAGE(PG8_SB(1, 0), cB + kstep, voffB); PG8_STAGE(PG8_SA(1, 0), cA + kstep, voffA); PG8_STAGE(PG8_SB(1, 1), cB + hstep + kstep, voffB);
        PG8_WAIT_V(6); PG8_BAR;
    }
    for (;;) {
        const bool has_next = S.next(ui + 1, nxt);
        const char* nA = has_next ? (const char*)g.A + (size_t)nxt.pm * tstep : cA; const char* nB = has_next ? (const char*)g.Bt + (size_t)nxt.pn * tstep : cB;
        for (int t = 0; t < nt; t += 2) {
            const bool last = (t == nt - 2);
            const char* a1 = cA + (size_t)(t + 1) * kstep;
            const char* a2 = last ? nA : cA + (size_t)(t + 2) * kstep; const char* b2 = last ? nB : cB + (size_t)(t + 2) * kstep;
            const char* a3 = a2 + kstep; const char* b3 = b2 + kstep;
            if (last && has_next) S.a_ready(nxt);
            if constexpr (SP2) {
            PG8_LDB(B0, 0, 0); PG8_LDB(B1, 0, 1); PG8_SCHED; PG8_LDA(At, 0, 0); PG8_STAGE(PG8_SA(1, 1), a1 + hstep, voffA);
            PG8_WAIT_V(8); PG8_WAIT_L(0); PG8_BAR; PG8_MMA(0, 0, At, B0); PG8_MMA(0, 1, At, B1); PG8_BAR; PG8_SCHED;
            PG8_LDA(At, 0, 1); PG8_STAGE(PG8_SB(0, 0), b2, voffB); PG8_STAGE(PG8_SB(0, 1), b2 + hstep, voffB); PG8_STAGE(PG8_SA(0, 0), a2, voffA);
            PG8_WAIT_V(8); PG8_WAIT_L(0); PG8_BAR; PG8_MMA(1, 0, At, B0); PG8_MMA(1, 1, At, B1); PG8_BAR; PG8_SCHED;
            PG8_LDB(B0, 1, 0); PG8_LDB(B1, 1, 1); PG8_SCHED; PG8_LDA(At, 1, 0); PG8_STAGE(PG8_SA(0, 1), a2 + hstep, voffA);
            PG8_WAIT_V(8); PG8_WAIT_L(0); PG8_BAR; PG8_MMA(0, 0, At, B0); PG8_MMA(0, 1, At, B1); PG8_BAR; PG8_SCHED;
            PG8_LDA(At, 1, 1); PG8_STAGE(PG8_SB(1, 0), b3, voffB); PG8_STAGE(PG8_SB(1, 1), b3 + hstep, voffB); PG8_STAGE(PG8_SA(1, 0), a3, voffA);
            PG8_WAIT_V(8); PG8_WAIT_L(0); PG8_BAR; PG8_MMA(1, 0, At, B0); PG8_MMA(1, 1, At, B1); PG8_BAR; PG8_SCHED;
            } else {
            PG8_LDB(B0, 0, 0); PG8_SCHED; PG8_LDA(At, 0, 0); PG8_STAGE(PG8_SA(1, 1), a1 + hstep, voffA);
            PG8_WAIT_L(8); PG8_BAR; PG8_WAIT_L(0); PG8_MMA(0, 0, At, B0); PG8_BAR; PG8_SCHED;
            PG8_LDB(B1, 0, 1); PG8_STAGE(PG8_SB(0, 0), b2, voffB);
            PG8_BAR; PG8_WAIT_L(0); PG8_MMA(0, 1, At, B1); PG8_BAR;
            PG8_LDA(At, 0, 1); PG8_STAGE(PG8_SA(0, 0), a2, voffA);
            PG8_BAR; PG8_WAIT_L(0); PG8_MMA(1, 0, At, B0); PG8_BAR; PG8_SCHED;
            PG8_STAGE(PG8_SB(0, 1), b2 + hstep, voffB);
            PG8_WAIT_V(6); PG8_BAR; PG8_MMA(1, 1, At, B1); PG8_BAR;
            PG8_LDB(B0, 1, 0); PG8_SCHED; PG8_LDA(At, 1, 0); PG8_STAGE(PG8_SA(0, 1), a2 + hstep, voffA);
            PG8_WAIT_L(8); PG8_BAR; PG8_WAIT_L(0); PG8_MMA(0, 0, At, B0); PG8_BAR; PG8_SCHED;
            PG8_LDB(B1, 1, 1); PG8_STAGE(PG8_SB(1, 0), b3, voffB);
            PG8_BAR; PG8_WAIT_L(0); PG8_MMA(0, 1, At, B1); PG8_BAR;
            PG8_LDA(At, 1, 1); PG8_STAGE(PG8_SA(1, 0), a3, voffA);
            PG8_BAR; PG8_WAIT_L(0); PG8_MMA(1, 0, At, B0); PG8_BAR; PG8_SCHED;
            PG8_STAGE(PG8_SB(1, 1), b3 + hstep, voffB);
            PG8_WAIT_V(6); PG8_BAR; PG8_MMA(1, 1, At, B1); PG8_BAR;
            }
        }
        if constexpr (ALIGN_EPI) { if (wr == 0) PG8_BAR; }
        if constexpr (!Epi::AFTER_DRAIN) { E(acc, cur, wr, wc, fr, fq); S.done(cur); }
        if (!has_next) break;
#pragma unroll
        for (int a = 0; a < 2; ++a)
#pragma unroll
            for (int b = 0; b < 2; ++b)
#pragma unroll
                for (int m = 0; m < 4; ++m)
#pragma unroll
                    for (int n = 0; n < 2; ++n) acc[a][b][m][n] = (f32x4){0.f, 0.f, 0.f, 0.f};
        cur = nxt; cA = nA; cB = nB; ++ui;
        if constexpr (ALIGN_EPI) { if (wr == 1) PG8_BAR; }
    }
    PG8_WAIT_V(0);
    if constexpr (!ALIGN_EPI) { if (wr == 0) PG8_BAR; }
    PG8_BAR;
    if constexpr (Epi::AFTER_DRAIN) { E.fused(acc, cur, wr, wc, fr, fq, lds, wid, lane); S.done(cur); }
#undef PG8_SA
#undef PG8_SB
#undef PG8_STAGE
#undef PG8_LDA
#undef PG8_LDB
#undef PG8_MMA
#undef PG8_WAIT_V
#undef PG8_WAIT_L
#undef PG8_BAR
#undef PG8_SCHED
}
}

#define LAS __attribute__((address_space(3)))
typedef unsigned short bf16_t;
typedef short bf16x8 __attribute__((ext_vector_type(8)));
typedef float f32x4 __attribute__((ext_vector_type(4)));
typedef float f32x16 __attribute__((ext_vector_type(16)));
typedef unsigned u32x4 __attribute__((ext_vector_type(4)));
typedef unsigned u32x2 __attribute__((ext_vector_type(2)));

constexpr int DM = 1024, NBATCH = 16, SEQ = 4096, TLAT = NBATCH * SEQ, LCTX = 256, TCTX = NBATCH * LCTX, MALL = TLAT + TCTX;
constexpr int DFF = 2816, INW = 2304, NWAVES = 8, NTHR = 512;
constexpr int QS = 1536, KS_ = 2048, VS_ = 2176;
constexpr float C2 = 0.125f * 1.4426950408889634f, LOG2E = 1.4426950408889634f;
constexpr size_t MiB = 1u << 20;
constexpr size_t WS_MOD = 1 * MiB, WS_TAB = 3 * MiB, WS_WIN = 4 * MiB, WS_WMIX = 13 * MiB, WS_WF = 17 * MiB, WS_WGU = 21 * MiB, WS_WD = 65 * MiB;
constexpr size_t WS_XB = 800 * MiB  ;
constexpr size_t WS_XC = 88 * MiB, WS_H = 104 * MiB, WS_R = 240 * MiB;
constexpr size_t WS_P = WS_R, WS_CAT = WS_R + 306 * MiB, WS_ACT = WS_R, WS_Z1 = WS_R, WS_ZC = WS_R + 256 * MiB, WS_A1 = WS_R + 272 * MiB, WS_FM = WS_R, WS_END = 1024 * MiB;
constexpr size_t TAB_ROPE = 0, TAB_TW = 64 * 1024, TAB_D1 = 128 * 1024, TAB_D2 = 192 * 1024, TAB_DC = 256 * 1024, TAB_DCTX = 512 * 1024;
constexpr int LDS_BYTES = 147456;

typedef float f32x2_t __attribute__((ext_vector_type(2))); typedef __bf16 bf16x2_t __attribute__((ext_vector_type(2)));
__device__ __forceinline__ unsigned cvt_pk(float lo, float hi) { f32x2_t v = {lo, hi}; bf16x2_t b = __builtin_convertvector(v, bf16x2_t); return __builtin_bit_cast(unsigned, b); }
__device__ __forceinline__ float bf_lo(unsigned w) { return __builtin_bit_cast(float, w << 16); }
__device__ __forceinline__ float bf_hi(unsigned w) { return __builtin_bit_cast(float, w & 0xffff0000u); }
__device__ __forceinline__ float fast_exp2(float x) { return __builtin_amdgcn_exp2f(x); }
__device__ __forceinline__ float fast_rcp(float x) { return __builtin_amdgcn_rcpf(x); }
__device__ __forceinline__ float silu_f(float x) { return x * fast_rcp(1.0f + fast_exp2(-x * LOG2E)); }
typedef _Float16 h16x2_t __attribute__((ext_vector_type(2)));
__device__ __forceinline__ float h2f(unsigned lowbits) { float f; asm("v_cvt_f32_f16 %0, %1" : "=v"(f) : "v"(lowbits)); return f; }
__device__ __forceinline__ f32x4 xs_unpack(u32x2 h) { return (f32x4){h2f(h.x), h2f(h.x >> 16), h2f(h.y), h2f(h.y >> 16)}; }
typedef __fp16 fp16x2_t __attribute__((ext_vector_type(2)));
__device__ __forceinline__ u32x2 xs_pack(f32x4 v) { const fp16x2_t a = __builtin_amdgcn_cvt_pkrtz(v.x, v.y), b = __builtin_amdgcn_cvt_pkrtz(v.z, v.w); u32x2 r; r.x = __builtin_bit_cast(unsigned, a); r.y = __builtin_bit_cast(unsigned, b); return r; }
#define LDS_WAIT() asm volatile("s_waitcnt lgkmcnt(0)" ::: "memory")

struct Args {
    const float* x; const float* c; const float* ctx; const float* c_ctx; const float* w_ada; const float* b_ada; const float* n1g; const float* n2g;
    const float* w_in; const float* conv_w; const float* sink; const float* w_mix; const float* w_four; const float* w_gate; const float* w_up; const float* w_down; const float* final_g;
    float* out; unsigned char* ws;
    double invf[16];
};

struct EpiInProj {
    static constexpr bool PERM = false, AFTER_DRAIN = false;
    bf16_t* P; const float* rope;
    __device__ __forceinline__ void operator()(const f32x4 (&acc)[2][2][4][2], const pg8::Unit& u, int wr, int wc, int fr, int fq) const {
        const bool lat = u.pm < 256, doq = (u.pn == 6 || u.pn == 7), ropeT = lat && u.pn >= 6;
#pragma unroll
        for (int ai = 0; ai < 2; ++ai)
#pragma unroll
            for (int m = 0; m < 4; ++m) {
                const int row = u.pm * 256 + ai * 128 + wr * 64 + m * 16 + fr;
                f32x4 cv = {1.f, 1.f, 1.f, 1.f}, sv = {0.f, 0.f, 0.f, 0.f};
                if (ropeT) { const int t = row & 4095; const int a = (wc & 1) ? (t & 63) : (t >> 6);
                    const f32x4* rp = (const f32x4*)(rope + (a * 16 + 4 * fq) * 2); const f32x4 c0 = rp[0], c1 = rp[1];
                    cv = (f32x4){c0.x, c0.z, c1.x, c1.z}; sv = (f32x4){c0.y, c0.w, c1.y, c1.w}; }
#pragma unroll
                for (int bj = 0; bj < 2; ++bj) {
                    f32x4 x1 = acc[ai][bj][m][0], x2 = acc[ai][bj][m][1];
                    if (u.pn >= 2 && u.pn <= 5) {
                        const f32x4 uv = x1 * x2; u32x2 wu; wu.x = cvt_pk(uv[0], uv[1]); wu.y = cvt_pk(uv[2], uv[3]);
                        *(u32x2*)(P + (size_t)row * INW + 512 + (((u.pn - 2) * 8 + bj * 4 + wc) << 4) + 4 * fq) = wu;
                        continue; }
                    if (ropeT && !(u.pn == 8 && bj == 1)) { const f32x4 o1 = x1 * cv - x2 * sv, o2 = x2 * cv + x1 * sv; x1 = o1; x2 = o2; }
                    if (doq) { x1 = x1 * C2; x2 = x2 * C2; }
                    bf16_t* p = P + (size_t)row * INW + u.pn * 256 + bj * 128 + wc * 32 + 4 * fq;
                    u32x2 w1, w2; w1.x = cvt_pk(x1[0], x1[1]); w1.y = cvt_pk(x1[2], x1[3]); w2.x = cvt_pk(x2[0], x2[1]); w2.y = cvt_pk(x2[2], x2[3]);
                    *(u32x2*)p = w1; *(u32x2*)(p + 16) = w2;
                }
            }
    }
};
template <bool IN_F32> struct EpiRes {
    static constexpr bool PERM = false, AFTER_DRAIN = false;
    const float* in_lat; const float* in_ctx; bf16_t* xb; const float* modl; int gate_idx;
    __device__ __forceinline__ void operator()(const f32x4 (&acc)[2][2][4][2], const pg8::Unit& u, int wr, int wc, int fr, int fq) const {
        const bool lat = u.pm < 256; const int rbase = lat ? u.pm * 256 : u.pm * 256 - TLAT; const int r = lat ? (u.pm >> 4) : 16;
        const float* ip = lat ? in_lat : in_ctx;
        const float* gate = modl + (r * 6 + gate_idx) * 1024;
        const int col0 = u.pn * 256 + wc * 32 + 4 * fq;
        f32x4 gv[2][2];
#pragma unroll
        for (int bj = 0; bj < 2; ++bj)
#pragma unroll
            for (int n = 0; n < 2; ++n) gv[bj][n] = *(const f32x4*)(gate + col0 + bj * 128 + 16 * n);
        const size_t offi = (size_t)(rbase + wr * 64 + fr) * DM + col0;
        const size_t offx = (size_t)(u.pm * 256 + wr * 64 + fr) * DM + col0;
        f32x4 xf[2][2][2]; u32x2 xh[2][2][2];
#pragma unroll
        for (int bj = 0; bj < 2; ++bj)
#pragma unroll
            for (int n = 0; n < 2; ++n) { if (IN_F32) xf[0][bj][n] = *(const f32x4*)(ip + offi + bj * 128 + 16 * n); else xh[0][bj][n] = *(const u32x2*)(xb + offx + bj * 128 + 16 * n); }
#pragma unroll
        for (int grp = 0; grp < 8; ++grp) {
            const int ai = grp >> 2, m = grp & 3, cb = grp & 1;
            const size_t roff = (size_t)(ai * 128 + m * 16) * DM;
            if (grp < 7) { const int ai2 = (grp + 1) >> 2, m2 = (grp + 1) & 3; const size_t rn = (size_t)(ai2 * 128 + m2 * 16) * DM;
#pragma unroll
                for (int bj = 0; bj < 2; ++bj)
#pragma unroll
                    for (int n = 0; n < 2; ++n) { if (IN_F32) xf[cb ^ 1][bj][n] = *(const f32x4*)(ip + offi + rn + bj * 128 + 16 * n); else xh[cb ^ 1][bj][n] = *(const u32x2*)(xb + offx + rn + bj * 128 + 16 * n); } }
            asm volatile("" ::: "memory");
#pragma unroll
            for (int bj = 0; bj < 2; ++bj)
#pragma unroll
                for (int n = 0; n < 2; ++n) {
                    f32x4 xi; if (IN_F32) xi = xf[cb][bj][n]; else xi = xs_unpack(xh[cb][bj][n]);
                    const f32x4 xo = xi + gv[bj][n] * acc[ai][bj][m][n];
                    *(u32x2*)(xb + offx + roff + bj * 128 + 16 * n) = xs_pack(xo); }
            asm volatile("" ::: "memory");
        }
    }
};
struct EpiSwiGLU {
    static constexpr bool PERM = false, AFTER_DRAIN = false;
    bf16_t* ACT;
    __device__ __forceinline__ void operator()(const f32x4 (&acc)[2][2][4][2], const pg8::Unit& u, int wr, int wc, int fr, int fq) const {
#pragma unroll
        for (int ai = 0; ai < 2; ++ai)
#pragma unroll
            for (int m = 0; m < 4; ++m) {
                const int row = u.pm * 256 + ai * 128 + wr * 64 + m * 16 + fr;
#pragma unroll
                for (int bj = 0; bj < 2; ++bj) {
                    const f32x4 g = acc[ai][bj][m][0], v = acc[ai][bj][m][1];
                    const int f = (u.pn * 8 + bj * 4 + wc) * 16 + 4 * fq;
                    u32x2 w; w.x = cvt_pk(silu_f(g[0]) * v[0], silu_f(g[1]) * v[1]); w.y = cvt_pk(silu_f(g[2]) * v[2], silu_f(g[3]) * v[3]);
                    *(u32x2*)(ACT + (size_t)row * DFF + f) = w;
                }
            }
    }
};
struct EpiPlain {
    static constexpr bool PERM = false, AFTER_DRAIN = false;
    bf16_t* O; int ldc;
    __device__ __forceinline__ void operator()(const f32x4 (&acc)[2][2][4][2], const pg8::Unit& u, int wr, int wc, int fr, int fq) const {
#pragma unroll
        for (int ai = 0; ai < 2; ++ai)
#pragma unroll
            for (int m = 0; m < 4; ++m) {
                const int row = u.pm * 256 + ai * 128 + wr * 64 + m * 16 + fr;
#pragma unroll
                for (int bj = 0; bj < 2; ++bj)
#pragma unroll
                    for (int n = 0; n < 2; ++n) {
                        const f32x4 x = acc[ai][bj][m][n]; u32x2 w; w.x = cvt_pk(x[0], x[1]); w.y = cvt_pk(x[2], x[3]);
                        *(u32x2*)(O + (size_t)row * ldc + u.pn * 256 + bj * 128 + wc * 32 + 16 * n + 4 * fq) = w;
                    }
            }
    }
};

__device__ __forceinline__ void sincos_turns(double x, double& s, double& c) {
    x = x - floor(x);
    const double q4 = floor(x * 4.0 + 0.5);
    const double r = x - q4 * 0.25;
    const int q = ((int)q4) & 3;
    const double th = r * 6.283185307179586476925, t2 = th * th;
    const double sp = th * (1.0 + t2 * (-1.0 / 6 + t2 * (1.0 / 120 + t2 * (-1.0 / 5040 + t2 * (1.0 / 362880 + t2 * (-1.0 / 39916800 + t2 * (1.0 / 6227020800.0)))))));
    const double cp = 1.0 + t2 * (-0.5 + t2 * (1.0 / 24 + t2 * (-1.0 / 720 + t2 * (1.0 / 40320 + t2 * (-1.0 / 3628800 + t2 * (1.0 / 479001600.0 + t2 * (-1.0 / 87178291200.0)))))));
    if (q == 0) { s = sp; c = cp; } else if (q == 1) { s = cp; c = -sp; } else if (q == 2) { s = -sp; c = -cp; } else { s = -cp; c = sp; }
}
__device__ __forceinline__ unsigned short f2bf(float f) { return __builtin_bit_cast(unsigned short, (__bf16)f); }

__device__ __forceinline__ void transpose_item(const float* W, int K, int N, bf16_t* WT, int mode, LAS float* scr, int item, int lane) {
    const int nblk = N / 32, kb = item / nblk, nb = item % nblk, k0 = 64 * kb, n0 = 32 * nb;
#pragma unroll 8
    for (int i = 0; i < 32; ++i) { const int kk = 2 * i + (lane >> 5); scr[kk * 33 + (lane & 31)] = W[(size_t)(k0 + kk) * N + n0 + (lane & 31)]; }
    LDS_WAIT(); asm volatile("" ::: "memory");
    const int c = lane & 7;
#pragma unroll
    for (int j = 0; j < 4; ++j) { const int n = (lane >> 3) + 8 * j; const LAS float* s = scr + (8 * c) * 33 + n;
        u32x4 o; o.x = cvt_pk(s[0 * 33], s[1 * 33]); o.y = cvt_pk(s[2 * 33], s[3 * 33]); o.z = cvt_pk(s[4 * 33], s[5 * 33]); o.w = cvt_pk(s[6 * 33], s[7 * 33]);
        const int f = n0 + n;
        const int orow = (mode == 0) ? f : (mode == 3) ? ((f >= 512 && f < 1536) ? 512 + ((((f - 512) & 511) >> 4) << 5) + (f & 15) + (f >= 1024 ? 16 : 0) : f)
                         : (((f >> 4) << 5) + (f & 15) + (mode == 2 ? 16 : 0));
        *(u32x4*)(WT + (size_t)orow * K + k0 + 8 * c) = o; }
    LDS_WAIT(); asm volatile("" ::: "memory");
}

__device__ __forceinline__ void prologue(const Args& A, LAS unsigned char* lds, int tid, int wave, int lane, int G) {
    unsigned char* ws = A.ws;
    {
        LAS float* scr = (LAS float*)(lds + wave * 16384);
        const int gw = blockIdx.x * NWAVES + wave, NGW = G * NWAVES;
        constexpr int I_IN = 16 * 72, I_SQ = 16 * 32, I_FF = 16 * 88, I_DN = 44 * 32;
        constexpr int NIT = 2 * I_IN + 4 * I_SQ + 8 * I_FF + 4 * I_DN;
        for (int it = gw; it < NIT; it += NGW) {
            int r = it;
            if (r < 2 * I_IN) { const int e = r / I_IN; transpose_item(A.w_in + (size_t)e * DM * INW, DM, INW, (bf16_t*)(ws + WS_WIN) + (size_t)e * INW * DM, 3, scr, r % I_IN, lane); continue; } r -= 2 * I_IN;
            if (r < 2 * I_SQ) { const int e = r / I_SQ; transpose_item(A.w_mix + (size_t)e * DM * DM, DM, DM, (bf16_t*)(ws + WS_WMIX) + (size_t)e * DM * DM, 0, scr, r % I_SQ, lane); continue; } r -= 2 * I_SQ;
            if (r < 2 * I_SQ) { const int e = r / I_SQ; transpose_item(A.w_four + (size_t)e * DM * DM, DM, DM, (bf16_t*)(ws + WS_WF) + (size_t)e * DM * DM, 0, scr, r % I_SQ, lane); continue; } r -= 2 * I_SQ;
            if (r < 4 * I_FF) { const int l = r / I_FF; transpose_item(A.w_gate + (size_t)l * DM * DFF, DM, DFF, (bf16_t*)(ws + WS_WGU) + (size_t)l * 2 * DFF * DM, 1, scr, r % I_FF, lane); continue; } r -= 4 * I_FF;
            if (r < 4 * I_FF) { const int l = r / I_FF; transpose_item(A.w_up + (size_t)l * DM * DFF, DM, DFF, (bf16_t*)(ws + WS_WGU) + (size_t)l * 2 * DFF * DM, 2, scr, r % I_FF, lane); continue; } r -= 4 * I_FF;
            { const int l = r / I_DN; transpose_item(A.w_down + (size_t)l * DFF * DM, DFF, DM, (bf16_t*)(ws + WS_WD) + (size_t)l * DM * DFF, 0, scr, r % I_DN, lane); }
        }
    }
    {
        const int gt = blockIdx.x * NTHR + tid, NGT = G * NTHR;
        float* rope = (float*)(ws + WS_TAB + TAB_ROPE); float* tw = (float*)(ws + WS_TAB + TAB_TW);
        bf16_t* D1 = (bf16_t*)(ws + WS_TAB + TAB_D1); bf16_t* D2 = (bf16_t*)(ws + WS_TAB + TAB_D2); bf16_t* DC = (bf16_t*)(ws + WS_TAB + TAB_DC); bf16_t* DX = (bf16_t*)(ws + WS_TAB + TAB_DCTX);
        constexpr int N_ROPE = 1024, N_TW = 4096, N_D1 = 16384, N_D2 = 8192, N_DC = 131072, N_DX = 131072;
        for (int i = gt; i < N_ROPE + N_TW + N_D1 + N_D2 + N_DC + N_DX; i += NGT) {
            int r = i; double s, c;
            if (r < N_ROPE) { const int a = r >> 4, f = r & 15; sincos_turns((double)a * A.invf[f] * 0.15915494309189533577, s, c); rope[2 * r] = (float)c; rope[2 * r + 1] = (float)s; continue; } r -= N_ROPE;
            if (r < N_TW) { const int k1 = r >> 6, n2 = r & 63; sincos_turns((double)(k1 * n2) / 4096.0, s, c); tw[2 * r] = (float)c; tw[2 * r + 1] = (float)s; continue; } r -= N_TW;
            if (r < N_D1) { const int row = r >> 7, col = r & 127, k1 = row >> 1, rio = row & 1, rii = col >> 6, n1 = col & 63; sincos_turns((double)((k1 * n1) & 63) / 64.0, s, c);
                const double v = (rio == rii) ? c : (rio == 0 ? s : -s); D1[r] = f2bf((float)(v * 0.125)); continue; } r -= N_D1;
            if (r < N_D2) { const int k2 = r >> 7, col = r & 127, ri = col >> 6, n2 = col & 63; sincos_turns((double)((k2 * n2) & 63) / 64.0, s, c); D2[r] = f2bf((float)((ri ? s : c) * 0.125)); continue; } r -= N_D2;
            if (r < N_DC) { const int row = r >> 8, cc = r & 255, ri = row >> 8, m = row & 255; sincos_turns((double)((m * cc) & 255) / 256.0, s, c); DC[r] = f2bf((float)((ri ? -s : c) * 0.0625)); continue; } r -= N_DC;
            { const int k = r >> 9, col = r & 511, ri = col >> 8, n = col & 255; sincos_turns((double)((k * n) & 255) / 256.0, s, c); DX[r] = f2bf((float)((ri ? s : c) * 0.0625)); }
        }
    }
    __syncthreads();
    {
        LAS float* S = (LAS float*)lds; LAS float* Pp = (LAS float*)(lds + 69632);
        for (int i = tid; i < 17 * 1024; i += NTHR) { const int r = i >> 10, k = i & 1023; const float v = (r < 16) ? A.c[r * 1024 + k] : A.c_ctx[k]; S[i] = v / (1.0f + expf(-v)); }
        __syncthreads();
        float* mod = (float*)(ws + WS_MOD);
        for (int task = blockIdx.x; task < 4 * 96; task += G) {
            const int l = task / 96, j0 = (task % 96) * 64;
            const float* w = A.w_ada + (size_t)l * 1024 * 6144 + j0 + lane;
            float acc[17];
#pragma unroll
            for (int r = 0; r < 17; ++r) acc[r] = 0.f;
#pragma unroll 4
            for (int kk = 0; kk < 128; ++kk) { const int k = wave * 128 + kk; const float wv = w[(size_t)k * 6144];
#pragma unroll
                for (int r = 0; r < 17; ++r) acc[r] += S[r * 1024 + k] * wv; }
#pragma unroll
            for (int r = 0; r < 17; ++r) Pp[(wave * 17 + r) * 64 + lane] = acc[r];
            __syncthreads();
            for (int o = tid; o < 17 * 64; o += NTHR) { const int r = o >> 6, jj = o & 63; float sum = 0.f;
#pragma unroll
                for (int w8 = 0; w8 < 8; ++w8) sum += Pp[(w8 * 17 + r) * 64 + jj];
                mod[(size_t)(l * 17 + r) * 6144 + j0 + jj] = sum + A.b_ada[l * 6144 + j0 + jj]; }
            __syncthreads();
        }
    }
}

template <bool IN_F32> __device__ __forceinline__ void norm_ld(f32x4 (&v)[4], const float* lat, const float* ctxp, const bf16_t* xb, int row, int lane) {
    if (IN_F32) { const float* xr = (row < TLAT) ? lat + (size_t)row * DM : ctxp + (size_t)(row - TLAT) * DM;
#pragma unroll
        for (int j = 0; j < 4; ++j) v[j] = *(const f32x4*)(xr + 4 * lane + 256 * j); }
    else {
#pragma unroll
        for (int j = 0; j < 4; ++j) { v[j] = xs_unpack(*(const u32x2*)(xb + (size_t)row * DM + 4 * lane + 256 * j)); } }
}
template <bool IN_F32> __device__ __forceinline__ void norm_phase(const float* lat, const float* ctxp, const bf16_t* xb, const float* g, const float* modl, int shift_idx, bf16_t* hout, int rbeg, int rend, int lane) {
    constexpr int NR = 2;
    if (rbeg >= rend) return;
    f32x4 gv[4];
#pragma unroll
    for (int j = 0; j < 4; ++j) gv[j] = *(const f32x4*)(g + 4 * lane + 256 * j);
    f32x4 vc[NR][4], vn[NR][4], scv[4], shv[4]; int rcur = -1;
#pragma unroll
    for (int q = 0; q < NR; ++q) norm_ld<IN_F32>(vc[q], lat, ctxp, xb, rbeg + q, lane);
    for (int row0 = rbeg; row0 < rend; row0 += NR) {
        const int r = (row0 < TLAT) ? (row0 >> 12) : 16;
        if (r != rcur) { rcur = r; const float* sh = modl + (r * 6 + shift_idx) * 1024; const float* sc = sh + 1024;
#pragma unroll
            for (int j = 0; j < 4; ++j) { scv[j] = (*(const f32x4*)(sc + 4 * lane + 256 * j) + 1.0f) * gv[j]; shv[j] = *(const f32x4*)(sh + 4 * lane + 256 * j); } }
        if (row0 + NR < rend) {
#pragma unroll
            for (int q = 0; q < NR; ++q) norm_ld<IN_F32>(vn[q], lat, ctxp, xb, row0 + NR + q, lane); }
        asm volatile("" ::: "memory");
#pragma unroll
        for (int q = 0; q < NR; ++q) { float ss = 0.f;
#pragma unroll
            for (int j = 0; j < 4; ++j) ss += (vc[q][j].x * vc[q][j].x + vc[q][j].y * vc[q][j].y) + (vc[q][j].z * vc[q][j].z + vc[q][j].w * vc[q][j].w);
#pragma unroll
            for (int o = 1; o < 64; o <<= 1) ss += __shfl_xor(ss, o);
            const float rstd = 1.0f / sqrtf(ss * (1.0f / DM) + 1e-6f);
#pragma unroll
            for (int j = 0; j < 4; ++j) { const f32x4 o = vc[q][j] * rstd * scv[j] + shv[j];
                u32x2 w; w.x = cvt_pk(o.x, o.y); w.y = cvt_pk(o.z, o.w);
                *(u32x2*)(hout + (size_t)(row0 + q) * DM + 4 * lane + 256 * j) = w; } }
        asm volatile("" ::: "memory");
#pragma unroll
        for (int q = 0; q < NR; ++q)
#pragma unroll
            for (int j = 0; j < 4; ++j) vc[q][j] = vn[q][j];
    }
}
__device__ __forceinline__ void final_norm_phase(const bf16_t* xb, float* xo, const float* g, int gw, int NGW, int lane) {
    constexpr int NR = 2;
    const int rpw = TLAT / NGW, rbeg = gw * rpw, rend = rbeg + rpw;
    f32x4 gv[4];
#pragma unroll
    for (int j = 0; j < 4; ++j) gv[j] = *(const f32x4*)(g + 4 * lane + 256 * j);
    f32x4 vc[NR][4], vn[NR][4];
#pragma unroll
    for (int q = 0; q < NR; ++q) norm_ld<false>(vc[q], nullptr, nullptr, xb, rbeg + q, lane);
    for (int row0 = rbeg; row0 < rend; row0 += NR) {
        if (row0 + NR < rend) {
#pragma unroll
            for (int q = 0; q < NR; ++q) norm_ld<false>(vn[q], nullptr, nullptr, xb, row0 + NR + q, lane); }
        asm volatile("" ::: "memory");
#pragma unroll
        for (int q = 0; q < NR; ++q) { float ss = 0.f;
#pragma unroll
            for (int j = 0; j < 4; ++j) ss += (vc[q][j].x * vc[q][j].x + vc[q][j].y * vc[q][j].y) + (vc[q][j].z * vc[q][j].z + vc[q][j].w * vc[q][j].w);
#pragma unroll
            for (int o = 1; o < 64; o <<= 1) ss += __shfl_xor(ss, o);
            const float rstd = 1.0f / sqrtf(ss * (1.0f / DM) + 1e-6f);
#pragma unroll
            for (int j = 0; j < 4; ++j) *(f32x4*)(xo + (size_t)(row0 + q) * DM + 4 * lane + 256 * j) = vc[q][j] * rstd * gv[j]; }
        asm volatile("" ::: "memory");
#pragma unroll
        for (int q = 0; q < NR; ++q)
#pragma unroll
            for (int j = 0; j < 4; ++j) vc[q][j] = vn[q][j];
    }
}

__device__ __forceinline__ int crow(int r, int hi) { return (r & 3) + 8 * (r >> 2) + 4 * hi; }

__device__ __forceinline__ void attn_phase(LAS unsigned char* lds, const bf16_t* P, bf16_t* cat, const float* sink, bool ctxq, int G, int tid, int wave, int lane) {
    constexpr int KROW = 144, VROW = 264;
    LAS unsigned char* Kl = lds; LAS unsigned char* Vl = lds + 128 * KROW;
    const int r32 = lane & 31, hi = lane >> 5, g = wave & 3, qh = wave >> 2;
    const int nitems = 1024 + (ctxq ? 64 : 0);
    for (int it = blockIdx.x; it < nitems; it += G) {
        int b, hk, qb, qr0; const bool isl = it < 1024;
        if (isl) { b = it >> 6; hk = (it >> 5) & 1; qb = it & 31; qr0 = b * SEQ + qb * 128; }
        else { const int j = it - 1024; b = j >> 2; hk = (j >> 1) & 1; qb = j & 1; qr0 = TLAT + b * LCTX + qb * 128; }
        const int crow0 = TLAT + b * LCTX, head = hk * 4 + g;
        bf16x8 qf[2][4];
#pragma unroll
        for (int s = 0; s < 2; ++s)
#pragma unroll
            for (int ks = 0; ks < 4; ++ks) qf[s][ks] = *(const bf16x8*)(P + (size_t)(qr0 + 64 * qh + 32 * s + r32) * INW + QS + head * 64 + 16 * ks + 8 * hi);
        float mrun[2], lrun[2]; f32x16 O[2][2];
        const float sk2 = sink[head] * LOG2E;
#pragma unroll
        for (int s = 0; s < 2; ++s) { mrun[s] = sk2; lrun[s] = 1.0f;
#pragma unroll
            for (int dt = 0; dt < 2; ++dt)
#pragma unroll
                for (int r = 0; r < 16; ++r) O[s][dt][r] = 0.f; }
#pragma unroll 1
        for (int ti = 0; ti < 5; ++ti) {
            int krow0, mtype = 0; bool valid = true;
            if (ti == 0) { krow0 = qr0 - 128; mtype = 1; valid = isl && qb > 0; }
            else if (ti == 1) { krow0 = qr0; valid = isl; }
            else if (ti == 2) { krow0 = qr0 + 128; mtype = 2; valid = isl && qb < 31; }
            else { krow0 = crow0 + (ti - 3) * 128; }
            if (!valid) continue;
            __syncthreads();
#pragma unroll
            for (int i = 0; i < 2; ++i) { const int id = tid + NTHR * i, key = id >> 3, c = id & 7;
                const u32x4 v = *(const u32x4*)(P + (size_t)(krow0 + key) * INW + KS_ + hk * 64 + 8 * c);
                *(LAS u32x4*)(Kl + key * KROW + c * 16) = v; }
#pragma unroll
            for (int i = 0; i < 2; ++i) { const int id = tid + NTHR * i, key = id & 127, c = id >> 7;
                const u32x4 v = *(const u32x4*)(P + (size_t)(krow0 + key) * INW + VS_ + hk * 64 + 8 * c);
                LAS unsigned char* vp = Vl + (8 * c) * VROW + key * 2;
                *(LAS unsigned short*)(vp + 0 * VROW) = (unsigned short)(v.x & 0xffffu); *(LAS unsigned short*)(vp + 1 * VROW) = (unsigned short)(v.x >> 16);
                *(LAS unsigned short*)(vp + 2 * VROW) = (unsigned short)(v.y & 0xffffu); *(LAS unsigned short*)(vp + 3 * VROW) = (unsigned short)(v.y >> 16);
                *(LAS unsigned short*)(vp + 4 * VROW) = (unsigned short)(v.z & 0xffffu); *(LAS unsigned short*)(vp + 5 * VROW) = (unsigned short)(v.z >> 16);
                *(LAS unsigned short*)(vp + 6 * VROW) = (unsigned short)(v.w & 0xffffu); *(LAS unsigned short*)(vp + 7 * VROW) = (unsigned short)(v.w >> 16); }
            __syncthreads();
#pragma unroll
            for (int half = 0; half < 2; ++half)
#pragma unroll
                for (int s = 0; s < 2; ++s) {
                    f32x16 S[2];
#pragma unroll
                    for (int rt = 0; rt < 2; ++rt) {
#pragma unroll
                        for (int r = 0; r < 16; ++r) S[rt][r] = 0.f;
#ifndef DIAG
                        asm volatile("" : "+v"(S[rt]));
#endif
#pragma unroll
                        for (int ks = 0; ks < 4; ++ks) { const bf16x8 kf = *(const LAS bf16x8*)(Kl + (64 * half + 32 * rt + r32) * KROW + (16 * ks + 8 * hi) * 2);
                            S[rt] = __builtin_amdgcn_mfma_f32_32x32x16_bf16(kf, qf[s][ks], S[rt], 0, 0, 0); }
                    }
                    if (mtype != 0) { int il = 64 * qh + 32 * s + r32; asm volatile("" : "+v"(il));
#pragma unroll
                        for (int rt = 0; rt < 2; ++rt)
#pragma unroll
                            for (int r = 0; r < 16; ++r) { const int jl = 64 * half + 32 * rt + crow(r, hi); const bool ok = (mtype == 1) ? (jl >= il) : (jl <= il); if (!ok) S[rt][r] = -INFINITY; } }
                    float tmax = S[0][0];
#pragma unroll
                    for (int rt = 0; rt < 2; ++rt)
#pragma unroll
                        for (int r = 0; r < 16; ++r) tmax = fmaxf(tmax, S[rt][r]);
                    tmax = fmaxf(tmax, __shfl_xor(tmax, 32));
                    const float mnew = fmaxf(mrun[s], tmax), alpha = fast_exp2(mrun[s] - mnew);
                    mrun[s] = mnew;
                    float psum = 0.f;
#pragma unroll
                    for (int rt = 0; rt < 2; ++rt)
#pragma unroll
                        for (int r = 0; r < 16; ++r) { const float p = fast_exp2(S[rt][r] - mnew); S[rt][r] = p; psum += p; }
                    psum += __shfl_xor(psum, 32);
                    lrun[s] = lrun[s] * alpha + psum;
#pragma unroll
                    for (int dt = 0; dt < 2; ++dt)
#pragma unroll
                        for (int r = 0; r < 16; ++r) O[s][dt][r] *= alpha;
#pragma unroll
                    for (int rt = 0; rt < 2; ++rt)
#pragma unroll
                        for (int s2 = 0; s2 < 2; ++s2) {
                            u32x4 pw; pw.x = cvt_pk(S[rt][8 * s2 + 0], S[rt][8 * s2 + 1]); pw.y = cvt_pk(S[rt][8 * s2 + 2], S[rt][8 * s2 + 3]);
                            pw.z = cvt_pk(S[rt][8 * s2 + 4], S[rt][8 * s2 + 5]); pw.w = cvt_pk(S[rt][8 * s2 + 6], S[rt][8 * s2 + 7]);
                            const bf16x8 pf = __builtin_bit_cast(bf16x8, pw);
#pragma unroll
                            for (int dt = 0; dt < 2; ++dt) {
                                const LAS unsigned char* vb = Vl + (32 * dt + r32) * VROW + (64 * half + 32 * rt + 16 * s2 + 4 * hi) * 2;
                                const u32x2 v0 = *(const LAS u32x2*)vb, v1 = *(const LAS u32x2*)(vb + 16);
                                const u32x4 vv = {v0.x, v0.y, v1.x, v1.y};
                                O[s][dt] = __builtin_amdgcn_mfma_f32_32x32x16_bf16(__builtin_bit_cast(bf16x8, vv), pf, O[s][dt], 0, 0, 0);
                            }
                        }
                }
        }
#pragma unroll
        for (int s = 0; s < 2; ++s) { const float inv = 1.0f / lrun[s];
            bf16_t* orow = cat + (size_t)(qr0 + 64 * qh + 32 * s + r32) * DM + 512 + head * 64;
#pragma unroll
            for (int dt = 0; dt < 2; ++dt)
#pragma unroll
                for (int q4 = 0; q4 < 4; ++q4) { u32x2 w; w.x = cvt_pk(O[s][dt][4 * q4 + 0] * inv, O[s][dt][4 * q4 + 1] * inv); w.y = cvt_pk(O[s][dt][4 * q4 + 2] * inv, O[s][dt][4 * q4 + 3] * inv);
                    *(u32x2*)(orow + 32 * dt + 8 * q4 + 4 * hi) = w; } }
    }
    __syncthreads();
}

__device__ __forceinline__ void load_u(const bf16_t* P, int t, int s0, int s1, int c8, float (&u)[8]) {
    if (t < s0 || t >= s1) {
#pragma unroll
        for (int j = 0; j < 8; ++j) u[j] = 0.f;
    } else {
        const u32x4 cv = *(const u32x4*)(P + (size_t)t * INW + 512 + 8 * c8);
        u[0] = bf_lo(cv.x); u[1] = bf_hi(cv.x); u[2] = bf_lo(cv.y); u[3] = bf_hi(cv.y); u[4] = bf_lo(cv.z); u[5] = bf_hi(cv.z); u[6] = bf_lo(cv.w); u[7] = bf_hi(cv.w);
    }
}
__device__ __forceinline__ void cvt8(const u32x4 v, float (&f)[8]) { f[0] = bf_lo(v.x); f[1] = bf_hi(v.x); f[2] = bf_lo(v.y); f[3] = bf_hi(v.y); f[4] = bf_lo(v.z); f[5] = bf_hi(v.z); f[6] = bf_lo(v.w); f[7] = bf_hi(v.w); }
__device__ __forceinline__ void conv_phase(const bf16_t* P, bf16_t* cat, const float* cw, int M, int G, int tid) {
    const int c8 = tid & 63, tg = tid >> 6;
    float w0[8], w1[8], w2[8];
#pragma unroll
    for (int j = 0; j < 8; ++j) { w0[j] = cw[8 * c8 + j]; w1[j] = cw[512 + 8 * c8 + j]; w2[j] = cw[1024 + 8 * c8 + j]; }
    for (int it = blockIdx.x; it < M / 128; it += G) {
        const int t0 = it * 128, ts = t0 + 16 * tg;
        int s0, s1; if (t0 < TLAT) { s0 = t0 & ~4095; s1 = s0 + 4096; } else { s0 = TLAT + ((t0 - TLAT) & ~255); s1 = s0 + 256; }
        float up[8], uc[8];
        load_u(P, ts - 1, s0, s1, c8, up); load_u(P, ts, s0, s1, c8, uc);
#pragma unroll 1
        for (int i = 0; i < 16; i += 4) {
            const int t = ts + i;
            u32x4 bv[4], cv[4];
#pragma unroll
            for (int q = 0; q < 4; ++q) { bv[q] = *(const u32x4*)(P + (size_t)(t + q) * INW + 8 * c8);
                const int tq = (t + q + 1 < s1) ? t + q + 1 : t + q;
                cv[q] = *(const u32x4*)(P + (size_t)tq * INW + 512 + 8 * c8); }
            asm volatile("" ::: "memory");
#pragma unroll
            for (int q = 0; q < 4; ++q) {
                float cf[8], bb[8], un[8], o[8]; cvt8(cv[q], cf); cvt8(bv[q], bb);
                const bool inb = (t + q + 1 < s1);
#pragma unroll
                for (int j = 0; j < 8; ++j) { un[j] = inb ? cf[j] : 0.f; o[j] = bb[j] * (w0[j] * up[j] + w1[j] * uc[j] + w2[j] * un[j]); up[j] = uc[j]; uc[j] = un[j]; }
                u32x4 w; w.x = cvt_pk(o[0], o[1]); w.y = cvt_pk(o[2], o[3]); w.z = cvt_pk(o[4], o[5]); w.w = cvt_pk(o[6], o[7]);
                *(u32x4*)(cat + (size_t)(t + q) * DM + 8 * c8) = w; }
            asm volatile("" ::: "memory");
        }
    }
}

template <int MT, int KS> __device__ __forceinline__ void dft_load_a(bf16x8 (&a)[MT][KS], const bf16_t* Mat, int row0, int r32, int hi) {
#pragma unroll
    for (int rt = 0; rt < MT; ++rt)
#pragma unroll
        for (int ks = 0; ks < KS; ++ks) a[rt][ks] = *(const bf16x8*)(Mat + (size_t)(row0 + 32 * rt + r32) * (KS * 16) + 16 * ks + 8 * hi);
}
template <int MT, int KS> __device__ __forceinline__ void dft_mm(f32x16 (&acc)[MT], const bf16x8 (&a)[MT][KS], const bf16_t* vec) {
#pragma unroll
    for (int rt = 0; rt < MT; ++rt)
#pragma unroll
        for (int r = 0; r < 16; ++r) acc[rt][r] = 0.f;
#pragma unroll
    for (int rt = 0; rt < MT; ++rt) asm volatile("" : "+v"(acc[rt]));
    constexpr int KC = 8;
#pragma unroll
    for (int kc = 0; kc < KS / KC; ++kc) {
        bf16x8 b[KC];
#pragma unroll
        for (int i = 0; i < KC; ++i) b[i] = *(const bf16x8*)(vec + 16 * (kc * KC + i));
#pragma unroll
        for (int i = 0; i < KC; ++i)
#pragma unroll
            for (int rt = 0; rt < MT; ++rt) acc[rt] = __builtin_amdgcn_mfma_f32_32x32x16_bf16(a[rt][kc * KC + i], b[i], acc[rt], 0, 0, 0);
    }
}
__device__ __forceinline__ void store_pair(bf16_t* base, size_t zoo, unsigned cA, unsigned cB, float va, float vb, bool odd) {
    const float keep = odd ? vb : va, send = odd ? va : vb;
    const float got = __builtin_bit_cast(float, __builtin_amdgcn_mov_dpp(__builtin_bit_cast(int, send), 0xB1, 0xf, 0xf, true));
    const unsigned w = odd ? cvt_pk(got, keep) : cvt_pk(keep, got);
    *(unsigned*)(base + zoo + (odd ? cB : cA)) = w;
}
__device__ __forceinline__ void dft_ld8(bf16x8 (&b)[8], const bf16_t* vec) {
#pragma unroll
    for (int i = 0; i < 8; ++i) b[i] = *(const bf16x8*)(vec + 16 * i);
}
template <int MT> __device__ __forceinline__ void dft_zero(f32x16 (&acc)[MT]) {
#pragma unroll
    for (int rt = 0; rt < MT; ++rt) {
#pragma unroll
        for (int r = 0; r < 16; ++r) acc[rt][r] = 0.f;
        asm volatile("" : "+v"(acc[rt]));
    }
}
template <int MT, int KS, int K0> __device__ __forceinline__ void dft_mma8(f32x16 (&acc)[MT], const bf16x8 (&a)[MT][KS], const bf16x8 (&b)[8]) {
#pragma unroll
    for (int i = 0; i < 8; ++i)
#pragma unroll
        for (int rt = 0; rt < MT; ++rt) acc[rt] = __builtin_amdgcn_mfma_f32_32x32x16_bf16(a[rt][K0 + i], b[i], acc[rt], 0, 0, 0);
}
__device__ __forceinline__ const bf16_t* fa_vec(const bf16_t* H, int tile, int r32, int hi) {
    int token, g;
    if (tile < 8192) { const int n1h = tile & 1, n2 = (tile >> 1) & 63, b = tile >> 9; g = (tile >> 7) & 3; token = b * SEQ + 64 * (32 * n1h + r32) + n2; }
    else { const int tc = tile - 8192, nq = tc & 7, b = tc >> 5; g = (tc >> 3) & 3; token = TLAT + b * LCTX + 32 * nq + r32; }
    return H + (size_t)token * DM + g * 256 + 8 * hi;
}
__device__ __forceinline__ int fa_token(int tile, int row) {
    if (tile < 8192) { const int n1h = tile & 1, n2 = (tile >> 1) & 63, b = tile >> 9; return b * SEQ + 64 * (32 * n1h + row) + n2; }
    const int tc = tile - 8192, nq = tc & 7, b = tc >> 5; return TLAT + b * LCTX + 32 * nq + row;
}
__device__ __forceinline__ void fourier_a(LAS unsigned char* lds, const bf16_t* H, const bf16_t* DC, bf16_t* Z1, bf16_t* Zc, bool with_ctx, int G, int vcu, int wave, int lane) {
    constexpr int ROWB = 528, BUFB = 32 * ROWB;
    const int r32 = lane & 31, hi = lane >> 5, sl = wave, tid = wave * 64 + lane; const bool odd = lane & 1;
    bf16x8 a[2][16]; dft_load_a<2, 16>(a, DC, 64 * sl, r32, hi);
    const int ntile = 8192 + (with_ctx ? 512 : 0);
    const int srow0 = tid >> 5, sch = tid & 31;
    u32x4 s0, s1;
    int it = vcu, cur = 0;
    if (it < ntile) { const int tile = ntile - 1 - it; const int g = (tile < 8192) ? (tile >> 7) & 3 : ((tile - 8192) >> 3) & 3;
        s0 = *(const u32x4*)(H + (size_t)fa_token(tile, srow0) * DM + g * 256 + sch * 8); s1 = *(const u32x4*)(H + (size_t)fa_token(tile, srow0 + 16) * DM + g * 256 + sch * 8); }
    for (; it < ntile; it += G) {
        const int tile = ntile - 1 - it;
        LAS unsigned char* buf = lds + cur * BUFB;
        *(LAS u32x4*)(buf + srow0 * ROWB + sch * 16) = s0; *(LAS u32x4*)(buf + (srow0 + 16) * ROWB + sch * 16) = s1;
        __syncthreads();
        if (it + G < ntile) { const int tn = ntile - 1 - (it + G); const int g = (tn < 8192) ? (tn >> 7) & 3 : ((tn - 8192) >> 3) & 3;
            s0 = *(const u32x4*)(H + (size_t)fa_token(tn, srow0) * DM + g * 256 + sch * 8); s1 = *(const u32x4*)(H + (size_t)fa_token(tn, srow0 + 16) * DM + g * 256 + sch * 8); }
        asm volatile("" ::: "memory");
        f32x16 acc[2]; dft_zero<2>(acc);
        const LAS unsigned char* bp = buf + r32 * ROWB + hi * 16;
#pragma unroll
        for (int ks = 0; ks < 16; ++ks) { const bf16x8 bf = *(const LAS bf16x8*)(bp + ks * 32);
#pragma unroll
            for (int rt = 0; rt < 2; ++rt) acc[rt] = __builtin_amdgcn_mfma_f32_32x32x16_bf16(a[rt][ks], bf, acc[rt], 0, 0, 0); }
        if (tile < 8192) {
            const int n1h = tile & 1, n2 = (tile >> 1) & 63, g = (tile >> 7) & 3, b = tile >> 9;
            size_t zo = ((((size_t)((b * 4 + g) * 256 + 64 * (sl & 3) + 4 * hi)) * 64 + n2) * 2 + (sl >> 2)) * 64 + 32 * n1h + (r32 & ~1);
            asm volatile("" : "+v"(zo));
#pragma unroll
            for (int rt = 0; rt < 2; ++rt)
#pragma unroll
                for (int r = 0; r < 16; r += 2) store_pair(Z1, zo, (unsigned)(32 * rt + (r & 3) + 8 * (r >> 2)) * 8192u, (unsigned)(32 * rt + ((r + 1) & 3) + 8 * (r >> 2)) * 8192u, acc[rt][r], acc[rt][r + 1], odd);
        } else {
            const int tc = tile - 8192, nq = tc & 7, g = (tc >> 3) & 3, b = tc >> 5;
            size_t zo = (((size_t)((b * 4 + g) * 256 + 64 * (sl & 3) + 4 * hi)) * 2 + (sl >> 2)) * 256 + 32 * nq + (r32 & ~1);
            asm volatile("" : "+v"(zo));
#pragma unroll
            for (int rt = 0; rt < 2; ++rt)
#pragma unroll
                for (int r = 0; r < 16; r += 2) store_pair(Zc, zo, (unsigned)(32 * rt + (r & 3) + 8 * (r >> 2)) * 512u, (unsigned)(32 * rt + ((r + 1) & 3) + 8 * (r >> 2)) * 512u, acc[rt][r], acc[rt][r + 1], odd);
        }
        asm volatile("" ::: "memory");
        cur ^= 1;
    }
    __syncthreads();
}
template <int VAR> __device__ __forceinline__ void fourier_s1(const bf16_t* Z1, const bf16_t* D1, const float* tw, bf16_t* A1p, int G, int vcu, int wave, int lane) {
    const int r32 = lane & 31, hi = lane >> 5, sl = wave & 1; const bool odd = lane & 1;
    bf16x8 a[2][8]; dft_load_a<2, 8>(a, D1, 64 * sl, r32, hi);
    int tile = vcu * 4 + (wave >> 1); const int step = G * 4;
    const int n2 = 32 * (tile & 1) + r32;
    float2 twr[16];
#pragma unroll
    for (int rt = 0; rt < 2; ++rt)
#pragma unroll
        for (int q4 = 0; q4 < 4; ++q4)
#pragma unroll
            for (int e = 0; e < 2; ++e) twr[rt * 8 + q4 * 2 + e] = *(const float2*)(tw + 2 * ((32 * sl + 2 * hi + 16 * rt + 4 * q4 + e) * 64 + n2));
    bf16x8 bc[8], bn[8];
    if (tile < 32768) dft_ld8(bc, Z1 + ((size_t)tile * 32 + r32) * 128 + 8 * hi);
    for (; tile < 32768; tile += step) {
        asm volatile("" ::: "memory");
        if (tile + step < 32768) dft_ld8(bn, Z1 + ((size_t)(tile + step) * 32 + r32) * 128 + 8 * hi);
        asm volatile("" ::: "memory");
        f32x16 acc[2]; dft_zero<2>(acc);
        dft_mma8<2, 8, 0>(acc, a, bc);
        const int bgm = tile >> 1, bg = bgm >> 8, m = bgm & 255;
        size_t ao = ((((size_t)(bg * 64 + 32 * sl + 2 * hi)) * 256 + m) * 2) * 64 + (n2 & ~1);
        asm volatile("" : "+v"(ao));
#pragma unroll
        for (int rt = 0; rt < 2; ++rt)
#pragma unroll
            for (int q4 = 0; q4 < 4; ++q4)
#pragma unroll
                for (int e = 0; e < 2; ++e) { const int dk = 16 * rt + 4 * q4 + e;
                    const float re = acc[rt][4 * q4 + 2 * e], im = acc[rt][4 * q4 + 2 * e + 1];
                    const float2 cs = twr[rt * 8 + q4 * 2 + e];
                    const float re2 = re * cs.x + im * cs.y, im2 = im * cs.x - re * cs.y;
                    store_pair(A1p, ao, (unsigned)dk * 32768u, (unsigned)dk * 32768u + 64u, re2, im2, odd); }
        asm volatile("" ::: "memory");
#pragma unroll
        for (int i = 0; i < 8; ++i) bc[i] = bn[i];
    }
}
__device__ __forceinline__ void fourier_s2(const bf16_t* A1p, const bf16_t* D2, const bf16_t* Zc, const bf16_t* DX, bf16_t* FM, bool with_ctx, int G, int vcu, int gw, int NGW, int wave, int lane) {
    const int r32 = lane & 31, hi = lane >> 5; const bool odd = lane & 1;
    {
        bf16x8 a[2][8]; dft_load_a<2, 8>(a, D2, 0, r32, hi);
        bf16x8 bc[8], bn[8];
        int it = gw;
        if (it < 32768) dft_ld8(bc, A1p + ((size_t)(32767 - it) * 32 + r32) * 128 + 8 * hi);
        for (; it < 32768; it += NGW) {
            const int tile = 32767 - it;
            asm volatile("" ::: "memory");
            if (it + NGW < 32768) dft_ld8(bn, A1p + ((size_t)(32767 - it - NGW) * 32 + r32) * 128 + 8 * hi);
            asm volatile("" ::: "memory");
            f32x16 acc[2]; dft_zero<2>(acc);
            dft_mma8<2, 8, 0>(acc, a, bc);
            const int m = 32 * (tile & 7) + r32, k1 = (tile >> 3) & 63, bg = tile >> 9, b = bg >> 2, g = bg & 3;
            size_t fo = (size_t)(b * SEQ + k1 + 256 * hi) * DM + g * 256 + (m & ~1);
            asm volatile("" : "+v"(fo));
#pragma unroll
            for (int rt = 0; rt < 2; ++rt)
#pragma unroll
                for (int r = 0; r < 16; r += 2) store_pair(FM, fo, (unsigned)(32 * rt + (r & 3) + 8 * (r >> 2)) * 65536u, (unsigned)(32 * rt + ((r + 1) & 3) + 8 * (r >> 2)) * 65536u, acc[rt][r], acc[rt][r + 1], odd);
            asm volatile("" ::: "memory");
#pragma unroll
            for (int i = 0; i < 8; ++i) bc[i] = bn[i];
        }
    }
    if (with_ctx) {
        for (int tile = vcu; tile < 512; tile += G) {
            f32x16 acc;
#pragma unroll
            for (int r = 0; r < 16; ++r) acc[r] = 0.f;
            asm volatile("" : "+v"(acc));
            const bf16_t* ap = DX + (size_t)(32 * wave + r32) * 512 + 8 * hi;
            const bf16_t* bp = Zc + ((size_t)tile * 32 + r32) * 512 + 8 * hi;
#pragma unroll 1
            for (int kc = 0; kc < 4; ++kc) {
                bf16x8 av[8], bv[8];
#pragma unroll
                for (int i = 0; i < 8; ++i) { av[i] = *(const bf16x8*)(ap + 16 * (kc * 8 + i)); bv[i] = *(const bf16x8*)(bp + 16 * (kc * 8 + i)); }
#pragma unroll
                for (int i = 0; i < 8; ++i) acc = __builtin_amdgcn_mfma_f32_32x32x16_bf16(av[i], bv[i], acc, 0, 0, 0);
            }
            const int m = 32 * (tile & 7) + r32, bg = tile >> 3, b = bg >> 2, g = bg & 3;
            size_t fo = (size_t)(TLAT + b * LCTX + 32 * wave + 4 * hi) * DM + g * 256 + (m & ~1);
            asm volatile("" : "+v"(fo));
#pragma unroll
            for (int r = 0; r < 16; r += 2) store_pair(FM, fo, (unsigned)((r & 3) + 8 * (r >> 2)) * 1024u, (unsigned)(((r + 1) & 3) + 8 * (r >> 2)) * 1024u, acc[r], acc[r + 1], odd);
        }
    }
}


#define RLX_AGENT __ATOMIC_RELAXED, __HIP_MEMORY_SCOPE_AGENT
#define XB_TMO      128
#define XB_XCNT(j)  (256  + 64 * (j))
#define XB_XSUB(j)  (1280 + 64 * (j))
#define XB_XGEN(j)  (2304 + 64 * (j))
#define XB_TOP      3328
#define XB_TOPGEN   3392
#define XCD_BAR_WORDS 3456
#define XB_SPIN_CAP (1u << 18)

__device__ __forceinline__ unsigned xb_ld(unsigned* p)              { return __hip_atomic_load(p, __ATOMIC_RELAXED, __HIP_MEMORY_SCOPE_AGENT); }
__device__ __forceinline__ unsigned xb_add(unsigned* p, unsigned v) { return __hip_atomic_fetch_add(p, v, __ATOMIC_RELAXED, __HIP_MEMORY_SCOPE_AGENT); }
__device__ __forceinline__ unsigned xb_xcc_id() { return (unsigned)__builtin_amdgcn_s_getreg((3 << 11) | 20) & 0xFu; }
#define XB_SPIN(cond, bar) do { unsigned _sp = 0; while (cond) { __builtin_amdgcn_s_sleep(1); \
    if ((++_sp & 255u) == 0u) { if (xb_ld(&(bar)[XB_TMO])) break; if (_sp > XB_SPIN_CAP) { atomicAdd(&(bar)[XB_TMO], 1u); break; } } } } while (0)

struct XcdBarrier {
    unsigned* bar; unsigned x;
    volatile LAS unsigned* st;
};

__device__ __forceinline__ XcdBarrier xcd_barrier_post(unsigned* bar, volatile LAS unsigned* st) {
    XcdBarrier b; b.bar = bar; b.x = xb_xcc_id(); b.st = st;
    if (threadIdx.x == 0) (void)xb_add(&bar[XB_XCNT(b.x)], 1u);
    return b;
}
__device__ __forceinline__ void xcd_barrier_complete(unsigned* bar, unsigned x, unsigned& nloc, unsigned& nx) {
    const unsigned G = gridDim.x * gridDim.y * gridDim.z;
    unsigned sum, cnt, mine, sp = 0u;
    for (;;) {
        sum = 0u; cnt = 0u; mine = 0u;
#pragma unroll
        for (unsigned j = 0; j < 16; ++j) { const unsigned c = xb_ld(&bar[XB_XCNT(j)]); sum += c; cnt += (c > 0u) ? 1u : 0u; mine = (j == x) ? c : mine; }
        if (sum == G) break;
        __builtin_amdgcn_s_sleep(1);
        if ((++sp & 255u) == 0u) { if (xb_ld(&bar[XB_TMO])) break; if (sp > XB_SPIN_CAP) { atomicAdd(&bar[XB_TMO], 1u); break; } }
    }
    nloc = mine > 0u ? mine : 1u; nx = cnt > 0u ? cnt : 1u;
}

__device__ __forceinline__ void xcd_barrier(const XcdBarrier& b) {
    asm volatile("s_waitcnt vmcnt(0)" ::: "memory");
    __syncthreads();
    if (threadIdx.x == 0) {
        unsigned* bar = b.bar;
        __builtin_amdgcn_s_waitcnt(0);
        unsigned nloc = b.st[0], nx = b.st[1];
        if (nloc == 0u) { xcd_barrier_complete(bar, b.x, nloc, nx); b.st[0] = nloc; b.st[1] = nx; }
        const unsigned old = xb_add(&bar[XB_XSUB(b.x)], 1u);
        const unsigned gen = old / nloc;
        if (old + 1u == (gen + 1u) * nloc) {
            __builtin_amdgcn_fence(__ATOMIC_RELEASE, "agent");
            asm volatile("s_waitcnt vmcnt(0)" ::: "memory");
            const unsigned og = xb_add(&bar[XB_TOP], 1u);
            const unsigned tg = og / nx;
            if (og + 1u == (tg + 1u) * nx) xb_add(&bar[XB_TOPGEN], 1u);
            else XB_SPIN(xb_ld(&bar[XB_TOPGEN]) == tg, bar);
            __builtin_amdgcn_fence(__ATOMIC_ACQUIRE, "agent");
            xb_add(&bar[XB_XGEN(b.x)], 1u);
            asm volatile("s_waitcnt vmcnt(0)" ::: "memory");
        } else {
            XB_SPIN(xb_ld(&bar[XB_XGEN(b.x)]) == gen, bar);
            __builtin_amdgcn_fence(__ATOMIC_ACQUIRE, "agent");
            asm volatile("s_waitcnt vmcnt(0)" ::: "memory");
        }
    }
    __syncthreads();
}

#ifdef DIAG
__device__ __forceinline__ void diag_scan(unsigned* ctl, const void* buf, size_t bytes, bool is_bf16, int stage) {
    const size_t n16 = bytes / 16; const u32x4* p = (const u32x4*)buf; bool bad = false;
    int ln = (int)__builtin_amdgcn_mbcnt_hi(~0u, __builtin_amdgcn_mbcnt_lo(~0u, 0u)); asm volatile("" : "+v"(ln)); ln += 64 * __builtin_amdgcn_readfirstlane((int)threadIdx.x >> 6);
    for (size_t i = (size_t)blockIdx.x * NTHR + ln; i < n16; i += (size_t)gridDim.x * NTHR) {
        const u32x4 v = p[i];
        if (is_bf16) { for (int q = 0; q < 4; ++q) { const unsigned w = v[q]; if (((w >> 7) & 0xff) == 0xff || ((w >> 23) & 0xff) == 0xff) bad = true; } }
        else { for (int q = 0; q < 4; ++q) { if (((v[q] >> 23) & 0xff) >= 0xf0) bad = true; } }
    }
    if (bad) atomicMin(ctl, (unsigned)stage);
}
#define DIAG_SCAN(buf, bytes, isbf, stage) diag_scan((unsigned*)ws, buf, bytes, isbf, stage)
#else
#define DIAG_SCAN(buf, bytes, isbf, stage) do {} while (0)
#endif

#ifdef DIAG2
__device__ __forceinline__ void diag_max(unsigned* ctl, const void* buf, size_t bytes) {
    const size_t n16 = bytes / 16; const u32x4* p = (const u32x4*)buf; unsigned mx = 0, nb = 0;
    int ln = (int)__builtin_amdgcn_mbcnt_hi(~0u, __builtin_amdgcn_mbcnt_lo(~0u, 0u)); asm volatile("" : "+v"(ln)); ln += 64 * __builtin_amdgcn_readfirstlane((int)threadIdx.x >> 6);
    for (size_t i = (size_t)blockIdx.x * NTHR + ln; i < n16; i += (size_t)gridDim.x * NTHR) {
        const u32x4 v = p[i];
        for (int q = 0; q < 4; ++q) { const unsigned lo = (v[q] << 16) & 0x7fffffffu, hi = v[q] & 0x7fff0000u;
            if ((lo >> 23) == 0xff) ++nb; else mx = mx > lo ? mx : lo;
            if ((hi >> 23) == 0xff) ++nb; else mx = mx > hi ? mx : hi; }
    }
    atomicMax(ctl + 1, mx); if (nb) atomicAdd(ctl + 2, nb);
}
#endif

#ifdef TSEL
#define TBEG(c) do { if ((TSEL >> (c)) & 1) t0_ = __builtin_amdgcn_s_memrealtime(); } while (0)
#define TEND(c) do { if ((TSEL >> (c)) & 1) tacc_ += __builtin_amdgcn_s_memrealtime() - t0_; } while (0)
#else
#define TBEG(c) do {} while (0)
#define TEND(c) do {} while (0)
#endif
__global__ void __launch_bounds__(NTHR, 2) fwd_megakernel(Args A) {
    extern __shared__ __attribute__((aligned(16))) unsigned char lds_raw[];
    cg::grid_group grid = cg::this_grid();
#define GRID_SYNC() xcd_barrier(xbar)
#define CG_SYNC() do { asm volatile("s_waitcnt vmcnt(0) lgkmcnt(0)" ::: "memory"); grid.sync(); } while (0)
    LAS unsigned char* lds = (LAS unsigned char*)lds_raw;
    const int wave = __builtin_amdgcn_readfirstlane((int)threadIdx.x >> 6);
#define FRESH_LANE(v) int v = LANE_ID(); asm volatile("" : "+v"(v))
#define LANE_ID() ((int)__builtin_amdgcn_mbcnt_hi(~0u, __builtin_amdgcn_mbcnt_lo(~0u, 0u)))
    const int lane = LANE_ID(), tid = wave * 64 + lane;
    const int G = gridDim.x, gw = blockIdx.x * NWAVES + wave, NGW = G * NWAVES;
    const int vcu = (G % 8 == 0) ? ((int)blockIdx.x % 8) * (G / 8) + (int)blockIdx.x / 8 : (int)blockIdx.x;
    const int gwv = vcu * NWAVES + wave;
    unsigned char* ws = A.ws;
    volatile LAS unsigned* xb_st = (volatile LAS unsigned*)(lds + 131072 + 64);
    if (threadIdx.x == 0) { xb_st[0] = 0u; xb_st[1] = 0u; }
    __syncthreads();
    const XcdBarrier xbar = xcd_barrier_post((unsigned*)ws + 4096, xb_st);
#ifdef TSEL
    unsigned long long t0_ = 0, tacc_ = 0;
#endif
#ifdef DIAG
    if (blockIdx.x == 0 && threadIdx.x == 0) *(unsigned*)ws = 0x7fffffffu;
#endif
#ifdef DIAG2
    if (blockIdx.x == 0 && threadIdx.x == 0) { ((unsigned*)ws)[1] = 0u; ((unsigned*)ws)[2] = 0u; }
#endif
    float* mod = (float*)(ws + WS_MOD);
    const float* rope = (const float*)(ws + WS_TAB + TAB_ROPE); const float* tw = (const float*)(ws + WS_TAB + TAB_TW);
    const bf16_t* D1 = (const bf16_t*)(ws + WS_TAB + TAB_D1); const bf16_t* D2 = (const bf16_t*)(ws + WS_TAB + TAB_D2);
    const bf16_t* DC = (const bf16_t*)(ws + WS_TAB + TAB_DC); const bf16_t* DX = (const bf16_t*)(ws + WS_TAB + TAB_DCTX);
    bf16_t* XB = (bf16_t*)(ws + WS_XB);
    bf16_t* Hb = (bf16_t*)(ws + WS_H); bf16_t* Pb = (bf16_t*)(ws + WS_P); bf16_t* CAT = (bf16_t*)(ws + WS_CAT); bf16_t* ACT = (bf16_t*)(ws + WS_ACT);
    bf16_t* Z1 = (bf16_t*)(ws + WS_Z1); bf16_t* Zc = (bf16_t*)(ws + WS_ZC); bf16_t* A1p = (bf16_t*)(ws + WS_A1); bf16_t* FM = (bf16_t*)(ws + WS_FM);


#ifndef SKIP_PRO
        TBEG(10);
    prologue(A, lds, tid, wave, lane, G);
#endif

    CG_SYNC();
        TEND(10);

    DIAG_SCAN(mod, 4 * 17 * 6144 * 4, false, 1); DIAG_SCAN(ws + WS_WIN, (size_t)83 * MiB, true, 2); DIAG_SCAN(ws + WS_TAB + TAB_D1, 640 * 1024, true, 3); DIAG_SCAN(ws + WS_TAB, 96 * 1024, false, 4);
#pragma unroll 1
    for (int l = 0; l < 4; ++l) {
        const bool even = (l & 1) == 0; const int e = l >> 1;
        const bool ctx_after = l < 2;
        const bool ctx_here = l < 3;
        const int Mfull = ctx_here ? MALL : TLAT;
        const int Mres = ctx_after ? MALL : TLAT;
        const float* modl = mod + (size_t)l * 17 * 6144;
        TBEG(4);
        if (l == 0 || l == 3) {
        { FRESH_LANE(lane_l); const int rpw_ = Mfull / NGW; if (l == 0) norm_phase<true>(A.x, A.ctx, XB, A.n1g + l * DM, modl, 0, Hb, gw * rpw_, gw * rpw_ + rpw_, lane_l); else norm_phase<false>(A.x, A.ctx, XB, A.n1g + l * DM, modl, 0, Hb, gw * rpw_, gw * rpw_ + rpw_, lane_l); }
        GRID_SYNC();
        }
        TEND(4);
        DIAG_SCAN(Hb, (size_t)Mfull * DM * 2, true, 10 + 10 * l);
        const bf16_t* mixA; const bf16_t* mixW;
        if (even) {
        TBEG(0);
            { int tg = LANE_ID(); asm volatile("" : "+v"(tg)); tg += wave * 64; pg8::Gemm g{Hb, (const bf16_t*)(ws + WS_WIN) + (size_t)e * INW * DM, Mfull, INW, DM}; pg8::StaticOrder S; S.init(Mfull, INW, G, (int)blockIdx.x);
              EpiInProj E{Pb, rope};
              pg8::gemm_phase<EpiInProj, pg8::StaticOrder, true, true>(lds, g, S, E, tg); }
            GRID_SYNC();
        TEND(0);
        DIAG_SCAN(Pb, (size_t)Mfull * INW * 2, true, 11 + 10 * l);

#ifndef SKIP_ATT
        TBEG(5);
            { FRESH_LANE(lane_l); const int tid_l = wave * 64 + lane_l; (void)tid_l; attn_phase(lds, Pb, CAT, A.sink + e * 8, ctx_after, G, tid_l, wave, lane_l); }
        TEND(5);
#endif


#ifndef SKIP_CONV
        TBEG(6);
            { FRESH_LANE(lane_l); const int tid_l = wave * 64 + lane_l; (void)tid_l; conv_phase(Pb, CAT, A.conv_w + e * 3 * 512, Mres, G, tid_l); }
#endif

            GRID_SYNC();
        TEND(6);
        DIAG_SCAN(CAT, (size_t)Mres * DM * 2, true, 12 + 10 * l);
            mixA = CAT; mixW = (const bf16_t*)(ws + WS_WMIX) + (size_t)e * DM * DM;
        } else {

#ifndef SKIP_FA
        TBEG(7);
            { FRESH_LANE(lane_l); const int tid_l = wave * 64 + lane_l; (void)tid_l; fourier_a(lds, Hb, DC, Z1, Zc, ctx_after, G, vcu, wave, lane_l); }
#endif

            GRID_SYNC();
        TEND(7);
        DIAG_SCAN(Z1, (size_t)128 * MiB, true, 11 + 10 * l); DIAG_SCAN(Z1 + 64 * MiB, (size_t)128 * MiB, true, 12 + 10 * l); DIAG_SCAN(Zc, (size_t)16 * MiB, true, 13 + 10 * l);
#ifdef DIAG2
        if (l == DIAG2_L) diag_max((unsigned*)ws, DIAG2_BUF, DIAG2_BYTES);
#endif

#ifndef SKIP_S1
        TBEG(8);
            { FRESH_LANE(lane_l); const int tid_l = wave * 64 + lane_l; (void)tid_l; fourier_s1<0>(Z1, D1, tw, A1p, G, vcu, wave, lane_l); }
#endif

            GRID_SYNC();
        TEND(8);
        DIAG_SCAN(A1p, (size_t)256 * MiB, true, 14 + 10 * l);

#ifndef SKIP_S2
        TBEG(9);
            { FRESH_LANE(lane_l); const int tid_l = wave * 64 + lane_l; (void)tid_l; fourier_s2(A1p, D2, Zc, DX, FM, ctx_after, G, vcu, gwv, NGW, wave, lane_l); }
#endif

            GRID_SYNC();
        TEND(9);
        DIAG_SCAN(FM, (size_t)Mres * DM * 2, true, 15 + 10 * l);
            mixA = FM; mixW = (const bf16_t*)(ws + WS_WF) + (size_t)e * DM * DM;
        }
        TBEG(1);
        { int tg = LANE_ID(); asm volatile("" : "+v"(tg)); tg += wave * 64; pg8::Gemm g{mixA, mixW, Mres, DM, DM}; pg8::StaticOrder S; S.init(Mres, DM, G, (int)blockIdx.x);
          if (l == 0) { EpiRes<true> E{A.x, A.ctx, XB, modl, 2}; pg8::gemm_phase<EpiRes<true>, pg8::StaticOrder, true, true>(lds, g, S, E, tg); }
          else { EpiRes<false> E{A.x, A.ctx, XB, modl, 2}; pg8::gemm_phase<EpiRes<false>, pg8::StaticOrder, true, true>(lds, g, S, E, tg); } }
        GRID_SYNC();
        TEND(1);
        TBEG(4);
        { FRESH_LANE(lane_l); const int tid_l = wave * 64 + lane_l; (void)tid_l; const int rpw_ = Mres / NGW; norm_phase<false>(A.x, A.ctx, XB, A.n2g + l * DM, modl, 3, Hb, gw * rpw_, gw * rpw_ + rpw_, lane_l); }
        GRID_SYNC();
        TEND(4);
        DIAG_SCAN(Hb, (size_t)Mres * DM * 2, true, 17 + 10 * l);
        TBEG(2);
        { int tg = LANE_ID(); asm volatile("" : "+v"(tg)); tg += wave * 64; pg8::Gemm g{Hb, (const bf16_t*)(ws + WS_WGU) + (size_t)l * 2 * DFF * DM, Mres, 2 * DFF, DM}; pg8::StaticOrder S; S.init(Mres, 2 * DFF, G, (int)blockIdx.x);
          EpiSwiGLU E{ACT};
          pg8::gemm_phase<EpiSwiGLU, pg8::StaticOrder, true, true>(lds, g, S, E, tg); }
        GRID_SYNC();
        TEND(2);
        DIAG_SCAN(ACT, (size_t)Mres * DFF * 2, true, 18 + 10 * l);
        TBEG(3);
        { int tg = LANE_ID(); asm volatile("" : "+v"(tg)); tg += wave * 64; pg8::Gemm g{ACT, (const bf16_t*)(ws + WS_WD) + (size_t)l * DM * DFF, TLAT, DM, DFF}; pg8::StaticOrder S; S.init(TLAT, DM, G, (int)blockIdx.x);
          EpiRes<false> E{A.x, A.ctx, XB, modl, 5}; pg8::gemm_phase<EpiRes<false>, pg8::StaticOrder, true, true>(lds, g, S, E, tg); }
        GRID_SYNC();
        if (l < 2) {
            const float* modn = mod + (size_t)(l + 1) * 17 * 6144;
            if (blockIdx.x < 64) {
                int tg = LANE_ID(); asm volatile("" : "+v"(tg)); tg += wave * 64; pg8::Gemm g{ACT, (const bf16_t*)(ws + WS_WD) + (size_t)l * DM * DFF, MALL, DM, DFF}; pg8::StaticOrder S; S.init(TCTX, DM, 64, (int)blockIdx.x); S.pm_off = 256;
                EpiRes<false> E{A.x, A.ctx, XB, modl, 5}; pg8::gemm_phase<EpiRes<false>, pg8::StaticOrder, true, true>(lds, g, S, E, tg);
            } else {
                FRESH_LANE(lane_l); const int gw2 = ((int)blockIdx.x - 64) * NWAVES + wave, rb = gw2 * 44;
                norm_phase<false>(A.x, A.ctx, XB, A.n1g + (l + 1) * DM, modn, 0, Hb, rb, (rb + 44 < TLAT) ? rb + 44 : TLAT, lane_l);
            }
            GRID_SYNC();
            { FRESH_LANE(lane_l); norm_phase<false>(A.x, A.ctx, XB, A.n1g + (l + 1) * DM, modn, 0, Hb, TLAT + 2 * gw, TLAT + 2 * gw + 2, lane_l); }
            GRID_SYNC();
        }
        TEND(3);
    }
    { int lane_f = LANE_ID(); asm volatile("" : "+v"(lane_f)); final_norm_phase(XB, A.out, A.final_g, gw, NGW, lane_f); }
#ifdef TSEL
    if (blockIdx.x == 0) { const unsigned long long ts_ = __builtin_amdgcn_s_memrealtime(); while (__builtin_amdgcn_s_memrealtime() - ts_ < (unsigned long long)TMULT * tacc_) __builtin_amdgcn_s_sleep(8); }
#endif
#ifdef DIAG2
    GRID_SYNC();
    if (blockIdx.x == 0 && threadIdx.x == 0) { const unsigned mx = ((volatile unsigned*)ws)[1], nb = ((volatile unsigned*)ws)[2]; A.out[0] = 1000.f * __builtin_bit_cast(float, mx); A.out[1] = nb ? 1e9f + 1000.f * (float)nb : 0.f; }
#endif
#ifdef DIAG
    GRID_SYNC();
    if (blockIdx.x == 0 && threadIdx.x == 0) { const unsigned c = *(volatile unsigned*)ws; A.out[0] = (c == 0x7fffffffu) ? 999000.f : 1000.f * (float)c; }
#endif
}

extern "C" void kernel_launch(void* const* d_in, const int* in_sizes, int n_in, void* d_out, int out_size, void* d_ws, size_t ws_size, hipStream_t stream) {
    static int grid = 0;
    if (grid == 0) {
        if (n_in != 17 || out_size != TLAT * DM || ws_size < WS_END) { fprintf(stderr, "kernel_launch: unexpected shapes (n_in %d, out %d, ws %zu)\n", n_in, out_size, ws_size); grid = -1; return; }
        int dev = 0, cus = 0, per_cu = 0;
        hipGetDevice(&dev); hipDeviceGetAttribute(&cus, hipDeviceAttributeMultiprocessorCount, dev);
        if (hipFuncSetAttribute((const void*)fwd_megakernel, hipFuncAttributeMaxDynamicSharedMemorySize, LDS_BYTES) != hipSuccess) { fprintf(stderr, "kernel_launch: hipFuncSetAttribute failed\n"); grid = -1; return; }
        if (hipOccupancyMaxActiveBlocksPerMultiprocessor(&per_cu, (const void*)fwd_megakernel, NTHR, LDS_BYTES) != hipSuccess || per_cu < 1) { fprintf(stderr, "kernel_launch: occupancy query says %d\n", per_cu); per_cu = 1; }
        (void)hipGetLastError();
        grid = cus * 1;
    }
    if (grid < 0) return;
    if (hipMemsetAsync(d_ws, 0, 65536, stream) != hipSuccess) { fprintf(stderr, "kernel_launch: hipMemsetAsync of the barrier words failed\n"); return; }
    Args a{};
    a.x = (const float*)d_in[0]; a.c = (const float*)d_in[1]; a.ctx = (const float*)d_in[2]; a.c_ctx = (const float*)d_in[3]; a.w_ada = (const float*)d_in[4]; a.b_ada = (const float*)d_in[5];
    a.n1g = (const float*)d_in[6]; a.n2g = (const float*)d_in[7]; a.w_in = (const float*)d_in[8]; a.conv_w = (const float*)d_in[9]; a.sink = (const float*)d_in[10]; a.w_mix = (const float*)d_in[11];
    a.w_four = (const float*)d_in[12]; a.w_gate = (const float*)d_in[13]; a.w_up = (const float*)d_in[14]; a.w_down = (const float*)d_in[15]; a.final_g = (const float*)d_in[16];
    a.out = (float*)d_out; a.ws = (unsigned char*)d_ws;
    for (int f = 0; f < 16; ++f) a.invf[f] = pow(10000.0, -(double)f / 16.0);
    void* args[] = {&a};
    hipError_t e = hipLaunchCooperativeKernel((const void*)fwd_megakernel, dim3(grid), dim3(NTHR), args, LDS_BYTES, stream);
    if (e != hipSuccess) fprintf(stderr, "kernel_launch: cooperative launch failed: %s (grid %d)\n", hipGetErrorString(e), grid);
}
```
